# Optimizing an MI355X kernel written in HIP

```python
import math
import jax, jax.numpy as jnp
from jax import lax
import numpy as np

D_MODEL = 1024
BATCH = 8
SEQ = 4096
DEPTH = 1

CHUNK = 64
Q_BLOCK = 128
HEAD_DIM = 64
FOX_HEADS = 8
FOX_WIDTH = FOX_HEADS * HEAD_DIM
DIFF_HEADS = 4
DIFF_V_DIM = 2 * HEAD_DIM
DIFF_QK_WIDTH = DIFF_HEADS * 2 * HEAD_DIM
DIFF_WIDTH = DIFF_HEADS * DIFF_V_DIM
MIX_WIDTH = FOX_WIDTH + DIFF_WIDTH
IN_COLS = 3 * FOX_WIDTH + FOX_HEADS + 2 * DIFF_QK_WIDTH + DIFF_WIDTH
N_GROUPS = 4
EXPERTS_PER_GROUP = 8
N_EXPERTS = N_GROUPS * EXPERTS_PER_GROUP
TOP_K_IN_GROUP = 2
D_EXPERT = 512
DISPATCH_BLOCK = 256
NORM_EPS = 1e-6
SUBLN_EPS = 1e-5
FORGET_BIAS_MEAN = 3.0

kernel_name = 'hybrid_fox_diffattn_hmoe_adaln'


def rms_norm(x, g, eps=NORM_EPS):
    xf = x.astype(jnp.float32)
    y = xf * lax.rsqrt(jnp.mean(xf * xf, axis=-1, keepdims=True) + eps)
    return (y * g.astype(jnp.float32)).astype(x.dtype)


def alibi_slopes(n):
    return jnp.asarray([2.0 ** (-8.0 * (i + 1) / n) for i in range(n)], dtype=jnp.float32)


def forgetting_attention(q, k, v, log_f_cum):
    seq = q.shape[1]
    scale = HEAD_DIM ** -0.5
    cum = jnp.swapaxes(log_f_cum, 1, 2)
    outs = []
    for q0 in range(0, seq, Q_BLOCK):
        q1 = q0 + Q_BLOCK
        s = jnp.einsum('bqhd,bkhd->bhqk', q[:, q0:q1], k[:, :q1],
                       preferred_element_type=jnp.float32) * scale
        s = s + (cum[:, :, q0:q1, None] - cum[:, :, None, :q1])
        causal = jnp.arange(q0, q1)[:, None] >= jnp.arange(q1)[None, :]
        p = jax.nn.softmax(jnp.where(causal, s, -jnp.inf), axis=-1)
        outs.append(jnp.einsum('bhqk,bkhd->bqhd', p.astype(v.dtype), v[:, :q1]))
    return jnp.concatenate(outs, axis=1)


def differential_attention(q, k, v, lam):
    seq = q.shape[1]
    scale = HEAD_DIM ** -0.5
    slopes = alibi_slopes(DIFF_HEADS)
    outs = []
    for q0 in range(0, seq, Q_BLOCK):
        q1 = q0 + Q_BLOCK
        tq = jnp.arange(q0, q1)
        tk = jnp.arange(q1)
        s = jnp.einsum('bqhmd,bkhmd->bhmqk', q[:, q0:q1], k[:, :q1],
                       preferred_element_type=jnp.float32) * scale
        dist = jnp.abs(tq[:, None] - tk[None, :]).astype(jnp.float32)
        s = s - slopes[:, None, None, None] * dist
        chunk_ok = (tq // CHUNK)[:, None] >= (tk // CHUNK)[None, :]
        p = jax.nn.softmax(jnp.where(chunk_ok, s, -jnp.inf), axis=-1)
        a = p[:, :, 0] - lam * p[:, :, 1]
        outs.append(jnp.einsum('bhqk,bkhe->bqhe', a.astype(v.dtype), v[:, :q1]))
    return jnp.concatenate(outs, axis=1)


def hybrid_mixer(h, w_in, b_f, lam_q1, lam_k1, lam_q2, lam_k2, subln_g, w_o, lam_init):
    b, s, _ = h.shape
    proj = h @ w_in
    cuts = [FOX_WIDTH, 2 * FOX_WIDTH, 3 * FOX_WIDTH, 3 * FOX_WIDTH + FOX_HEADS,
            3 * FOX_WIDTH + FOX_HEADS + DIFF_QK_WIDTH,
            3 * FOX_WIDTH + FOX_HEADS + 2 * DIFF_QK_WIDTH]
    fq, fk, fv, fz, dq, dk, dv = jnp.split(proj, cuts, axis=-1)
    log_f_cum = jnp.cumsum(jax.nn.log_sigmoid((fz + b_f).astype(jnp.float32)), axis=1)
    fox = forgetting_attention(fq.reshape(b, s, FOX_HEADS, HEAD_DIM),
                               fk.reshape(b, s, FOX_HEADS, HEAD_DIM),
                               fv.reshape(b, s, FOX_HEADS, HEAD_DIM), log_f_cum)
    fox = fox.reshape(b, s, FOX_WIDTH)
    f32 = jnp.float32
    lam = (jnp.exp(jnp.sum(lam_q1.astype(f32) * lam_k1.astype(f32)))
           - jnp.exp(jnp.sum(lam_q2.astype(f32) * lam_k2.astype(f32))) + lam_init)
    diff = differential_attention(dq.reshape(b, s, DIFF_HEADS, 2, HEAD_DIM),
                                  dk.reshape(b, s, DIFF_HEADS, 2, HEAD_DIM),
                                  dv.reshape(b, s, DIFF_HEADS, DIFF_V_DIM), lam)
    diff = (rms_norm(diff, subln_g, SUBLN_EPS) * (1.0 - lam_init)).reshape(b, s, DIFF_WIDTH)
    return jnp.concatenate([fox, diff], axis=-1) @ w_o


def hierarchical_route(h, w_rg, b_rg, w_re, b_re):
    t = h.shape[0]
    hf = h.astype(jnp.float32)
    g_logits = hf @ w_rg.astype(jnp.float32) + b_rg.astype(jnp.float32)
    g_prob = jax.nn.softmax(g_logits, axis=-1)
    g = jnp.argmax(g_logits, axis=-1).astype(jnp.int32)
    p_g = jnp.take_along_axis(g_prob, g[:, None], axis=-1)
    e_logits = (hf @ w_re.astype(jnp.float32) + b_re.astype(jnp.float32)).reshape(
        t, N_GROUPS, EXPERTS_PER_GROUP)
    e_logits = jnp.take_along_axis(e_logits, g[:, None, None], axis=1)[:, 0]
    top_v, top_i = lax.top_k(e_logits, TOP_K_IN_GROUP)
    w = jax.nn.softmax(top_v, axis=-1) * p_g
    eid = g[:, None] * EXPERTS_PER_GROUP + top_i.astype(jnp.int32)
    tok = jnp.repeat(jnp.arange(t, dtype=jnp.int32), TOP_K_IN_GROUP)
    return eid.reshape(-1), tok, w.reshape(-1)


def sparse_experts(h, eid, tok, wt, w_gate, w_up, w_down):
    n_assign = eid.shape[0]
    order = jnp.argsort(eid)
    se = eid[order]
    counts = jnp.zeros((N_EXPERTS,), jnp.int32).at[eid].add(1)
    starts = jnp.cumsum(counts) - counts
    padded = (counts + DISPATCH_BLOCK - 1) // DISPATCH_BLOCK * DISPATCH_BLOCK
    pends = jnp.cumsum(padded)
    pstarts = pends - padded
    dest = pstarts[se] + jnp.arange(n_assign, dtype=jnp.int32) - starts[se]
    n_blocks = -(-n_assign // DISPATCH_BLOCK) + N_EXPERTS
    n_slots = n_blocks * DISPATCH_BLOCK
    slot_tok = jnp.zeros((n_slots,), jnp.int32).at[dest].set(tok[order])
    slot_w = jnp.zeros((n_slots,), h.dtype).at[dest].set(wt[order].astype(h.dtype))
    block_e = jnp.clip(jnp.searchsorted(pends, jnp.arange(n_blocks) * DISPATCH_BLOCK, side='right'),
                       0, N_EXPERTS - 1).astype(jnp.int32)

    def run_block(args):
        btok, bw, e = args
        xb = h[btok]
        hid = jax.nn.silu(xb @ w_gate[e]) * (xb @ w_up[e])
        return (hid @ w_down[e]) * bw[:, None]

    y = lax.map(run_block, (slot_tok.reshape(n_blocks, DISPATCH_BLOCK),
                            slot_w.reshape(n_blocks, DISPATCH_BLOCK), block_e))
    return jnp.zeros_like(h).at[slot_tok].add(y.reshape(n_slots, h.shape[-1]))


def setup_inputs(seed: int = 0) -> dict:
    key = jax.random.key(seed)
    ks = jax.random.split(key, 24)
    f32 = jnp.float32

    def nrm(k, shape, std):
        return jax.random.normal(k, shape, f32) * std

    d, L = D_MODEL, DEPTH
    return {
        'x': nrm(ks[0], (BATCH, SEQ, d), 1.0),
        'c': nrm(ks[1], (BATCH, d), 1.0),
        'ada_w': nrm(ks[2], (L, d, 6 * d), 0.5 * d ** -0.5),
        'ada_b': nrm(ks[3], (L, 6 * d), 0.02),
        'norm1_g': 1.0 + nrm(ks[4], (L, d), 0.1),
        'w_in': nrm(ks[5], (L, d, IN_COLS), d ** -0.5),
        'b_f': FORGET_BIAS_MEAN + nrm(ks[6], (L, FOX_HEADS), 0.5),
        'lam_q1': nrm(ks[7], (L, HEAD_DIM), 0.1),
        'lam_k1': nrm(ks[8], (L, HEAD_DIM), 0.1),
        'lam_q2': nrm(ks[9], (L, HEAD_DIM), 0.1),
        'lam_k2': nrm(ks[10], (L, HEAD_DIM), 0.1),
        'subln_g': 1.0 + nrm(ks[11], (L, DIFF_V_DIM), 0.1),
        'w_o': nrm(ks[12], (L, MIX_WIDTH, d), MIX_WIDTH ** -0.5),
        'norm2_g': 1.0 + nrm(ks[13], (L, d), 0.1),
        'w_rg': nrm(ks[14], (L, d, N_GROUPS), d ** -0.5),
        'b_rg': nrm(ks[15], (L, N_GROUPS), 0.01),
        'w_re': nrm(ks[16], (L, d, N_EXPERTS), d ** -0.5),
        'b_re': nrm(ks[17], (L, N_EXPERTS), 0.01),
        'w_gate': nrm(ks[18], (L, N_EXPERTS, d, D_EXPERT), d ** -0.5),
        'w_up': nrm(ks[19], (L, N_EXPERTS, d, D_EXPERT), d ** -0.5),
        'w_down': nrm(ks[20], (L, N_EXPERTS, D_EXPERT, d), D_EXPERT ** -0.5),
        'norm_f_g': 1.0 + nrm(ks[21], (d,), 0.1),
    }


def reference(x, c, ada_w, ada_b, norm1_g, w_in, b_f, lam_q1, lam_k1, lam_q2, lam_k2,
              subln_g, w_o, norm2_g, w_rg, b_rg, w_re, b_re, w_gate, w_up, w_down, norm_f_g):
    b, s, d = x.shape
    for l in range(DEPTH):
        lam_init = 0.8 - 0.6 * math.exp(-0.3 * l)
        mod = (c @ ada_w[l] + ada_b[l]).reshape(b, 6, d)
        shift1, scale1, gate1, shift2, scale2, gate2 = [mod[:, i, None, :] for i in range(6)]
        h = rms_norm(x, norm1_g[l]) * (1.0 + scale1) + shift1
        x = x + gate1 * hybrid_mixer(h, w_in[l], b_f[l], lam_q1[l], lam_k1[l], lam_q2[l],
                                     lam_k2[l], subln_g[l], w_o[l], lam_init)
        h = (rms_norm(x, norm2_g[l]) * (1.0 + scale2) + shift2).reshape(b * s, d)
        eid, tok, wt = hierarchical_route(h, w_rg[l], b_rg[l], w_re[l], b_re[l])
        moe = sparse_experts(h, eid, tok, wt, w_gate[l], w_up[l], w_down[l])
        x = x + gate2 * moe.reshape(b, s, d)
    return rms_norm(x, norm_f_g)
```

```cpp
#include <hip/hip_runtime.h>
#include <hip/hip_bf16.h>
#include <cstdio>
#include <cstdint>

namespace pg8 {
#define PG8_LAS __attribute__((address_space(3)))
typedef unsigned short bf16_t;
typedef short bf16x8 __attribute__((ext_vector_type(8)));
typedef float f32x4 __attribute__((ext_vector_type(4)));
typedef unsigned u32x4 __attribute__((ext_vector_type(4)));
constexpr int BM = 256, BK = 64, HALF = 128, HTB = HALF * BK * 2  , STAGE_BYTES = 8 * HTB, NXCD = 8, WGM = 8;

__host__ __device__ __forceinline__ int lds_byte(int r, int c) { const int st = (r >> 4) * 2 + (c >> 5), rr = r & 15, cc = c & 31, ob = rr * 64 + cc * 2; return st * 1024 + (ob ^ (((ob >> 9) & 1) << 5)); }
__host__ __device__ __forceinline__ void stage_rc(int b, int& R, int& C) { const int st = b / 1024, sb = b % 1024, swz = sb ^ (((sb >> 9) & 1) << 5); R = (st >> 1) * 16 + swz / 64; C = (st & 1) * 32 + (swz % 64) / 2; }
__host__ __device__ __forceinline__ int perm32(int rho) { const int n = rho >> 4, i = rho & 15; return 8 * (i >> 2) + 4 * n + (i & 3); }

struct Unit { int pm, pn, e; };
struct Gemm { const bf16_t* A; const bf16_t* Bt; int M, N, K; };

struct StaticOrder {
    int nM, nN, nwg, G, c;
    __host__ __device__ void init(int M, int N, int G_, int c_) { nM = M / BM; nN = N / BM; nwg = nM * nN; G = G_; c = c_; }
    __host__ __device__ bool next(int i, Unit& u) const {
        const long L = (long)i * G + c; if (L >= nwg) return false;
        int wgid = (int)L; { const int q = nwg / NXCD, r = nwg % NXCD, xcd = wgid % NXCD, off = wgid / NXCD; wgid = (xcd < r ? xcd * (q + 1) : r * (q + 1) + (xcd - r) * q) + off; }
        const int nig = WGM * nN, gid = wgid / nig, fm = gid * WGM, gsz = (nM - fm) < WGM ? (nM - fm) : WGM;
        u.pm = fm + ((wgid % nig) % gsz); u.pn = (wgid % nig) / gsz; u.e = 0; return true;
    }
    __device__ __forceinline__ void a_off(const Unit& u, const int (&RA)[2], const int (&CA)[2], int K, unsigned (&off)[2][2]) const {
#pragma unroll
        for (int h = 0; h < 2; ++h)
#pragma unroll
            for (int i = 0; i < 2; ++i) off[h][i] = (unsigned)(((size_t)(u.pm * BM + h * HALF + RA[i]) * K + CA[i]) * 2);
    }
};


__device__ __forceinline__ unsigned cvt_pk_bf16(float lo, float hi) { unsigned r; asm volatile("v_cvt_pk_bf16_f32 %0, %1, %2" : "=v"(r) : "v"(lo), "v"(hi)); return r; }

struct EpiStore {
    static constexpr bool PERM = true, AFTER_DRAIN = false;
    bf16_t* O; int ldc; int pn_mask;
    __device__ __forceinline__ void operator()(const f32x4 (&acc)[2][2][4][2], const Unit& u, int wr, int wc, int fr, int fq) const {
        const int row0 = u.pm * BM + wr * 64 + fr; const int col0 = (u.pn & pn_mask) * BM + wc * 32 + 8 * fq;
#pragma unroll
        for (int ai = 0; ai < 2; ++ai)
#pragma unroll
            for (int m = 0; m < 4; ++m) { bf16_t* rowp = O + (size_t)(row0 + ai * HALF + m * 16) * ldc + col0;
#pragma unroll
                for (int bj = 0; bj < 2; ++bj) { const f32x4 v0 = acc[ai][bj][m][0], v1 = acc[ai][bj][m][1];
                    u32x4 w; w.x = cvt_pk_bf16(v0[0], v0[1]); w.y = cvt_pk_bf16(v0[2], v0[3]); w.z = cvt_pk_bf16(v1[0], v1[1]); w.w = cvt_pk_bf16(v1[2], v1[3]);
                    *(u32x4*)(rowp + bj * HALF) = w; } }
    }
};
struct EpiSwiglu {
    static constexpr bool PERM = true, AFTER_DRAIN = false;
    bf16_t* H;
    __device__ __forceinline__ void operator()(const f32x4 (&acc)[2][2][4][2], const Unit& u, int wr, int wc, int fr, int fq) const {
        const int row0 = u.pm * BM + wr * 64 + fr; const int col0 = (u.pn & 3) * 128 + wc * 32 + 8 * fq;
#pragma unroll
        for (int ai = 0; ai < 2; ++ai)
#pragma unroll
            for (int m = 0; m < 4; ++m) { bf16_t* rowp = H + (size_t)(row0 + ai * HALF + m * 16) * 512 + col0;
                float hv[8];
#pragma unroll
                for (int n = 0; n < 2; ++n)
#pragma unroll
                    for (int i = 0; i < 4; ++i) { const float g = acc[ai][0][m][n][i], up = acc[ai][1][m][n][i];
                        const float e = __builtin_amdgcn_exp2f(-g * 1.4426950408889634f);
                        hv[n * 4 + i] = g * __builtin_amdgcn_rcpf(1.0f + e) * up; }
                u32x4 w; w.x = cvt_pk_bf16(hv[0], hv[1]); w.y = cvt_pk_bf16(hv[2], hv[3]); w.z = cvt_pk_bf16(hv[4], hv[5]); w.w = cvt_pk_bf16(hv[6], hv[7]);
                *(u32x4*)rowp = w; }
    }
};
struct EpiResid {
    static constexpr bool PERM = false, AFTER_DRAIN = false;
    const float* base; float* out; const float* gate;
    __device__ __forceinline__ void operator()(const f32x4 (&acc)[2][2][4][2], const Unit& u, int wr, int wc, int fr, int fq) const {
        const int col0 = u.pn * BM + wc * 32 + 4 * fq; const float* gp = gate + (size_t)(u.pm >> 4) * 6144 + col0;
        f32x4 gv[2][2];
#pragma unroll
        for (int bj = 0; bj < 2; ++bj)
#pragma unroll
            for (int n = 0; n < 2; ++n) gv[bj][n] = *(const f32x4*)(gp + bj * HALF + n * 16);
#pragma unroll
        for (int ai = 0; ai < 2; ++ai)
#pragma unroll
            for (int m = 0; m < 4; ++m) { const size_t off = (size_t)(u.pm * BM + ai * HALF + wr * 64 + m * 16 + fr) * 1024 + col0;
#pragma unroll
                for (int bj = 0; bj < 2; ++bj)
#pragma unroll
                    for (int n = 0; n < 2; ++n) { const f32x4 bs = *(const f32x4*)(base + off + bj * HALF + n * 16);
                        *(f32x4*)(out + off + bj * HALF + n * 16) = bs + gv[bj][n] * acc[ai][bj][m][n]; } }
    }
};

template <class Epi, class Sched, bool ALIGN_EPI = false, bool SP2 = false>
__device__ __forceinline__ void gemm_phase(PG8_LAS unsigned char* lds, const Gemm g, const Sched& S, const Epi& E) {
    const int tid = threadIdx.x, wid = __builtin_amdgcn_readfirstlane(tid >> 6), lane = tid & 63, wr = wid >> 2, wc = wid & 3, fr = lane & 15, fq = lane >> 4;
    const int K = g.K, nt = K / BK;
    int RA[2], CA[2]; unsigned voffB[2];
#pragma unroll
    for (int i = 0; i < 2; ++i) { int R, C; stage_rc(tid * 16 + i * 8192, R, C); const int Rb = Epi::PERM ? ((R & ~31) + perm32(R & 31)) : R;
        RA[i] = R; CA[i] = C; voffB[i] = (unsigned)(Rb * K + C) * 2u; }
    const size_t kstep = (size_t)(BK * 2);
    const size_t hstep = (size_t)HALF * K * 2;
    const size_t tstep = 2 * hstep;
    const unsigned ldsw = (unsigned)wid * 1024u;
    const int aoff = lds_byte(wr * 64 + fr, fq * 8), boff = lds_byte(wc * 32 + fr, fq * 8);
#define PG8_SA(b, h) (((b) * 2 + (h)) * HTB)
#define PG8_SB(b, h) ((4 + (b) * 2 + (h)) * HTB)
#define PG8_STAGE(bufoff, gbase, voff) do { _Pragma("unroll") for (int _i = 0; _i < 2; ++_i) \
        __builtin_amdgcn_global_load_lds((const unsigned*)((const char*)(gbase) + (voff)[_i]), (PG8_LAS unsigned*)(lds + (bufoff) + ldsw + _i * 8192), 16, 0, 0); } while (0)
#define PG8_LDA(dst, b, h) do { _Pragma("unroll") for (int m = 0; m < 4; ++m) _Pragma("unroll") for (int k = 0; k < 2; ++k) dst[m][k] = *(const PG8_LAS bf16x8*)(lds + PG8_SA(b, h) + aoff + m * 2048 + k * 1024); } while (0)
#define PG8_LDB(dst, b, h) do { _Pragma("unroll") for (int n = 0; n < 2; ++n) _Pragma("unroll") for (int k = 0; k < 2; ++k) dst[n][k] = *(const PG8_LAS bf16x8*)(lds + PG8_SB(b, h) + boff + n * 2048 + k * 1024); } while (0)
#define PG8_MMA(ai, bj, At, Bt) do { __builtin_amdgcn_s_setprio(1); _Pragma("unroll") for (int m = 0; m < 4; ++m) _Pragma("unroll") for (int n = 0; n < 2; ++n) _Pragma("unroll") for (int k = 0; k < 2; ++k) \
        acc[ai][bj][m][n] = __builtin_amdgcn_mfma_f32_16x16x32_bf16(Bt[n][k], At[m][k], acc[ai][bj][m][n], 0, 0, 0); __builtin_amdgcn_s_setprio(0); } while (0)
#define PG8_WAIT_V(n) asm volatile("s_waitcnt vmcnt(" #n ")" ::: "memory")
#define PG8_WAIT_L(n) asm volatile("s_waitcnt lgkmcnt(" #n ")" ::: "memory")
#define PG8_BAR __builtin_amdgcn_s_barrier()
#define PG8_SCHED __builtin_amdgcn_sched_barrier(0)
    Unit cur, nxt; int ui = 0;
    if (!S.next(0, cur)) return;
    f32x4 acc[2][2][4][2];
#pragma unroll
    for (int a = 0; a < 2; ++a)
#pragma unroll
        for (int b = 0; b < 2; ++b)
#pragma unroll
            for (int m = 0; m < 4; ++m)
#pragma unroll
                for (int n = 0; n < 2; ++n) acc[a][b][m][n] = (f32x4){0.f, 0.f, 0.f, 0.f};
    bf16x8 At[4][2], B0[2][2], B1[2][2];
    unsigned oc[2][2], on[2][2];
    S.a_off(cur, RA, CA, K, oc);
    const char* A0 = (const char*)g.A;
    const char* cB = (const char*)g.Bt + (size_t)cur.pn * tstep;
    if constexpr (SP2) {
        PG8_STAGE(PG8_SB(0, 0), cB, voffB); PG8_STAGE(PG8_SB(0, 1), cB + hstep, voffB); PG8_STAGE(PG8_SA(0, 0), A0, oc[0]); PG8_STAGE(PG8_SA(0, 1), A0, oc[1]);
        if (wr == 1) PG8_BAR;
        PG8_WAIT_V(2); PG8_BAR;
        PG8_STAGE(PG8_SB(1, 0), cB + kstep, voffB); PG8_STAGE(PG8_SA(1, 0), A0 + kstep, oc[0]); PG8_STAGE(PG8_SB(1, 1), cB + hstep + kstep, voffB);
        PG8_WAIT_V(6); PG8_BAR;
    } else {
        PG8_STAGE(PG8_SB(0, 0), cB, voffB); PG8_STAGE(PG8_SA(0, 0), A0, oc[0]); PG8_STAGE(PG8_SB(0, 1), cB + hstep, voffB); PG8_STAGE(PG8_SA(0, 1), A0, oc[1]);
        if (wr == 1) PG8_BAR;
        PG8_WAIT_V(4); PG8_BAR;
        PG8_STAGE(PG8_SB(1, 0), cB + kstep, voffB); PG8_STAGE(PG8_SA(1, 0), A0 + kstep, oc[0]); PG8_STAGE(PG8_SB(1, 1), cB + hstep + kstep, voffB);
        PG8_WAIT_V(6); PG8_BAR;
    }
    for (;;) {
        const bool has_next = S.next(ui + 1, nxt);
        if (has_next) S.a_off(nxt, RA, CA, K, on);
        else {
#pragma unroll
            for (int h = 0; h < 2; ++h)
#pragma unroll
                for (int i = 0; i < 2; ++i) on[h][i] = oc[h][i]; }
        const char* nB = has_next ? (const char*)g.Bt + (size_t)nxt.pn * tstep : cB;
        for (int t = 0; t < nt; t += 2) {
            const bool last = (t == nt - 2);
            const char* a1 = A0 + (size_t)(t + 1) * kstep;
            const char* a2 = last ? A0 : A0 + (size_t)(t + 2) * kstep; const char* b2 = last ? nB : cB + (size_t)(t + 2) * kstep;
            const char* a3 = a2 + kstep; const char* b3 = b2 + kstep;
            unsigned o2[2][2];
#pragma unroll
            for (int h = 0; h < 2; ++h)
#pragma unroll
                for (int i = 0; i < 2; ++i) o2[h][i] = last ? on[h][i] : oc[h][i];
            if constexpr (SP2) {
            PG8_LDB(B0, 0, 0); PG8_LDB(B1, 0, 1); PG8_SCHED; PG8_LDA(At, 0, 0); PG8_STAGE(PG8_SA(1, 1), a1, oc[1]);
            PG8_WAIT_V(8); PG8_WAIT_L(0); PG8_BAR; PG8_MMA(0, 0, At, B0); PG8_MMA(0, 1, At, B1); PG8_BAR; PG8_SCHED;
            PG8_LDA(At, 0, 1); PG8_STAGE(PG8_SB(0, 0), b2, voffB); PG8_STAGE(PG8_SB(0, 1), b2 + hstep, voffB); PG8_STAGE(PG8_SA(0, 0), a2, o2[0]);
            PG8_WAIT_V(8); PG8_WAIT_L(0); PG8_BAR; PG8_MMA(1, 0, At, B0); PG8_MMA(1, 1, At, B1); PG8_BAR; PG8_SCHED;
            PG8_LDB(B0, 1, 0); PG8_LDB(B1, 1, 1); PG8_SCHED; PG8_LDA(At, 1, 0); PG8_STAGE(PG8_SA(0, 1), a2, o2[1]);
            PG8_WAIT_V(8); PG8_WAIT_L(0); PG8_BAR; PG8_MMA(0, 0, At, B0); PG8_MMA(0, 1, At, B1); PG8_BAR; PG8_SCHED;
            PG8_LDA(At, 1, 1); PG8_STAGE(PG8_SB(1, 0), b3, voffB); PG8_STAGE(PG8_SB(1, 1), b3 + hstep, voffB); PG8_STAGE(PG8_SA(1, 0), a3, o2[0]);
            PG8_WAIT_V(8); PG8_WAIT_L(0); PG8_BAR; PG8_MMA(1, 0, At, B0); PG8_MMA(1, 1, At, B1); PG8_BAR; PG8_SCHED;
            } else {
            PG8_LDB(B0, 0, 0); PG8_SCHED; PG8_LDA(At, 0, 0); PG8_STAGE(PG8_SA(1, 1), a1, oc[1]);
            PG8_WAIT_L(8); PG8_BAR; PG8_WAIT_L(0); PG8_MMA(0, 0, At, B0); PG8_BAR; PG8_SCHED;
            PG8_LDB(B1, 0, 1); PG8_STAGE(PG8_SB(0, 0), b2, voffB);
            PG8_BAR; PG8_WAIT_L(0); PG8_MMA(0, 1, At, B1); PG8_BAR;
            PG8_LDA(At, 0, 1); PG8_STAGE(PG8_SA(0, 0), a2, o2[0]);
            PG8_BAR; PG8_WAIT_L(0); PG8_MMA(1, 0, At, B0); PG8_BAR; PG8_SCHED;
            PG8_STAGE(PG8_SB(0, 1), b2 + hstep, voffB);
            PG8_WAIT_V(6); PG8_BAR; PG8_MMA(1, 1, At, B1); PG8_BAR;
            PG8_LDB(B0, 1, 0); PG8_SCHED; PG8_LDA(At, 1, 0); PG8_STAGE(PG8_SA(0, 1), a2, o2[1]);
            PG8_WAIT_L(8); PG8_BAR; PG8_WAIT_L(0); PG8_MMA(0, 0, At, B0); PG8_BAR; PG8_SCHED;
            PG8_LDB(B1, 1, 1); PG8_STAGE(PG8_SB(1, 0), b3, voffB);
            PG8_BAR; PG8_WAIT_L(0); PG8_MMA(0, 1, At, B1); PG8_BAR;
            PG8_LDA(At, 1, 1); PG8_STAGE(PG8_SA(1, 0), a3, o2[0]);
            PG8_BAR; PG8_WAIT_L(0); PG8_MMA(1, 0, At, B0); PG8_BAR; PG8_SCHED;
            PG8_STAGE(PG8_SB(1, 1), b3 + hstep, voffB);
            PG8_WAIT_V(6); PG8_BAR; PG8_MMA(1, 1, At, B1); PG8_BAR;
            }
        }
        if constexpr (ALIGN_EPI) { if (wr == 0) PG8_BAR; }
        if constexpr (!Epi::AFTER_DRAIN) { E(acc, cur, wr, wc, fr, fq); }
        if (!has_next) break;
#pragma unroll
        for (int a = 0; a < 2; ++a)
#pragma unroll
            for (int b = 0; b < 2; ++b)
#pragma unroll
                for (int m = 0; m < 4; ++m)
#pragma unroll
                    for (int n = 0; n < 2; ++n) acc[a][b][m][n] = (f32x4){0.f, 0.f, 0.f, 0.f};
        cur = nxt; cB = nB; ++ui;
#pragma unroll
        for (int h = 0; h < 2; ++h)
#pragma unroll
            for (int i = 0; i < 2; ++i) oc[h][i] = on[h][i];
        if constexpr (ALIGN_EPI) { if (wr == 1) PG8_BAR; }
    }
    PG8_WAIT_V(0);
    if constexpr (!ALIGN_EPI) { if (wr == 0) PG8_BAR; }
    PG8_BAR;
#undef PG8_SA
#undef PG8_SB
#undef PG8_STAGE
#undef PG8_LDA
#undef PG8_LDB
#undef PG8_MMA
#undef PG8_WAIT_V
#undef PG8_WAIT_L
#undef PG8_BAR
#undef PG8_SCHED
}
}

namespace att {
#define ATT_LAS __attribute__((address_space(3)))
typedef unsigned short bf16_t;
using bf16x8 = __attribute__((ext_vector_type(8))) short;
using s16x4  = __attribute__((ext_vector_type(4))) short;
using f32x16 = __attribute__((ext_vector_type(16))) float;
using f32x4  = __attribute__((ext_vector_type(4))) float;
using u32x4  = __attribute__((ext_vector_type(4))) unsigned;
using u32x2  = __attribute__((ext_vector_type(2))) unsigned;
constexpr int SEQ = 4096, LDQKV = 3072, LDATT = 1024;
constexpr float LOG2E = 1.4426950408889634f;
#define ATT_SBAR() __builtin_amdgcn_sched_barrier(0)
__device__ __forceinline__ int opaque(int v) { asm volatile("" : "+v"(v)); return v; }
__device__ __forceinline__ void dma16(const void* g, ATT_LAS unsigned char* l) { __builtin_amdgcn_global_load_lds((const unsigned*)g, (ATT_LAS unsigned*)l, 16, 0, 0); }
__device__ __forceinline__ int swap23(int k) { return (k & ~0xC) | ((k & 4) << 1) | ((k & 8) >> 1); }
__device__ __forceinline__ int crow(int r, int hi) { return (r & 3) + 8 * (r >> 2) + 4 * hi; }
__device__ __forceinline__ unsigned cvtpk(float lo, float hi) { unsigned r; asm volatile("v_cvt_pk_bf16_f32 %0, %1, %2" : "=v"(r) : "v"(lo), "v"(hi)); return r; }
__device__ __forceinline__ int ksw(int row, int c) { return row * 128 + ((c ^ ((row >> 1) & 7)) << 4); }
template <int NC> __device__ __forceinline__ int v_st(int k, int c) { const int kk = (k & ~0xC) | ((k & 4) << 1) | ((k & 8) >> 1); return ((kk >> 3) * NC + (c >> 5)) * 512 + ((kk & 7) * 32 + (c & 31)) * 2; }
__device__ __forceinline__ int v_rd_base(int lane) { return ((lane & 3) << 3) | (((lane >> 2) & 3) << 6) | (((lane >> 4) & 1) << 5) | (((lane >> 5) & 1) << 8); }
template <int NC> constexpr int v_rd_off(int d0, int ks, int half) { return d0 * 512 + ks * (2 * NC * 512) + half * (NC * 512); }
template <int OFF> __device__ __forceinline__ s16x4 tr_read(int vb) {
  s16x4 r; asm volatile("ds_read_b64_tr_b16 %0, %1 offset:%2" : "=&v"(r) : "v"(vb), "i"(OFF) : "memory"); return r;
}
template <int NC, int D0> __device__ __forceinline__ void pv_one(f32x16& od, int vb, bf16x8 pa0, bf16x8 pa1, bf16x8 pa2, bf16x8 pa3) {
  const s16x4 l0 = tr_read<v_rd_off<NC>(D0, 0, 0)>(vb), h0 = tr_read<v_rd_off<NC>(D0, 0, 1)>(vb), l1 = tr_read<v_rd_off<NC>(D0, 1, 0)>(vb), h1 = tr_read<v_rd_off<NC>(D0, 1, 1)>(vb);
  const s16x4 l2 = tr_read<v_rd_off<NC>(D0, 2, 0)>(vb), h2 = tr_read<v_rd_off<NC>(D0, 2, 1)>(vb), l3 = tr_read<v_rd_off<NC>(D0, 3, 0)>(vb), h3 = tr_read<v_rd_off<NC>(D0, 3, 1)>(vb);
  asm volatile("s_waitcnt lgkmcnt(0)" ::: "memory"); ATT_SBAR();
#define ATT_PK(L, H) (bf16x8){L[0], L[1], L[2], L[3], H[0], H[1], H[2], H[3]}
  od = __builtin_amdgcn_mfma_f32_32x32x16_bf16(pa0, ATT_PK(l0, h0), od, 0, 0, 0);
  od = __builtin_amdgcn_mfma_f32_32x32x16_bf16(pa1, ATT_PK(l1, h1), od, 0, 0, 0);
  od = __builtin_amdgcn_mfma_f32_32x32x16_bf16(pa2, ATT_PK(l2, h2), od, 0, 0, 0);
  od = __builtin_amdgcn_mfma_f32_32x32x16_bf16(pa3, ATT_PK(l3, h3), od, 0, 0, 0);
#undef ATT_PK
}
__device__ __forceinline__ void qkt(f32x16& p0, f32x16& p1, const ATT_LAS unsigned char* Ks, const bf16x8 (&qr)[4], int r32, int hi) {
  p0 = f32x16{}; p1 = f32x16{};
#pragma unroll
  for (int d0 = 0; d0 < 4; ++d0) {
    const bf16x8 b0 = *(const ATT_LAS bf16x8*)(Ks + ksw(r32, 2 * d0 + hi));
    const bf16x8 b1 = *(const ATT_LAS bf16x8*)(Ks + ksw(32 + r32, 2 * d0 + hi));
    p0 = __builtin_amdgcn_mfma_f32_32x32x16_bf16(b0, qr[d0], p0, 0, 0, 0);
    p1 = __builtin_amdgcn_mfma_f32_32x32x16_bf16(b1, qr[d0], p1, 0, 0, 0);
    if (d0 == 1) ATT_SBAR(); }
}
template <int NO> __device__ __forceinline__ void online_sm(f32x16& p0, f32x16& p1, float& m_reg, float& l_reg, f32x16 (&o)[NO], ATT_LAS float* al_l, int r32, int hi,
                                                             bf16x8& pa0, bf16x8& pa1, bf16x8& pa2, bf16x8& pa3) {
  float pmax = p0[0];
#pragma unroll
  for (int r = 1; r < 16; ++r) pmax = fmaxf(pmax, p0[r]);
#pragma unroll
  for (int r = 0; r < 16; ++r) pmax = fmaxf(pmax, p1[r]);
  { auto rr = __builtin_amdgcn_permlane32_swap(__float_as_uint(pmax), __float_as_uint(pmax), false, false);
    pmax = fmaxf(__uint_as_float(rr[0]), __uint_as_float(rr[1])); }
  const float mn = fmaxf(m_reg, pmax);
  const float alpha = __builtin_amdgcn_exp2f(m_reg - mn);
  m_reg = mn;
#pragma unroll
  for (int r = 0; r < 16; ++r) { p0[r] = __builtin_amdgcn_exp2f(p0[r] - mn); p1[r] = __builtin_amdgcn_exp2f(p1[r] - mn); }
  float ps = 0.f;
#pragma unroll
  for (int r = 0; r < 16; ++r) ps += p0[r];
#pragma unroll
  for (int r = 0; r < 16; ++r) ps += p1[r];
  { auto rr = __builtin_amdgcn_permlane32_swap(__float_as_uint(ps), __float_as_uint(ps), false, false);
    ps = __uint_as_float(rr[0]) + __uint_as_float(rr[1]); }
  l_reg = l_reg * alpha + ps;
  if (__any(alpha < 1.f)) {
    if (hi == 0) al_l[r32] = alpha;
    asm volatile("s_waitcnt lgkmcnt(0)" ::: "memory");
#pragma unroll
    for (int r = 0; r < 16; ++r) { const float a = al_l[crow(r, hi)];
#pragma unroll
      for (int d = 0; d < NO; ++d) o[d][r] *= a; }
    asm volatile("s_waitcnt lgkmcnt(0)" ::: "memory");
  }
#define ATT_PK4(P, BASE, OUT) do { unsigned a0 = cvtpk(P[BASE + 0], P[BASE + 1]), a1 = cvtpk(P[BASE + 2], P[BASE + 3]);   \
    unsigned b0 = cvtpk(P[BASE + 4], P[BASE + 5]), b1 = cvtpk(P[BASE + 6], P[BASE + 7]);                              \
    auto r0 = __builtin_amdgcn_permlane32_swap(a0, b0, false, false); auto r1 = __builtin_amdgcn_permlane32_swap(a1, b1, false, false); \
    u32x4 w = {r0[0], r1[0], r0[1], r1[1]}; OUT = __builtin_bit_cast(bf16x8, w); } while (0)
  ATT_PK4(p0, 0, pa0); ATT_PK4(p0, 8, pa1); ATT_PK4(p1, 0, pa2); ATT_PK4(p1, 8, pa3);
#undef ATT_PK4
}

__device__ __forceinline__ void fox_unit(ATT_LAS unsigned char* lds, const bf16_t* __restrict__ qkv, bf16_t* __restrict__ attn, const float* __restrict__ cumloc, const float* __restrict__ blktot,
                                         int b, int h, int qb) {
  const int tid = opaque((int)threadIdx.x), lane = tid & 63, r32 = lane & 31, hi = lane >> 5; const int wid = __builtin_amdgcn_readfirstlane(tid >> 6);
  ATT_LAS float* BIAS = (ATT_LAS float*)(lds + 32768); ATT_LAS float* CARRY = (ATT_LAS float*)(lds + 33280); ATT_LAS float* wsf = (ATT_LAS float*)(lds + 33792) + wid * 64;
  const int q0 = qb * 256, NT = 4 * (qb + 1), jl = 4 * qb + (wid >> 1);
  const size_t rowb = (size_t)b * SEQ; const int bh = b * 8 + h;
  if (wid == 0 && lane < 32) { float s = 0.f; for (int k = 0; k < lane; ++k) s += blktot[(b * 32 + k) * 8 + h]; CARRY[lane] = s; }
  __syncthreads();
  const float cumq0 = CARRY[q0 >> 7] + cumloc[(size_t)bh * SEQ + q0];
  bf16x8 qr[4];
  { const bf16_t* Qw = qkv + (rowb + q0 + wid * 32 + r32) * LDQKV + h * 64 + hi * 8;
#pragma unroll
    for (int d0 = 0; d0 < 4; ++d0) qr[d0] = *(const bf16x8*)(Qw + d0 * 16); }
  const int pk = 64 * wid + lane;
  unsigned koff, voff;
  { const int row = pk >> 3, c = (pk & 7) ^ ((row >> 1) & 7); koff = (unsigned)((row * LDQKV + 512 + h * 64 + c * 8) * 2);
    const int sub = pk >> 5, kk = 8 * (sub >> 1) + ((pk & 31) >> 2), k = swap23(kk), cv = (sub & 1) * 32 + (pk & 3) * 8; voff = (unsigned)((k * LDQKV + 1024 + h * 64 + cv) * 2); }
  const char* tb = (const char*)(qkv + rowb * LDQKV);
  const float* cg = cumloc + (size_t)bh * SEQ + 4 * tid;
  const int vb0 = (int)(uintptr_t)(lds + 16384) + v_rd_base(lane);
  f32x4 breg = {0.f, 0.f, 0.f, 0.f};
#define FOX_LOAD(j, buf) do { const char* tj = tb + (size_t)(j) * (64 * LDQKV * 2); dma16(tj + koff, lds + (buf) * 8192 + wid * 1024); dma16(tj + voff, lds + 16384 + (buf) * 8192 + wid * 1024); \
    if (tid < 16) breg = *(const f32x4*)(cg + (j) * 64); } while (0)
#define FOX_WRITE(j, buf) do { \
    if (tid < 16) { const float c = cumq0 - CARRY[(j) >> 1]; f32x4 bv = (c - breg) * LOG2E; *(ATT_LAS f32x4*)(BIAS + (buf) * 64 + 4 * tid) = bv; } } while (0)
  FOX_LOAD(0, 0); FOX_WRITE(0, 0); asm volatile("s_waitcnt vmcnt(0)" ::: "memory"); __syncthreads();
  float m_reg = -1e30f, l_reg = 0.f; f32x16 o[2]; o[0] = f32x16{}; o[1] = f32x16{};
  for (int j = 0; j < NT; ++j) {
    const int cur = j & 1;
    if (j + 1 < NT) FOX_LOAD(j + 1, cur ^ 1);
    if (j <= jl) {
      f32x16 p0, p1; bf16x8 pa0, pa1, pa2, pa3;
      qkt(p0, p1, lds + cur * 8192, qr, r32, hi);
#pragma unroll
      for (int g = 0; g < 4; ++g) { const f32x4 b0 = *(const ATT_LAS f32x4*)(BIAS + cur * 64 + 8 * g + 4 * hi), b1 = *(const ATT_LAS f32x4*)(BIAS + cur * 64 + 32 + 8 * g + 4 * hi);
#pragma unroll
        for (int i = 0; i < 4; ++i) { p0[4 * g + i] += b0[i]; p1[4 * g + i] += b1[i]; } }
      if (j == jl) { const int qrel = 32 * (wid & 1) + r32;
#pragma unroll
        for (int r = 0; r < 16; ++r) { const int kr = crow(r, hi); if (kr > qrel) p0[r] = -1e30f; if (kr + 32 > qrel) p1[r] = -1e30f; } }
      online_sm<2>(p0, p1, m_reg, l_reg, o, wsf, r32, hi, pa0, pa1, pa2, pa3);
      pv_one<2, 0>(o[0], vb0 + cur * 8192, pa0, pa1, pa2, pa3); pv_one<2, 1>(o[1], vb0 + cur * 8192, pa0, pa1, pa2, pa3);
    }
    if (j + 1 < NT) FOX_WRITE(j + 1, cur ^ 1);
    asm volatile("s_waitcnt vmcnt(0)" ::: "memory"); __syncthreads();
  }
#undef FOX_LOAD
#undef FOX_WRITE
  if (hi == 0) wsf[32 + r32] = l_reg; asm volatile("s_waitcnt lgkmcnt(0)" ::: "memory");
  { const int le = opaque(lane), r32e = le & 31, hie = le >> 5;
  bf16_t* Ow = attn + (rowb + q0 + wid * 32) * LDATT + h * 64 + r32e;
#pragma unroll
  for (int r = 0; r < 16; ++r) { const int orow = crow(r, hie); const float rl = __builtin_amdgcn_rcpf(wsf[32 + orow]);
#pragma unroll
    for (int d0 = 0; d0 < 2; ++d0) { const unsigned w = cvtpk(o[d0][r] * rl, 0.f); Ow[(size_t)orow * LDATT + d0 * 32] = (bf16_t)(w & 0xffffu); } } }
  asm volatile("s_waitcnt lgkmcnt(0)" ::: "memory");
  __syncthreads();
}

__device__ __forceinline__ void diff_unit(ATT_LAS unsigned char* lds, const bf16_t* __restrict__ qkv, bf16_t* __restrict__ attn, const float* __restrict__ subln_g, float lam,
                                          int b, int h, int qb) {
  const int tid = opaque((int)threadIdx.x), lane = tid & 63, r32 = lane & 31, hi = lane >> 5; const int wid = __builtin_amdgcn_readfirstlane(tid >> 6);
  ATT_LAS float* wsf = (ATT_LAS float*)(lds + 69632) + wid * 64;
  const int map = wid >> 2, w4 = wid & 3;
  const int q0 = qb * 128, NT = 2 * (qb + 1), jl = 2 * qb + (w4 >> 1);
  const size_t rowb = (size_t)b * SEQ;
  const float sl2 = LOG2E * (h == 0 ? 0.25f : h == 1 ? 0.0625f : h == 2 ? 0.015625f : 0.00390625f);
  bf16x8 qr[4];
  { const bf16_t* Qw = qkv + (rowb + q0 + w4 * 32 + r32) * LDQKV + 1536 + h * 128 + map * 64 + hi * 8;
#pragma unroll
    for (int d0 = 0; d0 < 4; ++d0) qr[d0] = *(const bf16x8*)(Qw + d0 * 16); }
  const int pk = 64 * wid + lane;
  unsigned koff, voff0, voff1;
  { const int row = pk >> 3, c = (pk & 7) ^ ((row >> 1) & 7); koff = (unsigned)((row * LDQKV + 2048 + h * 128 + c * 8) * 2);
    const int sub0 = pk >> 5, kk0 = 8 * (sub0 >> 2) + ((pk & 31) >> 2), k0 = swap23(kk0), c0 = (sub0 & 3) * 32 + (pk & 3) * 8; voff0 = (unsigned)((k0 * LDQKV + 2560 + h * 128 + c0) * 2);
    const int p1 = pk + 512, sub1 = p1 >> 5, kk1 = 8 * (sub1 >> 2) + ((p1 & 31) >> 2), k1 = swap23(kk1), c1 = (sub1 & 3) * 32 + (p1 & 3) * 8; voff1 = (unsigned)((k1 * LDQKV + 2560 + h * 128 + c1) * 2); }
  const char* tb = (const char*)(qkv + rowb * LDQKV);
  const int vb0 = (int)(uintptr_t)(lds + 32768) + v_rd_base(lane);
#define DIFF_LOAD(j, buf) do { const char* tj = tb + (size_t)(j) * (64 * LDQKV * 2); dma16(tj + koff, lds + (buf) * 8192 + wid * 1024); dma16(tj + koff + 128, lds + 16384 + (buf) * 8192 + wid * 1024); \
    dma16(tj + voff0, lds + 32768 + (buf) * 16384 + wid * 1024); dma16(tj + voff1, lds + 32768 + (buf) * 16384 + 8192 + wid * 1024); } while (0)
  DIFF_LOAD(0, 0); asm volatile("s_waitcnt vmcnt(0)" ::: "memory"); __syncthreads();
  float m_reg = -1e30f, l_reg = 0.f; f32x16 o[4]; o[0] = f32x16{}; o[1] = f32x16{}; o[2] = f32x16{}; o[3] = f32x16{};
  for (int j = 0; j < NT; ++j) {
    const int cur = j & 1;
    if (j + 1 < NT) DIFF_LOAD(j + 1, cur ^ 1);
    if (j <= jl) {
      f32x16 p0, p1; bf16x8 pa0, pa1, pa2, pa3;
      qkt(p0, p1, lds + map * 16384 + cur * 8192, qr, r32, hi);
      if (j < jl) { const float tbf = (float)(64 * j - q0 + 4 * hi);
#pragma unroll
        for (int r = 0; r < 16; ++r) { const float cc = (float)((r & 3) + 8 * (r >> 2)); p0[r] = fmaf(sl2, tbf + cc, p0[r]); p1[r] = fmaf(sl2, tbf + (cc + 32.f), p1[r]); }
      } else { const int tq = 32 * w4 + r32 + q0 - 64 * j;
#pragma unroll
        for (int r = 0; r < 16; ++r) { const int k0 = crow(r, hi), k1 = k0 + 32; const int d0 = tq - k0, d1 = tq - k1;
          p0[r] += sl2 * (float)(64 * j - q0 + tq - (d0 < 0 ? -d0 : d0)); p1[r] += sl2 * (float)(64 * j - q0 + tq - (d1 < 0 ? -d1 : d1)); } }
      online_sm<4>(p0, p1, m_reg, l_reg, o, wsf, r32, hi, pa0, pa1, pa2, pa3);
      const int vb = vb0 + cur * 16384;
      pv_one<4, 0>(o[0], vb, pa0, pa1, pa2, pa3); pv_one<4, 1>(o[1], vb, pa0, pa1, pa2, pa3); pv_one<4, 2>(o[2], vb, pa0, pa1, pa2, pa3); pv_one<4, 3>(o[3], vb, pa0, pa1, pa2, pa3);
    }
    asm volatile("s_waitcnt vmcnt(0)" ::: "memory"); __syncthreads();
  }
#undef DIFF_LOAD
  if (hi == 0) wsf[32 + r32] = l_reg; asm volatile("s_waitcnt lgkmcnt(0)" ::: "memory");
  ATT_LAS float* X = (ATT_LAS float*)lds;
  const int te = opaque(tid), r32e = te & 31, hie = (te >> 5) & 1;
  if (map == 1) {
#pragma unroll
    for (int r = 0; r < 16; ++r) { const int orow = crow(r, hie); const float rl = __builtin_amdgcn_rcpf(wsf[32 + orow]);
#pragma unroll
      for (int d0 = 0; d0 < 4; ++d0) X[(32 * w4 + orow) * 132 + d0 * 32 + r32e] = o[d0][r] * rl; } }
  __syncthreads();
  if (map == 0) {
#pragma unroll
    for (int r = 0; r < 16; ++r) { const int orow = crow(r, hie); const float rl = __builtin_amdgcn_rcpf(wsf[32 + orow]);
#pragma unroll
      for (int d0 = 0; d0 < 4; ++d0) { const int idx = (32 * w4 + orow) * 132 + d0 * 32 + r32e; X[idx] = o[d0][r] * rl - lam * X[idx]; } } }
  __syncthreads();
  { const int row = te >> 2, qt = te & 3; float v[32]; float ss = 0.f;
#pragma unroll
    for (int i = 0; i < 8; ++i) { const f32x4 t = *(const ATT_LAS f32x4*)(X + row * 132 + qt * 32 + 4 * i); v[4 * i] = t[0]; v[4 * i + 1] = t[1]; v[4 * i + 2] = t[2]; v[4 * i + 3] = t[3];
      ss += t[0] * t[0] + t[1] * t[1] + t[2] * t[2] + t[3] * t[3]; }
    ss += __shfl_xor(ss, 1); ss += __shfl_xor(ss, 2);
    const float rstd = 0.8f / sqrtf(ss * (1.0f / 128.0f) + 1e-5f);
    bf16_t* op = attn + (rowb + q0 + row) * LDATT + 512 + h * 128 + qt * 32; const float* gp = subln_g + qt * 32;
#pragma unroll
    for (int i = 0; i < 4; ++i) { u32x4 w;
      w.x = cvtpk(v[8 * i + 0] * rstd * gp[8 * i + 0], v[8 * i + 1] * rstd * gp[8 * i + 1]); w.y = cvtpk(v[8 * i + 2] * rstd * gp[8 * i + 2], v[8 * i + 3] * rstd * gp[8 * i + 3]);
      w.z = cvtpk(v[8 * i + 4] * rstd * gp[8 * i + 4], v[8 * i + 5] * rstd * gp[8 * i + 5]); w.w = cvtpk(v[8 * i + 6] * rstd * gp[8 * i + 6], v[8 * i + 7] * rstd * gp[8 * i + 7]);
      *(u32x4*)(op + 8 * i) = w; } }
  __syncthreads();
}
#undef ATT_SBAR
}

constexpr int NWAVES = 8;
constexpr int BATCH = 8, SEQ = 4096, D = 1024, T = BATCH * SEQ;
constexpr int IN_COLS = 3080, NQKV = 3072;
constexpr int NEXP = 32, DEXP = 512, NSLOT_MAX = 73728;
constexpr int NPH = 9;
constexpr float C2 = 0.125f * 1.4426950408889634f;
constexpr float LAM_INIT = 0.2f;

constexpr size_t MiB = 1u << 20;
constexpr size_t WS_CTL = 0, CTL_ZERO_BYTES = 1 * MiB;
constexpr size_t WS_WIN = 1 * MiB;
constexpr size_t WS_WO = 7 * MiB;
constexpr size_t WS_WGU = 9 * MiB;
constexpr size_t WS_WD = 73 * MiB;
constexpr size_t WS_WR = 105 * MiB;
constexpr size_t WS_MOD = 106 * MiB;
constexpr size_t WS_CUM = 107 * MiB;
constexpr size_t WS_BLK = 108 * MiB;
constexpr size_t WS_RT = 109 * MiB;
constexpr size_t WS_STOK = 110 * MiB;
constexpr size_t WS_R = 118 * MiB;
constexpr size_t WS_H = WS_R;
constexpr size_t WS_QKV = WS_R + 64 * MiB;
constexpr size_t WS_Y = WS_R;
constexpr size_t WS_HID = WS_R + 144 * MiB;
constexpr size_t WS_END = WS_R + 256 * MiB;
constexpr int CW_BAR = 4096;
constexpr int CW_CNT = 16384;

constexpr int LDS_BYTES = 155648;
constexpr int MISC_OFF = LDS_BYTES - 256;

#define GAS __attribute__((address_space(1)))
#define LAS __attribute__((address_space(3)))
typedef unsigned short bf16;
typedef unsigned v4u __attribute__((ext_vector_type(4)));
typedef unsigned v2u __attribute__((ext_vector_type(2)));
typedef float f32x4 __attribute__((ext_vector_type(4)));
typedef GAS unsigned gu32;
#define RLX_AGENT __ATOMIC_RELAXED, __HIP_MEMORY_SCOPE_AGENT
#define LDS_WAIT() asm volatile("s_waitcnt lgkmcnt(0)" ::: "memory")
#define VM_WAIT() asm volatile("s_waitcnt vmcnt(0)" ::: "memory")
__device__ __forceinline__ unsigned f2bf(float f) { unsigned u = __builtin_bit_cast(unsigned, f); return (u + 0x7fffu + ((u >> 16) & 1u)) >> 16; }
__device__ __forceinline__ unsigned pk2(float lo, float hi) { return f2bf(lo) | (f2bf(hi) << 16); }
__device__ __forceinline__ float bflo(unsigned w) { return __builtin_bit_cast(float, w << 16); }
__device__ __forceinline__ float bfhi(unsigned w) { return __builtin_bit_cast(float, w & 0xffff0000u); }
__device__ __forceinline__ float wave_sum(float v) {
#pragma unroll
    for (int o = 1; o < 64; o <<= 1) v += __shfl_xor(v, o);
    return v;
}
#define XB_TMO      128
#define XB_XCNT(j)  (256  + 64 * (j))
#define XB_XSUB(j)  (1280 + 64 * (j))
#define XB_XGEN(j)  (2304 + 64 * (j))
#define XB_TOP      3328
#define XB_TOPGEN   3392
#define XCD_BAR_WORDS 3456
#define XB_SPIN_CAP (1u << 18)

__device__ __forceinline__ unsigned xb_ld(unsigned* p)              { return __hip_atomic_load(p, __ATOMIC_RELAXED, __HIP_MEMORY_SCOPE_AGENT); }
__device__ __forceinline__ unsigned xb_add(unsigned* p, unsigned v) { return __hip_atomic_fetch_add(p, v, __ATOMIC_RELAXED, __HIP_MEMORY_SCOPE_AGENT); }
__device__ __forceinline__ unsigned xb_xcc_id() { return (unsigned)__builtin_amdgcn_s_getreg((3 << 11) | 20) & 0xFu; }
#define XB_SPIN(cond, bar) do { unsigned _sp = 0; while (cond) { __builtin_amdgcn_s_sleep(1); \
    if ((++_sp & 255u) == 0u) { if (xb_ld(&(bar)[XB_TMO])) break; if (_sp > XB_SPIN_CAP) { atomicAdd(&(bar)[XB_TMO], 1u); break; } } } } while (0)

struct XcdBarrier {
    unsigned* bar; unsigned x;
    volatile LAS unsigned* st;
};

__device__ __forceinline__ XcdBarrier xcd_barrier_post(unsigned* bar, volatile LAS unsigned* st) {
    XcdBarrier b; b.bar = bar; b.x = xb_xcc_id(); b.st = st;
    if (threadIdx.x == 0) (void)xb_add(&bar[XB_XCNT(b.x)], 1u);
    return b;
}
__device__ __forceinline__ void xcd_barrier_complete(unsigned* bar, unsigned x, unsigned& nloc, unsigned& nx) {
    const unsigned G = gridDim.x * gridDim.y * gridDim.z;
    unsigned sum, cnt, mine, sp = 0u;
    for (;;) {
        sum = 0u; cnt = 0u; mine = 0u;
#pragma unroll
        for (unsigned j = 0; j < 16; ++j) { const unsigned c = xb_ld(&bar[XB_XCNT(j)]); sum += c; cnt += (c > 0u) ? 1u : 0u; mine = (j == x) ? c : mine; }
        if (sum == G) break;
        __builtin_amdgcn_s_sleep(1);
        if ((++sp & 255u) == 0u) { if (xb_ld(&bar[XB_TMO])) break; if (sp > XB_SPIN_CAP) { atomicAdd(&bar[XB_TMO], 1u); break; } }
    }
    nloc = mine > 0u ? mine : 1u; nx = cnt > 0u ? cnt : 1u;
}

__device__ __forceinline__ void xcd_barrier(const XcdBarrier& b) {
    asm volatile("s_waitcnt vmcnt(0)" ::: "memory");
    __syncthreads();
    if (threadIdx.x == 0) {
        unsigned* bar = b.bar;
        __builtin_amdgcn_s_waitcnt(0);
        unsigned nloc = b.st[0], nx = b.st[1];
        if (nloc == 0u) { xcd_barrier_complete(bar, b.x, nloc, nx); b.st[0] = nloc; b.st[1] = nx; }
        const unsigned old = xb_add(&bar[XB_XSUB(b.x)], 1u);
        const unsigned gen = old / nloc;
        if (old + 1u == (gen + 1u) * nloc) {
            __builtin_amdgcn_fence(__ATOMIC_RELEASE, "agent");
            asm volatile("s_waitcnt vmcnt(0)" ::: "memory");
            const unsigned og = xb_add(&bar[XB_TOP], 1u);
            const unsigned tg = og / nx;
            if (og + 1u == (tg + 1u) * nx) xb_add(&bar[XB_TOPGEN], 1u);
            else XB_SPIN(xb_ld(&bar[XB_TOPGEN]) == tg, bar);
            __builtin_amdgcn_fence(__ATOMIC_ACQUIRE, "agent");
            xb_add(&bar[XB_XGEN(b.x)], 1u);
            asm volatile("s_waitcnt vmcnt(0)" ::: "memory");
        } else {
            XB_SPIN(xb_ld(&bar[XB_XGEN(b.x)]) == gen, bar);
            __builtin_amdgcn_fence(__ATOMIC_ACQUIRE, "agent");
            asm volatile("s_waitcnt vmcnt(0)" ::: "memory");
        }
    }
    __syncthreads();
}

__device__ __forceinline__ void tr_item(const float* __restrict__ src, int ldS, bf16* __restrict__ dst, int ldD, float scale, LAS float* scr, int lane) {
#pragma unroll 8
    for (int i = 0; i < 32; ++i) { const int kk = 2 * i + (lane >> 5); scr[kk * 33 + (lane & 31)] = src[(size_t)kk * ldS + (lane & 31)]; }
    LDS_WAIT(); asm volatile("" ::: "memory");
    const int c = lane & 7;
#pragma unroll
    for (int j = 0; j < 4; ++j) { const int n = (lane >> 3) + 8 * j; const LAS float* s = scr + (8 * c) * 33 + n;
        v4u o; o.x = pk2(s[0 * 33] * scale, s[1 * 33] * scale); o.y = pk2(s[2 * 33] * scale, s[3 * 33] * scale); o.z = pk2(s[4 * 33] * scale, s[5 * 33] * scale); o.w = pk2(s[6 * 33] * scale, s[7 * 33] * scale);
        *(v4u*)(dst + (size_t)n * ldD + 8 * c) = o; }
    LDS_WAIT(); asm volatile("" ::: "memory");
}
struct P0Args { const float *c, *ada_w, *ada_b, *w_in, *w_o, *w_rg, *w_re, *w_gate, *w_up, *w_down; bf16 *Wt_in, *Wt_o, *Wt_gu, *Wt_d; float *Wr, *mod; };
__device__ __forceinline__ void p0_prologue(const P0Args& a, LAS unsigned char* lds, int vcu, int G, int tid, int wave, int lane) {
    LAS float* scr = (LAS float*)(lds + wave * 8448);
    const int gw = vcu * NWAVES + wave, NGW = G * NWAVES;
    constexpr int I_IN = 16 * 96, I_O = 16 * 32, I_GU = 32 * 16 * 32, I_D = 32 * 8 * 32;
    constexpr int NITEMS = I_IN + I_O + I_GU + I_D;
    for (int it = gw; it < NITEMS; it += NGW) {
        int r = it;
        if (r < I_IN) { const int kb = r / 96, nb = r % 96, n0 = 32 * nb, sc = n0 < 1536 ? n0 : n0 + 8;
            const float scale = (n0 < 512 || (n0 >= 1536 && n0 < 2048)) ? C2 : 1.0f;
            tr_item(a.w_in + (size_t)(64 * kb) * IN_COLS + sc, IN_COLS, a.Wt_in + (size_t)n0 * 1024 + 64 * kb, 1024, scale, scr, lane); continue; }
        r -= I_IN;
        if (r < I_O) { const int kb = r / 32, nb = r % 32;
            tr_item(a.w_o + (size_t)(64 * kb) * 1024 + 32 * nb, 1024, a.Wt_o + (size_t)(32 * nb) * 1024 + 64 * kb, 1024, 1.0f, scr, lane); continue; }
        r -= I_O;
        if (r < I_GU) { const int e = r / 512, q = r % 512, kb = q / 32, nb = q % 32, n0 = 32 * nb, pn = n0 >> 8, bj = (n0 >> 7) & 1, j0 = n0 & 127;
            const float* src = (bj ? a.w_up : a.w_gate) + (size_t)e * 1024 * 512 + (size_t)(64 * kb) * 512 + 128 * pn + j0;
            tr_item(src, 512, a.Wt_gu + ((size_t)e * 1024 + n0) * 1024 + 64 * kb, 1024, 1.0f, scr, lane); continue; }
        r -= I_GU;
        { const int e = r / 256, q = r % 256, kb = q / 32, nb = q % 32;
            tr_item(a.w_down + (size_t)e * 512 * 1024 + (size_t)(64 * kb) * 1024 + 32 * nb, 1024, a.Wt_d + ((size_t)e * 1024 + 32 * nb) * 512 + 64 * kb, 512, 1.0f, scr, lane); }
    }
    for (int i = (vcu * NWAVES * 64 + tid); i < 36 * 1024; i += G * NWAVES * 64) { const int n = i >> 10, k = i & 1023;
        a.Wr[i] = n < 32 ? a.w_re[k * 32 + n] : a.w_rg[k * 4 + (n - 32)]; }
    __syncthreads();
    LAS float* cs = (LAS float*)(lds + 69632);
    LAS float* red = (LAS float*)(lds + 69632 + 32768);
    for (int i = tid; i < 8192; i += NWAVES * 64) cs[i] = a.c[i];
    __syncthreads();
    for (int ch = vcu; ch < 96; ch += G) {
        float acc[8];
#pragma unroll
        for (int b = 0; b < 8; ++b) acc[b] = 0.f;
        const float* wp = a.ada_w + (size_t)(wave * 128) * 6144 + ch * 64 + lane;
#pragma unroll 8
        for (int k = 0; k < 128; ++k) { const float wv = wp[(size_t)k * 6144];
#pragma unroll
            for (int b = 0; b < 8; ++b) acc[b] = fmaf(cs[b * 1024 + wave * 128 + k], wv, acc[b]); }
#pragma unroll
        for (int b = 0; b < 8; ++b) red[(wave * 8 + b) * 64 + lane] = acc[b];
        __syncthreads();
        { const int b = tid >> 6, l = tid & 63; float s = a.ada_b[ch * 64 + l];
#pragma unroll
          for (int w = 0; w < 8; ++w) s += red[(w * 8 + b) * 64 + l];
          a.mod[b * 6144 + ch * 64 + l] = s; }
        __syncthreads();
    }
}

__device__ __forceinline__ void p1_norm(const float* __restrict__ x, const float* __restrict__ g1, const float* __restrict__ mod, const float* __restrict__ w_in, const float* __restrict__ b_f,
                                        bf16* __restrict__ H, float* __restrict__ cumloc, float* __restrict__ blktot, LAS unsigned char* lds, int vcu, int G, int tid, int wave, int lane) {
    LAS float* wfz = (LAS float*)lds; LAS float* lf = (LAS float*)(lds + 32768); LAS float* segtot = (LAS float*)(lds + 36864);
    for (int i = tid; i < 8192; i += NWAVES * 64) { const int jh = i >> 10, k = i & 1023; wfz[i] = w_in[(size_t)k * IN_COLS + 1536 + jh]; }
    __syncthreads();
    for (int rb = vcu; rb < T / 128; rb += G) {
        const int b = rb >> 5;
        f32x4 A[4], Bc[4];
#pragma unroll
        for (int j = 0; j < 4; ++j) { const int col = 256 * j + 4 * lane; const f32x4 g = *(const f32x4*)(g1 + col), sc = *(const f32x4*)(mod + b * 6144 + 1024 + col);
            A[j] = g * (1.0f + sc); Bc[j] = *(const f32x4*)(mod + b * 6144 + col); }
        const float bfv = b_f[lane & 7];
        for (int rr = 0; rr < 16; ++rr) {
            const int row = rb * 128 + wave * 16 + rr;
            const f32x4* xr = (const f32x4*)(x + (size_t)row * D) + lane;
            f32x4 v[4]; float s = 0.f;
#pragma unroll
            for (int j = 0; j < 4; ++j) { v[j] = xr[64 * j]; s += (v[j].x * v[j].x + v[j].y * v[j].y) + (v[j].z * v[j].z + v[j].w * v[j].w); }
            const float rstd = 1.0f / sqrtf(wave_sum(s) * (1.0f / D) + 1e-6f);
#pragma unroll
            for (int j = 0; j < 4; ++j) v[j] = v[j] * rstd * A[j] + Bc[j];
            v2u* o8 = (v2u*)(H + (size_t)row * D) + lane;
#pragma unroll
            for (int j = 0; j < 4; ++j) { v2u w; w.x = pk2(v[j].x, v[j].y); w.y = pk2(v[j].z, v[j].w); o8[64 * j] = w; }
            float z = 0.f;
#pragma unroll
            for (int jh = 0; jh < 8; ++jh) { float acc = 0.f;
#pragma unroll
                for (int j = 0; j < 4; ++j) { const f32x4 w4 = *(const LAS f32x4*)(wfz + jh * 1024 + 256 * j + 4 * lane); acc += (v[j].x * w4.x + v[j].y * w4.y) + (v[j].z * w4.z + v[j].w * w4.w); }
                acc = wave_sum(acc); z = ((lane & 7) == jh) ? acc : z; }
            z += bfv;
            const float lfv = fminf(z, 0.f) - log1pf(expf(-fabsf(z)));
            if (lane < 8) lf[(wave * 16 + rr) * 8 + lane] = lfv;
        }
        __syncthreads();
        float run[16]; const int hh = tid & 7, seg = (tid >> 3) & 7;
        if (tid < 64) { float s = 0.f;
#pragma unroll
            for (int i = 0; i < 16; ++i) { s += lf[(seg * 16 + i) * 8 + hh]; run[i] = s; }
            segtot[seg * 8 + hh] = s; }
        __syncthreads();
        if (tid < 64) { float off = 0.f;
            for (int s2 = 0; s2 < seg; ++s2) off += segtot[s2 * 8 + hh];
            float* cp = cumloc + (size_t)(b * 8 + hh) * SEQ + (rb & 31) * 128 + seg * 16;
#pragma unroll
            for (int i = 0; i < 4; ++i) { f32x4 t; t.x = run[4 * i] + off; t.y = run[4 * i + 1] + off; t.z = run[4 * i + 2] + off; t.w = run[4 * i + 3] + off; *(f32x4*)(cp + 4 * i) = t; }
            if (seg == 7) blktot[rb * 8 + hh] = run[15] + off; }
        __syncthreads();
    }
}

__device__ __forceinline__ void p5_route(const float* __restrict__ x1, const float* __restrict__ g2, const float* __restrict__ mod, const float* __restrict__ Wr, const float* __restrict__ b_rg, const float* __restrict__ b_re,
                                         bf16* __restrict__ H2, gu32* cnt, int* __restrict__ stok, int* __restrict__ rt_e, int* __restrict__ rt_pos, float* __restrict__ rt_w,
                                         LAS unsigned char* lds, int vcu, int G, int tid, int wave, int lane) {
    LAS float* wr = (LAS float*)lds; LAS unsigned* CNT = (LAS unsigned*)(lds + 147456); LAS unsigned* BASE = (LAS unsigned*)(lds + 147584); LAS unsigned* REC = (LAS unsigned*)(lds + 147712);
    for (int i = tid; i < 36 * 1024 / 4; i += NWAVES * 64) ((LAS f32x4*)wr)[i] = ((const f32x4*)Wr)[i];
    if (tid < 32) CNT[tid] = 0u;
    __syncthreads();
    for (int rb = vcu; rb < T / 128; rb += G) {
        const int b = rb >> 5;
        f32x4 A[4], Bc[4];
#pragma unroll
        for (int j = 0; j < 4; ++j) { const int col = 256 * j + 4 * lane; const f32x4 g = *(const f32x4*)(g2 + col), sc = *(const f32x4*)(mod + b * 6144 + 4096 + col);
            A[j] = g * (1.0f + sc); Bc[j] = *(const f32x4*)(mod + b * 6144 + 3072 + col); }
        for (int rr = 0; rr < 16; ++rr) {
            const int rl = wave * 16 + rr, row = rb * 128 + rl;
            const f32x4* xr = (const f32x4*)(x1 + (size_t)row * D) + lane;
            f32x4 v[4]; float s = 0.f;
#pragma unroll
            for (int j = 0; j < 4; ++j) { v[j] = xr[64 * j]; s += (v[j].x * v[j].x + v[j].y * v[j].y) + (v[j].z * v[j].z + v[j].w * v[j].w); }
            const float rstd = 1.0f / sqrtf(wave_sum(s) * (1.0f / D) + 1e-6f);
#pragma unroll
            for (int j = 0; j < 4; ++j) v[j] = v[j] * rstd * A[j] + Bc[j];
            v2u* o8 = (v2u*)(H2 + (size_t)row * D) + lane;
#pragma unroll
            for (int j = 0; j < 4; ++j) { v2u w; w.x = pk2(v[j].x, v[j].y); w.y = pk2(v[j].z, v[j].w); o8[64 * j] = w; }
            float L[36];
#pragma unroll
            for (int n = 0; n < 36; ++n) { float acc = 0.f;
#pragma unroll
                for (int j = 0; j < 4; ++j) { const f32x4 w4 = *(const LAS f32x4*)(wr + n * 1024 + 256 * j + 4 * lane); acc += (v[j].x * w4.x + v[j].y * w4.y) + (v[j].z * w4.z + v[j].w * w4.w); }
                L[n] = wave_sum(acc); if ((n & 3) == 3) __builtin_amdgcn_sched_barrier(0); }
            float gl[4];
#pragma unroll
            for (int i = 0; i < 4; ++i) gl[i] = L[32 + i] + b_rg[i];
            int g = 0; float gm = gl[0];
#pragma unroll
            for (int i = 1; i < 4; ++i) if (gl[i] > gm) { gm = gl[i]; g = i; }
            float gs = 0.f;
#pragma unroll
            for (int i = 0; i < 4; ++i) gs += expf(gl[i] - gm);
            const float pg = 1.0f / gs;
            float el[8];
#pragma unroll
            for (int i = 0; i < 8; ++i) { const float v0 = L[i] + b_re[i], v1 = L[8 + i] + b_re[8 + i], v2 = L[16 + i] + b_re[16 + i], v3 = L[24 + i] + b_re[24 + i];
                el[i] = g == 0 ? v0 : g == 1 ? v1 : g == 2 ? v2 : v3; }
            int i1 = 0; float m1 = el[0];
#pragma unroll
            for (int i = 1; i < 8; ++i) if (el[i] > m1) { m1 = el[i]; i1 = i; }
            int i2 = -1; float m2 = -3.0e38f;
#pragma unroll
            for (int i = 0; i < 8; ++i) if (i != i1 && el[i] > m2) { m2 = el[i]; i2 = i; }
            const float ex = expf(m2 - m1); const float w1 = pg / (1.0f + ex), w2 = pg * ex / (1.0f + ex);
            if (lane == 0) { const int e1 = g * 8 + i1, e2 = g * 8 + i2;
                const unsigned p1 = __hip_atomic_fetch_add(&CNT[e1], 1u, __ATOMIC_RELAXED, __HIP_MEMORY_SCOPE_WORKGROUP), p2 = __hip_atomic_fetch_add(&CNT[e2], 1u, __ATOMIC_RELAXED, __HIP_MEMORY_SCOPE_WORKGROUP);
                REC[(rl * 2 + 0) * 4 + 0] = (unsigned)e1; REC[(rl * 2 + 0) * 4 + 1] = p1; REC[(rl * 2 + 0) * 4 + 2] = __float_as_uint(w1);
                REC[(rl * 2 + 1) * 4 + 0] = (unsigned)e2; REC[(rl * 2 + 1) * 4 + 1] = p2; REC[(rl * 2 + 1) * 4 + 2] = __float_as_uint(w2); }
        }
        __syncthreads();
        if (tid < 32) BASE[tid] = __hip_atomic_fetch_add(cnt + 64 * tid, CNT[tid], RLX_AGENT);
        __syncthreads();
        if (tid < 256) { const unsigned e = REC[tid * 4 + 0], pl = REC[tid * 4 + 1], wb = REC[tid * 4 + 2]; const unsigned pos = BASE[e] + pl; const int tok = rb * 128 + (tid >> 1);
            stok[(size_t)e * 65536 + pos] = tok; rt_e[tok * 2 + (tid & 1)] = (int)e; rt_pos[tok * 2 + (tid & 1)] = (int)pos; rt_w[tok * 2 + (tid & 1)] = __uint_as_float(wb); }
        __syncthreads();
        if (tid < 32) CNT[tid] = 0u;
        __syncthreads();
    }
}

__device__ __forceinline__ void moe_tables(gu32* cnt, LAS int* TB, LAS int* CN, int tid) {
    if (tid == 0) { int s = 0;
        for (int e = 0; e < 32; ++e) { const int c = (int)__hip_atomic_load(cnt + 64 * e, RLX_AGENT); CN[e] = c; TB[e] = s; s += (c + 255) >> 8; }
        TB[32] = s; }
    __syncthreads();
}
struct MoeOrder {
    const LAS int* TB; const LAS int* CN; const int* stok; int G, c; bool gather;
    __device__ __forceinline__ bool next(int i, pg8::Unit& u) const {
        const int L = i * G + c; if (L >= 4 * TB[32]) return false;
        const int gt = L >> 2, ct = L & 3; int e = 0;
        for (int k = 1; k < 32; ++k) e += (gt >= TB[k]) ? 1 : 0;
        u.pm = gt; u.pn = e * 4 + ct; u.e = e; return true;
    }
    __device__ __forceinline__ void a_off(const pg8::Unit& u, const int (&RA)[2], const int (&CA)[2], int K, unsigned (&off)[2][2]) const {
        if (gather) {
            const int p0 = (u.pm - TB[u.e]) * 256, n = CN[u.e];
#pragma unroll
            for (int h = 0; h < 2; ++h)
#pragma unroll
                for (int i = 0; i < 2; ++i) { const int pos = p0 + h * 128 + RA[i]; const int tok = pos < n ? stok[(size_t)u.e * 65536 + pos] : 0;
                    off[h][i] = (unsigned)(((size_t)tok * K + CA[i]) * 2); }
            __builtin_amdgcn_s_waitcnt(0x0F70);
        } else {
#pragma unroll
            for (int h = 0; h < 2; ++h)
#pragma unroll
                for (int i = 0; i < 2; ++i) off[h][i] = (unsigned)(((size_t)(u.pm * 256 + h * 128 + RA[i]) * K + CA[i]) * 2);
        }
    }
};

__device__ __forceinline__ void p8_final(float* __restrict__ xo, const bf16* __restrict__ Y, const float* __restrict__ mod, const float* __restrict__ gf,
                                         const int* __restrict__ rt_e, const int* __restrict__ rt_pos, const float* __restrict__ rt_w, const LAS int* TB,
                                         int vcu, int G, int wave, int lane) {
    const int gw = vcu * NWAVES + wave, NGW = G * NWAVES;
    f32x4 gfv[4];
#pragma unroll
    for (int j = 0; j < 4; ++j) gfv[j] = *(const f32x4*)(gf + 256 * j + 4 * lane);
    for (int row = gw; row < T; row += NGW) {
        const int b = row >> 12;
        const int e0 = rt_e[row * 2], e1 = rt_e[row * 2 + 1]; const int s0 = TB[e0] * 256 + rt_pos[row * 2], s1 = TB[e1] * 256 + rt_pos[row * 2 + 1];
        const float w0 = rt_w[row * 2], w1 = rt_w[row * 2 + 1];
        f32x4* xr = (f32x4*)(xo + (size_t)row * D) + lane;
        const v2u* y0 = (const v2u*)(Y + (size_t)s0 * D) + lane; const v2u* y1 = (const v2u*)(Y + (size_t)s1 * D) + lane;
        f32x4 v[4]; float s = 0.f;
#pragma unroll
        for (int j = 0; j < 4; ++j) { const f32x4 xv = xr[64 * j]; const v2u a = y0[64 * j], c = y1[64 * j]; const f32x4 g2 = *(const f32x4*)(mod + b * 6144 + 5120 + 256 * j + 4 * lane);
            f32x4 y; y.x = w0 * bflo(a.x) + w1 * bflo(c.x); y.y = w0 * bfhi(a.x) + w1 * bfhi(c.x); y.z = w0 * bflo(a.y) + w1 * bflo(c.y); y.w = w0 * bfhi(a.y) + w1 * bfhi(c.y);
            v[j] = xv + g2 * y; s += (v[j].x * v[j].x + v[j].y * v[j].y) + (v[j].z * v[j].z + v[j].w * v[j].w); }
        const float rstd = 1.0f / sqrtf(wave_sum(s) * (1.0f / D) + 1e-6f);
#pragma unroll
        for (int j = 0; j < 4; ++j) xr[64 * j] = v[j] * rstd * gfv[j];
    }
}

struct Args { const float* in[22]; float* out; unsigned char* ws; int ph_lo, ph_hi; };
__global__ void __launch_bounds__(NWAVES * 64, 2) fwd_kernel(Args args) {
    extern __shared__ __attribute__((aligned(16))) unsigned char lds_raw[];
    LAS unsigned char* lds = (LAS unsigned char*)lds_raw;
    volatile LAS unsigned* MISC = (volatile LAS unsigned*)(lds + MISC_OFF);
    const int tid = threadIdx.x, lane = tid & 63, wave = __builtin_amdgcn_readfirstlane(tid >> 6);
    const int G = gridDim.x; const int bx = blockIdx.x; const int vcu = (G % 8 == 0) ? (bx % 8) * (G / 8) + bx / 8 : bx;
    unsigned char* ws = args.ws;
    gu32* ctl = (gu32*)(ws + WS_CTL);
    const float* x = args.in[0]; const float* c_in = args.in[1]; const float* ada_w = args.in[2]; const float* ada_b = args.in[3]; const float* norm1_g = args.in[4];
    const float* w_in = args.in[5]; const float* b_f = args.in[6]; const float* lam_q1 = args.in[7]; const float* lam_k1 = args.in[8]; const float* lam_q2 = args.in[9]; const float* lam_k2 = args.in[10];
    const float* subln_g = args.in[11]; const float* w_o = args.in[12]; const float* norm2_g = args.in[13]; const float* w_rg = args.in[14]; const float* b_rg = args.in[15];
    const float* w_re = args.in[16]; const float* b_re = args.in[17]; const float* w_gate = args.in[18]; const float* w_up = args.in[19]; const float* w_down = args.in[20]; const float* norm_f_g = args.in[21];
    float* out = args.out;
    bf16* Wt_in = (bf16*)(ws + WS_WIN); bf16* Wt_o = (bf16*)(ws + WS_WO); bf16* Wt_gu = (bf16*)(ws + WS_WGU); bf16* Wt_d = (bf16*)(ws + WS_WD);
    float* Wr = (float*)(ws + WS_WR); float* mod = (float*)(ws + WS_MOD); float* cumloc = (float*)(ws + WS_CUM); float* blktot = (float*)(ws + WS_BLK);
    int* rt_e = (int*)(ws + WS_RT); int* rt_pos = rt_e + 2 * T; float* rt_w = (float*)(rt_pos + 2 * T); int* stok = (int*)(ws + WS_STOK);
    bf16* HB = (bf16*)(ws + WS_H); bf16* QKV = (bf16*)(ws + WS_QKV); bf16* YB = (bf16*)(ws + WS_Y); bf16* HID = (bf16*)(ws + WS_HID);
    gu32* cnt = ctl + CW_CNT;

    if (tid < 64) MISC[tid] = 0u;
    __syncthreads();
    XcdBarrier bar = xcd_barrier_post((unsigned*)(ctl + CW_BAR), MISC + 8);
    const int lo = args.ph_lo, hi = args.ph_hi;
#ifndef PHASE_MASK
#define PHASE_MASK 0x1ff
#endif
#define IN(k) ((((PHASE_MASK) >> (k)) & 1) && lo <= (k) && (k) < hi)
#define SEAM(k) do { if (IN(k) && IN((k) + 1)) xcd_barrier(bar); } while (0)

    if (IN(0)) {
        P0Args a{c_in, ada_w, ada_b, w_in, w_o, w_rg, w_re, w_gate, w_up, w_down, Wt_in, Wt_o, Wt_gu, Wt_d, Wr, mod};
        p0_prologue(a, lds, vcu, G, tid, wave, lane);
    }
    SEAM(0);
    if (IN(1)) p1_norm(x, norm1_g, mod, w_in, b_f, HB, cumloc, blktot, lds, vcu, G, tid, wave, lane);
    SEAM(1);
    if (IN(2)) {
        pg8::Gemm g{HB, Wt_in, T, NQKV, D}; pg8::StaticOrder S; S.init(T, NQKV, G, bx);
        pg8::EpiStore E{QKV, NQKV, 0xffff};
        pg8::gemm_phase<pg8::EpiStore, pg8::StaticOrder, true, true>(lds, g, S, E);
    }
    SEAM(2);
    if (IN(3)) {
        float lam;
        { const float a = wave_sum(lam_q1[lane] * lam_k1[lane]), b2 = wave_sum(lam_q2[lane] * lam_k2[lane]); lam = expf(a) - expf(b2) + LAM_INIT; }
        for (int v = vcu; v < 256; v += G) {
            const int b = v >> 5, ci = v & 31;
#ifndef NO_DIFF
#pragma unroll 1
            for (int s = 0; s < 4; ++s) { const int qb = (s & 1) ? 31 - ci : ci; att::diff_unit(lds, QKV, HB, subln_g, lam, b, s, qb); }
#endif
#ifndef NO_FOX
#pragma unroll 1
            for (int p = 0; p < 4; ++p) { const int h = 2 * p + (ci >> 4), i16 = ci & 15, qb = (p & 1) ? 15 - i16 : i16; att::fox_unit(lds, QKV, HB, cumloc, blktot, b, h, qb); }
#endif
        }
    }
    SEAM(3);
    if (IN(4)) {
        pg8::Gemm g{HB, Wt_o, T, D, D}; pg8::StaticOrder S; S.init(T, D, G, bx);
        pg8::EpiResid E{x, out, mod + 2048};
        pg8::gemm_phase<pg8::EpiResid, pg8::StaticOrder, true, true>(lds, g, S, E);
    }
    SEAM(4);
    if (IN(5)) p5_route(out, norm2_g, mod, Wr, b_rg, b_re, HB, cnt, stok, rt_e, rt_pos, rt_w, lds, vcu, G, tid, wave, lane);
    SEAM(5);
    LAS int* TB = (LAS int*)(lds + 131072); LAS int* CN = (LAS int*)(lds + 131072 + 256);
    if (IN(6)) {
        moe_tables(cnt, TB, CN, tid);
        pg8::Gemm g{HB, Wt_gu, T, 1024, D}; MoeOrder S{TB, CN, stok, G, bx, true};
        pg8::EpiSwiglu E{HID};
        pg8::gemm_phase<pg8::EpiSwiglu, MoeOrder, true, true>(lds, g, S, E);
    }
    SEAM(6);
    if (IN(7)) {
        moe_tables(cnt, TB, CN, tid);
        pg8::Gemm g{HID, Wt_d, NSLOT_MAX, 1024, DEXP}; MoeOrder S{TB, CN, stok, G, bx, false};
        pg8::EpiStore E{YB, 1024, 3};
        pg8::gemm_phase<pg8::EpiStore, MoeOrder, true, true>(lds, g, S, E);
    }
    SEAM(7);
    if (IN(8)) {
        moe_tables(cnt, TB, CN, tid);
        p8_final(out, YB, mod, norm_f_g, rt_e, rt_pos, rt_w, TB, vcu, G, wave, lane);
    }
#undef IN
#undef SEAM
}

#ifndef MK_N_LAUNCHES
#define MK_N_LAUNCHES 9
#endif
extern "C" void kernel_launch(void* const* d_in, const int* in_sizes, int n_in, void* d_out, int out_size, void* d_ws, size_t ws_size, hipStream_t stream) {
    static int grid = 0;
    if (grid == 0) {
        if (n_in != 22 || in_sizes[0] != T * D || out_size != T * D || ws_size < WS_END) { fprintf(stderr, "kernel_launch: shape/workspace mismatch (n_in %d, in0 %d, out %d, ws %zu, need %zu)\n", n_in, n_in > 0 ? in_sizes[0] : -1, out_size, ws_size, (size_t)WS_END); grid = -1; return; }
        int dev = 0, cus = 0, per_cu = 0;
        if (hipGetDevice(&dev) != hipSuccess || hipDeviceGetAttribute(&cus, hipDeviceAttributeMultiprocessorCount, dev) != hipSuccess) { grid = -1; return; }
        if (hipFuncSetAttribute((const void*)fwd_kernel, hipFuncAttributeMaxDynamicSharedMemorySize, LDS_BYTES) != hipSuccess) { fprintf(stderr, "kernel_launch: hipFuncSetAttribute failed\n"); grid = -1; return; }
        if (hipOccupancyMaxActiveBlocksPerMultiprocessor(&per_cu, (const void*)fwd_kernel, NWAVES * 64, LDS_BYTES) != hipSuccess || per_cu < 1) fprintf(stderr, "kernel_launch: occupancy query reports %d\n", per_cu);
        (void)hipGetLastError();
        grid = cus > 0 ? cus : 256;
    }
    if (grid < 0) return;
    (void)hipMemsetAsync((char*)d_ws + WS_CTL, 0, CTL_ZERO_BYTES, stream);
    Args a{};
    for (int i = 0; i < 22; ++i) a.in[i] = (const float*)d_in[i];
    a.out = (float*)d_out; a.ws = (unsigned char*)d_ws;
    if (MK_N_LAUNCHES == 1) { a.ph_lo = 0; a.ph_hi = NPH; hipLaunchKernelGGL(fwd_kernel, dim3(grid), dim3(NWAVES * 64), LDS_BYTES, stream, a); }
    else for (int p = 0; p < NPH; ++p) { a.ph_lo = p; a.ph_hi = p + 1; hipLaunchKernelGGL(fwd_kernel, dim3(grid), dim3(NWAVES * 64), LDS_BYTES, stream, a); }
    const hipError_t le = hipPeekAtLastError();
    if (le != hipSuccess) fprintf(stderr, "kernel_launch: launch failed: %s\n", hipGetErrorName(le));
}
```

```cpp
#include <hip/hip_runtime.h>
#include <hip/hip_bf16.h>
#include <cstdio>
#include <cstdint>

namespace pg8 {
#define PG8_LAS __attribute__((address_space(3)))
typedef unsigned short bf16_t;
typedef short bf16x8 __attribute__((ext_vector_type(8)));
typedef float f32x4 __attribute__((ext_vector_type(4)));
typedef unsigned u32x4 __attribute__((ext_vector_type(4)));
constexpr int BM = 256, BK = 64, HALF = 128, HTB = HALF * BK * 2  , STAGE_BYTES = 8 * HTB, NXCD = 8, WGM = 8;

__host__ __device__ __forceinline__ int lds_byte(int r, int c) { const int st = (r >> 4) * 2 + (c >> 5), rr = r & 15, cc = c & 31, ob = rr * 64 + cc * 2; return st * 1024 + (ob ^ (((ob >> 9) & 1) << 5)); }
__host__ __device__ __forceinline__ void stage_rc(int b, int& R, int& C) { const int st = b / 1024, sb = b % 1024, swz = sb ^ (((sb >> 9) & 1) << 5); R = (st >> 1) * 16 + swz / 64; C = (st & 1) * 32 + (swz % 64) / 2; }
__host__ __device__ __forceinline__ int perm32(int rho) { const int n = rho >> 4, i = rho & 15; return 8 * (i >> 2) + 4 * n + (i & 3); }

struct Unit { int pm, pn, e; };
struct Gemm { const bf16_t* A; const bf16_t* Bt; int M, N, K; };

struct StaticOrder {
    int nM, nN, nwg, G, c;
    __host__ __device__ void init(int M, int N, int G_, int c_) { nM = M / BM; nN = N / BM; nwg = nM * nN; G = G_; c = c_; }
    __host__ __device__ bool next(int i, Unit& u) const {
        const long L = (long)i * G + c; if (L >= nwg) return false;
        int wgid = (int)L; { const int q = nwg / NXCD, r = nwg % NXCD, xcd = wgid % NXCD, off = wgid / NXCD; wgid = (xcd < r ? xcd * (q + 1) : r * (q + 1) + (xcd - r) * q) + off; }
        const int nig = WGM * nN, gid = wgid / nig, fm = gid * WGM, gsz = (nM - fm) < WGM ? (nM - fm) : WGM;
        u.pm = fm + ((wgid % nig) % gsz); u.pn = (wgid % nig) / gsz; u.e = 0; return true;
    }
    __device__ __forceinline__ void a_off(const Unit& u, const int (&RA)[2], const int (&CA)[2], int K, unsigned (&off)[2][2]) const {
#pragma unroll
        for (int h = 0; h < 2; ++h)
#pragma unroll
            for (int i = 0; i < 2; ++i) off[h][i] = (unsigned)(((size_t)(u.pm * BM + h * HALF + RA[i]) * K + CA[i]) * 2);
    }
};


__device__ __forceinline__ unsigned cvt_pk_bf16(float lo, float hi) { unsigned r; asm volatile("v_cvt_pk_bf16_f32 %0, %1, %2" : "=v"(r) : "v"(lo), "v"(hi)); return r; }

struct EpiStore {
    static constexpr bool PERM = true, AFTER_DRAIN = false;
    bf16_t* O; int ldc; int pn_mask;
    __device__ __forceinline__ void operator()(const f32x4 (&acc)[2][2][4][2], const Unit& u, int wr, int wc, int fr, int fq) const {
        const int row0 = u.pm * BM + wr * 64 + fr; const int col0 = (u.pn & pn_mask) * BM + wc * 32 + 8 * fq;
#pragma unroll
        for (int ai = 0; ai < 2; ++ai)
#pragma unroll
            for (int m = 0; m < 4; ++m) { bf16_t* rowp = O + (size_t)(row0 + ai * HALF + m * 16) * ldc + col0;
#pragma unroll
                for (int bj = 0; bj < 2; ++bj) { const f32x4 v0 = acc[ai][bj][m][0], v1 = acc[ai][bj][m][1];
                    u32x4 w; w.x = cvt_pk_bf16(v0[0], v0[1]); w.y = cvt_pk_bf16(v0[2], v0[3]); w.z = cvt_pk_bf16(v1[0], v1[1]); w.w = cvt_pk_bf16(v1[2], v1[3]);
                    *(u32x4*)(rowp + bj * HALF) = w; } }
    }
};
struct EpiSwiglu {
    static constexpr bool PERM = true, AFTER_DRAIN = false;
    bf16_t* H;
    __device__ __forceinline__ void operator()(const f32x4 (&acc)[2][2][4][2], const Unit& u, int wr, int wc, int fr, int fq) const {
        const int row0 = u.pm * BM + wr * 64 + fr; const int col0 = (u.pn & 3) * 128 + wc * 32 + 8 * fq;
#pragma unroll
        for (int ai = 0; ai < 2; ++ai)
#pragma unroll
            for (int m = 0; m < 4; ++m) { bf16_t* rowp = H + (size_t)(row0 + ai * HALF + m * 16) * 512 + col0;
                float hv[8];
#pragma unroll
                for (int n = 0; n < 2; ++n)
#pragma unroll
                    for (int i = 0; i < 4; ++i) { const float g = acc[ai][0][m][n][i], up = acc[ai][1][m][n][i];
                        const float e = __builtin_amdgcn_exp2f(-g * 1.4426950408889634f);
                        hv[n * 4 + i] = g * __builtin_amdgcn_rcpf(1.0f + e) * up; }
                u32x4 w; w.x = cvt_pk_bf16(hv[0], hv[1]); w.y = cvt_pk_bf16(hv[2], hv[3]); w.z = cvt_pk_bf16(hv[4], hv[5]); w.w = cvt_pk_bf16(hv[6], hv[7]);
                *(u32x4*)rowp = w; }
    }
};
struct EpiResid {
    static constexpr bool PERM = false, AFTER_DRAIN = false;
    const float* base; float* out; const float* gate;
    __device__ __forceinline__ void operator()(const f32x4 (&acc)[2][2][4][2], const Unit& u, int wr, int wc, int fr, int fq) const {
        const int col0 = u.pn * BM + wc * 32 + 4 * fq; const float* gp = gate + (size_t)(u.pm >> 4) * 6144 + col0;
        f32x4 gv[2][2];
#pragma unroll
        for (int bj = 0; bj < 2; ++bj)
#pragma unroll
            for (int n = 0; n < 2; ++n) gv[bj][n] = *(const f32x4*)(gp + bj * HALF + n * 16);
#pragma unroll
        for (int ai = 0; ai < 2; ++ai)
#pragma unroll
            for (int m = 0; m < 4; ++m) { const size_t off = (size_t)(u.pm * BM + ai * HALF + wr * 64 + m * 16 + fr) * 1024 + col0;
#pragma unroll
                for (int bj = 0; bj < 2; ++bj)
#pragma unroll
                    for (int n = 0; n < 2; ++n) { const f32x4 bs = *(const f32x4*)(base + off + bj * HALF + n * 16);
                        *(f32x4*)(out + off + bj * HALF + n * 16) = bs + gv[bj][n] * acc[ai][bj][m][n]; } }
    }
};

template <class Epi, class Sched, bool ALIGN_EPI = false, bool SP2 = false>
__device__ __forceinline__ void gemm_phase(PG8_LAS unsigned char* lds, const Gemm g, const Sched& S, const Epi& E) {
    const int tid = threadIdx.x, wid = __builtin_amdgcn_readfirstlane(tid >> 6), lane = tid & 63, wr = wid >> 2, wc = wid & 3, fr = lane & 15, fq = lane >> 4;
    const int K = g.K, nt = K / BK;
    int RA[2], CA[2]; unsigned voffB[2];
#pragma unroll
    for (int i = 0; i < 2; ++i) { int R, C; stage_rc(tid * 16 + i * 8192, R, C); const int Rb = Epi::PERM ? ((R & ~31) + perm32(R & 31)) : R;
        RA[i] = R; CA[i] = C; voffB[i] = (unsigned)(Rb * K + C) * 2u; }
    const size_t kstep = (size_t)(BK * 2);
    const size_t hstep = (size_t)HALF * K * 2;
    const size_t tstep = 2 * hstep;
    const unsigned ldsw = (unsigned)wid * 1024u;
    const int aoff = lds_byte(wr * 64 + fr, fq * 8), boff = lds_byte(wc * 32 + fr, fq * 8);
#define PG8_SA(b, h) (((b) * 2 + (h)) * HTB)
#define PG8_SB(b, h) ((4 + (b) * 2 + (h)) * HTB)
#define PG8_STAGE(bufoff, gbase, voff) do { _Pragma("unroll") for (int _i = 0; _i < 2; ++_i) \
        __builtin_amdgcn_global_load_lds((const unsigned*)((const char*)(gbase) + (voff)[_i]), (PG8_LAS unsigned*)(lds + (bufoff) + ldsw + _i * 8192), 16, 0, 0); } while (0)
#define PG8_LDA(dst, b, h) do { _Pragma("unroll") for (int m = 0; m < 4; ++m) _Pragma("unroll") for (int k = 0; k < 2; ++k) dst[m][k] = *(const PG8_LAS bf16x8*)(lds + PG8_SA(b, h) + aoff + m * 2048 + k * 1024); } while (0)
#define PG8_LDB(dst, b, h) do { _Pragma("unroll") for (int n = 0; n < 2; ++n) _Pragma("unroll") for (int k = 0; k < 2; ++k) dst[n][k] = *(const PG8_LAS bf16x8*)(lds + PG8_SB(b, h) + boff + n * 2048 + k * 1024); } while (0)
#define PG8_MMA(ai, bj, At, Bt) do { __builtin_amdgcn_s_setprio(1); _Pragma("unroll") for (int m = 0; m < 4; ++m) _Pragma("unroll") for (int n = 0; n < 2; ++n) _Pragma("unroll") for (int k = 0; k < 2; ++k) \
        acc[ai][bj][m][n] = __builtin_amdgcn_mfma_f32_16x16x32_bf16(Bt[n][k], At[m][k], acc[ai][bj][m][n], 0, 0, 0); __builtin_amdgcn_s_setprio(0); } while (0)
#define PG8_WAIT_V(n) asm volatile("s_waitcnt vmcnt(" #n ")" ::: "memory")
#define PG8_WAIT_L(n) asm volatile("s_waitcnt lgkmcnt(" #n ")" ::: "memory")
#define PG8_BAR __builtin_amdgcn_s_barrier()
#define PG8_SCHED __builtin_amdgcn_sched_barrier(0)
    Unit cur, nxt; int ui = 0;
    if (!S.next(0, cur)) return;
    f32x4 acc[2][2][4][2];
#pragma unroll
    for (int a = 0; a < 2; ++a)
#pragma unroll
        for (int b = 0; b < 2; ++b)
#pragma unroll
            for (int m = 0; m < 4; ++m)
#pragma unroll
                for (int n = 0; n < 2; ++n) acc[a][b][m][n] = (f32x4){0.f, 0.f, 0.f, 0.f};
    bf16x8 At[4][2], B0[2][2], B1[2][2];
    unsigned oc[2][2], on[2][2];
    S.a_off(cur, RA, CA, K, oc);
    const char* A0 = (const char*)g.A;
    const char* cB = (const char*)g.Bt + (size_t)cur.pn * tstep;
    if constexpr (SP2) {
        PG8_STAGE(PG8_SB(0, 0), cB, voffB); PG8_STAGE(PG8_SB(0, 1), cB + hstep, voffB); PG8_STAGE(PG8_SA(0, 0), A0, oc[0]); PG8_STAGE(PG8_SA(0, 1), A0, oc[1]);
        if (wr == 1) PG8_BAR;
        PG8_WAIT_V(2); PG8_BAR;
        PG8_STAGE(PG8_SB(1, 0), cB + kstep, voffB); PG8_STAGE(PG8_SA(1, 0), A0 + kstep, oc[0]); PG8_STAGE(PG8_SB(1, 1), cB + hstep + kstep, voffB);
        PG8_WAIT_V(6); PG8_BAR;
    } else {
        PG8_STAGE(PG8_SB(0, 0), cB, voffB); PG8_STAGE(PG8_SA(0, 0), A0, oc[0]); PG8_STAGE(PG8_SB(0, 1), cB + hstep, voffB); PG8_STAGE(PG8_SA(0, 1), A0, oc[1]);
        if (wr == 1) PG8_BAR;
        PG8_WAIT_V(4); PG8_BAR;
        PG8_STAGE(PG8_SB(1, 0), cB + kstep, voffB); PG8_STAGE(PG8_SA(1, 0), A0 + kstep, oc[0]); PG8_STAGE(PG8_SB(1, 1), cB + hstep + kstep, voffB);
        PG8_WAIT_V(6); PG8_BAR;
    }
    for (;;) {
        const bool has_next = S.next(ui + 1, nxt);
        if (has_next) S.a_off(nxt, RA, CA, K, on);
        else {
#pragma unroll
            for (int h = 0; h < 2; ++h)
#pragma unroll
                for (int i = 0; i < 2; ++i) on[h][i] = oc[h][i]; }
        const char* nB = has_next ? (const char*)g.Bt + (size_t)nxt.pn * tstep : cB;
        for (int t = 0; t < nt; t += 2) {
            const bool last = (t == nt - 2);
            const char* a1 = A0 + (size_t)(t + 1) * kstep;
            const char* a2 = last ? A0 : A0 + (size_t)(t + 2) * kstep; const char* b2 = last ? nB : cB + (size_t)(t + 2) * kstep;
            const char* a3 = a2 + kstep; const char* b3 = b2 + kstep;
            unsigned o2[2][2];
#pragma unroll
            for (int h = 0; h < 2; ++h)
#pragma unroll
                for (int i = 0; i < 2; ++i) o2[h][i] = last ? on[h][i] : oc[h][i];
            if constexpr (SP2) {
            PG8_LDB(B0, 0, 0); PG8_LDB(B1, 0, 1); PG8_SCHED; PG8_LDA(At, 0, 0); PG8_STAGE(PG8_SA(1, 1), a1, oc[1]);
            PG8_WAIT_V(8); PG8_WAIT_L(0); PG8_BAR; PG8_MMA(0, 0, At, B0); PG8_MMA(0, 1, At, B1); PG8_BAR; PG8_SCHED;
            PG8_LDA(At, 0, 1); PG8_STAGE(PG8_SB(0, 0), b2, voffB); PG8_STAGE(PG8_SB(0, 1), b2 + hstep, voffB); PG8_STAGE(PG8_SA(0, 0), a2, o2[0]);
            PG8_WAIT_V(8); PG8_WAIT_L(0); PG8_BAR; PG8_MMA(1, 0, At, B0); PG8_MMA(1, 1, At, B1); PG8_BAR; PG8_SCHED;
            PG8_LDB(B0, 1, 0); PG8_LDB(B1, 1, 1); PG8_SCHED; PG8_LDA(At, 1, 0); PG8_STAGE(PG8_SA(0, 1), a2, o2[1]);
            PG8_WAIT_V(8); PG8_WAIT_L(0); PG8_BAR; PG8_MMA(0, 0, At, B0); PG8_MMA(0, 1, At, B1); PG8_BAR; PG8_SCHED;
            PG8_LDA(At, 1, 1); PG8_STAGE(PG8_SB(1, 0), b3, voffB); PG8_STAGE(PG8_SB(1, 1), b3 + hstep, voffB); PG8_STAGE(PG8_SA(1, 0), a3, o2[0]);
            PG8_WAIT_V(8); PG8_WAIT_L(0); PG8_BAR; PG8_MMA(1, 0, At, B0); PG8_MMA(1, 1, At, B1); PG8_BAR; PG8_SCHED;
            } else {
            PG8_LDB(B0, 0, 0); PG8_SCHED; PG8_LDA(At, 0, 0); PG8_STAGE(PG8_SA(1, 1), a1, oc[1]);
            PG8_WAIT_L(8); PG8_BAR; PG8_WAIT_L(0); PG8_MMA(0, 0, At, B0); PG8_BAR; PG8_SCHED;
            PG8_LDB(B1, 0, 1); PG8_STAGE(PG8_SB(0, 0), b2, voffB);
            PG8_BAR; PG8_WAIT_L(0); PG8_MMA(0, 1, At, B1); PG8_BAR;
            PG8_LDA(At, 0, 1); PG8_STAGE(PG8_SA(0, 0), a2, o2[0]);
            PG8_BAR; PG8_WAIT_L(0); PG8_MMA(1, 0, At, B0); PG8_BAR; PG8_SCHED;
            PG8_STAGE(PG8_SB(0, 1), b2 + hstep, voffB);
            PG8_WAIT_V(6); PG8_BAR; PG8_MMA(1, 1, At, B1); PG8_BAR;
            PG8_LDB(B0, 1, 0); PG8_SCHED; PG8_LDA(At, 1, 0); PG8_STAGE(PG8_SA(0, 1), a2, o2[1]);
            PG8_WAIT_L(8); PG8_BAR; PG8_WAIT_L(0); PG8_MMA(0, 0, At, B0); PG8_BAR; PG8_SCHED;
            PG8_LDB(B1, 1, 1); PG8_STAGE(PG8_SB(1, 0), b3, voffB);
            PG8_BAR; PG8_WAIT_L(0); PG8_MMA(0, 1, At, B1); PG8_BAR;
            PG8_LDA(At, 1, 1); PG8_STAGE(PG8_SA(1, 0), a3, o2[0]);
            PG8_BAR; PG8_WAIT_L(0); PG8_MMA(1, 0, At, B0); PG8_BAR; PG8_SCHED;
            PG8_STAGE(PG8_SB(1, 1), b3 + hstep, voffB);
            PG8_WAIT_V(6); PG8_BAR; PG8_MMA(1, 1, At, B1); PG8_BAR;
            }
        }
        if constexpr (ALIGN_EPI) { if (wr == 0) PG8_BAR; }
        if constexpr (!Epi::AFTER_DRAIN) { E(acc, cur, wr, wc, fr, fq); }
        if (!has_next) break;
#pragma unroll
        for (int a = 0; a < 2; ++a)
#pragma unroll
            for (int b = 0; b < 2; ++b)
#pragma unroll
                for (int m = 0; m < 4; ++m)
#pragma unroll
                    for (int n = 0; n < 2; ++n) acc[a][b][m][n] = (f32x4){0.f, 0.f, 0.f, 0.f};
        cur = nxt; cB = nB; ++ui;
#pragma unroll
        for (int h = 0; h < 2; ++h)
#pragma unroll
            for (int i = 0; i < 2; ++i) oc[h][i] = on[h][i];
        if constexpr (ALIGN_EPI) { if (wr == 1) PG8_BAR; }
    }
    PG8_WAIT_V(0);
    if constexpr (!ALIGN_EPI) { if (wr == 0) PG8_BAR; }
    PG8_BAR;
#undef PG8_SA
#undef PG8_SB
#undef PG8_STAGE
#undef PG8_LDA
#undef PG8_LDB
#undef PG8_MMA
#undef PG8_WAIT_V
#undef PG8_WAIT_L
#undef PG8_BAR
#undef PG8_SCHED
}
}

namespace att {
#define ATT_LAS __attribute__((address_space(3)))
typedef unsigned short bf16_t;
using bf16x8 = __attribute__((ext_vector_type(8))) short;
using s16x4  = __attribute__((ext_vector_type(4))) short;
using f32x16 = __attribute__((ext_vector_type(16))) float;
using f32x4  = __attribute__((ext_vector_type(4))) float;
using u32x4  = __attribute__((ext_vector_type(4))) unsigned;
using u32x2  = __attribute__((ext_vector_type(2))) unsigned;
constexpr int SEQ = 4096, LDQKV = 3072, LDATT = 1024;
constexpr float LOG2E = 1.4426950408889634f;
#define ATT_SBAR() __builtin_amdgcn_sched_barrier(0)
__device__ __forceinline__ int opaque(int v) { asm volatile("" : "+v"(v)); return v; }
__device__ __forceinline__ void dma16(const void* g, ATT_LAS unsigned char* l) { __builtin_amdgcn_global_load_lds((const unsigned*)g, (ATT_LAS unsigned*)l, 16, 0, 0); }
__device__ __forceinline__ int swap23(int k) { return (k & ~0xC) | ((k & 4) << 1) | ((k & 8) >> 1); }
__device__ __forceinline__ int crow(int r, int hi) { return (r & 3) + 8 * (r >> 2) + 4 * hi; }
__device__ __forceinline__ unsigned cvtpk(float lo, float hi) { unsigned r; asm volatile("v_cvt_pk_bf16_f32 %0, %1, %2" : "=v"(r) : "v"(lo), "v"(hi)); return r; }
__device__ __forceinline__ int ksw(int row, int c) { return row * 128 + ((c ^ ((row >> 1) & 7)) << 4); }
template <int NC> __device__ __forceinline__ int v_st(int k, int c) { const int kk = (k & ~0xC) | ((k & 4) << 1) | ((k & 8) >> 1); return ((kk >> 3) * NC + (c >> 5)) * 512 + ((kk & 7) * 32 + (c & 31)) * 2; }
__device__ __forceinline__ int v_rd_base(int lane) { return ((lane & 3) << 3) | (((lane >> 2) & 3) << 6) | (((lane >> 4) & 1) << 5) | (((lane >> 5) & 1) << 8); }
template <int NC> constexpr int v_rd_off(int d0, int ks, int half) { return d0 * 512 + ks * (2 * NC * 512) + half * (NC * 512); }
template <int OFF> __device__ __forceinline__ s16x4 tr_read(int vb) {
  s16x4 r; asm volatile("ds_read_b64_tr_b16 %0, %1 offset:%2" : "=&v"(r) : "v"(vb), "i"(OFF) : "memory"); return r;
}
template <int NC, int D0> __device__ __forceinline__ void pv_one(f32x16& od, int vb, bf16x8 pa0, bf16x8 pa1, bf16x8 pa2, bf16x8 pa3) {
  const s16x4 l0 = tr_read<v_rd_off<NC>(D0, 0, 0)>(vb), h0 = tr_read<v_rd_off<NC>(D0, 0, 1)>(vb), l1 = tr_read<v_rd_off<NC>(D0, 1, 0)>(vb), h1 = tr_read<v_rd_off<NC>(D0, 1, 1)>(vb);
  const s16x4 l2 = tr_read<v_rd_off<NC>(D0, 2, 0)>(vb), h2 = tr_read<v_rd_off<NC>(D0, 2, 1)>(vb), l3 = tr_read<v_rd_off<NC>(D0, 3, 0)>(vb), h3 = tr_read<v_rd_off<NC>(D0, 3, 1)>(vb);
  asm volatile("s_waitcnt lgkmcnt(0)" ::: "memory"); ATT_SBAR();
#define ATT_PK(L, H) (bf16x8){L[0], L[1], L[2], L[3], H[0], H[1], H[2], H[3]}
  od = __builtin_amdgcn_mfma_f32_32x32x16_bf16(pa0, ATT_PK(l0, h0), od, 0, 0, 0);
  od = __builtin_amdgcn_mfma_f32_32x32x16_bf16(pa1, ATT_PK(l1, h1), od, 0, 0, 0);
  od = __builtin_amdgcn_mfma_f32_32x32x16_bf16(pa2, ATT_PK(l2, h2), od, 0, 0, 0);
  od = __builtin_amdgcn_mfma_f32_32x32x16_bf16(pa3, ATT_PK(l3, h3), od, 0, 0, 0);
#undef ATT_PK
}
__device__ __forceinline__ void qkt(f32x16& p0, f32x16& p1, const ATT_LAS unsigned char* Ks, const bf16x8 (&qr)[4], int r32, int hi) {
  p0 = f32x16{}; p1 = f32x16{};
#pragma unroll
  for (int d0 = 0; d0 < 4; ++d0) {
    const bf16x8 b0 = *(const ATT_LAS bf16x8*)(Ks + ksw(r32, 2 * d0 + hi));
    const bf16x8 b1 = *(const ATT_LAS bf16x8*)(Ks + ksw(32 + r32, 2 * d0 + hi));
    p0 = __builtin_amdgcn_mfma_f32_32x32x16_bf16(b0, qr[d0], p0, 0, 0, 0);
    p1 = __builtin_amdgcn_mfma_f32_32x32x16_bf16(b1, qr[d0], p1, 0, 0, 0);
    if (d0 == 1) ATT_SBAR(); }
}
template <int NO> __device__ __forceinline__ void online_sm(f32x16& p0, f32x16& p1, float& m_reg, float& l_reg, f32x16 (&o)[NO], ATT_LAS float* al_l, int r32, int hi,
                                                             bf16x8& pa0, bf16x8& pa1, bf16x8& pa2, bf16x8& pa3) {
  float pmax = p0[0];
#pragma unroll
  for (int r = 1; r < 16; ++r) pmax = fmaxf(pmax, p0[r]);
#pragma unroll
  for (int r = 0; r < 16; ++r) pmax = fmaxf(pmax, p1[r]);
  { auto rr = __builtin_amdgcn_permlane32_swap(__float_as_uint(pmax), __float_as_uint(pmax), false, false);
    pmax = fmaxf(__uint_as_float(rr[0]), __uint_as_float(rr[1])); }
  const float mn = fmaxf(m_reg, pmax);
  const float alpha = __builtin_amdgcn_exp2f(m_reg - mn);
  m_reg = mn;
#pragma unroll
  for (int r = 0; r < 16; ++r) { p0[r] = __builtin_amdgcn_exp2f(p0[r] - mn); p1[r] = __builtin_amdgcn_exp2f(p1[r] - mn); }
  float ps = 0.f;
#pragma unroll
  for (int r = 0; r < 16; ++r) ps += p0[r];
#pragma unroll
  for (int r = 0; r < 16; ++r) ps += p1[r];
  { auto rr = __builtin_amdgcn_permlane32_swap(__float_as_uint(ps), __float_as_uint(ps), false, false);
    ps = __uint_as_float(rr[0]) + __uint_as_float(rr[1]); }
  l_reg = l_reg * alpha + ps;
  if (__any(alpha < 1.f)) {
    if (hi == 0) al_l[r32] = alpha;
    asm volatile("s_waitcnt lgkmcnt(0)" ::: "memory");
#pragma unroll
    for (int r = 0; r < 16; ++r) { const float a = al_l[crow(r, hi)];
#pragma unroll
      for (int d = 0; d < NO; ++d) o[d][r] *= a; }
    asm volatile("s_waitcnt lgkmcnt(0)" ::: "memory");
  }
#define ATT_PK4(P, BASE, OUT) do { unsigned a0 = cvtpk(P[BASE + 0], P[BASE + 1]), a1 = cvtpk(P[BASE + 2], P[BASE + 3]);   \
    unsigned b0 = cvtpk(P[BASE + 4], P[BASE + 5]), b1 = cvtpk(P[BASE + 6], P[BASE + 7]);                              \
    auto r0 = __builtin_amdgcn_permlane32_swap(a0, b0, false, false); auto r1 = __builtin_amdgcn_permlane32_swap(a1, b1, false, false); \
    u32x4 w = {r0[0], r1[0], r0[1], r1[1]}; OUT = __builtin_bit_cast(bf16x8, w); } while (0)
  ATT_PK4(p0, 0, pa0); ATT_PK4(p0, 8, pa1); ATT_PK4(p1, 0, pa2); ATT_PK4(p1, 8, pa3);
#undef ATT_PK4
}

__device__ __forceinline__ void fox_unit(ATT_LAS unsigned char* lds, const bf16_t* __restrict__ qkv, bf16_t* __restrict__ attn, const float* __restrict__ cumloc, const float* __restrict__ blktot,
                                         int b, int h, int qb) {
  const int tid = opaque((int)threadIdx.x), lane = tid & 63, r32 = lane & 31, hi = lane >> 5; const int wid = __builtin_amdgcn_readfirstlane(tid >> 6);
  ATT_LAS float* BIAS = (ATT_LAS float*)(lds + 32768); ATT_LAS float* CARRY = (ATT_LAS float*)(lds + 33280); ATT_LAS float* wsf = (ATT_LAS float*)(lds + 33792) + wid * 64;
  const int q0 = qb * 256, NT = 4 * (qb + 1), jl = 4 * qb + (wid >> 1);
  const size_t rowb = (size_t)b * SEQ; const int bh = b * 8 + h;
  if (wid == 0 && lane < 32) { float s = 0.f; for (int k = 0; k < lane; ++k) s += blktot[(b * 32 + k) * 8 + h]; CARRY[lane] = s; }
  __syncthreads();
  const float cumq0 = CARRY[q0 >> 7] + cumloc[(size_t)bh * SEQ + q0];
  bf16x8 qr[4];
  { const bf16_t* Qw = qkv + (rowb + q0 + wid * 32 + r32) * LDQKV + h * 64 + hi * 8;
#pragma unroll
    for (int d0 = 0; d0 < 4; ++d0) qr[d0] = *(const bf16x8*)(Qw + d0 * 16); }
  const int pk = 64 * wid + lane;
  unsigned koff, voff;
  { const int row = pk >> 3, c = (pk & 7) ^ ((row >> 1) & 7); koff = (unsigned)((row * LDQKV + 512 + h * 64 + c * 8) * 2);
    const int sub = pk >> 5, kk = 8 * (sub >> 1) + ((pk & 31) >> 2), k = swap23(kk), cv = (sub & 1) * 32 + (pk & 3) * 8; voff = (unsigned)((k * LDQKV + 1024 + h * 64 + cv) * 2); }
  const char* tb = (const char*)(qkv + rowb * LDQKV);
  const float* cg = cumloc + (size_t)bh * SEQ + 4 * tid;
  const int vb0 = (int)(uintptr_t)(lds + 16384) + v_rd_base(lane);
  f32x4 breg = {0.f, 0.f, 0.f, 0.f};
#define FOX_LOAD(j, buf) do { const char* tj = tb + (size_t)(j) * (64 * LDQKV * 2); dma16(tj + koff, lds + (buf) * 8192 + wid * 1024); dma16(tj + voff, lds + 16384 + (buf) * 8192 + wid * 1024); \
    if (tid < 16) breg = *(const f32x4*)(cg + (j) * 64); } while (0)
#define FOX_WRITE(j, buf) do { \
    if (tid < 16) { const float c = cumq0 - CARRY[(j) >> 1]; f32x4 bv = (c - breg) * LOG2E; *(ATT_LAS f32x4*)(BIAS + (buf) * 64 + 4 * tid) = bv; } } while (0)
  FOX_LOAD(0, 0); FOX_WRITE(0, 0); asm volatile("s_waitcnt vmcnt(0)" ::: "memory"); __syncthreads();
  float m_reg = -1e30f, l_reg = 0.f; f32x16 o[2]; o[0] = f32x16{}; o[1] = f32x16{};
  for (int j = 0; j < NT; ++j) {
    const int cur = j & 1;
    if (j + 1 < NT) FOX_LOAD(j + 1, cur ^ 1);
    if (j <= jl) {
      f32x16 p0, p1; bf16x8 pa0, pa1, pa2, pa3;
      qkt(p0, p1, lds + cur * 8192, qr, r32, hi);
#pragma unroll
      for (int g = 0; g < 4; ++g) { const f32x4 b0 = *(const ATT_LAS f32x4*)(BIAS + cur * 64 + 8 * g + 4 * hi), b1 = *(const ATT_LAS f32x4*)(BIAS + cur * 64 + 32 + 8 * g + 4 * hi);
#pragma unroll
        for (int i = 0; i < 4; ++i) { p0[4 * g + i] += b0[i]; p1[4 * g + i] += b1[i]; } }
      if (j == jl) { const int qrel = 32 * (wid & 1) + r32;
#pragma unroll
        for (int r = 0; r < 16; ++r) { const int kr = crow(r, hi); if (kr > qrel) p0[r] = -1e30f; if (kr + 32 > qrel) p1[r] = -1e30f; } }
      online_sm<2>(p0, p1, m_reg, l_reg, o, wsf, r32, hi, pa0, pa1, pa2, pa3);
      pv_one<2, 0>(o[0], vb0 + cur * 8192, pa0, pa1, pa2, pa3); pv_one<2, 1>(o[1], vb0 + cur * 8192, pa0, pa1, pa2, pa3);
    }
    if (j + 1 < NT) FOX_WRITE(j + 1, cur ^ 1);
    asm volatile("s_waitcnt vmcnt(0)" ::: "memory"); __syncthreads();
  }
#undef FOX_LOAD
#undef FOX_WRITE
  if (hi == 0) wsf[32 + r32] = l_reg; asm volatile("s_waitcnt lgkmcnt(0)" ::: "memory");
  { const int le = opaque(lane), r32e = le & 31, hie = le >> 5;
  bf16_t* Ow = attn + (rowb + q0 + wid * 32) * LDATT + h * 64 + r32e;
#pragma unroll
  for (int r = 0; r < 16; ++r) { const int orow = crow(r, hie); const float rl = __builtin_amdgcn_rcpf(wsf[32 + orow]);
#pragma unroll
    for (int d0 = 0; d0 < 2; ++d0) { const unsigned w = cvtpk(o[d0][r] * rl, 0.f); Ow[(size_t)orow * LDATT + d0 * 32] = (bf16_t)(w & 0xffffu); } } }
  asm volatile("s_waitcnt lgkmcnt(0)" ::: "memory");
  __syncthreads();
}

__device__ __forceinline__ void diff_unit(ATT_LAS unsigned char* lds, const bf16_t* __restrict__ qkv, bf16_t* __restrict__ attn, const float* __restrict__ subln_g, float lam,
                                          int b, int h, int qb) {
  const int tid = opaque((int)threadIdx.x), lane = tid & 63, r32 = lane & 31, hi = lane >> 5; const int wid = __builtin_amdgcn_readfirstlane(tid >> 6);
  ATT_LAS float* wsf = (ATT_LAS float*)(lds + 69632) + wid * 64;
  const int map = wid >> 2, w4 = wid & 3;
  const int q0 = qb * 128, NT = 2 * (qb + 1), jl = 2 * qb + (w4 >> 1);
  const size_t rowb = (size_t)b * SEQ;
  const float sl2 = LOG2E * (h == 0 ? 0.25f : h == 1 ? 0.0625f : h == 2 ? 0.015625f : 0.00390625f);
  bf16x8 qr[4];
  { const bf16_t* Qw = qkv + (rowb + q0 + w4 * 32 + r32) * LDQKV + 1536 + h * 128 + map * 64 + hi * 8;
#pragma unroll
    for (int d0 = 0; d0 < 4; ++d0) qr[d0] = *(const bf16x8*)(Qw + d0 * 16); }
  const int pk = 64 * wid + lane;
  unsigned koff, voff0, voff1;
  { const int row = pk >> 3, c = (pk & 7) ^ ((row >> 1) & 7); koff = (unsigned)((row * LDQKV + 2048 + h * 128 + c * 8) * 2);
    const int sub0 = pk >> 5, kk0 = 8 * (sub0 >> 2) + ((pk & 31) >> 2), k0 = swap23(kk0), c0 = (sub0 & 3) * 32 + (pk & 3) * 8; voff0 = (unsigned)((k0 * LDQKV + 2560 + h * 128 + c0) * 2);
    const int p1 = pk + 512, sub1 = p1 >> 5, kk1 = 8 * (sub1 >> 2) + ((p1 & 31) >> 2), k1 = swap23(kk1), c1 = (sub1 & 3) * 32 + (p1 & 3) * 8; voff1 = (unsigned)((k1 * LDQKV + 2560 + h * 128 + c1) * 2); }
  const char* tb = (const char*)(qkv + rowb * LDQKV);
  const int vb0 = (int)(uintptr_t)(lds + 32768) + v_rd_base(lane);
#define DIFF_LOAD(j, buf) do { const char* tj = tb + (size_t)(j) * (64 * LDQKV * 2); dma16(tj + koff, lds + (buf) * 8192 + wid * 1024); dma16(tj + koff + 128, lds + 16384 + (buf) * 8192 + wid * 1024); \
    dma16(tj + voff0, lds + 32768 + (buf) * 16384 + wid * 1024); dma16(tj + voff1, lds + 32768 + (buf) * 16384 + 8192 + wid * 1024); } while (0)
  DIFF_LOAD(0, 0); asm volatile("s_waitcnt vmcnt(0)" ::: "memory"); __syncthreads();
  float m_reg = -1e30f, l_reg = 0.f; f32x16 o[4]; o[0] = f32x16{}; o[1] = f32x16{}; o[2] = f32x16{}; o[3] = f32x16{};
  for (int j = 0; j < NT; ++j) {
    const int cur = j & 1;
    if (j + 1 < NT) DIFF_LOAD(j + 1, cur ^ 1);
    if (j <= jl) {
      f32x16 p0, p1; bf16x8 pa0, pa1, pa2, pa3;
      qkt(p0, p1, lds + map * 16384 + cur * 8192, qr, r32, hi);
      if (j < jl) { const float tbf = (float)(64 * j - q0 + 4 * hi);
#pragma unroll
        for (int r = 0; r < 16; ++r) { const float cc = (float)((r & 3) + 8 * (r >> 2)); p0[r] = fmaf(sl2, tbf + cc, p0[r]); p1[r] = fmaf(sl2, tbf + (cc + 32.f), p1[r]); }
      } else { const int tq = 32 * w4 + r32 + q0 - 64 * j;
#pragma unroll
        for (int r = 0; r < 16; ++r) { const int k0 = crow(r, hi), k1 = k0 + 32; const int d0 = tq - k0, d1 = tq - k1;
          p0[r] += sl2 * (float)(64 * j - q0 + tq - (d0 < 0 ? -d0 : d0)); p1[r] += sl2 * (float)(64 * j - q0 + tq - (d1 < 0 ? -d1 : d1)); } }
      online_sm<4>(p0, p1, m_reg, l_reg, o, wsf, r32, hi, pa0, pa1, pa2, pa3);
      const int vb = vb0 + cur * 16384;
      pv_one<4, 0>(o[0], vb, pa0, pa1, pa2, pa3); pv_one<4, 1>(o[1], vb, pa0, pa1, pa2, pa3); pv_one<4, 2>(o[2], vb, pa0, pa1, pa2, pa3); pv_one<4, 3>(o[3], vb, pa0, pa1, pa2, pa3);
    }
    asm volatile("s_waitcnt vmcnt(0)" ::: "memory"); __syncthreads();
  }
#undef DIFF_LOAD
  if (hi == 0) wsf[32 + r32] = l_reg; asm volatile("s_waitcnt lgkmcnt(0)" ::: "memory");
  ATT_LAS float* X = (ATT_LAS float*)lds;
  const int te = opaque(tid), r32e = te & 31, hie = (te >> 5) & 1;
  if (map == 1) {
#pragma unroll
    for (int r = 0; r < 16; ++r) { const int orow = crow(r, hie); const float rl = __builtin_amdgcn_rcpf(wsf[32 + orow]);
#pragma unroll
      for (int d0 = 0; d0 < 4; ++d0) X[(32 * w4 + orow) * 132 + d0 * 32 + r32e] = o[d0][r] * rl; } }
  __syncthreads();
  if (map == 0) {
#pragma unroll
    for (int r = 0; r < 16; ++r) { const int orow = crow(r, hie); const float rl = __builtin_amdgcn_rcpf(wsf[32 + orow]);
#pragma unroll
      for (int d0 = 0; d0 < 4; ++d0) { const int idx = (32 * w4 + orow) * 132 + d0 * 32 + r32e; X[idx] = o[d0][r] * rl - lam * X[idx]; } } }
  __syncthreads();
  { const int row = te >> 2, qt = te & 3; float v[32]; float ss = 0.f;
#pragma unroll
    for (int i = 0; i < 8; ++i) { const f32x4 t = *(const ATT_LAS f32x4*)(X + row * 132 + qt * 32 + 4 * i); v[4 * i] = t[0]; v[4 * i + 1] = t[1]; v[4 * i + 2] = t[2]; v[4 * i + 3] = t[3];
      ss += t[0] * t[0] + t[1] * t[1] + t[2] * t[2] + t[3] * t[3]; }
    ss += __shfl_xor(ss, 1); ss += __shfl_xor(ss, 2);
    const float rstd = 0.8f / sqrtf(ss * (1.0f / 128.0f) + 1e-5f);
    bf16_t* op = attn + (rowb + q0 + row) * LDATT + 512 + h * 128 + qt * 32; const float* gp = subln_g + qt * 32;
#pragma unroll
    for (int i = 0; i < 4; ++i) { u32x4 w;
      w.x = cvtpk(v[8 * i + 0] * rstd * gp[8 * i + 0], v[8 * i + 1] * rstd * gp[8 * i + 1]); w.y = cvtpk(v[8 * i + 2] * rstd * gp[8 * i + 2], v[8 * i + 3] * rstd * gp[8 * i + 3]);
      w.z = cvtpk(v[8 * i + 4] * rstd * gp[8 * i + 4], v[8 * i + 5] * rstd * gp[8 * i + 5]); w.w = cvtpk(v[8 * i + 6] * rstd * gp[8 * i + 6], v[8 * i + 7] * rstd * gp[8 * i + 7]);
      *(u32x4*)(op + 8 * i) = w; } }
  __syncthreads();
}
#undef ATT_SBAR
}

constexpr int NWAVES = 8;
constexpr int BATCH = 8, SEQ = 4096, D = 1024, T = BATCH * SEQ;
constexpr int IN_COLS = 3080, NQKV = 3072;
constexpr int NEXP = 32, DEXP = 512, NSLOT_MAX = 73728;
constexpr int NPH = 9;
constexpr float C2 = 0.125f * 1.4426950408889634f;
constexpr float LAM_INIT = 0.2f;

constexpr size_t MiB = 1u << 20;
constexpr size_t WS_CTL = 0, CTL_ZERO_BYTES = 1 * MiB;
constexpr size_t WS_WIN = 1 * MiB;
constexpr size_t WS_WO = 7 * MiB;
constexpr size_t WS_WGU = 9 * MiB;
constexpr size_t WS_WD = 73 * MiB;
constexpr size_t WS_WR = 105 * MiB;
constexpr size_t WS_MOD = 106 * MiB;
constexpr size_t WS_CUM = 107 * MiB;
constexpr size_t WS_BLK = 108 * MiB;
constexpr size_t WS_RT = 109 * MiB;
constexpr size_t WS_STOK = 110 * MiB;
constexpr size_t WS_R = 118 * MiB;
constexpr size_t WS_H = WS_R;
constexpr size_t WS_QKV = WS_R + 64 * MiB;
constexpr size_t WS_Y = WS_R;
constexpr size_t WS_HID = WS_R + 144 * MiB;
constexpr size_t WS_END = WS_R + 256 * MiB;
constexpr int CW_BAR = 4096;
constexpr int CW_CNT = 16384;

constexpr int LDS_BYTES = 155648;
constexpr int MISC_OFF = LDS_BYTES - 256;

#define GAS __attribute__((address_space(1)))
#define LAS __attribute__((address_space(3)))
typedef unsigned short bf16;
typedef unsigned v4u __attribute__((ext_vector_type(4)));
typedef unsigned v2u __attribute__((ext_vector_type(2)));
typedef float f32x4 __attribute__((ext_vector_type(4)));
typedef GAS unsigned gu32;
#define RLX_AGENT __ATOMIC_RELAXED, __HIP_MEMORY_SCOPE_AGENT
#define LDS_WAIT() asm volatile("s_waitcnt lgkmcnt(0)" ::: "memory")
#define VM_WAIT() asm volatile("s_waitcnt vmcnt(0)" ::: "memory")
__device__ __forceinline__ unsigned f2bf(float f) { unsigned u = __builtin_bit_cast(unsigned, f); return (u + 0x7fffu + ((u >> 16) & 1u)) >> 16; }
__device__ __forceinline__ unsigned pk2(float lo, float hi) { return f2bf(lo) | (f2bf(hi) << 16); }
__device__ __forceinline__ float bflo(unsigned w) { return __builtin_bit_cast(float, w << 16); }
__device__ __forceinline__ float bfhi(unsigned w) { return __builtin_bit_cast(float, w & 0xffff0000u); }
__device__ __forceinline__ float wave_sum(float v) {
#pragma unroll
    for (int o = 1; o < 64; o <<= 1) v += __shfl_xor(v, o);
    return v;
}
#define XB_TMO      128
#define XB_XCNT(j)  (256  + 64 * (j))
#define XB_XSUB(j)  (1280 + 64 * (j))
#define XB_XGEN(j)  (2304 + 64 * (j))
#define XB_TOP      3328
#define XB_TOPGEN   3392
#define XCD_BAR_WORDS 3456
#define XB_SPIN_CAP (1u << 18)

__device__ __forceinline__ unsigned xb_ld(unsigned* p)              { return __hip_atomic_load(p, __ATOMIC_RELAXED, __HIP_MEMORY_SCOPE_AGENT); }
__device__ __forceinline__ unsigned xb_add(unsigned* p, unsigned v) { return __hip_atomic_fetch_add(p, v, __ATOMIC_RELAXED, __HIP_MEMORY_SCOPE_AGENT); }
__device__ __forceinline__ unsigned xb_xcc_id() { return (unsigned)__builtin_amdgcn_s_getreg((3 << 11) | 20) & 0xFu; }
#define XB_SPIN(cond, bar) do { unsigned _sp = 0; while (cond) { __builtin_amdgcn_s_sleep(1); \
    if ((++_sp & 255u) == 0u) { if (xb_ld(&(bar)[XB_TMO])) break; if (_sp > XB_SPIN_CAP) { atomicAdd(&(bar)[XB_TMO], 1u); break; } } } } while (0)

struct XcdBarrier {
    unsigned* bar; unsigned x;
    volatile LAS unsigned* st;
};

__device__ __forceinline__ XcdBarrier xcd_barrier_post(unsigned* bar, volatile LAS unsigned* st) {
    XcdBarrier b; b.bar = bar; b.x = xb_xcc_id(); b.st = st;
    if (threadIdx.x == 0) (void)xb_add(&bar[XB_XCNT(b.x)], 1u);
    return b;
}
__device__ __forceinline__ void xcd_barrier_complete(unsigned* bar, unsigned x, unsigned& nloc, unsigned& nx) {
    const unsigned G = gridDim.x * gridDim.y * gridDim.z;
    unsigned sum, cnt, mine, sp = 0u;
    for (;;) {
        sum = 0u; cnt = 0u; mine = 0u;
#pragma unroll
        for (unsigned j = 0; j < 16; ++j) { const unsigned c = xb_ld(&bar[XB_XCNT(j)]); sum += c; cnt += (c > 0u) ? 1u : 0u; mine = (j == x) ? c : mine; }
        if (sum == G) break;
        __builtin_amdgcn_s_sleep(1);
        if ((++sp & 255u) == 0u) { if (xb_ld(&bar[XB_TMO])) break; if (sp > XB_SPIN_CAP) { atomicAdd(&bar[XB_TMO], 1u); break; } }
    }
    nloc = mine > 0u ? mine : 1u; nx = cnt > 0u ? cnt : 1u;
}

__device__ __forceinline__ void xcd_barrier(const XcdBarrier& b) {
    asm volatile("s_waitcnt vmcnt(0)" ::: "memory");
    __syncthreads();
    if (threadIdx.x == 0) {
        unsigned* bar = b.bar;
        __builtin_amdgcn_s_waitcnt(0);
        unsigned nloc = b.st[0], nx = b.st[1];
        if (nloc == 0u) { xcd_barrier_complete(bar, b.x, nloc, nx); b.st[0] = nloc; b.st[1] = nx; }
        const unsigned old = xb_add(&bar[XB_XSUB(b.x)], 1u);
        const unsigned gen = old / nloc;
        if (old + 1u == (gen + 1u) * nloc) {
            __builtin_amdgcn_fence(__ATOMIC_RELEASE, "agent");
            asm volatile("s_waitcnt vmcnt(0)" ::: "memory");
            const unsigned og = xb_add(&bar[XB_TOP], 1u);
            const unsigned tg = og / nx;
            if (og + 1u == (tg + 1u) * nx) xb_add(&bar[XB_TOPGEN], 1u);
            else XB_SPIN(xb_ld(&bar[XB_TOPGEN]) == tg, bar);
            __builtin_amdgcn_fence(__ATOMIC_ACQUIRE, "agent");
            xb_add(&bar[XB_XGEN(b.x)], 1u);
            asm volatile("s_waitcnt vmcnt(0)" ::: "memory");
        } else {
            XB_SPIN(xb_ld(&bar[XB_XGEN(b.x)]) == gen, bar);
            __builtin_amdgcn_fence(__ATOMIC_ACQUIRE, "agent");
            asm volatile("s_waitcnt vmcnt(0)" ::: "memory");
        }
    }
    __syncthreads();
}

__device__ __forceinline__ void tr_item(const float* __restrict__ src, int ldS, bf16* __restrict__ dst, int ldD, float scale, LAS float* scr, int lane) {
#pragma unroll 8
    for (int i = 0; i < 32; ++i) { const int kk = 2 * i + (lane >> 5); scr[kk * 33 + (lane & 31)] = src[(size_t)kk * ldS + (lane & 31)]; }
    LDS_WAIT(); asm volatile("" ::: "memory");
    const int c = lane & 7;
#pragma unroll
    for (int j = 0; j < 4; ++j) { const int n = (lane >> 3) + 8 * j; const LAS float* s = scr + (8 * c) * 33 + n;
        v4u o; o.x = pk2(s[0 * 33] * scale, s[1 * 33] * scale); o.y = pk2(s[2 * 33] * scale, s[3 * 33] * scale); o.z = pk2(s[4 * 33] * scale, s[5 * 33] * scale); o.w = pk2(s[6 * 33] * scale, s[7 * 33] * scale);
        *(v4u*)(dst + (size_t)n * ldD + 8 * c) = o; }
    LDS_WAIT(); asm volatile("" ::: "memory");
}
struct P0Args { const float *c, *ada_w, *ada_b, *w_in, *w_o, *w_rg, *w_re, *w_gate, *w_up, *w_down; bf16 *Wt_in, *Wt_o, *Wt_gu, *Wt_d; float *Wr, *mod; };
__device__ __forceinline__ void p0_prologue(const P0Args& a, LAS unsigned char* lds, int vcu, int G, int tid, int wave, int lane) {
    LAS float* scr = (LAS float*)(lds + wave * 8448);
    const int gw = vcu * NWAVES + wave, NGW = G * NWAVES;
    constexpr int I_IN = 16 * 96, I_O = 16 * 32, I_GU = 32 * 16 * 32, I_D = 32 * 8 * 32;
    constexpr int NITEMS = I_IN + I_O + I_GU + I_D;
    for (int it = gw; it < NITEMS; it += NGW) {
        int r = it;
        if (r < I_IN) { const int kb = r / 96, nb = r % 96, n0 = 32 * nb, sc = n0 < 1536 ? n0 : n0 + 8;
            const float scale = (n0 < 512 || (n0 >= 1536 && n0 < 2048)) ? C2 : 1.0f;
            tr_item(a.w_in + (size_t)(64 * kb) * IN_COLS + sc, IN_COLS, a.Wt_in + (size_t)n0 * 1024 + 64 * kb, 1024, scale, scr, lane); continue; }
        r -= I_IN;
        if (r < I_O) { const int kb = r / 32, nb = r % 32;
            tr_item(a.w_o + (size_t)(64 * kb) * 1024 + 32 * nb, 1024, a.Wt_o + (size_t)(32 * nb) * 1024 + 64 * kb, 1024, 1.0f, scr, lane); continue; }
        r -= I_O;
        if (r < I_GU) { const int e = r / 512, q = r % 512, kb = q / 32, nb = q % 32, n0 = 32 * nb, pn = n0 >> 8, bj = (n0 >> 7) & 1, j0 = n0 & 127;
            const float* src = (bj ? a.w_up : a.w_gate) + (size_t)e * 1024 * 512 + (size_t)(64 * kb) * 512 + 128 * pn + j0;
            tr_item(src, 512, a.Wt_gu + ((size_t)e * 1024 + n0) * 1024 + 64 * kb, 1024, 1.0f, scr, lane); continue; }
        r -= I_GU;
        { const int e = r / 256, q = r % 256, kb = q / 32, nb = q % 32;
            tr_item(a.w_down + (size_t)e * 512 * 1024 + (size_t)(64 * kb) * 1024 + 32 * nb, 1024, a.Wt_d + ((size_t)e * 1024 + 32 * nb) * 512 + 64 * kb, 512, 1.0f, scr, lane); }
    }
    for (int i = (vcu * NWAVES * 64 + tid); i < 36 * 1024; i += G * NWAVES * 64) { const int n = i >> 10, k = i & 1023;
        a.Wr[i] = n < 32 ? a.w_re[k * 32 + n] : a.w_rg[k * 4 + (n - 32)]; }
    __syncthreads();
    LAS float* cs = (LAS float*)(lds + 69632);
    LAS float* red = (LAS float*)(lds + 69632 + 32768);
    for (int i = tid; i < 8192; i += NWAVES * 64) cs[i] = a.c[i];
    __syncthreads();
    for (int ch = vcu; ch < 96; ch += G) {
        float acc[8];
#pragma unroll
        for (int b = 0; b < 8; ++b) acc[b] = 0.f;
        const float* wp = a.ada_w + (size_t)(wave * 128) * 6144 + ch * 64 + lane;
#pragma unroll 8
        for (int k = 0; k < 128; ++k) { const float wv = wp[(size_t)k * 6144];
#pragma unroll
            for (int b = 0; b < 8; ++b) acc[b] = fmaf(cs[b * 1024 + wave * 128 + k], wv, acc[b]); }
#pragma unroll
        for (int b = 0; b < 8; ++b) red[(wave * 8 + b) * 64 + lane] = acc[b];
        __syncthreads();
        { const int b = tid >> 6, l = tid & 63; float s = a.ada_b[ch * 64 + l];
#pragma unroll
          for (int w = 0; w < 8; ++w) s += red[(w * 8 + b) * 64 + l];
          a.mod[b * 6144 + ch * 64 + l] = s; }
        __syncthreads();
    }
}

__device__ __forceinline__ void p1_norm(const float* __restrict__ x, const float* __restrict__ g1, const float* __restrict__ mod, const float* __restrict__ w_in, const float* __restrict__ b_f,
                                        bf16* __restrict__ H, float* __restrict__ cumloc, float* __restrict__ blktot, LAS unsigned char* lds, int vcu, int G, int tid, int wave, int lane) {
    LAS float* wfz = (LAS float*)lds; LAS float* lf = (LAS float*)(lds + 32768); LAS float* segtot = (LAS float*)(lds + 36864);
    for (int i = tid; i < 8192; i += NWAVES * 64) { const int jh = i >> 10, k = i & 1023; wfz[i] = w_in[(size_t)k * IN_COLS + 1536 + jh]; }
    __syncthreads();
    for (int rb = vcu; rb < T / 128; rb += G) {
        const int b = rb >> 5;
        f32x4 A[4], Bc[4];
#pragma unroll
        for (int j = 0; j < 4; ++j) { const int col = 256 * j + 4 * lane; const f32x4 g = *(const f32x4*)(g1 + col), sc = *(const f32x4*)(mod + b * 6144 + 1024 + col);
            A[j] = g * (1.0f + sc); Bc[j] = *(const f32x4*)(mod + b * 6144 + col); }
        const float bfv = b_f[lane & 7];
        for (int rr = 0; rr < 16; ++rr) {
            const int row = rb * 128 + wave * 16 + rr;
            const f32x4* xr = (const f32x4*)(x + (size_t)row * D) + lane;
            f32x4 v[4]; float s = 0.f;
#pragma unroll
            for (int j = 0; j < 4; ++j) { v[j] = xr[64 * j]; s += (v[j].x * v[j].x + v[j].y * v[j].y) + (v[j].z * v[j].z + v[j].w * v[j].w); }
            const float rstd = 1.0f / sqrtf(wave_sum(s) * (1.0f / D) + 1e-6f);
#pragma unroll
            for (int j = 0; j < 4; ++j) v[j] = v[j] * rstd * A[j] + Bc[j];
            v2u* o8 = (v2u*)(H + (size_t)row * D) + lane;
#pragma unroll
            for (int j = 0; j < 4; ++j) { v2u w; w.x = pk2(v[j].x, v[j].y); w.y = pk2(v[j].z, v[j].w); o8[64 * j] = w; }
            float z = 0.f;
#pragma unroll
            for (int jh = 0; jh < 8; ++jh) { float acc = 0.f;
#pragma unroll
                for (int j = 0; j < 4; ++j) { const f32x4 w4 = *(const LAS f32x4*)(wfz + jh * 1024 + 256 * j + 4 * lane); acc += (v[j].x * w4.x + v[j].y * w4.y) + (v[j].z * w4.z + v[j].w * w4.w); }
                acc = wave_sum(acc); z = ((lane & 7) == jh) ? acc : z; }
            z += bfv;
            const float lfv = fminf(z, 0.f) - log1pf(expf(-fabsf(z)));
            if (lane < 8) lf[(wave * 16 + rr) * 8 + lane] = lfv;
        }
        __syncthreads();
        float run[16]; const int hh = tid & 7, seg = (tid >> 3) & 7;
        if (tid < 64) { float s = 0.f;
#pragma unroll
            for (int i = 0; i < 16; ++i) { s += lf[(seg * 16 + i) * 8 + hh]; run[i] = s; }
            segtot[seg * 8 + hh] = s; }
        __syncthreads();
        if (tid < 64) { float off = 0.f;
            for (int s2 = 0; s2 < seg; ++s2) off += segtot[s2 * 8 + hh];
            float* cp = cumloc + (size_t)(b * 8 + hh) * SEQ + (rb & 31) * 128 + seg * 16;
#pragma unroll
            for (int i = 0; i < 4; ++i) { f32x4 t; t.x = run[4 * i] + off; t.y = run[4 * i + 1] + off; t.z = run[4 * i + 2] + off; t.w = run[4 * i + 3] + off; *(f32x4*)(cp + 4 * i) = t; }
            if (seg == 7) blktot[rb * 8 + hh] = run[15] + off; }
        __syncthreads();
    }
}

__device__ __forceinline__ void p5_route(const float* __restrict__ x1, const float* __restrict__ g2, const float* __restrict__ mod, const float* __restrict__ Wr, const float* __restrict__ b_rg, const float* __restrict__ b_re,
                                         bf16* __restrict__ H2, gu32* cnt, int* __restrict__ stok, int* __restrict__ rt_e, int* __restrict__ rt_pos, float* __restrict__ rt_w,
                                         LAS unsigned char* lds, int vcu, int G, int tid, int wave, int lane) {
    LAS float* wr = (LAS float*)lds; LAS unsigned* CNT = (LAS unsigned*)(lds + 147456); LAS unsigned* BASE = (LAS unsigned*)(lds + 147584); LAS unsigned* REC = (LAS unsigned*)(lds + 147712);
    for (int i = tid; i < 36 * 1024 / 4; i += NWAVES * 64) ((LAS f32x4*)wr)[i] = ((const f32x4*)Wr)[i];
    if (tid < 32) CNT[tid] = 0u;
    __syncthreads();
    for (int rb = vcu; rb < T / 128; rb += G) {
        const int b = rb >> 5;
        f32x4 A[4], Bc[4];
#pragma unroll
        for (int j = 0; j < 4; ++j) { const int col = 256 * j + 4 * lane; const f32x4 g = *(const f32x4*)(g2 + col), sc = *(const f32x4*)(mod + b * 6144 + 4096 + col);
            A[j] = g * (1.0f + sc); Bc[j] = *(const f32x4*)(mod + b * 6144 + 3072 + col); }
        for (int rr = 0; rr < 16; ++rr) {
            const int rl = wave * 16 + rr, row = rb * 128 + rl;
            const f32x4* xr = (const f32x4*)(x1 + (size_t)row * D) + lane;
            f32x4 v[4]; float s = 0.f;
#pragma unroll
            for (int j = 0; j < 4; ++j) { v[j] = xr[64 * j]; s += (v[j].x * v[j].x + v[j].y * v[j].y) + (v[j].z * v[j].z + v[j].w * v[j].w); }
            const float rstd = 1.0f / sqrtf(wave_sum(s) * (1.0f / D) + 1e-6f);
#pragma unroll
            for (int j = 0; j < 4; ++j) v[j] = v[j] * rstd * A[j] + Bc[j];
            v2u* o8 = (v2u*)(H2 + (size_t)row * D) + lane;
#pragma unroll
            for (int j = 0; j < 4; ++j) { v2u w; w.x = pk2(v[j].x, v[j].y); w.y = pk2(v[j].z, v[j].w); o8[64 * j] = w; }
            float L[36];
#pragma unroll
            for (int n = 0; n < 36; ++n) { float acc = 0.f;
#pragma unroll
                for (int j = 0; j < 4; ++j) { const f32x4 w4 = *(const LAS f32x4*)(wr + n * 1024 + 256 * j + 4 * lane); acc += (v[j].x * w4.x + v[j].y * w4.y) + (v[j].z * w4.z + v[j].w * w4.w); }
                L[n] = wave_sum(acc); if ((n & 3) == 3) __builtin_amdgcn_sched_barrier(0); }
            float gl[4];
#pragma unroll
            for (int i = 0; i < 4; ++i) gl[i] = L[32 + i] + b_rg[i];
            int g = 0; float gm = gl[0];
#pragma unroll
            for (int i = 1; i < 4; ++i) if (gl[i] > gm) { gm = gl[i]; g = i; }
            float gs = 0.f;
#pragma unroll
            for (int i = 0; i < 4; ++i) gs += expf(gl[i] - gm);
            const float pg = 1.0f / gs;
            float el[8];
#pragma unroll
            for (int i = 0; i < 8; ++i) { const float v0 = L[i] + b_re[i], v1 = L[8 + i] + b_re[8 + i], v2 = L[16 + i] + b_re[16 + i], v3 = L[24 + i] + b_re[24 + i];
                el[i] = g == 0 ? v0 : g == 1 ? v1 : g == 2 ? v2 : v3; }
            int i1 = 0; float m1 = el[0];
#pragma unroll
            for (int i = 1; i < 8; ++i) if (el[i] > m1) { m1 = el[i]; i1 = i; }
            int i2 = -1; float m2 = -3.0e38f;
#pragma unroll
            for (int i = 0; i < 8; ++i) if (i != i1 && el[i] > m2) { m2 = el[i]; i2 = i; }
            const float ex = expf(m2 - m1); const float w1 = pg / (1.0f + ex), w2 = pg * ex / (1.0f + ex);
            if (lane == 0) { const int e1 = g * 8 + i1, e2 = g * 8 + i2;
                const unsigned p1 = __hip_atomic_fetch_add(&CNT[e1], 1u, __ATOMIC_RELAXED, __HIP_MEMORY_SCOPE_WORKGROUP), p2 = __hip_atomic_fetch_add(&CNT[e2], 1u, __ATOMIC_RELAXED, __HIP_MEMORY_SCOPE_WORKGROUP);
                REC[(rl * 2 + 0) * 4 + 0] = (unsigned)e1; REC[(rl * 2 + 0) * 4 + 1] = p1; REC[(rl * 2 + 0) * 4 + 2] = __float_as_uint(w1);
                REC[(rl * 2 + 1) * 4 + 0] = (unsigned)e2; REC[(rl * 2 + 1) * 4 + 1] = p2; REC[(rl * 2 + 1) * 4 + 2] = __float_as_uint(w2); }
        }
        __syncthreads();
        if (tid < 32) BASE[tid] = __hip_atomic_fetch_add(cnt + 64 * tid, CNT[tid], RLX_AGENT);
        __syncthreads();
        if (tid < 256) { const unsigned e = REC[tid * 4 + 0], pl = REC[tid * 4 + 1], wb = REC[tid * 4 + 2]; const unsigned pos = BASE[e] + pl; const int tok = rb * 128 + (tid >> 1);
            stok[(size_t)e * 65536 + pos] = tok; rt_e[tok * 2 + (tid & 1)] = (int)e; rt_pos[tok * 2 + (tid & 1)] = (int)pos; rt_w[tok * 2 + (tid & 1)] = __uint_as_float(wb); }
        __syncthreads();
        if (tid < 32) CNT[tid] = 0u;
        __syncthreads();
    }
}

__device__ __forceinline__ void moe_tables(gu32* cnt, LAS int* TB, LAS int* CN, int tid) {
    if (tid == 0) { int s = 0;
        for (int e = 0; e < 32; ++e) { const int c = (int)__hip_atomic_load(cnt + 64 * e, RLX_AGENT); CN[e] = c; TB[e] = s; s += (c + 255) >> 8; }
        TB[32] = s; }
    __syncthreads();
}
struct MoeOrder {
    const LAS int* TB; const LAS int* CN; const int* stok; int G, c; bool gather;
    __device__ __forceinline__ bool next(int i, pg8::Unit& u) const {
        const int L = i * G + c; if (L >= 4 * TB[32]) return false;
        const int gt = L >> 2, ct = L & 3; int e = 0;
        for (int k = 1; k < 32; ++k) e += (gt >= TB[k]) ? 1 : 0;
        u.pm = gt; u.pn = e * 4 + ct; u.e = e; return true;
    }
    __device__ __forceinline__ void a_off(const pg8::Unit& u, const int (&RA)[2], const int (&CA)[2], int K, unsigned (&off)[2][2]) const {
        if (gather) {
            const int p0 = (u.pm - TB[u.e]) * 256, n = CN[u.e];
#pragma unroll
            for (int h = 0; h < 2; ++h)
#pragma unroll
                for (int i = 0; i < 2; ++i) { const int pos = p0 + h * 128 + RA[i]; const int tok = pos < n ? stok[(size_t)u.e * 65536 + pos] : 0;
                    off[h][i] = (unsigned)(((size_t)tok * K + CA[i]) * 2); }
            __builtin_amdgcn_s_waitcnt(0x0F70);
        } else {
#pragma unroll
            for (int h = 0; h < 2; ++h)
#pragma unroll
                for (int i = 0; i < 2; ++i) off[h][i] = (unsigned)(((size_t)(u.pm * 256 + h * 128 + RA[i]) * K + CA[i]) * 2);
        }
    }
};

__device__ __forceinline__ void p8_final(float* __restrict__ xo, const bf16* __restrict__ Y, const float* __restrict__ mod, const float* __restrict__ gf,
                                         const int* __restrict__ rt_e, const int* __restrict__ rt_pos, const float* __restrict__ rt_w, const LAS int* TB,
                                         int vcu, int G, int wave, int lane) {
    const int gw = vcu * NWAVES + wave, NGW = G * NWAVES;
    f32x4 gfv[4];
#pragma unroll
    for (int j = 0; j < 4; ++j) gfv[j] = *(const f32x4*)(gf + 256 * j + 4 * lane);
    for (int row = gw; row < T; row += NGW) {
        const int b = row >> 12;
        const int e0 = rt_e[row * 2], e1 = rt_e[row * 2 + 1]; const int s0 = TB[e0] * 256 + rt_pos[row * 2], s1 = TB[e1] * 256 + rt_pos[row * 2 + 1];
        const float w0 = rt_w[row * 2], w1 = rt_w[row * 2 + 1];
        f32x4* xr = (f32x4*)(xo + (size_t)row * D) + lane;
        const v2u* y0 = (const v2u*)(Y + (size_t)s0 * D) + lane; const v2u* y1 = (const v2u*)(Y + (size_t)s1 * D) + lane;
        f32x4 v[4]; float s = 0.f;
#pragma unroll
        for (int j = 0; j < 4; ++j) { const f32x4 xv = xr[64 * j]; const v2u a = y0[64 * j], c = y1[64 * j]; const f32x4 g2 = *(const f32x4*)(mod + b * 6144 + 5120 + 256 * j + 4 * lane);
            f32x4 y; y.x = w0 * bflo(a.x) + w1 * bflo(c.x); y.y = w0 * bfhi(a.x) + w1 * bfhi(c.x); y.z = w0 * bflo(a.y) + w1 * bflo(c.y); y.w = w0 * bfhi(a.y) + w1 * bfhi(c.y);
            v[j] = xv + g2 * y; s += (v[j].x * v[j].x + v[j].y * v[j].y) + (v[j].z * v[j].z + v[j].w * v[j].w); }
        const float rstd = 1.0f / sqrtf(wave_sum(s) * (1.0f / D) + 1e-6f);
#pragma unroll
        for (int j = 0; j < 4; ++j) xr[64 * j] = v[j] * rstd * gfv[j];
    }
}

struct Args { const float* in[22]; float* out; unsigned char* ws; int ph_lo, ph_hi; };
__global__ void __launch_bounds__(NWAVES * 64, 2) fwd_kernel(Args args) {
    extern __shared__ __attribute__((aligned(16))) unsigned char lds_raw[];
    LAS unsigned char* lds = (LAS unsigned char*)lds_raw;
    volatile LAS unsigned* MISC = (volatile LAS unsigned*)(lds + MISC_OFF);
    const int tid = threadIdx.x, lane = tid & 63, wave = __builtin_amdgcn_readfirstlane(tid >> 6);
    const int G = gridDim.x; const int bx = blockIdx.x; const int vcu = (G % 8 == 0) ? (bx % 8) * (G / 8) + bx / 8 : bx;
    unsigned char* ws = args.ws;
    gu32* ctl = (gu32*)(ws + WS_CTL);
    const float* x = args.in[0]; const float* c_in = args.in[1]; const float* ada_w = args.in[2]; const float* ada_b = args.in[3]; const float* norm1_g = args.in[4];
    const float* w_in = args.in[5]; const float* b_f = args.in[6]; const float* lam_q1 = args.in[7]; const float* lam_k1 = args.in[8]; const float* lam_q2 = args.in[9]; const float* lam_k2 = args.in[10];
    const float* subln_g = args.in[11]; const float* w_o = args.in[12]; const float* norm2_g = args.in[13]; const float* w_rg = args.in[14]; const float* b_rg = args.in[15];
    const float* w_re = args.in[16]; const float* b_re = args.in[17]; const float* w_gate = args.in[18]; const float* w_up = args.in[19]; const float* w_down = args.in[20]; const float* norm_f_g = args.in[21];
    float* out = args.out;
    bf16* Wt_in = (bf16*)(ws + WS_WIN); bf16* Wt_o = (bf16*)(ws + WS_WO); bf16* Wt_gu = (bf16*)(ws + WS_WGU); bf16* Wt_d = (bf16*)(ws + WS_WD);
    float* Wr = (float*)(ws + WS_WR); float* mod = (float*)(ws + WS_MOD); float* cumloc = (float*)(ws + WS_CUM); float* blktot = (float*)(ws + WS_BLK);
    int* rt_e = (int*)(ws + WS_RT); int* rt_pos = rt_e + 2 * T; float* rt_w = (float*)(rt_pos + 2 * T); int* stok = (int*)(ws + WS_STOK);
    bf16* HB = (bf16*)(ws + WS_H); bf16* QKV = (bf16*)(ws + WS_QKV); bf16* YB = (bf16*)(ws + WS_Y); bf16* HID = (bf16*)(ws + WS_HID);
    gu32* cnt = ctl + CW_CNT;

    if (tid < 64) MISC[tid] = 0u;
    __syncthreads();
    XcdBarrier bar = xcd_barrier_post((unsigned*)(ctl + CW_BAR), MISC + 8);
    const int lo = args.ph_lo, hi = args.ph_hi;
#ifndef PHASE_MASK
#define PHASE_MASK 0x1ff
#endif
#define IN(k) ((((PHASE_MASK) >> (k)) & 1) && lo <= (k) && (k) < hi)
#define SEAM(k) do { if (IN(k) && IN((k) + 1)) xcd_barrier(bar); } while (0)

    if (IN(0)) {
        P0Args a{c_in, ada_w, ada_b, w_in, w_o, w_rg, w_re, w_gate, w_up, w_down, Wt_in, Wt_o, Wt_gu, Wt_d, Wr, mod};
        p0_prologue(a, lds, vcu, G, tid, wave, lane);
    }
    SEAM(0);
    if (IN(1)) p1_norm(x, norm1_g, mod, w_in, b_f, HB, cumloc, blktot, lds, vcu, G, tid, wave, lane);
    SEAM(1);
    if (IN(2)) {
        pg8::Gemm g{HB, Wt_in, T, NQKV, D}; pg8::StaticOrder S; S.init(T, NQKV, G, bx);
        pg8::EpiStore E{QKV, NQKV, 0xffff};
        pg8::gemm_phase<pg8::EpiStore, pg8::StaticOrder, true, true>(lds, g, S, E);
    }
    SEAM(2);
    if (IN(3)) {
        float lam;
        { const float a = wave_sum(lam_q1[lane] * lam_k1[lane]), b2 = wave_sum(lam_q2[lane] * lam_k2[lane]); lam = expf(a) - expf(b2) + LAM_INIT; }
        for (int v = vcu; v < 256; v += G) {
            const int b = v >> 5, ci = v & 31;
#ifndef NO_DIFF
#pragma unroll 1
            for (int s = 0; s < 4; ++s) { const int qb = (s & 1) ? 31 - ci : ci; att::diff_unit(lds, QKV, HB, subln_g, lam, b, s, qb); }
#endif
#ifndef NO_FOX
#pragma unroll 1
            for (int p = 0; p < 4; ++p) { const int h = 2 * p + (ci >> 4), i16 = ci & 15, qb = (p & 1) ? 15 - i16 : i16; att::fox_unit(lds, QKV, HB, cumloc, blktot, b, h, qb); }
#endif
        }
    }
    SEAM(3);
    if (IN(4)) {
        pg8::Gemm g{HB, Wt_o, T, D, D}; pg8::StaticOrder S; S.init(T, D, G, bx);
        pg8::EpiResid E{x, out, mod + 2048};
        pg8::gemm_phase<pg8::EpiResid, pg8::StaticOrder, true, true>(lds, g, S, E);
    }
    SEAM(4);
    if (IN(5)) p5_route(out, norm2_g, mod, Wr, b_rg, b_re, HB, cnt, stok, rt_e, rt_pos, rt_w, lds, vcu, G, tid, wave, lane);
    SEAM(5);
    LAS int* TB = (LAS int*)(lds + 131072); LAS int* CN = (LAS int*)(lds + 131072 + 256);
    if (IN(6)) {
        moe_tables(cnt, TB, CN, tid);
        pg8::Gemm g{HB, Wt_gu, T, 1024, D}; MoeOrder S{TB, CN, stok, G, bx, true};
        pg8::EpiSwiglu E{HID};
        pg8::gemm_phase<pg8::EpiSwiglu, MoeOrder, true, true>(lds, g, S, E);
    }
    SEAM(6);
    if (IN(7)) {
        moe_tables(cnt, TB, CN, tid);
        pg8::Gemm g{HID, Wt_d, NSLOT_MAX, 1024, DEXP}; MoeOrder S{TB, CN, stok, G, bx, false};
        pg8::EpiStore E{YB, 1024, 3};
        pg8::gemm_phase<pg8::EpiStore, MoeOrder, true, true>(lds, g, S, E);
    }
    SEAM(7);
    if (IN(8)) {
        moe_tables(cnt, TB, CN, tid);
        p8_final(out, YB, mod, norm_f_g, rt_e, rt_pos, rt_w, TB, vcu, G, wave, lane);
    }
#undef IN
#undef SEAM
}

#ifndef MK_N_LAUNCHES
#define MK_N_LAUNCHES 1
#endif
extern "C" void kernel_launch(void* const* d_in, const int* in_sizes, int n_in, void* d_out, int out_size, void* d_ws, size_t ws_size, hipStream_t stream) {
    static int grid = 0;
    if (grid == 0) {
        if (n_in != 22 || in_sizes[0] != T * D || out_size != T * D || ws_size < WS_END) { fprintf(stderr, "kernel_launch: shape/workspace mismatch (n_in %d, in0 %d, out %d, ws %zu, need %zu)\n", n_in, n_in > 0 ? in_sizes[0] : -1, out_size, ws_size, (size_t)WS_END); grid = -1; return; }
        int dev = 0, cus = 0, per_cu = 0;
        if (hipGetDevice(&dev) != hipSuccess || hipDeviceGetAttribute(&cus, hipDeviceAttributeMultiprocessorCount, dev) != hipSuccess) { grid = -1; return; }
        if (hipFuncSetAttribute((const void*)fwd_kernel, hipFuncAttributeMaxDynamicSharedMemorySize, LDS_BYTES) != hipSuccess) { fprintf(stderr, "kernel_launch: hipFuncSetAttribute failed\n"); grid = -1; return; }
        if (hipOccupancyMaxActiveBlocksPerMultiprocessor(&per_cu, (const void*)fwd_kernel, NWAVES * 64, LDS_BYTES) != hipSuccess || per_cu < 1) fprintf(stderr, "kernel_launch: occupancy query reports %d\n", per_cu);
        (void)hipGetLastError();
        grid = cus > 0 ? cus : 256;
    }
    if (grid < 0) return;
    (void)hipMemsetAsync((char*)d_ws + WS_CTL, 0, CTL_ZERO_BYTES, stream);
    Args a{};
    for (int i = 0; i < 22; ++i) a.in[i] = (const float*)d_in[i];
    a.out = (float*)d_out; a.ws = (unsigned char*)d_ws;
    if (MK_N_LAUNCHES == 1) { a.ph_lo = 0; a.ph_hi = NPH; hipLaunchKernelGGL(fwd_kernel, dim3(grid), dim3(NWAVES * 64), LDS_BYTES, stream, a); }
    else for (int p = 0; p < NPH; ++p) { a.ph_lo = p; a.ph_hi = p + 1; hipLaunchKernelGGL(fwd_kernel, dim3(grid), dim3(NWAVES * 64), LDS_BYTES, stream, a); }
    const hipError_t le = hipPeekAtLastError();
    if (le != hipSuccess) fprintf(stderr, "kernel_launch: launch failed: %s\n", hipGetErrorName(le));
}
```

```cpp
#include <hip/hip_runtime.h>
#include <hip/hip_bf16.h>
#include <cstdio>
#include <cstdint>

__device__ __forceinline__ int fresh_lane() { int l; asm volatile("v_mbcnt_lo_u32_b32 %0, -1, 0\n\tv_mbcnt_hi_u32_b32 %0, -1, %0" : "=v"(l)); return l; }
template <int M> __device__ __forceinline__ float lx_get(float v) {
    static_assert(M == 1 || M == 2 || M == 4 || M == 8 || M == 16, "lx_get: M");
    return __builtin_bit_cast(float, __builtin_amdgcn_ds_swizzle(__builtin_bit_cast(int, v), (M << 10) | 0x1f));
}
__device__ __forceinline__ void swap32(float v, float& lo, float& hi) { const unsigned a = __float_as_uint(v);
    auto rr = __builtin_amdgcn_permlane32_swap(a, a, false, false); const unsigned r0 = rr[0], r1 = rr[1]; lo = __uint_as_float(r0); hi = __uint_as_float(r1); }
__device__ __forceinline__ float lx_sum32(float v) { float lo, hi; swap32(v, lo, hi); return lo + hi; }
__device__ __forceinline__ float lx_max32(float v) { float lo, hi; swap32(v, lo, hi); return fmaxf(lo, hi); }
namespace pg8 {
#define PG8_LAS __attribute__((address_space(3)))
typedef unsigned short bf16_t;
typedef short bf16x8 __attribute__((ext_vector_type(8)));
typedef float f32x4 __attribute__((ext_vector_type(4)));
typedef unsigned u32x4 __attribute__((ext_vector_type(4)));
constexpr int BM = 256, BK = 64, HALF = 128, HTB = HALF * BK * 2  , STAGE_BYTES = 8 * HTB, NXCD = 8, WGM = 8;

__host__ __device__ __forceinline__ int lds_byte(int r, int c) { const int st = (r >> 4) * 2 + (c >> 5), rr = r & 15, cc = c & 31, ob = rr * 64 + cc * 2; return st * 1024 + (ob ^ (((ob >> 9) & 1) << 5)); }
__host__ __device__ __forceinline__ void stage_rc(int b, int& R, int& C) { const int st = b / 1024, sb = b % 1024, swz = sb ^ (((sb >> 9) & 1) << 5); R = (st >> 1) * 16 + swz / 64; C = (st & 1) * 32 + (swz % 64) / 2; }
__host__ __device__ __forceinline__ int perm32(int rho) { const int n = rho >> 4, i = rho & 15; return 8 * (i >> 2) + 4 * n + (i & 3); }

struct Unit { int pm, pn, e; };
struct Gemm { const bf16_t* A; const bf16_t* Bt; int M, N, K; };

struct StaticOrder {
    int nM, nN, nwg, G, c;
    __host__ __device__ void init(int M, int N, int G_, int c_) { nM = M / BM; nN = N / BM; nwg = nM * nN; G = G_; c = c_; }
    __host__ __device__ bool next(int i, Unit& u) const {
        const long L = (long)i * G + c; if (L >= nwg) return false;
        int wgid = (int)L; { const int q = nwg / NXCD, r = nwg % NXCD, xcd = wgid % NXCD, off = wgid / NXCD; wgid = (xcd < r ? xcd * (q + 1) : r * (q + 1) + (xcd - r) * q) + off; }
        const int nig = WGM * nN, gid = wgid / nig, fm = gid * WGM, gsz = (nM - fm) < WGM ? (nM - fm) : WGM;
        u.pm = fm + ((wgid % nig) % gsz); u.pn = (wgid % nig) / gsz; u.e = 0; return true;
    }
    __device__ __forceinline__ void a_off(const Unit& u, const int (&RA)[2], const int (&CA)[2], int K, unsigned (&off)[2][2]) const {
#pragma unroll
        for (int h = 0; h < 2; ++h)
#pragma unroll
            for (int i = 0; i < 2; ++i) off[h][i] = (unsigned)(((size_t)(u.pm * BM + h * HALF + RA[i]) * K + CA[i]) * 2);
    }
};


__device__ __forceinline__ unsigned cvt_pk_bf16(float lo, float hi) { unsigned r; asm volatile("v_cvt_pk_bf16_f32 %0, %1, %2" : "=v"(r) : "v"(lo), "v"(hi)); return r; }

struct EpiStore {
    static constexpr bool PERM = true, AFTER_DRAIN = false;
    bf16_t* O; int ldc; int pn_mask; unsigned* km;
    __device__ __forceinline__ void operator()(const f32x4 (&acc)[2][2][4][2], const Unit& u, int wr, int wc, int fr, int fq) const {
        const int row0 = u.pm * BM + wr * 64 + fr; const int col0 = (u.pn & pn_mask) * BM + wc * 32 + 8 * fq;
        if (km && (u.pn == 2 || u.pn == 3 || u.pn == 8 || u.pn == 9)) {
#pragma unroll
            for (int bj = 0; bj < 2; ++bj) { float mx = 0.f;
#pragma unroll
                for (int ai = 0; ai < 2; ++ai)
#pragma unroll
                    for (int m = 0; m < 4; ++m) { const f32x4 v0 = acc[ai][bj][m][0], v1 = acc[ai][bj][m][1];
                        float ss = (v0[0] * v0[0] + v0[1] * v0[1]) + (v0[2] * v0[2] + v0[3] * v0[3]) + (v1[0] * v1[0] + v1[1] * v1[1]) + (v1[2] * v1[2] + v1[3] * v1[3]);
                        ss += lx_get<16>(ss); ss = lx_sum32(ss); mx = fmaxf(mx, ss); }
                mx = fmaxf(mx, lx_get<1>(mx)); mx = fmaxf(mx, lx_get<2>(mx)); mx = fmaxf(mx, lx_get<4>(mx)); mx = fmaxf(mx, lx_get<8>(mx));
                if ((fr | fq) == 0) __hip_atomic_fetch_max(km + (u.pm >> 4) * 96 + (u.pn * BM + bj * HALF + wc * 32) / 32, __float_as_uint(mx), __ATOMIC_RELAXED, __HIP_MEMORY_SCOPE_AGENT); }
        }
#pragma unroll
        for (int ai = 0; ai < 2; ++ai)
#pragma unroll
            for (int m = 0; m < 4; ++m) { bf16_t* rowp = O + (size_t)(row0 + ai * HALF + m * 16) * ldc + col0;
#pragma unroll
                for (int bj = 0; bj < 2; ++bj) { const f32x4 v0 = acc[ai][bj][m][0], v1 = acc[ai][bj][m][1];
                    u32x4 w; w.x = cvt_pk_bf16(v0[0], v0[1]); w.y = cvt_pk_bf16(v0[2], v0[3]); w.z = cvt_pk_bf16(v1[0], v1[1]); w.w = cvt_pk_bf16(v1[2], v1[3]);
                    *(u32x4*)(rowp + bj * HALF) = w; } }
    }
};
struct EpiSwiglu {
    static constexpr bool PERM = true, AFTER_DRAIN = false;
    bf16_t* H;
    __device__ __forceinline__ void operator()(const f32x4 (&acc)[2][2][4][2], const Unit& u, int wr, int wc, int fr, int fq) const {
        const int row0 = u.pm * BM + wr * 64 + fr; const int col0 = (u.pn & 3) * 128 + wc * 32 + 8 * fq;
#pragma unroll
        for (int ai = 0; ai < 2; ++ai)
#pragma unroll
            for (int m = 0; m < 4; ++m) { bf16_t* rowp = H + (size_t)(row0 + ai * HALF + m * 16) * 512 + col0;
                float hv[8];
#pragma unroll
                for (int n = 0; n < 2; ++n)
#pragma unroll
                    for (int i = 0; i < 4; ++i) { const float g = acc[ai][0][m][n][i], up = acc[ai][1][m][n][i];
                        const float e = __builtin_amdgcn_exp2f(-g * 1.4426950408889634f);
                        hv[n * 4 + i] = g * __builtin_amdgcn_rcpf(1.0f + e) * up; }
                u32x4 w; w.x = cvt_pk_bf16(hv[0], hv[1]); w.y = cvt_pk_bf16(hv[2], hv[3]); w.z = cvt_pk_bf16(hv[4], hv[5]); w.w = cvt_pk_bf16(hv[6], hv[7]);
                *(u32x4*)rowp = w; }
    }
};
struct EpiResid {
    static constexpr bool PERM = false, AFTER_DRAIN = false;
    const float* base; float* out; const float* gate;
    __device__ __forceinline__ void operator()(const f32x4 (&acc)[2][2][4][2], const Unit& u, int wr, int wc, int fr, int fq) const {
        const int col0 = u.pn * BM + wc * 32 + 4 * fq; const float* gp = gate + (size_t)(u.pm >> 4) * 6144 + col0;
        f32x4 gv[2][2];
#pragma unroll
        for (int bj = 0; bj < 2; ++bj)
#pragma unroll
            for (int n = 0; n < 2; ++n) gv[bj][n] = *(const f32x4*)(gp + bj * HALF + n * 16);
#pragma unroll
        for (int ai = 0; ai < 2; ++ai)
#pragma unroll
            for (int m = 0; m < 4; ++m) { const size_t off = (size_t)(u.pm * BM + ai * HALF + wr * 64 + m * 16 + fr) * 1024 + col0;
#pragma unroll
                for (int bj = 0; bj < 2; ++bj)
#pragma unroll
                    for (int n = 0; n < 2; ++n) { const f32x4 bs = *(const f32x4*)(base + off + bj * HALF + n * 16);
                        *(f32x4*)(out + off + bj * HALF + n * 16) = bs + gv[bj][n] * acc[ai][bj][m][n]; } }
    }
};

template <class Epi, class Sched, bool ALIGN_EPI = false, bool SP2 = false>
__device__ __forceinline__ void gemm_phase(PG8_LAS unsigned char* lds, const Gemm g, const Sched& S, const Epi& E, int wave) {
    const int wid = wave, lane = fresh_lane(), tid = wid * 64 + lane, wr = wid >> 2, wc = wid & 3, fr = lane & 15, fq = lane >> 4;
    const int K = g.K, nt = K / BK;
    int RA[2], CA[2]; unsigned voffB[2];
#pragma unroll
    for (int i = 0; i < 2; ++i) { int R, C; stage_rc(tid * 16 + i * 8192, R, C); const int Rb = Epi::PERM ? ((R & ~31) + perm32(R & 31)) : R;
        RA[i] = R; CA[i] = C; voffB[i] = (unsigned)(Rb * K + C) * 2u; }
    const size_t kstep = (size_t)(BK * 2);
    const size_t hstep = (size_t)HALF * K * 2;
    const size_t tstep = 2 * hstep;
    const unsigned ldsw = (unsigned)wid * 1024u;
    const int aoff = lds_byte(wr * 64 + fr, fq * 8), boff = lds_byte(wc * 32 + fr, fq * 8);
#define PG8_SA(b, h) (((b) * 2 + (h)) * HTB)
#define PG8_SB(b, h) ((4 + (b) * 2 + (h)) * HTB)
#define PG8_STAGE(bufoff, gbase, voff) do { _Pragma("unroll") for (int _i = 0; _i < 2; ++_i) \
        __builtin_amdgcn_global_load_lds((const unsigned*)((const char*)(gbase) + (voff)[_i]), (PG8_LAS unsigned*)(lds + (bufoff) + ldsw + _i * 8192), 16, 0, 0); } while (0)
#define PG8_LDA(dst, b, h) do { _Pragma("unroll") for (int m = 0; m < 4; ++m) _Pragma("unroll") for (int k = 0; k < 2; ++k) dst[m][k] = *(const PG8_LAS bf16x8*)(lds + PG8_SA(b, h) + aoff + m * 2048 + k * 1024); } while (0)
#define PG8_LDB(dst, b, h) do { _Pragma("unroll") for (int n = 0; n < 2; ++n) _Pragma("unroll") for (int k = 0; k < 2; ++k) dst[n][k] = *(const PG8_LAS bf16x8*)(lds + PG8_SB(b, h) + boff + n * 2048 + k * 1024); } while (0)
#define PG8_MMA(ai, bj, At, Bt) do { __builtin_amdgcn_s_setprio(1); _Pragma("unroll") for (int m = 0; m < 4; ++m) _Pragma("unroll") for (int n = 0; n < 2; ++n) _Pragma("unroll") for (int k = 0; k < 2; ++k) \
        acc[ai][bj][m][n] = __builtin_amdgcn_mfma_f32_16x16x32_bf16(Bt[n][k], At[m][k], acc[ai][bj][m][n], 0, 0, 0); __builtin_amdgcn_s_setprio(0); } while (0)
#define PG8_WAIT_V(n) asm volatile("s_waitcnt vmcnt(" #n ")" ::: "memory")
#define PG8_WAIT_L(n) asm volatile("s_waitcnt lgkmcnt(" #n ")" ::: "memory")
#define PG8_BAR __builtin_amdgcn_s_barrier()
#define PG8_SCHED __builtin_amdgcn_sched_barrier(0)
    Unit cur, nxt; int ui = 0;
    if (!S.next(0, cur)) return;
    f32x4 acc[2][2][4][2];
#pragma unroll
    for (int a = 0; a < 2; ++a)
#pragma unroll
        for (int b = 0; b < 2; ++b)
#pragma unroll
            for (int m = 0; m < 4; ++m)
#pragma unroll
                for (int n = 0; n < 2; ++n) acc[a][b][m][n] = (f32x4){0.f, 0.f, 0.f, 0.f};
    bf16x8 At[4][2], B0[2][2], B1[2][2];
    unsigned oc[2][2], on[2][2];
    S.a_off(cur, RA, CA, K, oc);
    const char* A0 = (const char*)g.A;
    const char* cB = (const char*)g.Bt + (size_t)cur.pn * tstep;
    if constexpr (SP2) {
        PG8_STAGE(PG8_SB(0, 0), cB, voffB); PG8_STAGE(PG8_SB(0, 1), cB + hstep, voffB); PG8_STAGE(PG8_SA(0, 0), A0, oc[0]); PG8_STAGE(PG8_SA(0, 1), A0, oc[1]);
        if (wr == 1) PG8_BAR;
        PG8_WAIT_V(2); PG8_BAR;
        PG8_STAGE(PG8_SB(1, 0), cB + kstep, voffB); PG8_STAGE(PG8_SA(1, 0), A0 + kstep, oc[0]); PG8_STAGE(PG8_SB(1, 1), cB + hstep + kstep, voffB);
        PG8_WAIT_V(6); PG8_BAR;
    } else {
        PG8_STAGE(PG8_SB(0, 0), cB, voffB); PG8_STAGE(PG8_SA(0, 0), A0, oc[0]); PG8_STAGE(PG8_SB(0, 1), cB + hstep, voffB); PG8_STAGE(PG8_SA(0, 1), A0, oc[1]);
        if (wr == 1) PG8_BAR;
        PG8_WAIT_V(4); PG8_BAR;
        PG8_STAGE(PG8_SB(1, 0), cB + kstep, voffB); PG8_STAGE(PG8_SA(1, 0), A0 + kstep, oc[0]); PG8_STAGE(PG8_SB(1, 1), cB + hstep + kstep, voffB);
        PG8_WAIT_V(6); PG8_BAR;
    }
    for (;;) {
        const bool has_next = S.next(ui + 1, nxt);
        if (has_next) S.a_off(nxt, RA, CA, K, on);
        else {
#pragma unroll
            for (int h = 0; h < 2; ++h)
#pragma unroll
                for (int i = 0; i < 2; ++i) on[h][i] = oc[h][i]; }
        const char* nB = has_next ? (const char*)g.Bt + (size_t)nxt.pn * tstep : cB;
        for (int t = 0; t < nt; t += 2) {
            const bool last = (t == nt - 2);
            const char* a1 = A0 + (size_t)(t + 1) * kstep;
            const char* a2 = last ? A0 : A0 + (size_t)(t + 2) * kstep; const char* b2 = last ? nB : cB + (size_t)(t + 2) * kstep;
            const char* a3 = a2 + kstep; const char* b3 = b2 + kstep;
            unsigned o2[2][2];
#pragma unroll
            for (int h = 0; h < 2; ++h)
#pragma unroll
                for (int i = 0; i < 2; ++i) o2[h][i] = last ? on[h][i] : oc[h][i];
            if constexpr (SP2) {
            PG8_LDB(B0, 0, 0); PG8_LDB(B1, 0, 1); PG8_SCHED; PG8_LDA(At, 0, 0); PG8_STAGE(PG8_SA(1, 1), a1, oc[1]);
            PG8_WAIT_V(8); PG8_WAIT_L(0); PG8_BAR; PG8_MMA(0, 0, At, B0); PG8_MMA(0, 1, At, B1); PG8_BAR; PG8_SCHED;
            PG8_LDA(At, 0, 1); PG8_STAGE(PG8_SB(0, 0), b2, voffB); PG8_STAGE(PG8_SB(0, 1), b2 + hstep, voffB); PG8_STAGE(PG8_SA(0, 0), a2, o2[0]);
            PG8_WAIT_V(8); PG8_WAIT_L(0); PG8_BAR; PG8_MMA(1, 0, At, B0); PG8_MMA(1, 1, At, B1); PG8_BAR; PG8_SCHED;
            PG8_LDB(B0, 1, 0); PG8_LDB(B1, 1, 1); PG8_SCHED; PG8_LDA(At, 1, 0); PG8_STAGE(PG8_SA(0, 1), a2, o2[1]);
            PG8_WAIT_V(8); PG8_WAIT_L(0); PG8_BAR; PG8_MMA(0, 0, At, B0); PG8_MMA(0, 1, At, B1); PG8_BAR; PG8_SCHED;
            PG8_LDA(At, 1, 1); PG8_STAGE(PG8_SB(1, 0), b3, voffB); PG8_STAGE(PG8_SB(1, 1), b3 + hstep, voffB); PG8_STAGE(PG8_SA(1, 0), a3, o2[0]);
            PG8_WAIT_V(8); PG8_WAIT_L(0); PG8_BAR; PG8_MMA(1, 0, At, B0); PG8_MMA(1, 1, At, B1); PG8_BAR; PG8_SCHED;
            } else {
            PG8_LDB(B0, 0, 0); PG8_SCHED; PG8_LDA(At, 0, 0); PG8_STAGE(PG8_SA(1, 1), a1, oc[1]);
            PG8_WAIT_L(8); PG8_BAR; PG8_WAIT_L(0); PG8_MMA(0, 0, At, B0); PG8_BAR; PG8_SCHED;
            PG8_LDB(B1, 0, 1); PG8_STAGE(PG8_SB(0, 0), b2, voffB);
            PG8_BAR; PG8_WAIT_L(0); PG8_MMA(0, 1, At, B1); PG8_BAR;
            PG8_LDA(At, 0, 1); PG8_STAGE(PG8_SA(0, 0), a2, o2[0]);
            PG8_BAR; PG8_WAIT_L(0); PG8_MMA(1, 0, At, B0); PG8_BAR; PG8_SCHED;
            PG8_STAGE(PG8_SB(0, 1), b2 + hstep, voffB);
            PG8_WAIT_V(6); PG8_BAR; PG8_MMA(1, 1, At, B1); PG8_BAR;
            PG8_LDB(B0, 1, 0); PG8_SCHED; PG8_LDA(At, 1, 0); PG8_STAGE(PG8_SA(0, 1), a2, o2[1]);
            PG8_WAIT_L(8); PG8_BAR; PG8_WAIT_L(0); PG8_MMA(0, 0, At, B0); PG8_BAR; PG8_SCHED;
            PG8_LDB(B1, 1, 1); PG8_STAGE(PG8_SB(1, 0), b3, voffB);
            PG8_BAR; PG8_WAIT_L(0); PG8_MMA(0, 1, At, B1); PG8_BAR;
            PG8_LDA(At, 1, 1); PG8_STAGE(PG8_SA(1, 0), a3, o2[0]);
            PG8_BAR; PG8_WAIT_L(0); PG8_MMA(1, 0, At, B0); PG8_BAR; PG8_SCHED;
            PG8_STAGE(PG8_SB(1, 1), b3 + hstep, voffB);
            PG8_WAIT_V(6); PG8_BAR; PG8_MMA(1, 1, At, B1); PG8_BAR;
            }
        }
        if constexpr (ALIGN_EPI) { if (wr == 0) PG8_BAR; }
        if constexpr (!Epi::AFTER_DRAIN) { E(acc, cur, wr, wc, fr, fq); }
        if (!has_next) break;
#pragma unroll
        for (int a = 0; a < 2; ++a)
#pragma unroll
            for (int b = 0; b < 2; ++b)
#pragma unroll
                for (int m = 0; m < 4; ++m)
#pragma unroll
                    for (int n = 0; n < 2; ++n) acc[a][b][m][n] = (f32x4){0.f, 0.f, 0.f, 0.f};
        cur = nxt; cB = nB; ++ui;
#pragma unroll
        for (int h = 0; h < 2; ++h)
#pragma unroll
            for (int i = 0; i < 2; ++i) oc[h][i] = on[h][i];
        if constexpr (ALIGN_EPI) { if (wr == 1) PG8_BAR; }
    }
    PG8_WAIT_V(0);
    if constexpr (!ALIGN_EPI) { if (wr == 0) PG8_BAR; }
    PG8_BAR;
#undef PG8_SA
#undef PG8_SB
#undef PG8_STAGE
#undef PG8_LDA
#undef PG8_LDB
#undef PG8_MMA
#undef PG8_WAIT_V
#undef PG8_WAIT_L
#undef PG8_BAR
#undef PG8_SCHED
}
}

namespace att {
#define ATT_LAS __attribute__((address_space(3)))
typedef unsigned short bf16_t;
using bf16x8 = __attribute__((ext_vector_type(8))) short;
using s16x4  = __attribute__((ext_vector_type(4))) short;
using f32x16 = __attribute__((ext_vector_type(16))) float;
using f32x4  = __attribute__((ext_vector_type(4))) float;
using u32x4  = __attribute__((ext_vector_type(4))) unsigned;
using u32x2  = __attribute__((ext_vector_type(2))) unsigned;
constexpr int SEQ = 4096, LDQKV = 3072, LDATT = 1024;
constexpr float LOG2E = 1.4426950408889634f;
#define ATT_SBAR() __builtin_amdgcn_sched_barrier(0)
__device__ __forceinline__ int opaque(int v) { asm volatile("" : "+v"(v)); return v; }
__device__ __forceinline__ void dma16(const void* g, ATT_LAS unsigned char* l) { __builtin_amdgcn_global_load_lds((const unsigned*)g, (ATT_LAS unsigned*)l, 16, 0, 0); }
__device__ __forceinline__ int swap23(int k) { return (k & ~0xC) | ((k & 4) << 1) | ((k & 8) >> 1); }
__device__ __forceinline__ int crow(int r, int hi) { return (r & 3) + 8 * (r >> 2) + 4 * hi; }
__device__ __forceinline__ unsigned cvtpk(float lo, float hi) { unsigned r; asm volatile("v_cvt_pk_bf16_f32 %0, %1, %2" : "=v"(r) : "v"(lo), "v"(hi)); return r; }
__device__ __forceinline__ int ksw(int row, int c) { return row * 128 + ((c ^ ((row >> 1) & 7)) << 4); }
template <int NC> __device__ __forceinline__ int v_st(int k, int c) { const int kk = (k & ~0xC) | ((k & 4) << 1) | ((k & 8) >> 1); return ((kk >> 3) * NC + (c >> 5)) * 512 + ((kk & 7) * 32 + (c & 31)) * 2; }
__device__ __forceinline__ int v_rd_base(int lane) { return ((lane & 3) << 3) | (((lane >> 2) & 3) << 6) | (((lane >> 4) & 1) << 5) | (((lane >> 5) & 1) << 8); }
template <int NC> constexpr int v_rd_off(int d0, int ks, int half) { return d0 * 512 + ks * (2 * NC * 512) + half * (NC * 512); }
template <int OFF> __device__ __forceinline__ s16x4 tr_read(int vb) {
  s16x4 r; asm volatile("ds_read_b64_tr_b16 %0, %1 offset:%2" : "=&v"(r) : "v"(vb), "i"(OFF) : "memory"); return r;
}
template <int NC, int D0> __device__ __forceinline__ void pv_one(f32x16& od, int vb, bf16x8 pa0, bf16x8 pa1, bf16x8 pa2, bf16x8 pa3) {
  const s16x4 l0 = tr_read<v_rd_off<NC>(D0, 0, 0)>(vb), h0 = tr_read<v_rd_off<NC>(D0, 0, 1)>(vb), l1 = tr_read<v_rd_off<NC>(D0, 1, 0)>(vb), h1 = tr_read<v_rd_off<NC>(D0, 1, 1)>(vb);
  const s16x4 l2 = tr_read<v_rd_off<NC>(D0, 2, 0)>(vb), h2 = tr_read<v_rd_off<NC>(D0, 2, 1)>(vb), l3 = tr_read<v_rd_off<NC>(D0, 3, 0)>(vb), h3 = tr_read<v_rd_off<NC>(D0, 3, 1)>(vb);
  asm volatile("s_waitcnt lgkmcnt(0)" ::: "memory"); ATT_SBAR();
#define ATT_PK(L, H) (bf16x8){L[0], L[1], L[2], L[3], H[0], H[1], H[2], H[3]}
  od = __builtin_amdgcn_mfma_f32_32x32x16_bf16(pa0, ATT_PK(l0, h0), od, 0, 0, 0);
  od = __builtin_amdgcn_mfma_f32_32x32x16_bf16(pa1, ATT_PK(l1, h1), od, 0, 0, 0);
  od = __builtin_amdgcn_mfma_f32_32x32x16_bf16(pa2, ATT_PK(l2, h2), od, 0, 0, 0);
  od = __builtin_amdgcn_mfma_f32_32x32x16_bf16(pa3, ATT_PK(l3, h3), od, 0, 0, 0);
#undef ATT_PK
}
__device__ __forceinline__ void qkt(f32x16& p0, f32x16& p1, const ATT_LAS unsigned char* Ks, const bf16x8 (&qr)[4], int r32, int hi) {
  p0 = f32x16{}; p1 = f32x16{};
#pragma unroll
  for (int d0 = 0; d0 < 4; ++d0) {
    const bf16x8 b0 = *(const ATT_LAS bf16x8*)(Ks + ksw(r32, 2 * d0 + hi));
    const bf16x8 b1 = *(const ATT_LAS bf16x8*)(Ks + ksw(32 + r32, 2 * d0 + hi));
    p0 = __builtin_amdgcn_mfma_f32_32x32x16_bf16(b0, qr[d0], p0, 0, 0, 0);
    p1 = __builtin_amdgcn_mfma_f32_32x32x16_bf16(b1, qr[d0], p1, 0, 0, 0);
    if (d0 == 1) ATT_SBAR(); }
}
template <int NO> __device__ __forceinline__ void online_sm(f32x16& p0, f32x16& p1, float& m_reg, float& l_reg, f32x16 (&o)[NO], ATT_LAS float* al_l, int r32, int hi,
                                                             bf16x8& pa0, bf16x8& pa1, bf16x8& pa2, bf16x8& pa3, float c2) {
  float pmax = p0[0];
#pragma unroll
  for (int r = 1; r < 16; ++r) pmax = fmaxf(pmax, p0[r]);
#pragma unroll
  for (int r = 0; r < 16; ++r) pmax = fmaxf(pmax, p1[r]);
  pmax = lx_max32(pmax);
  const float meff = m_reg - c2;
  const float mn = fmaxf(meff, pmax);
  const float alpha = __builtin_amdgcn_exp2f(meff - mn);
  m_reg = mn + c2;
#pragma unroll
  for (int r = 0; r < 16; ++r) { p0[r] = __builtin_amdgcn_exp2f(p0[r] - mn); p1[r] = __builtin_amdgcn_exp2f(p1[r] - mn); }
  float ps = 0.f;
#pragma unroll
  for (int r = 0; r < 16; ++r) ps += p0[r];
#pragma unroll
  for (int r = 0; r < 16; ++r) ps += p1[r];
  ps = lx_sum32(ps);
  l_reg = l_reg * alpha + ps;
  if (__any(alpha < 1.f)) {
    if (hi == 0) al_l[r32] = alpha;
    asm volatile("s_waitcnt lgkmcnt(0)" ::: "memory");
#pragma unroll
    for (int r = 0; r < 16; ++r) { const float a = al_l[crow(r, hi)];
#pragma unroll
      for (int d = 0; d < NO; ++d) o[d][r] *= a; }
    asm volatile("s_waitcnt lgkmcnt(0)" ::: "memory");
  }
#define ATT_PK4(P, BASE, OUT) do { unsigned a0 = cvtpk(P[BASE + 0], P[BASE + 1]), a1 = cvtpk(P[BASE + 2], P[BASE + 3]);   \
    unsigned b0 = cvtpk(P[BASE + 4], P[BASE + 5]), b1 = cvtpk(P[BASE + 6], P[BASE + 7]);                              \
    auto r0 = __builtin_amdgcn_permlane32_swap(a0, b0, false, false); auto r1 = __builtin_amdgcn_permlane32_swap(a1, b1, false, false); \
    u32x4 w = {r0[0], r1[0], r0[1], r1[1]}; OUT = __builtin_bit_cast(bf16x8, w); } while (0)
  ATT_PK4(p0, 0, pa0); ATT_PK4(p0, 8, pa1); ATT_PK4(p1, 0, pa2); ATT_PK4(p1, 8, pa3);
#undef ATT_PK4
}

__device__ __forceinline__ void qkt_bias(f32x16& p0, f32x16& p1, const ATT_LAS float* BT, const ATT_LAS unsigned char* Ks, const bf16x8 (&qr)[4], int r32, int hi) {
#pragma unroll
  for (int g = 0; g < 4; ++g) { const f32x4 b0 = *(const ATT_LAS f32x4*)(BT + 8 * g + 4 * hi), b1 = *(const ATT_LAS f32x4*)(BT + 32 + 8 * g + 4 * hi);
#pragma unroll
    for (int i = 0; i < 4; ++i) { p0[4 * g + i] = b0[i]; p1[4 * g + i] = b1[i]; } }
#pragma unroll
  for (int d0 = 0; d0 < 4; ++d0) {
    const bf16x8 b0 = *(const ATT_LAS bf16x8*)(Ks + ksw(r32, 2 * d0 + hi));
    const bf16x8 b1 = *(const ATT_LAS bf16x8*)(Ks + ksw(32 + r32, 2 * d0 + hi));
    p0 = __builtin_amdgcn_mfma_f32_32x32x16_bf16(b0, qr[d0], p0, 0, 0, 0);
    p1 = __builtin_amdgcn_mfma_f32_32x32x16_bf16(b1, qr[d0], p1, 0, 0, 0);
    if (d0 == 1) ATT_SBAR(); }
}

constexpr float SKIP_T = 40.0f;
__device__ __forceinline__ float q_norm(const bf16x8 (&qr)[4]) {
  float s = 0.f;
#pragma unroll
  for (int d0 = 0; d0 < 4; ++d0)
#pragma unroll
    for (int e = 0; e < 8; ++e) { const float v = __uint_as_float(((unsigned)(unsigned short)qr[d0][e]) << 16); s = fmaf(v, v, s); }
  return sqrtf(lx_sum32(s));
}
__device__ __forceinline__ float k_max(const unsigned* km, int g) {
  const float a = __uint_as_float(__hip_atomic_load(km + g, __ATOMIC_RELAXED, __HIP_MEMORY_SCOPE_AGENT)), b = __uint_as_float(__hip_atomic_load(km + g + 1, __ATOMIC_RELAXED, __HIP_MEMORY_SCOPE_AGENT));
  return sqrtf(a + b) * 1.005f;
}
__device__ __forceinline__ bool all_done(const ATT_LAS int* DONE, int i) {
  const ATT_LAS u32x4* d = (const ATT_LAS u32x4*)DONE; const u32x4 a = d[0], b = d[1];
  const unsigned m = max(max(max(a.x, a.y), max(a.z, a.w)), max(max(b.x, b.y), max(b.z, b.w)));
  return __builtin_amdgcn_readfirstlane((int)(m < (unsigned)i)) != 0;
}
#define ATT_WAIT_BAR(N) asm volatile("s_waitcnt vmcnt(" #N ") lgkmcnt(0)\n\ts_barrier" ::: "memory")

__device__ __forceinline__ void fox_unit(ATT_LAS unsigned char* lds, const bf16_t* __restrict__ qkv, bf16_t* __restrict__ attn, const float* __restrict__ cl2, const float* __restrict__ blk2, const unsigned* km,
                                         int b, int h, int qb, int wave) {
  const int wid = wave, lane = fresh_lane(), tid = wid * 64 + lane, r32 = lane & 31, hi = lane >> 5;
  ATT_LAS float* CARRY = (ATT_LAS float*)(lds + 55296); ATT_LAS float* wsf = (ATT_LAS float*)(lds + 55552) + wid * 64;
  ATT_LAS unsigned char* BW = lds + 49152 + wid * 768; ATT_LAS int* DONE = (ATT_LAS int*)(lds + 57600);
  if (lane == 0) DONE[wid] = 0x7fffffff;
  const int q0 = qb * 256, NT = 4 * (qb + 1), jl = 4 * qb + (wid >> 1);
  const size_t rowb = (size_t)b * SEQ; const int bh = b * 8 + h;
  if (wid == 0) { float v = lane < 32 ? blk2[(b * 32 + lane) * 8 + h] : 0.f; float s = v;
#pragma unroll
    for (int o = 1; o < 32; o <<= 1) { const float t = __builtin_bit_cast(float, __builtin_amdgcn_ds_bpermute(((lane - o) & 63) << 2, __builtin_bit_cast(int, s))); if (lane >= o) s += t; }
    if (lane < 32) CARRY[lane] = s - v; }
  __syncthreads();
  const float cq = CARRY[q0 >> 7] + cl2[(size_t)bh * SEQ + q0];
  bf16x8 qr[4];
  { const bf16_t* Qw = qkv + (rowb + q0 + wid * 32 + r32) * LDQKV + h * 64 + hi * 8;
#pragma unroll
    for (int d0 = 0; d0 < 4; ++d0) qr[d0] = *(const bf16x8*)(Qw + d0 * 16); }
  const int pk = 64 * wid + lane;
  unsigned koff, voff;
  { const int row = pk >> 3, c = (pk & 7) ^ ((row >> 1) & 7); koff = (unsigned)((row * LDQKV + 512 + h * 64 + c * 8) * 2);
    const int sub = pk >> 5, kk = 8 * (sub >> 1) + ((pk & 31) >> 2), k = swap23(kk), cv = (sub & 1) * 32 + (pk & 3) * 8; voff = (unsigned)((k * LDQKV + 1024 + h * 64 + cv) * 2); }
  const char* tb = (const char*)(qkv + rowb * LDQKV);
  const char* cg = (const char*)(cl2 + (size_t)bh * SEQ) + (lane & 15) * 16;
  const int vb0 = (int)(uintptr_t)(lds + 24576) + v_rd_base(lane);
#define FOX_LOAD(j, bo) do { const char* tj = tb + (size_t)(j) * (64 * LDQKV * 2); dma16(tj + koff, lds + (bo) * 8192 + wid * 1024); dma16(tj + voff, lds + 24576 + (bo) * 8192 + wid * 1024); \
    if (lane < 16) dma16(cg + (j) * 256, BW + (bo) * 256); } while (0)
  FOX_LOAD(NT - 1, 0); FOX_LOAD(NT - 2, 1);
  __builtin_amdgcn_s_waitcnt(0x0F70);
  float m_reg = -1e30f, l_reg = 0.f; f32x16 o[2]; o[0] = f32x16{}; o[1] = f32x16{};
  const float bnd = q_norm(qr) * k_max(km + b * 96, 16 + 2 * h);
  bool stopped = false;
  int cur = 0, nx2 = 2;
  for (int i = 0; i < NT; ++i) {
    const int j = NT - 1 - i;
    if (i + 1 < NT) ATT_WAIT_BAR(3); else ATT_WAIT_BAR(0);
    if (all_done(DONE, i)) break;
    if (i + 2 < NT) FOX_LOAD(j - 2, nx2);
    if (j <= jl && !stopped) {
      const float bj = ((const ATT_LAS float*)(BW + cur * 256))[63] + (CARRY[j >> 1] - cq);
      if (!__any(bnd + bj - m_reg >= -SKIP_T)) { stopped = true; if (lane == 0) DONE[wid] = i; }
    }
    if (j <= jl && !stopped) {
      f32x16 p0, p1; bf16x8 pa0, pa1, pa2, pa3;
      qkt_bias(p0, p1, (const ATT_LAS float*)(BW + cur * 256), lds + cur * 8192, qr, r32, hi);
      if (j == jl) { const int qrel = 32 * (wid & 1) + r32;
#pragma unroll
        for (int r = 0; r < 16; ++r) { const int kr = crow(r, hi); if (kr > qrel) p0[r] = -1e30f; if (kr + 32 > qrel) p1[r] = -1e30f; } }
      const float c2 = CARRY[j >> 1] - cq;
      online_sm<2>(p0, p1, m_reg, l_reg, o, wsf, r32, hi, pa0, pa1, pa2, pa3, c2);
      pv_one<2, 0>(o[0], vb0 + cur * 8192, pa0, pa1, pa2, pa3); pv_one<2, 1>(o[1], vb0 + cur * 8192, pa0, pa1, pa2, pa3);
    }
    cur = cur == 2 ? 0 : cur + 1; nx2 = nx2 == 2 ? 0 : nx2 + 1;
  }
#undef FOX_LOAD
  asm volatile("s_waitcnt vmcnt(0)" ::: "memory");
  if (hi == 0) wsf[32 + r32] = l_reg; asm volatile("s_waitcnt lgkmcnt(0)" ::: "memory");
  { const int le = opaque(lane), r32e = le & 31, hie = le >> 5;
  bf16_t* Ow = attn + (rowb + q0 + wid * 32) * LDATT + h * 64 + r32e;
#pragma unroll
  for (int r = 0; r < 16; ++r) { const int orow = crow(r, hie); const float rl = __builtin_amdgcn_rcpf(wsf[32 + orow]);
#pragma unroll
    for (int d0 = 0; d0 < 2; ++d0) { const unsigned w = cvtpk(o[d0][r] * rl, 0.f); Ow[(size_t)orow * LDATT + d0 * 32] = (bf16_t)(w & 0xffffu); } } }
  asm volatile("s_waitcnt lgkmcnt(0)" ::: "memory");
  __syncthreads();
}

__device__ __forceinline__ void diff_unit(ATT_LAS unsigned char* lds, const bf16_t* __restrict__ qkv, bf16_t* __restrict__ attn, const float* __restrict__ subln_g, float lam, const unsigned* km,
                                          int b, int h, int qb, int wave) {
  const int wid = wave, lane = fresh_lane(), tid = wid * 64 + lane, r32 = lane & 31, hi = lane >> 5;
  ATT_LAS float* wsf = (ATT_LAS float*)(lds + 98304) + wid * 64; ATT_LAS float* BT = (ATT_LAS float*)(lds + 100352) + wid * 64;
  ATT_LAS int* DONE = (ATT_LAS int*)(lds + 102400);
  if (lane == 0) DONE[wid] = 0x7fffffff;
  const int map = wid >> 2, w4 = wid & 3;
  const int q0 = qb * 128, NT = 2 * (qb + 1), jl = 2 * qb + (w4 >> 1);
  const size_t rowb = (size_t)b * SEQ;
  const float sl2 = LOG2E * (h == 0 ? 0.25f : h == 1 ? 0.0625f : h == 2 ? 0.015625f : 0.00390625f);
  BT[lane] = sl2 * (float)lane;
  bf16x8 qr[4];
  { const bf16_t* Qw = qkv + (rowb + q0 + w4 * 32 + r32) * LDQKV + 1536 + h * 128 + map * 64 + hi * 8;
#pragma unroll
    for (int d0 = 0; d0 < 4; ++d0) qr[d0] = *(const bf16x8*)(Qw + d0 * 16); }
  const int pk = 64 * wid + lane;
  unsigned koff, voff0, voff1;
  { const int row = pk >> 3, c = (pk & 7) ^ ((row >> 1) & 7); koff = (unsigned)((row * LDQKV + 2048 + h * 128 + c * 8) * 2);
    const int sub0 = pk >> 5, kk0 = 8 * (sub0 >> 2) + ((pk & 31) >> 2), k0 = swap23(kk0), c0 = (sub0 & 3) * 32 + (pk & 3) * 8; voff0 = (unsigned)((k0 * LDQKV + 2560 + h * 128 + c0) * 2);
    const int p1 = pk + 512, sub1 = p1 >> 5, kk1 = 8 * (sub1 >> 2) + ((p1 & 31) >> 2), k1 = swap23(kk1), c1 = (sub1 & 3) * 32 + (p1 & 3) * 8; voff1 = (unsigned)((k1 * LDQKV + 2560 + h * 128 + c1) * 2); }
  const char* tb = (const char*)(qkv + rowb * LDQKV);
  const int vb0 = (int)(uintptr_t)(lds + 49152) + v_rd_base(lane);
#define DIFF_LOAD(j, bo) do { const char* tj = tb + (size_t)(j) * (64 * LDQKV * 2); dma16(tj + koff, lds + (bo) * 8192 + wid * 1024); dma16(tj + koff + 128, lds + 24576 + (bo) * 8192 + wid * 1024); \
    dma16(tj + voff0, lds + 49152 + (bo) * 16384 + wid * 1024); dma16(tj + voff1, lds + 49152 + (bo) * 16384 + 8192 + wid * 1024); } while (0)
  DIFF_LOAD(NT - 1, 0); DIFF_LOAD(NT - 2, 1);
  __builtin_amdgcn_s_waitcnt(0x0F70);
  float m_reg = -1e30f, l_reg = 0.f; f32x16 o[4]; o[0] = f32x16{}; o[1] = f32x16{}; o[2] = f32x16{}; o[3] = f32x16{};
  const float bnd = q_norm(qr) * k_max(km + b * 96, 64 + 4 * h + 2 * map);
  bool stopped = false;
  int cur = 0, nx2 = 2;
  for (int i = 0; i < NT; ++i) {
    const int j = NT - 1 - i;
    if (i + 1 < NT) ATT_WAIT_BAR(4); else ATT_WAIT_BAR(0);
    if (all_done(DONE, i)) break;
    if (i + 2 < NT) DIFF_LOAD(j - 2, nx2);
    if (j < jl && !stopped) {
      const float bj = sl2 * (float)(64 * j + 63 - q0);
      if (!__any(bnd + bj - m_reg >= -SKIP_T)) { stopped = true; if (lane == 0) DONE[wid] = i; }
    }
    if (j <= jl && !stopped) {
      f32x16 p0, p1; bf16x8 pa0, pa1, pa2, pa3;
      qkt_bias(p0, p1, BT, lds + map * 24576 + cur * 8192, qr, r32, hi);
      if (j == jl) { const int tq = 32 * (w4 & 1) + r32;
#pragma unroll
        for (int r = 0; r < 16; ++r) { const int k0 = crow(r, hi), k1 = k0 + 32; if (k0 > tq) p0[r] += sl2 * (float)(2 * (tq - k0)); if (k1 > tq) p1[r] += sl2 * (float)(2 * (tq - k1)); } }
      const float c2 = sl2 * (float)(64 * j - q0);
      online_sm<4>(p0, p1, m_reg, l_reg, o, wsf, r32, hi, pa0, pa1, pa2, pa3, c2);
      const int vb = vb0 + cur * 16384;
      pv_one<4, 0>(o[0], vb, pa0, pa1, pa2, pa3); pv_one<4, 1>(o[1], vb, pa0, pa1, pa2, pa3); pv_one<4, 2>(o[2], vb, pa0, pa1, pa2, pa3); pv_one<4, 3>(o[3], vb, pa0, pa1, pa2, pa3);
    }
    cur = cur == 2 ? 0 : cur + 1; nx2 = nx2 == 2 ? 0 : nx2 + 1;
  }
#undef DIFF_LOAD
  asm volatile("s_waitcnt vmcnt(0)" ::: "memory");
  if (hi == 0) wsf[32 + r32] = l_reg; asm volatile("s_waitcnt lgkmcnt(0)" ::: "memory");
  __syncthreads();
  ATT_LAS float* X = (ATT_LAS float*)lds;
  const int te = opaque(tid), r32e = te & 31, hie = (te >> 5) & 1;
  if (map == 1) {
#pragma unroll
    for (int r = 0; r < 16; ++r) { const int orow = crow(r, hie); const float rl = __builtin_amdgcn_rcpf(wsf[32 + orow]);
#pragma unroll
      for (int d0 = 0; d0 < 4; ++d0) X[(32 * w4 + orow) * 132 + d0 * 32 + r32e] = o[d0][r] * rl; } }
  __syncthreads();
  if (map == 0) {
#pragma unroll
    for (int r = 0; r < 16; ++r) { const int orow = crow(r, hie); const float rl = __builtin_amdgcn_rcpf(wsf[32 + orow]);
#pragma unroll
      for (int d0 = 0; d0 < 4; ++d0) { const int idx = (32 * w4 + orow) * 132 + d0 * 32 + r32e; X[idx] = o[d0][r] * rl - lam * X[idx]; } } }
  __syncthreads();
  { const int row = te >> 2, qt = te & 3; float v[32]; float ss = 0.f;
#pragma unroll
    for (int i = 0; i < 8; ++i) { const f32x4 t = *(const ATT_LAS f32x4*)(X + row * 132 + qt * 32 + 4 * i); v[4 * i] = t[0]; v[4 * i + 1] = t[1]; v[4 * i + 2] = t[2]; v[4 * i + 3] = t[3];
      ss += t[0] * t[0] + t[1] * t[1] + t[2] * t[2] + t[3] * t[3]; }
    ss += lx_get<1>(ss); ss += lx_get<2>(ss);
    const float rstd = 0.8f / sqrtf(ss * (1.0f / 128.0f) + 1e-5f);
    bf16_t* op = attn + (rowb + q0 + row) * LDATT + 512 + h * 128 + qt * 32; const float* gp = subln_g + qt * 32;
#pragma unroll
    for (int i = 0; i < 4; ++i) { u32x4 w;
      w.x = cvtpk(v[8 * i + 0] * rstd * gp[8 * i + 0], v[8 * i + 1] * rstd * gp[8 * i + 1]); w.y = cvtpk(v[8 * i + 2] * rstd * gp[8 * i + 2], v[8 * i + 3] * rstd * gp[8 * i + 3]);
      w.z = cvtpk(v[8 * i + 4] * rstd * gp[8 * i + 4], v[8 * i + 5] * rstd * gp[8 * i + 5]); w.w = cvtpk(v[8 * i + 6] * rstd * gp[8 * i + 6], v[8 * i + 7] * rstd * gp[8 * i + 7]);
      *(u32x4*)(op + 8 * i) = w; } }
  __syncthreads();
}
#undef ATT_WAIT_BAR
#undef ATT_SBAR
}

constexpr int NWAVES = 8;
constexpr int BATCH = 8, SEQ = 4096, D = 1024, T = BATCH * SEQ;
constexpr int IN_COLS = 3080, NQKV = 3072;
constexpr int NEXP = 32, DEXP = 512, NSLOT_MAX = 73728;
constexpr int NPH = 9;
constexpr float C2 = 0.125f * 1.4426950408889634f;
constexpr float LAM_INIT = 0.2f;

constexpr size_t MiB = 1u << 20;
constexpr size_t WS_CTL = 0, CTL_ZERO_BYTES = 1 * MiB;
constexpr size_t WS_WIN = 1 * MiB;
constexpr size_t WS_WO = 7 * MiB;
constexpr size_t WS_WGU = 9 * MiB;
constexpr size_t WS_WD = 73 * MiB;
constexpr size_t WS_WR = 105 * MiB;
constexpr size_t WS_MOD = 106 * MiB;
constexpr size_t WS_CUM = 107 * MiB;
constexpr size_t WS_BLK = 108 * MiB;
constexpr size_t WS_RT = 109 * MiB;
constexpr size_t WS_STOK = 110 * MiB;
constexpr size_t WS_R = 118 * MiB;
constexpr size_t WS_H = WS_R;
constexpr size_t WS_QKV = WS_R + 64 * MiB;
constexpr size_t WS_Y = WS_R;
constexpr size_t WS_HID = WS_R + 144 * MiB;
constexpr size_t WS_END = WS_R + 256 * MiB;
constexpr int CW_BAR = 4096;
constexpr int CW_KM = 32768;
constexpr int CW_CNT = 16384;

constexpr int LDS_BYTES = 155648;
constexpr int MISC_OFF = LDS_BYTES - 256;

#define GAS __attribute__((address_space(1)))
#define LAS __attribute__((address_space(3)))
typedef unsigned short bf16;
typedef unsigned v4u __attribute__((ext_vector_type(4)));
typedef unsigned v2u __attribute__((ext_vector_type(2)));
typedef float f32x4 __attribute__((ext_vector_type(4)));
typedef GAS unsigned gu32;
#define RLX_AGENT __ATOMIC_RELAXED, __HIP_MEMORY_SCOPE_AGENT
#define LDS_WAIT() asm volatile("s_waitcnt lgkmcnt(0)" ::: "memory")
#define VM_WAIT() asm volatile("s_waitcnt vmcnt(0)" ::: "memory")
__device__ __forceinline__ unsigned f2bf(float f) { unsigned u = __builtin_bit_cast(unsigned, f); return (u + 0x7fffu + ((u >> 16) & 1u)) >> 16; }
__device__ __forceinline__ unsigned pk2(float lo, float hi) { return f2bf(lo) | (f2bf(hi) << 16); }
__device__ __forceinline__ float bflo(unsigned w) { return __builtin_bit_cast(float, w << 16); }
__device__ __forceinline__ float bfhi(unsigned w) { return __builtin_bit_cast(float, w & 0xffff0000u); }
__device__ __forceinline__ float wave_sum(float v) {
#ifdef OLD_WSUM
#pragma unroll
    for (int o = 1; o < 64; o <<= 1) v += __shfl_xor(v, o);
    return v;
#else
    v += lx_get<1>(v); v += lx_get<2>(v); v += lx_get<4>(v); v += lx_get<8>(v); v += lx_get<16>(v);
    return lx_sum32(v);
#endif
}
#define XB_TMO      128
#define XB_XCNT(j)  (256  + 64 * (j))
#define XB_XSUB(j)  (1280 + 64 * (j))
#define XB_XGEN(j)  (2304 + 64 * (j))
#define XB_TOP      3328
#define XB_TOPGEN   3392
#define XCD_BAR_WORDS 3456
#define XB_SPIN_CAP (1u << 18)

__device__ __forceinline__ unsigned xb_ld(unsigned* p)              { return __hip_atomic_load(p, __ATOMIC_RELAXED, __HIP_MEMORY_SCOPE_AGENT); }
__device__ __forceinline__ unsigned xb_add(unsigned* p, unsigned v) { return __hip_atomic_fetch_add(p, v, __ATOMIC_RELAXED, __HIP_MEMORY_SCOPE_AGENT); }
__device__ __forceinline__ unsigned xb_xcc_id() { return (unsigned)__builtin_amdgcn_s_getreg((3 << 11) | 20) & 0xFu; }
#define XB_SPIN(cond, bar) do { unsigned _sp = 0; while (cond) { __builtin_amdgcn_s_sleep(1); \
    if ((++_sp & 255u) == 0u) { if (xb_ld(&(bar)[XB_TMO])) break; if (_sp > XB_SPIN_CAP) { atomicAdd(&(bar)[XB_TMO], 1u); break; } } } } while (0)

struct XcdBarrier {
    int wave;
    unsigned* bar; unsigned x;
    volatile LAS unsigned* st;
};

__device__ __forceinline__ XcdBarrier xcd_barrier_post(unsigned* bar, volatile LAS unsigned* st) {
    XcdBarrier b; b.bar = bar; b.x = xb_xcc_id(); b.st = st;
    if (threadIdx.x == 0) (void)xb_add(&bar[XB_XCNT(b.x)], 1u);
    return b;
}
__device__ __forceinline__ void xcd_barrier_complete(unsigned* bar, unsigned x, unsigned& nloc, unsigned& nx) {
    const unsigned G = gridDim.x * gridDim.y * gridDim.z;
    unsigned sum, cnt, mine, sp = 0u;
    for (;;) {
        sum = 0u; cnt = 0u; mine = 0u;
#pragma unroll
        for (unsigned j = 0; j < 16; ++j) { const unsigned c = xb_ld(&bar[XB_XCNT(j)]); sum += c; cnt += (c > 0u) ? 1u : 0u; mine = (j == x) ? c : mine; }
        if (sum == G) break;
        __builtin_amdgcn_s_sleep(1);
        if ((++sp & 255u) == 0u) { if (xb_ld(&bar[XB_TMO])) break; if (sp > XB_SPIN_CAP) { atomicAdd(&bar[XB_TMO], 1u); break; } }
    }
    nloc = mine > 0u ? mine : 1u; nx = cnt > 0u ? cnt : 1u;
}

__device__ __forceinline__ void xcd_barrier(const XcdBarrier& b) {
    asm volatile("s_waitcnt vmcnt(0)" ::: "memory");
    __syncthreads();
    if (b.wave == 0 && fresh_lane() == 0) {
        unsigned* bar = b.bar;
        __builtin_amdgcn_s_waitcnt(0);
        unsigned nloc = b.st[0], nx = b.st[1];
        if (nloc == 0u) { xcd_barrier_complete(bar, b.x, nloc, nx); b.st[0] = nloc; b.st[1] = nx; }
        const unsigned old = xb_add(&bar[XB_XSUB(b.x)], 1u);
        const unsigned gen = old / nloc;
        if (old + 1u == (gen + 1u) * nloc) {
            __builtin_amdgcn_fence(__ATOMIC_RELEASE, "agent");
            asm volatile("s_waitcnt vmcnt(0)" ::: "memory");
            const unsigned og = xb_add(&bar[XB_TOP], 1u);
            const unsigned tg = og / nx;
            if (og + 1u == (tg + 1u) * nx) xb_add(&bar[XB_TOPGEN], 1u);
            else XB_SPIN(xb_ld(&bar[XB_TOPGEN]) == tg, bar);
            __builtin_amdgcn_fence(__ATOMIC_ACQUIRE, "agent");
            xb_add(&bar[XB_XGEN(b.x)], 1u);
            asm volatile("s_waitcnt vmcnt(0)" ::: "memory");
        } else {
            XB_SPIN(xb_ld(&bar[XB_XGEN(b.x)]) == gen, bar);
            __builtin_amdgcn_fence(__ATOMIC_ACQUIRE, "agent");
            asm volatile("s_waitcnt vmcnt(0)" ::: "memory");
        }
    }
    __syncthreads();
}

__device__ __forceinline__ void tr_item(const float* __restrict__ src, int ldS, bf16* __restrict__ dst, int ldD, float scale, LAS float* scr, int lane) {
#pragma unroll 8
    for (int i = 0; i < 32; ++i) { const int kk = 2 * i + (lane >> 5); scr[kk * 33 + (lane & 31)] = src[(size_t)kk * ldS + (lane & 31)]; }
    LDS_WAIT(); asm volatile("" ::: "memory");
    const int c = lane & 7;
#pragma unroll
    for (int j = 0; j < 4; ++j) { const int n = (lane >> 3) + 8 * j; const LAS float* s = scr + (8 * c) * 33 + n;
        v4u o; o.x = pk2(s[0 * 33] * scale, s[1 * 33] * scale); o.y = pk2(s[2 * 33] * scale, s[3 * 33] * scale); o.z = pk2(s[4 * 33] * scale, s[5 * 33] * scale); o.w = pk2(s[6 * 33] * scale, s[7 * 33] * scale);
        *(v4u*)(dst + (size_t)n * ldD + 8 * c) = o; }
    LDS_WAIT(); asm volatile("" ::: "memory");
}
struct P0Args { const float *c, *ada_w, *ada_b, *w_in, *w_o, *w_rg, *w_re, *w_gate, *w_up, *w_down; bf16 *Wt_in, *Wt_o, *Wt_gu, *Wt_d; float *Wr, *mod; };
__device__ __forceinline__ void p0_prologue(const P0Args& a, LAS unsigned char* lds, int vcu, int G, int tid, int wave, int lane) {
    LAS float* scr = (LAS float*)(lds + wave * 8448);
    const int gw = vcu * NWAVES + wave, NGW = G * NWAVES;
    constexpr int I_IN = 16 * 96, I_O = 16 * 32, I_GU = 32 * 16 * 32, I_D = 32 * 8 * 32;
    constexpr int NITEMS = I_IN + I_O + I_GU + I_D;
    for (int it = gw; it < NITEMS; it += NGW) {
        int r = it;
        if (r < I_IN) { const int kb = r / 96, nb = r % 96, n0 = 32 * nb, sc = n0 < 1536 ? n0 : n0 + 8;
            const float scale = (n0 < 512 || (n0 >= 1536 && n0 < 2048)) ? C2 : 1.0f;
            tr_item(a.w_in + (size_t)(64 * kb) * IN_COLS + sc, IN_COLS, a.Wt_in + (size_t)n0 * 1024 + 64 * kb, 1024, scale, scr, lane); continue; }
        r -= I_IN;
        if (r < I_O) { const int kb = r / 32, nb = r % 32;
            tr_item(a.w_o + (size_t)(64 * kb) * 1024 + 32 * nb, 1024, a.Wt_o + (size_t)(32 * nb) * 1024 + 64 * kb, 1024, 1.0f, scr, lane); continue; }
        r -= I_O;
        if (r < I_GU) { const int e = r / 512, q = r % 512, kb = q / 32, nb = q % 32, n0 = 32 * nb, pn = n0 >> 8, bj = (n0 >> 7) & 1, j0 = n0 & 127;
            const float* src = (bj ? a.w_up : a.w_gate) + (size_t)e * 1024 * 512 + (size_t)(64 * kb) * 512 + 128 * pn + j0;
            tr_item(src, 512, a.Wt_gu + ((size_t)e * 1024 + n0) * 1024 + 64 * kb, 1024, 1.0f, scr, lane); continue; }
        r -= I_GU;
        { const int e = r / 256, q = r % 256, kb = q / 32, nb = q % 32;
            tr_item(a.w_down + (size_t)e * 512 * 1024 + (size_t)(64 * kb) * 1024 + 32 * nb, 1024, a.Wt_d + ((size_t)e * 1024 + 32 * nb) * 512 + 64 * kb, 512, 1.0f, scr, lane); }
    }
    for (int i = (vcu * NWAVES * 64 + tid); i < 36 * 1024; i += G * NWAVES * 64) { const int n = i >> 10, k = i & 1023;
        a.Wr[i] = n < 32 ? a.w_re[k * 32 + n] : a.w_rg[k * 4 + (n - 32)]; }
    __syncthreads();
    LAS float* cs = (LAS float*)(lds + 69632);
    LAS float* red = (LAS float*)(lds + 69632 + 32768);
    for (int i = tid; i < 8192; i += NWAVES * 64) cs[i] = a.c[i];
    __syncthreads();
    for (int ch = vcu; ch < 96; ch += G) {
        float acc[8];
#pragma unroll
        for (int b = 0; b < 8; ++b) acc[b] = 0.f;
        const float* wp = a.ada_w + (size_t)(wave * 128) * 6144 + ch * 64 + lane;
#pragma unroll 8
        for (int k = 0; k < 128; ++k) { const float wv = wp[(size_t)k * 6144];
#pragma unroll
            for (int b = 0; b < 8; ++b) acc[b] = fmaf(cs[b * 1024 + wave * 128 + k], wv, acc[b]); }
#pragma unroll
        for (int b = 0; b < 8; ++b) red[(wave * 8 + b) * 64 + lane] = acc[b];
        __syncthreads();
        { const int b = tid >> 6, l = tid & 63; float s = a.ada_b[ch * 64 + l];
#pragma unroll
          for (int w = 0; w < 8; ++w) s += red[(w * 8 + b) * 64 + l];
          a.mod[b * 6144 + ch * 64 + l] = s; }
        __syncthreads();
    }
}

__device__ __forceinline__ void p1_norm(const float* __restrict__ x, const float* __restrict__ g1, const float* __restrict__ mod, const float* __restrict__ w_in, const float* __restrict__ b_f,
                                        bf16* __restrict__ H, float* __restrict__ cumloc, float* __restrict__ blktot, LAS unsigned char* lds, int vcu, int G, int tid, int wave, int lane) {
    LAS float* wfz = (LAS float*)lds; LAS float* lf = (LAS float*)(lds + 32768); LAS float* segtot = (LAS float*)(lds + 36864);
    for (int i = tid; i < 8192; i += NWAVES * 64) { const int jh = i >> 10, k = i & 1023; wfz[i] = w_in[(size_t)k * IN_COLS + 1536 + jh]; }
    __syncthreads();
    for (int rb = vcu; rb < T / 128; rb += G) {
        const int b = rb >> 5;
        f32x4 A[4], Bc[4];
#pragma unroll
        for (int j = 0; j < 4; ++j) { const int col = 256 * j + 4 * lane; const f32x4 g = *(const f32x4*)(g1 + col), sc = *(const f32x4*)(mod + b * 6144 + 1024 + col);
            A[j] = g * (1.0f + sc); Bc[j] = *(const f32x4*)(mod + b * 6144 + col); }
        const float bfv = b_f[lane & 7];
        for (int rr = 0; rr < 16; ++rr) {
            const int row = rb * 128 + wave * 16 + rr;
            const f32x4* xr = (const f32x4*)(x + (size_t)row * D) + lane;
            f32x4 v[4]; float s = 0.f;
#pragma unroll
            for (int j = 0; j < 4; ++j) { v[j] = xr[64 * j]; s += (v[j].x * v[j].x + v[j].y * v[j].y) + (v[j].z * v[j].z + v[j].w * v[j].w); }
            const float rstd = 1.0f / sqrtf(wave_sum(s) * (1.0f / D) + 1e-6f);
#pragma unroll
            for (int j = 0; j < 4; ++j) v[j] = v[j] * rstd * A[j] + Bc[j];
            v2u* o8 = (v2u*)(H + (size_t)row * D) + lane;
#pragma unroll
            for (int j = 0; j < 4; ++j) { v2u w; w.x = pk2(v[j].x, v[j].y); w.y = pk2(v[j].z, v[j].w); o8[64 * j] = w; }
            float z = 0.f;
#pragma unroll
            for (int jh = 0; jh < 8; ++jh) { float acc = 0.f;
#pragma unroll
                for (int j = 0; j < 4; ++j) { const f32x4 w4 = *(const LAS f32x4*)(wfz + jh * 1024 + 256 * j + 4 * lane); acc += (v[j].x * w4.x + v[j].y * w4.y) + (v[j].z * w4.z + v[j].w * w4.w); }
                acc = wave_sum(acc); z = ((lane & 7) == jh) ? acc : z; }
            z += bfv;
            const float lfv = fminf(z, 0.f) - log1pf(expf(-fabsf(z)));
            if (lane < 8) lf[(wave * 16 + rr) * 8 + lane] = lfv;
        }
        __syncthreads();
        float run[16]; const int hh = tid & 7, seg = (tid >> 3) & 7;
        if (tid < 64) { float s = 0.f;
#pragma unroll
            for (int i = 0; i < 16; ++i) { s += lf[(seg * 16 + i) * 8 + hh]; run[i] = s; }
            segtot[seg * 8 + hh] = s; }
        __syncthreads();
        if (tid < 64) { float off = 0.f;
            for (int s2 = 0; s2 < seg; ++s2) off += segtot[s2 * 8 + hh];
            float* cp = cumloc + (size_t)(b * 8 + hh) * SEQ + (rb & 31) * 128 + seg * 16;
            const float NL2E = -1.4426950408889634f;
#pragma unroll
            for (int i = 0; i < 4; ++i) { f32x4 t; t.x = (run[4 * i] + off) * NL2E; t.y = (run[4 * i + 1] + off) * NL2E; t.z = (run[4 * i + 2] + off) * NL2E; t.w = (run[4 * i + 3] + off) * NL2E; *(f32x4*)(cp + 4 * i) = t; }
            if (seg == 7) blktot[rb * 8 + hh] = (run[15] + off) * NL2E; }
        __syncthreads();
    }
}

__device__ __forceinline__ void p5_route(const float* __restrict__ x1, const float* __restrict__ g2, const float* __restrict__ mod, const float* __restrict__ Wr, const float* __restrict__ b_rg, const float* __restrict__ b_re,
                                         bf16* __restrict__ H2, gu32* cnt, int* __restrict__ stok, int* __restrict__ rt_e, int* __restrict__ rt_pos, float* __restrict__ rt_w,
                                         LAS unsigned char* lds, int vcu, int G, int tid, int wave, int lane) {
    LAS float* wr = (LAS float*)lds; LAS unsigned* CNT = (LAS unsigned*)(lds + 147456); LAS unsigned* BASE = (LAS unsigned*)(lds + 147584); LAS unsigned* REC = (LAS unsigned*)(lds + 147712);
    for (int i = tid; i < 36 * 1024 / 4; i += NWAVES * 64) ((LAS f32x4*)wr)[i] = ((const f32x4*)Wr)[i];
    if (tid < 32) CNT[tid] = 0u;
    __syncthreads();
    for (int rb = vcu; rb < T / 128; rb += G) {
        const int b = rb >> 5;
        f32x4 A[4], Bc[4];
#pragma unroll
        for (int j = 0; j < 4; ++j) { const int col = 256 * j + 4 * lane; const f32x4 g = *(const f32x4*)(g2 + col), sc = *(const f32x4*)(mod + b * 6144 + 4096 + col);
            A[j] = g * (1.0f + sc); Bc[j] = *(const f32x4*)(mod + b * 6144 + 3072 + col); }
        for (int rr = 0; rr < 16; ++rr) {
            const int rl = wave * 16 + rr, row = rb * 128 + rl;
            const f32x4* xr = (const f32x4*)(x1 + (size_t)row * D) + lane;
            f32x4 v[4]; float s = 0.f;
#pragma unroll
            for (int j = 0; j < 4; ++j) { v[j] = xr[64 * j]; s += (v[j].x * v[j].x + v[j].y * v[j].y) + (v[j].z * v[j].z + v[j].w * v[j].w); }
            const float rstd = 1.0f / sqrtf(wave_sum(s) * (1.0f / D) + 1e-6f);
#pragma unroll
            for (int j = 0; j < 4; ++j) v[j] = v[j] * rstd * A[j] + Bc[j];
            v2u* o8 = (v2u*)(H2 + (size_t)row * D) + lane;
#pragma unroll
            for (int j = 0; j < 4; ++j) { v2u w; w.x = pk2(v[j].x, v[j].y); w.y = pk2(v[j].z, v[j].w); o8[64 * j] = w; }
            float L[36];
#pragma unroll
            for (int n = 0; n < 36; ++n) { float acc = 0.f;
#pragma unroll
                for (int j = 0; j < 4; ++j) { const f32x4 w4 = *(const LAS f32x4*)(wr + n * 1024 + 256 * j + 4 * lane); acc += (v[j].x * w4.x + v[j].y * w4.y) + (v[j].z * w4.z + v[j].w * w4.w); }
                L[n] = wave_sum(acc); if ((n & 3) == 3) __builtin_amdgcn_sched_barrier(0); }
            float gl[4];
#pragma unroll
            for (int i = 0; i < 4; ++i) gl[i] = L[32 + i] + b_rg[i];
            int g = 0; float gm = gl[0];
#pragma unroll
            for (int i = 1; i < 4; ++i) if (gl[i] > gm) { gm = gl[i]; g = i; }
            float gs = 0.f;
#pragma unroll
            for (int i = 0; i < 4; ++i) gs += expf(gl[i] - gm);
            const float pg = 1.0f / gs;
            float el[8];
#pragma unroll
            for (int i = 0; i < 8; ++i) { const float v0 = L[i] + b_re[i], v1 = L[8 + i] + b_re[8 + i], v2 = L[16 + i] + b_re[16 + i], v3 = L[24 + i] + b_re[24 + i];
                el[i] = g == 0 ? v0 : g == 1 ? v1 : g == 2 ? v2 : v3; }
            int i1 = 0; float m1 = el[0];
#pragma unroll
            for (int i = 1; i < 8; ++i) if (el[i] > m1) { m1 = el[i]; i1 = i; }
            int i2 = -1; float m2 = -3.0e38f;
#pragma unroll
            for (int i = 0; i < 8; ++i) if (i != i1 && el[i] > m2) { m2 = el[i]; i2 = i; }
            const float ex = expf(m2 - m1); const float w1 = pg / (1.0f + ex), w2 = pg * ex / (1.0f + ex);
            if (lane == 0) { const int e1 = g * 8 + i1, e2 = g * 8 + i2;
                const unsigned p1 = __hip_atomic_fetch_add(&CNT[e1], 1u, __ATOMIC_RELAXED, __HIP_MEMORY_SCOPE_WORKGROUP), p2 = __hip_atomic_fetch_add(&CNT[e2], 1u, __ATOMIC_RELAXED, __HIP_MEMORY_SCOPE_WORKGROUP);
                REC[(rl * 2 + 0) * 4 + 0] = (unsigned)e1; REC[(rl * 2 + 0) * 4 + 1] = p1; REC[(rl * 2 + 0) * 4 + 2] = __float_as_uint(w1);
                REC[(rl * 2 + 1) * 4 + 0] = (unsigned)e2; REC[(rl * 2 + 1) * 4 + 1] = p2; REC[(rl * 2 + 1) * 4 + 2] = __float_as_uint(w2); }
        }
        __syncthreads();
        if (tid < 32) BASE[tid] = __hip_atomic_fetch_add(cnt + 64 * tid, CNT[tid], RLX_AGENT);
        __syncthreads();
        if (tid < 256) { const unsigned e = REC[tid * 4 + 0], pl = REC[tid * 4 + 1], wb = REC[tid * 4 + 2]; const unsigned pos = BASE[e] + pl; const int tok = rb * 128 + (tid >> 1);
            stok[(size_t)e * 65536 + pos] = tok; rt_e[tok * 2 + (tid & 1)] = (int)e; rt_pos[tok * 2 + (tid & 1)] = (int)pos; rt_w[tok * 2 + (tid & 1)] = __uint_as_float(wb); }
        __syncthreads();
        if (tid < 32) CNT[tid] = 0u;
        __syncthreads();
    }
}

__device__ __forceinline__ void moe_tables(gu32* cnt, LAS int* TB, LAS int* CN, int tid) {
    if (tid == 0) { int s = 0;
        for (int e = 0; e < 32; ++e) { const int c = (int)__hip_atomic_load(cnt + 64 * e, RLX_AGENT); CN[e] = c; TB[e] = s; s += (c + 255) >> 8; }
        TB[32] = s; }
    __syncthreads();
}
struct MoeOrder {
    const LAS int* TB; const LAS int* CN; const int* stok; int G, c; bool gather;
    __device__ __forceinline__ bool next(int i, pg8::Unit& u) const {
        const int L = i * G + c; if (L >= 4 * TB[32]) return false;
        const int gt = L >> 2, ct = L & 3; int e = 0;
        for (int k = 1; k < 32; ++k) e += (gt >= TB[k]) ? 1 : 0;
        u.pm = gt; u.pn = e * 4 + ct; u.e = e; return true;
    }
    __device__ __forceinline__ void a_off(const pg8::Unit& u, const int (&RA)[2], const int (&CA)[2], int K, unsigned (&off)[2][2]) const {
        if (gather) {
            const int p0 = (u.pm - TB[u.e]) * 256, n = CN[u.e];
#pragma unroll
            for (int h = 0; h < 2; ++h)
#pragma unroll
                for (int i = 0; i < 2; ++i) { const int pos = p0 + h * 128 + RA[i]; const int tok = pos < n ? stok[(size_t)u.e * 65536 + pos] : 0;
                    off[h][i] = (unsigned)(((size_t)tok * K + CA[i]) * 2); }
            __builtin_amdgcn_s_waitcnt(0x0F70);
        } else {
#pragma unroll
            for (int h = 0; h < 2; ++h)
#pragma unroll
                for (int i = 0; i < 2; ++i) off[h][i] = (unsigned)(((size_t)(u.pm * 256 + h * 128 + RA[i]) * K + CA[i]) * 2);
        }
    }
};

__device__ __forceinline__ void p8_final(float* __restrict__ xo, const bf16* __restrict__ Y, const float* __restrict__ mod, const float* __restrict__ gf,
                                         const int* __restrict__ rt_e, const int* __restrict__ rt_pos, const float* __restrict__ rt_w, const LAS int* TB,
                                         int vcu, int G, int wave, int lane) {
    const int gw = vcu * NWAVES + wave, NGW = G * NWAVES;
    f32x4 gfv[4];
#pragma unroll
    for (int j = 0; j < 4; ++j) gfv[j] = *(const f32x4*)(gf + 256 * j + 4 * lane);
    for (int row = gw; row < T; row += NGW) {
        const int b = row >> 12;
        const int e0 = rt_e[row * 2], e1 = rt_e[row * 2 + 1]; const int s0 = TB[e0] * 256 + rt_pos[row * 2], s1 = TB[e1] * 256 + rt_pos[row * 2 + 1];
        const float w0 = rt_w[row * 2], w1 = rt_w[row * 2 + 1];
        f32x4* xr = (f32x4*)(xo + (size_t)row * D) + lane;
        const v2u* y0 = (const v2u*)(Y + (size_t)s0 * D) + lane; const v2u* y1 = (const v2u*)(Y + (size_t)s1 * D) + lane;
        f32x4 v[4]; float s = 0.f;
#pragma unroll
        for (int j = 0; j < 4; ++j) { const f32x4 xv = xr[64 * j]; const v2u a = y0[64 * j], c = y1[64 * j]; const f32x4 g2 = *(const f32x4*)(mod + b * 6144 + 5120 + 256 * j + 4 * lane);
            f32x4 y; y.x = w0 * bflo(a.x) + w1 * bflo(c.x); y.y = w0 * bfhi(a.x) + w1 * bfhi(c.x); y.z = w0 * bflo(a.y) + w1 * bflo(c.y); y.w = w0 * bfhi(a.y) + w1 * bfhi(c.y);
            v[j] = xv + g2 * y; s += (v[j].x * v[j].x + v[j].y * v[j].y) + (v[j].z * v[j].z + v[j].w * v[j].w); }
        const float rstd = 1.0f / sqrtf(wave_sum(s) * (1.0f / D) + 1e-6f);
#pragma unroll
        for (int j = 0; j < 4; ++j) xr[64 * j] = v[j] * rstd * gfv[j];
    }
}

struct Args { const float* in[22]; float* out; unsigned char* ws; int ph_lo, ph_hi; };
typedef __attribute__((address_space(4))) const unsigned long long cu64;
__device__ __forceinline__ cu64* karg() { cu64* p = (cu64*)__builtin_amdgcn_kernarg_segment_ptr(); asm volatile("" : "+s"(p)); return p; }
#define KA_IN(ka, i) ((const float*)(ka)[i])
#define KA_OUT(ka) ((float*)(ka)[22])
#define KA_WS(ka) ((unsigned char*)(ka)[23])
__global__ void __launch_bounds__(NWAVES * 64, 2) fwd_kernel(Args args) {
    extern __shared__ __attribute__((aligned(16))) unsigned char lds_raw[];
    LAS unsigned char* lds = (LAS unsigned char*)lds_raw;
    volatile LAS unsigned* MISC = (volatile LAS unsigned*)(lds + MISC_OFF);
    const int wave = __builtin_amdgcn_readfirstlane((int)threadIdx.x >> 6);
    const int G = gridDim.x; const int bx = blockIdx.x; const int vcu = (G % 8 == 0) ? (bx % 8) * (G / 8) + bx / 8 : bx;
    if (wave == 0) MISC[fresh_lane()] = 0u;
    __syncthreads();
    XcdBarrier bar = xcd_barrier_post((unsigned*)((gu32*)(args.ws + WS_CTL) + CW_BAR), MISC + 8); bar.wave = wave;
    const int lo = args.ph_lo, hi = args.ph_hi;
#ifndef PHASE_MASK
#define PHASE_MASK 0x1ff
#endif
#define IN(k) ((((PHASE_MASK) >> (k)) & 1) && lo <= (k) && (k) < hi)
#define SEAM(k) do { if (IN(k) && IN((k) + 1)) xcd_barrier(bar); } while (0)
#ifndef PROBE_PHASE
#define PROBE_PHASE -1
#endif
#define REP(k) _Pragma("unroll 1") for (int rep_ = 0; rep_ < ((PROBE_PHASE) == (k) ? 2 : 1); ++rep_)

    if (IN(0)) REP(0) {
        cu64* ka = karg(); unsigned char* ws = KA_WS(ka);
        P0Args a{KA_IN(ka, 1), KA_IN(ka, 2), KA_IN(ka, 3), KA_IN(ka, 5), KA_IN(ka, 12), KA_IN(ka, 14), KA_IN(ka, 16), KA_IN(ka, 18), KA_IN(ka, 19), KA_IN(ka, 20),
                 (bf16*)(ws + WS_WIN), (bf16*)(ws + WS_WO), (bf16*)(ws + WS_WGU), (bf16*)(ws + WS_WD), (float*)(ws + WS_WR), (float*)(ws + WS_MOD)};
        const int lane = fresh_lane(), tid = wave * 64 + lane; p0_prologue(a, lds, vcu, G, tid, wave, lane);
    }
    SEAM(0);
    if (IN(1)) REP(1) { cu64* ka = karg(); unsigned char* ws = KA_WS(ka); const int lane = fresh_lane(), tid = wave * 64 + lane;
        p1_norm(KA_IN(ka, 0), KA_IN(ka, 4), (const float*)(ws + WS_MOD), KA_IN(ka, 5), KA_IN(ka, 6), (bf16*)(ws + WS_H), (float*)(ws + WS_CUM), (float*)(ws + WS_BLK), lds, vcu, G, tid, wave, lane); }
    SEAM(1);
#define P2BODY { cu64* ka = karg(); unsigned char* ws = KA_WS(ka); pg8::Gemm g{(const bf16*)(ws + WS_H), (const bf16*)(ws + WS_WIN), T, NQKV, D}; pg8::StaticOrder S; S.init(T, NQKV, G, bx); \
        pg8::EpiStore E{(bf16*)(ws + WS_QKV), NQKV, 0xffff, (unsigned*)(ws + WS_CTL) + CW_KM}; \
        pg8::gemm_phase<pg8::EpiStore, pg8::StaticOrder, true, true>(lds, g, S, E, wave); }
    if (IN(2)) { P2BODY if (PROBE_PHASE == 2) P2BODY }
    SEAM(2);
    if (IN(3)) REP(3) {
        float lam;
        { cu64* ka = karg(); const float* lq1 = KA_IN(ka, 7); const float* lk1 = KA_IN(ka, 8); const float* lq2 = KA_IN(ka, 9); const float* lk2 = KA_IN(ka, 10);
          const int lane = fresh_lane(); const float a = wave_sum(lq1[lane] * lk1[lane]), b2 = wave_sum(lq2[lane] * lk2[lane]); lam = expf(a) - expf(b2) + LAM_INIT; }
        for (int v = vcu; v < 256; v += G) {
            const int b = v >> 5, ci = v & 31;
#ifndef NO_DIFF
#pragma unroll 1
            for (int s = 0; s < 4; ++s) { const int qb = (s & 1) ? 31 - ci : ci; cu64* ka = karg(); unsigned char* ws = KA_WS(ka);
                att::diff_unit(lds, (const bf16*)(ws + WS_QKV), (bf16*)(ws + WS_H), KA_IN(ka, 11), lam, (const unsigned*)(ws + WS_CTL) + CW_KM, b, s, qb, wave); }
#endif
#ifndef NO_FOX
#pragma unroll 1
            for (int p = 0; p < 4; ++p) { const int h = 2 * p + (ci >> 4), i16 = ci & 15, qb = (p & 1) ? 15 - i16 : i16; cu64* ka = karg(); unsigned char* ws = KA_WS(ka);
                att::fox_unit(lds, (const bf16*)(ws + WS_QKV), (bf16*)(ws + WS_H), (const float*)(ws + WS_CUM), (const float*)(ws + WS_BLK), (const unsigned*)(ws + WS_CTL) + CW_KM, b, h, qb, wave); }
#endif
        }
    }
    SEAM(3);
#define P4BODY { cu64* ka = karg(); unsigned char* ws = KA_WS(ka); pg8::Gemm g{(const bf16*)(ws + WS_H), (const bf16*)(ws + WS_WO), T, D, D}; pg8::StaticOrder S; S.init(T, D, G, bx); \
        pg8::EpiResid E{KA_IN(ka, 0), KA_OUT(ka), (const float*)(ws + WS_MOD) + 2048}; \
        pg8::gemm_phase<pg8::EpiResid, pg8::StaticOrder, true, true>(lds, g, S, E, wave); }
    if (IN(4)) { P4BODY if (PROBE_PHASE == 4) P4BODY }
    SEAM(4);
    if (IN(5)) { cu64* ka = karg(); unsigned char* ws = KA_WS(ka); int* rt_e = (int*)(ws + WS_RT); const int lane = fresh_lane(), tid = wave * 64 + lane;
        p5_route(KA_OUT(ka), KA_IN(ka, 13), (const float*)(ws + WS_MOD), (const float*)(ws + WS_WR), KA_IN(ka, 15), KA_IN(ka, 17), (bf16*)(ws + WS_H), (gu32*)(ws + WS_CTL) + CW_CNT, (int*)(ws + WS_STOK),
                 rt_e, rt_e + 2 * T, (float*)(rt_e + 4 * T), lds, vcu, G, tid, wave, lane); }
    SEAM(5);
    LAS int* TB = (LAS int*)(lds + 131072); LAS int* CN = (LAS int*)(lds + 131072 + 256);
#define P6BODY { cu64* ka = karg(); unsigned char* ws = KA_WS(ka); moe_tables((gu32*)(ws + WS_CTL) + CW_CNT, TB, CN, wave * 64 + fresh_lane()); pg8::Gemm g{(const bf16*)(ws + WS_H), (const bf16*)(ws + WS_WGU), T, 1024, D}; \
        MoeOrder S{TB, CN, (const int*)(ws + WS_STOK), G, bx, true}; pg8::EpiSwiglu E{(bf16*)(ws + WS_HID)}; \
        pg8::gemm_phase<pg8::EpiSwiglu, MoeOrder, true, true>(lds, g, S, E, wave); }
    if (IN(6)) { P6BODY if (PROBE_PHASE == 6) P6BODY }
    SEAM(6);
#define P7BODY { cu64* ka = karg(); unsigned char* ws = KA_WS(ka); moe_tables((gu32*)(ws + WS_CTL) + CW_CNT, TB, CN, wave * 64 + fresh_lane()); pg8::Gemm g{(const bf16*)(ws + WS_HID), (const bf16*)(ws + WS_WD), NSLOT_MAX, 1024, DEXP}; \
        MoeOrder S{TB, CN, (const int*)(ws + WS_STOK), G, bx, false}; pg8::EpiStore E{(bf16*)(ws + WS_Y), 1024, 3, nullptr}; \
        pg8::gemm_phase<pg8::EpiStore, MoeOrder, true, true>(lds, g, S, E, wave); }
    if (IN(7)) { P7BODY if (PROBE_PHASE == 7) P7BODY }
    SEAM(7);
    if (IN(8)) { cu64* ka = karg(); unsigned char* ws = KA_WS(ka); int* rt_e = (int*)(ws + WS_RT);
        moe_tables((gu32*)(ws + WS_CTL) + CW_CNT, TB, CN, wave * 64 + fresh_lane());
        p8_final(KA_OUT(ka), (const bf16*)(ws + WS_Y), (const float*)(ws + WS_MOD), KA_IN(ka, 21), rt_e, rt_e + 2 * T, (const float*)(rt_e + 4 * T), TB, vcu, G, wave, fresh_lane());
    }
#undef IN
#undef SEAM
}

#ifndef MK_N_LAUNCHES
#define MK_N_LAUNCHES 1
#endif
extern "C" void kernel_launch(void* const* d_in, const int* in_sizes, int n_in, void* d_out, int out_size, void* d_ws, size_t ws_size, hipStream_t stream) {
    static int grid = 0;
    if (grid == 0) {
        if (n_in != 22 || in_sizes[0] != T * D || out_size != T * D || ws_size < WS_END) { fprintf(stderr, "kernel_launch: shape/workspace mismatch (n_in %d, in0 %d, out %d, ws %zu, need %zu)\n", n_in, n_in > 0 ? in_sizes[0] : -1, out_size, ws_size, (size_t)WS_END); grid = -1; return; }
        int dev = 0, cus = 0, per_cu = 0;
        if (hipGetDevice(&dev) != hipSuccess || hipDeviceGetAttribute(&cus, hipDeviceAttributeMultiprocessorCount, dev) != hipSuccess) { grid = -1; return; }
        if (hipFuncSetAttribute((const void*)fwd_kernel, hipFuncAttributeMaxDynamicSharedMemorySize, LDS_BYTES) != hipSuccess) { fprintf(stderr, "kernel_launch: hipFuncSetAttribute failed\n"); grid = -1; return; }
        if (hipOccupancyMaxActiveBlocksPerMultiprocessor(&per_cu, (const void*)fwd_kernel, NWAVES * 64, LDS_BYTES) != hipSuccess || per_cu < 1) fprintf(stderr, "kernel_launch: occupancy query reports %d\n", per_cu);
        (void)hipGetLastError();
        grid = cus > 0 ? cus : 256;
    }
    if (grid < 0) return;
    (void)hipMemsetAsync((char*)d_ws + WS_CTL, 0, CTL_ZERO_BYTES, stream);
    Args a{};
    for (int i = 0; i < 22; ++i) a.in[i] = (const float*)d_in[i];
    a.out = (float*)d_out; a.ws = (unsigned char*)d_ws;
    if (MK_N_LAUNCHES == 1) { a.ph_lo = 0; a.ph_hi = NPH; hipLaunchKernelGGL(fwd_kernel, dim3(grid), dim3(NWAVES * 64), LDS_BYTES, stream, a); }
    else for (int p = 0; p < NPH; ++p) { a.ph_lo = p; a.ph_hi = p + 1; hipLaunchKernelGGL(fwd_kernel, dim3(grid), dim3(NWAVES * 64), LDS_BYTES, stream, a); }
    const hipError_t le = hipPeekAtLastError();
    if (le != hipSuccess) fprintf(stderr, "kernel_launch: launch failed: %s\n", hipGetErrorName(le));
}
```

```cpp
#include <hip/hip_runtime.h>
#include <hip/hip_bf16.h>
#include <cstdio>
#include <cstdint>

__device__ __forceinline__ int fresh_lane() { int l; asm volatile("v_mbcnt_lo_u32_b32 %0, -1, 0\n\tv_mbcnt_hi_u32_b32 %0, -1, %0" : "=v"(l)); return l; }
template <int M> __device__ __forceinline__ float lx_get(float v) {
    static_assert(M == 1 || M == 2 || M == 4 || M == 8 || M == 16, "lx_get: M");
    return __builtin_bit_cast(float, __builtin_amdgcn_ds_swizzle(__builtin_bit_cast(int, v), (M << 10) | 0x1f));
}
__device__ __forceinline__ void swap32(float v, float& lo, float& hi) { const unsigned a = __float_as_uint(v);
    auto rr = __builtin_amdgcn_permlane32_swap(a, a, false, false); const unsigned r0 = rr[0], r1 = rr[1]; lo = __uint_as_float(r0); hi = __uint_as_float(r1); }
__device__ __forceinline__ float lx_sum32(float v) { float lo, hi; swap32(v, lo, hi); return lo + hi; }
__device__ __forceinline__ float lx_max32(float v) { float lo, hi; swap32(v, lo, hi); return fmaxf(lo, hi); }
namespace pg8 {
#define PG8_LAS __attribute__((address_space(3)))
typedef unsigned short bf16_t;
typedef short bf16x8 __attribute__((ext_vector_type(8)));
typedef float f32x4 __attribute__((ext_vector_type(4)));
typedef unsigned u32x4 __attribute__((ext_vector_type(4)));
constexpr int BM = 256, BK = 64, HALF = 128, HTB = HALF * BK * 2  , STAGE_BYTES = 8 * HTB, NXCD = 8, WGM = 8;

__host__ __device__ __forceinline__ int lds_byte(int r, int c) { const int st = (r >> 4) * 2 + (c >> 5), rr = r & 15, cc = c & 31, ob = rr * 64 + cc * 2; return st * 1024 + (ob ^ (((ob >> 9) & 1) << 5)); }
__host__ __device__ __forceinline__ void stage_rc(int b, int& R, int& C) { const int st = b / 1024, sb = b % 1024, swz = sb ^ (((sb >> 9) & 1) << 5); R = (st >> 1) * 16 + swz / 64; C = (st & 1) * 32 + (swz % 64) / 2; }
__host__ __device__ __forceinline__ int perm32(int rho) { const int n = rho >> 4, i = rho & 15; return 8 * (i >> 2) + 4 * n + (i & 3); }

struct Unit { int pm, pn, e; };
struct Gemm { const bf16_t* A; const bf16_t* Bt; int M, N, K; };

struct StaticOrder {
    int nM, nN, nwg, G, c;
    __host__ __device__ void init(int M, int N, int G_, int c_) { nM = M / BM; nN = N / BM; nwg = nM * nN; G = G_; c = c_; }
    __host__ __device__ bool next(int i, Unit& u) const {
        const long L = (long)i * G + c; if (L >= nwg) return false;
        int wgid = (int)L; { const int q = nwg / NXCD, r = nwg % NXCD, xcd = wgid % NXCD, off = wgid / NXCD; wgid = (xcd < r ? xcd * (q + 1) : r * (q + 1) + (xcd - r) * q) + off; }
        const int nig = WGM * nN, gid = wgid / nig, fm = gid * WGM, gsz = (nM - fm) < WGM ? (nM - fm) : WGM;
        u.pm = fm + ((wgid % nig) % gsz); u.pn = (wgid % nig) / gsz; u.e = 0; return true;
    }
    __device__ __forceinline__ void a_off(const Unit& u, const int (&RA)[2], const int (&CA)[2], int K, unsigned (&off)[2][2]) const {
#pragma unroll
        for (int h = 0; h < 2; ++h)
#pragma unroll
            for (int i = 0; i < 2; ++i) off[h][i] = (unsigned)(((size_t)(u.pm * BM + h * HALF + RA[i]) * K + CA[i]) * 2);
    }
};


__device__ __forceinline__ unsigned cvt_pk_bf16(float lo, float hi) { unsigned r; asm volatile("v_cvt_pk_bf16_f32 %0, %1, %2" : "=v"(r) : "v"(lo), "v"(hi)); return r; }

struct EpiStore {
    static constexpr bool PERM = true, AFTER_DRAIN = false;
    bf16_t* O; int ldc; int pn_mask; unsigned* km;
    __device__ __forceinline__ void operator()(const f32x4 (&acc)[2][2][4][2], const Unit& u, int wr, int wc, int fr, int fq) const {
        const int row0 = u.pm * BM + wr * 64 + fr; const int col0 = (u.pn & pn_mask) * BM + wc * 32 + 8 * fq;
        if (km && (u.pn == 2 || u.pn == 3 || u.pn == 8 || u.pn == 9)) {
#pragma unroll
            for (int bj = 0; bj < 2; ++bj) { float mx = 0.f;
#pragma unroll
                for (int ai = 0; ai < 2; ++ai)
#pragma unroll
                    for (int m = 0; m < 4; ++m) { const f32x4 v0 = acc[ai][bj][m][0], v1 = acc[ai][bj][m][1];
                        float ss = (v0[0] * v0[0] + v0[1] * v0[1]) + (v0[2] * v0[2] + v0[3] * v0[3]) + (v1[0] * v1[0] + v1[1] * v1[1]) + (v1[2] * v1[2] + v1[3] * v1[3]);
                        ss += lx_get<16>(ss); ss = lx_sum32(ss); mx = fmaxf(mx, ss); }
                mx = fmaxf(mx, lx_get<1>(mx)); mx = fmaxf(mx, lx_get<2>(mx)); mx = fmaxf(mx, lx_get<4>(mx)); mx = fmaxf(mx, lx_get<8>(mx));
                if ((fr | fq) == 0) __hip_atomic_fetch_max(km + (u.pm >> 4) * 96 + (u.pn * BM + bj * HALF + wc * 32) / 32, __float_as_uint(mx), __ATOMIC_RELAXED, __HIP_MEMORY_SCOPE_AGENT); }
        }
#pragma unroll
        for (int ai = 0; ai < 2; ++ai)
#pragma unroll
            for (int m = 0; m < 4; ++m) { bf16_t* rowp = O + (size_t)(row0 + ai * HALF + m * 16) * ldc + col0;
#pragma unroll
                for (int bj = 0; bj < 2; ++bj) { const f32x4 v0 = acc[ai][bj][m][0], v1 = acc[ai][bj][m][1];
                    u32x4 w; w.x = cvt_pk_bf16(v0[0], v0[1]); w.y = cvt_pk_bf16(v0[2], v0[3]); w.z = cvt_pk_bf16(v1[0], v1[1]); w.w = cvt_pk_bf16(v1[2], v1[3]);
                    *(u32x4*)(rowp + bj * HALF) = w; } }
    }
};
struct EpiSwiglu {
    static constexpr bool PERM = true, AFTER_DRAIN = false;
    bf16_t* H;
    __device__ __forceinline__ void operator()(const f32x4 (&acc)[2][2][4][2], const Unit& u, int wr, int wc, int fr, int fq) const {
        const int row0 = u.pm * BM + wr * 64 + fr; const int col0 = (u.pn & 3) * 128 + wc * 32 + 8 * fq;
#pragma unroll
        for (int ai = 0; ai < 2; ++ai)
#pragma unroll
            for (int m = 0; m < 4; ++m) { bf16_t* rowp = H + (size_t)(row0 + ai * HALF + m * 16) * 512 + col0;
                float hv[8];
#pragma unroll
                for (int n = 0; n < 2; ++n)
#pragma unroll
                    for (int i = 0; i < 4; ++i) { const float g = acc[ai][0][m][n][i], up = acc[ai][1][m][n][i];
                        const float e = __builtin_amdgcn_exp2f(-g * 1.4426950408889634f);
                        hv[n * 4 + i] = g * __builtin_amdgcn_rcpf(1.0f + e) * up; }
                u32x4 w; w.x = cvt_pk_bf16(hv[0], hv[1]); w.y = cvt_pk_bf16(hv[2], hv[3]); w.z = cvt_pk_bf16(hv[4], hv[5]); w.w = cvt_pk_bf16(hv[6], hv[7]);
                *(u32x4*)rowp = w; }
    }
};
struct EpiResid {
    static constexpr bool PERM = false, AFTER_DRAIN = false;
    const float* base; float* out; const float* gate;
    __device__ __forceinline__ void operator()(const f32x4 (&acc)[2][2][4][2], const Unit& u, int wr, int wc, int fr, int fq) const {
        const int col0 = u.pn * BM + wc * 32 + 4 * fq; const float* gp = gate + (size_t)(u.pm >> 4) * 6144 + col0;
        f32x4 gv[2][2];
#pragma unroll
        for (int bj = 0; bj < 2; ++bj)
#pragma unroll
            for (int n = 0; n < 2; ++n) gv[bj][n] = *(const f32x4*)(gp + bj * HALF + n * 16);
#pragma unroll
        for (int ai = 0; ai < 2; ++ai)
#pragma unroll
            for (int m = 0; m < 4; ++m) { const size_t off = (size_t)(u.pm * BM + ai * HALF + wr * 64 + m * 16 + fr) * 1024 + col0;
#pragma unroll
                for (int bj = 0; bj < 2; ++bj)
#pragma unroll
                    for (int n = 0; n < 2; ++n) { const f32x4 bs = *(const f32x4*)(base + off + bj * HALF + n * 16);
                        *(f32x4*)(out + off + bj * HALF + n * 16) = bs + gv[bj][n] * acc[ai][bj][m][n]; } }
    }
};

template <class Epi, class Sched, bool ALIGN_EPI = false, bool SP2 = false>
__device__ __forceinline__ void gemm_phase(PG8_LAS unsigned char* lds, const Gemm g, const Sched& S, const Epi& E, int wave) {
    const int wid = wave, lane = fresh_lane(), tid = wid * 64 + lane, wr = wid >> 2, wc = wid & 3, fr = lane & 15, fq = lane >> 4;
    const int K = g.K, nt = K / BK;
    int RA[2], CA[2]; unsigned voffB[2];
#pragma unroll
    for (int i = 0; i < 2; ++i) { int R, C; stage_rc(tid * 16 + i * 8192, R, C); const int Rb = Epi::PERM ? ((R & ~31) + perm32(R & 31)) : R;
        RA[i] = R; CA[i] = C; voffB[i] = (unsigned)(Rb * K + C) * 2u; }
    const size_t kstep = (size_t)(BK * 2);
    const size_t hstep = (size_t)HALF * K * 2;
    const size_t tstep = 2 * hstep;
    const unsigned ldsw = (unsigned)wid * 1024u;
    const int aoff = lds_byte(wr * 64 + fr, fq * 8), boff = lds_byte(wc * 32 + fr, fq * 8);
#define PG8_SA(b, h) (((b) * 2 + (h)) * HTB)
#define PG8_SB(b, h) ((4 + (b) * 2 + (h)) * HTB)
#define PG8_STAGE(bufoff, gbase, voff) do { _Pragma("unroll") for (int _i = 0; _i < 2; ++_i) \
        __builtin_amdgcn_global_load_lds((const unsigned*)((const char*)(gbase) + (voff)[_i]), (PG8_LAS unsigned*)(lds + (bufoff) + ldsw + _i * 8192), 16, 0, 0); } while (0)
#define PG8_LDA(dst, b, h) do { _Pragma("unroll") for (int m = 0; m < 4; ++m) _Pragma("unroll") for (int k = 0; k < 2; ++k) dst[m][k] = *(const PG8_LAS bf16x8*)(lds + PG8_SA(b, h) + aoff + m * 2048 + k * 1024); } while (0)
#define PG8_LDB(dst, b, h) do { _Pragma("unroll") for (int n = 0; n < 2; ++n) _Pragma("unroll") for (int k = 0; k < 2; ++k) dst[n][k] = *(const PG8_LAS bf16x8*)(lds + PG8_SB(b, h) + boff + n * 2048 + k * 1024); } while (0)
#define PG8_MMA(ai, bj, At, Bt) do { __builtin_amdgcn_s_setprio(1); _Pragma("unroll") for (int m = 0; m < 4; ++m) _Pragma("unroll") for (int n = 0; n < 2; ++n) _Pragma("unroll") for (int k = 0; k < 2; ++k) \
        acc[ai][bj][m][n] = __builtin_amdgcn_mfma_f32_16x16x32_bf16(Bt[n][k], At[m][k], acc[ai][bj][m][n], 0, 0, 0); __builtin_amdgcn_s_setprio(0); } while (0)
#define PG8_WAIT_V(n) asm volatile("s_waitcnt vmcnt(" #n ")" ::: "memory")
#define PG8_WAIT_L(n) asm volatile("s_waitcnt lgkmcnt(" #n ")" ::: "memory")
#define PG8_BAR __builtin_amdgcn_s_barrier()
#define PG8_SCHED __builtin_amdgcn_sched_barrier(0)
    Unit cur, nxt; int ui = 0;
    if (!S.next(0, cur)) return;
    f32x4 acc[2][2][4][2];
#pragma unroll
    for (int a = 0; a < 2; ++a)
#pragma unroll
        for (int b = 0; b < 2; ++b)
#pragma unroll
            for (int m = 0; m < 4; ++m)
#pragma unroll
                for (int n = 0; n < 2; ++n) acc[a][b][m][n] = (f32x4){0.f, 0.f, 0.f, 0.f};
    bf16x8 At[4][2], B0[2][2], B1[2][2];
    unsigned oc[2][2], on[2][2];
    S.a_off(cur, RA, CA, K, oc);
    const char* A0 = (const char*)g.A;
    const char* cB = (const char*)g.Bt + (size_t)cur.pn * tstep;
    if constexpr (SP2) {
        PG8_STAGE(PG8_SB(0, 0), cB, voffB); PG8_STAGE(PG8_SB(0, 1), cB + hstep, voffB); PG8_STAGE(PG8_SA(0, 0), A0, oc[0]); PG8_STAGE(PG8_SA(0, 1), A0, oc[1]);
        if (wr == 1) PG8_BAR;
        PG8_WAIT_V(2); PG8_BAR;
        PG8_STAGE(PG8_SB(1, 0), cB + kstep, voffB); PG8_STAGE(PG8_SA(1, 0), A0 + kstep, oc[0]); PG8_STAGE(PG8_SB(1, 1), cB + hstep + kstep, voffB);
        PG8_WAIT_V(6); PG8_BAR;
    } else {
        PG8_STAGE(PG8_SB(0, 0), cB, voffB); PG8_STAGE(PG8_SA(0, 0), A0, oc[0]); PG8_STAGE(PG8_SB(0, 1), cB + hstep, voffB); PG8_STAGE(PG8_SA(0, 1), A0, oc[1]);
        if (wr == 1) PG8_BAR;
        PG8_WAIT_V(4); PG8_BAR;
        PG8_STAGE(PG8_SB(1, 0), cB + kstep, voffB); PG8_STAGE(PG8_SA(1, 0), A0 + kstep, oc[0]); PG8_STAGE(PG8_SB(1, 1), cB + hstep + kstep, voffB);
        PG8_WAIT_V(6); PG8_BAR;
    }
    for (;;) {
        const bool has_next = S.next(ui + 1, nxt);
        if (has_next) S.a_off(nxt, RA, CA, K, on);
        else {
#pragma unroll
            for (int h = 0; h < 2; ++h)
#pragma unroll
                for (int i = 0; i < 2; ++i) on[h][i] = oc[h][i]; }
        const char* nB = has_next ? (const char*)g.Bt + (size_t)nxt.pn * tstep : cB;
        for (int t = 0; t < nt; t += 2) {
            const bool last = (t == nt - 2);
            const char* a1 = A0 + (size_t)(t + 1) * kstep;
            const char* a2 = last ? A0 : A0 + (size_t)(t + 2) * kstep; const char* b2 = last ? nB : cB + (size_t)(t + 2) * kstep;
            const char* a3 = a2 + kstep; const char* b3 = b2 + kstep;
            unsigned o2[2][2];
#pragma unroll
            for (int h = 0; h < 2; ++h)
#pragma unroll
                for (int i = 0; i < 2; ++i) o2[h][i] = last ? on[h][i] : oc[h][i];
            if constexpr (SP2) {
            PG8_LDB(B0, 0, 0); PG8_LDB(B1, 0, 1); PG8_SCHED; PG8_LDA(At, 0, 0); PG8_STAGE(PG8_SA(1, 1), a1, oc[1]);
            PG8_WAIT_V(8); PG8_WAIT_L(0); PG8_BAR; PG8_MMA(0, 0, At, B0); PG8_MMA(0, 1, At, B1); PG8_BAR; PG8_SCHED;
            PG8_LDA(At, 0, 1); PG8_STAGE(PG8_SB(0, 0), b2, voffB); PG8_STAGE(PG8_SB(0, 1), b2 + hstep, voffB); PG8_STAGE(PG8_SA(0, 0), a2, o2[0]);
            PG8_WAIT_V(8); PG8_WAIT_L(0); PG8_BAR; PG8_MMA(1, 0, At, B0); PG8_MMA(1, 1, At, B1); PG8_BAR; PG8_SCHED;
            PG8_LDB(B0, 1, 0); PG8_LDB(B1, 1, 1); PG8_SCHED; PG8_LDA(At, 1, 0); PG8_STAGE(PG8_SA(0, 1), a2, o2[1]);
            PG8_WAIT_V(8); PG8_WAIT_L(0); PG8_BAR; PG8_MMA(0, 0, At, B0); PG8_MMA(0, 1, At, B1); PG8_BAR; PG8_SCHED;
            PG8_LDA(At, 1, 1); PG8_STAGE(PG8_SB(1, 0), b3, voffB); PG8_STAGE(PG8_SB(1, 1), b3 + hstep, voffB); PG8_STAGE(PG8_SA(1, 0), a3, o2[0]);
            PG8_WAIT_V(8); PG8_WAIT_L(0); PG8_BAR; PG8_MMA(1, 0, At, B0); PG8_MMA(1, 1, At, B1); PG8_BAR; PG8_SCHED;
            } else {
            PG8_LDB(B0, 0, 0); PG8_SCHED; PG8_LDA(At, 0, 0); PG8_STAGE(PG8_SA(1, 1), a1, oc[1]);
            PG8_WAIT_L(8); PG8_BAR; PG8_WAIT_L(0); PG8_MMA(0, 0, At, B0); PG8_BAR; PG8_SCHED;
            PG8_LDB(B1, 0, 1); PG8_STAGE(PG8_SB(0, 0), b2, voffB);
            PG8_BAR; PG8_WAIT_L(0); PG8_MMA(0, 1, At, B1); PG8_BAR;
            PG8_LDA(At, 0, 1); PG8_STAGE(PG8_SA(0, 0), a2, o2[0]);
            PG8_BAR; PG8_WAIT_L(0); PG8_MMA(1, 0, At, B0); PG8_BAR; PG8_SCHED;
            PG8_STAGE(PG8_SB(0, 1), b2 + hstep, voffB);
            PG8_WAIT_V(6); PG8_BAR; PG8_MMA(1, 1, At, B1); PG8_BAR;
            PG8_LDB(B0, 1, 0); PG8_SCHED; PG8_LDA(At, 1, 0); PG8_STAGE(PG8_SA(0, 1), a2, o2[1]);
            PG8_WAIT_L(8); PG8_BAR; PG8_WAIT_L(0); PG8_MMA(0, 0, At, B0); PG8_BAR; PG8_SCHED;
            PG8_LDB(B1, 1, 1); PG8_STAGE(PG8_SB(1, 0), b3, voffB);
            PG8_BAR; PG8_WAIT_L(0); PG8_MMA(0, 1, At, B1); PG8_BAR;
            PG8_LDA(At, 1, 1); PG8_STAGE(PG8_SA(1, 0), a3, o2[0]);
            PG8_BAR; PG8_WAIT_L(0); PG8_MMA(1, 0, At, B0); PG8_BAR; PG8_SCHED;
            PG8_STAGE(PG8_SB(1, 1), b3 + hstep, voffB);
            PG8_WAIT_V(6); PG8_BAR; PG8_MMA(1, 1, At, B1); PG8_BAR;
            }
        }
        if constexpr (ALIGN_EPI) { if (wr == 0) PG8_BAR; }
        if constexpr (!Epi::AFTER_DRAIN) { E(acc, cur, wr, wc, fr, fq); }
        if (!has_next) break;
#pragma unroll
        for (int a = 0; a < 2; ++a)
#pragma unroll
            for (int b = 0; b < 2; ++b)
#pragma unroll
                for (int m = 0; m < 4; ++m)
#pragma unroll
                    for (int n = 0; n < 2; ++n) acc[a][b][m][n] = (f32x4){0.f, 0.f, 0.f, 0.f};
        cur = nxt; cB = nB; ++ui;
#pragma unroll
        for (int h = 0; h < 2; ++h)
#pragma unroll
            for (int i = 0; i < 2; ++i) oc[h][i] = on[h][i];
        if constexpr (ALIGN_EPI) { if (wr == 1) PG8_BAR; }
    }
    PG8_WAIT_V(0);
    if constexpr (!ALIGN_EPI) { if (wr == 0) PG8_BAR; }
    PG8_BAR;
#undef PG8_SA
#undef PG8_SB
#undef PG8_STAGE
#undef PG8_LDA
#undef PG8_LDB
#undef PG8_MMA
#undef PG8_WAIT_V
#undef PG8_WAIT_L
#undef PG8_BAR
#undef PG8_SCHED
}
}

namespace att {
#define ATT_LAS __attribute__((address_space(3)))
typedef unsigned short bf16_t;
using bf16x8 = __attribute__((ext_vector_type(8))) short;
using s16x4  = __attribute__((ext_vector_type(4))) short;
using f32x16 = __attribute__((ext_vector_type(16))) float;
using f32x4  = __attribute__((ext_vector_type(4))) float;
using u32x4  = __attribute__((ext_vector_type(4))) unsigned;
using u32x2  = __attribute__((ext_vector_type(2))) unsigned;
constexpr int SEQ = 4096, LDQKV = 3072, LDATT = 1024;
constexpr float LOG2E = 1.4426950408889634f;
#define ATT_SBAR() __builtin_amdgcn_sched_barrier(0)
__device__ __forceinline__ int opaque(int v) { asm volatile("" : "+v"(v)); return v; }
__device__ __forceinline__ void dma16(const void* g, ATT_LAS unsigned char* l) { __builtin_amdgcn_global_load_lds((const unsigned*)g, (ATT_LAS unsigned*)l, 16, 0, 0); }
__device__ __forceinline__ int swap23(int k) { return (k & ~0xC) | ((k & 4) << 1) | ((k & 8) >> 1); }
__device__ __forceinline__ int crow(int r, int hi) { return (r & 3) + 8 * (r >> 2) + 4 * hi; }
__device__ __forceinline__ unsigned cvtpk(float lo, float hi) { unsigned r; asm volatile("v_cvt_pk_bf16_f32 %0, %1, %2" : "=v"(r) : "v"(lo), "v"(hi)); return r; }
__device__ __forceinline__ int ksw(int row, int c) { return row * 128 + ((c ^ ((row >> 1) & 7)) << 4); }
template <int NC> __device__ __forceinline__ int v_st(int k, int c) { const int kk = (k & ~0xC) | ((k & 4) << 1) | ((k & 8) >> 1); return ((kk >> 3) * NC + (c >> 5)) * 512 + ((kk & 7) * 32 + (c & 31)) * 2; }
__device__ __forceinline__ int v_rd_base(int lane) { return ((lane & 3) << 3) | (((lane >> 2) & 3) << 6) | (((lane >> 4) & 1) << 5) | (((lane >> 5) & 1) << 8); }
template <int NC> constexpr int v_rd_off(int d0, int ks, int half) { return d0 * 512 + ks * (2 * NC * 512) + half * (NC * 512); }
template <int OFF> __device__ __forceinline__ s16x4 tr_read(int vb) {
  s16x4 r; asm volatile("ds_read_b64_tr_b16 %0, %1 offset:%2" : "=&v"(r) : "v"(vb), "i"(OFF) : "memory"); return r;
}
template <int NC, int D0> __device__ __forceinline__ void pv_one(f32x16& od, int vb, bf16x8 pa0, bf16x8 pa1, bf16x8 pa2, bf16x8 pa3) {
  const s16x4 l0 = tr_read<v_rd_off<NC>(D0, 0, 0)>(vb), h0 = tr_read<v_rd_off<NC>(D0, 0, 1)>(vb), l1 = tr_read<v_rd_off<NC>(D0, 1, 0)>(vb), h1 = tr_read<v_rd_off<NC>(D0, 1, 1)>(vb);
  const s16x4 l2 = tr_read<v_rd_off<NC>(D0, 2, 0)>(vb), h2 = tr_read<v_rd_off<NC>(D0, 2, 1)>(vb), l3 = tr_read<v_rd_off<NC>(D0, 3, 0)>(vb), h3 = tr_read<v_rd_off<NC>(D0, 3, 1)>(vb);
  asm volatile("s_waitcnt lgkmcnt(0)" ::: "memory"); ATT_SBAR();
#define ATT_PK(L, H) (bf16x8){L[0], L[1], L[2], L[3], H[0], H[1], H[2], H[3]}
  od = __builtin_amdgcn_mfma_f32_32x32x16_bf16(pa0, ATT_PK(l0, h0), od, 0, 0, 0);
  od = __builtin_amdgcn_mfma_f32_32x32x16_bf16(pa1, ATT_PK(l1, h1), od, 0, 0, 0);
  od = __builtin_amdgcn_mfma_f32_32x32x16_bf16(pa2, ATT_PK(l2, h2), od, 0, 0, 0);
  od = __builtin_amdgcn_mfma_f32_32x32x16_bf16(pa3, ATT_PK(l3, h3), od, 0, 0, 0);
#undef ATT_PK
}
__device__ __forceinline__ void qkt(f32x16& p0, f32x16& p1, const ATT_LAS unsigned char* Ks, const bf16x8 (&qr)[4], int r32, int hi) {
  p0 = f32x16{}; p1 = f32x16{};
#pragma unroll
  for (int d0 = 0; d0 < 4; ++d0) {
    const bf16x8 b0 = *(const ATT_LAS bf16x8*)(Ks + ksw(r32, 2 * d0 + hi));
    const bf16x8 b1 = *(const ATT_LAS bf16x8*)(Ks + ksw(32 + r32, 2 * d0 + hi));
    p0 = __builtin_amdgcn_mfma_f32_32x32x16_bf16(b0, qr[d0], p0, 0, 0, 0);
    p1 = __builtin_amdgcn_mfma_f32_32x32x16_bf16(b1, qr[d0], p1, 0, 0, 0);
    if (d0 == 1) ATT_SBAR(); }
}
template <int NO> __device__ __forceinline__ void online_sm(f32x16& p0, f32x16& p1, float& m_reg, float& l_reg, f32x16 (&o)[NO], ATT_LAS float* al_l, int r32, int hi,
                                                             bf16x8& pa0, bf16x8& pa1, bf16x8& pa2, bf16x8& pa3, float c2) {
  float pmax = p0[0];
#pragma unroll
  for (int r = 1; r < 16; ++r) pmax = fmaxf(pmax, p0[r]);
#pragma unroll
  for (int r = 0; r < 16; ++r) pmax = fmaxf(pmax, p1[r]);
  pmax = lx_max32(pmax);
  const float meff = m_reg - c2;
  const float mn = fmaxf(meff, pmax);
  const float alpha = __builtin_amdgcn_exp2f(meff - mn);
  m_reg = mn + c2;
#pragma unroll
  for (int r = 0; r < 16; ++r) { p0[r] = __builtin_amdgcn_exp2f(p0[r] - mn); p1[r] = __builtin_amdgcn_exp2f(p1[r] - mn); }
  float ps = 0.f;
#pragma unroll
  for (int r = 0; r < 16; ++r) ps += p0[r];
#pragma unroll
  for (int r = 0; r < 16; ++r) ps += p1[r];
  ps = lx_sum32(ps);
  l_reg = l_reg * alpha + ps;
  if (__any(alpha < 1.f)) {
    if (hi == 0) al_l[r32] = alpha;
    asm volatile("s_waitcnt lgkmcnt(0)" ::: "memory");
#pragma unroll
    for (int r = 0; r < 16; ++r) { const float a = al_l[crow(r, hi)];
#pragma unroll
      for (int d = 0; d < NO; ++d) o[d][r] *= a; }
    asm volatile("s_waitcnt lgkmcnt(0)" ::: "memory");
  }
#define ATT_PK4(P, BASE, OUT) do { unsigned a0 = cvtpk(P[BASE + 0], P[BASE + 1]), a1 = cvtpk(P[BASE + 2], P[BASE + 3]);   \
    unsigned b0 = cvtpk(P[BASE + 4], P[BASE + 5]), b1 = cvtpk(P[BASE + 6], P[BASE + 7]);                              \
    auto r0 = __builtin_amdgcn_permlane32_swap(a0, b0, false, false); auto r1 = __builtin_amdgcn_permlane32_swap(a1, b1, false, false); \
    u32x4 w = {r0[0], r1[0], r0[1], r1[1]}; OUT = __builtin_bit_cast(bf16x8, w); } while (0)
  ATT_PK4(p0, 0, pa0); ATT_PK4(p0, 8, pa1); ATT_PK4(p1, 0, pa2); ATT_PK4(p1, 8, pa3);
#undef ATT_PK4
}

__device__ __forceinline__ void qkt_bias(f32x16& p0, f32x16& p1, const ATT_LAS float* BT, const ATT_LAS unsigned char* Ks, const bf16x8 (&qr)[4], int r32, int hi) {
#pragma unroll
  for (int g = 0; g < 4; ++g) { const f32x4 b0 = *(const ATT_LAS f32x4*)(BT + 8 * g + 4 * hi), b1 = *(const ATT_LAS f32x4*)(BT + 32 + 8 * g + 4 * hi);
#pragma unroll
    for (int i = 0; i < 4; ++i) { p0[4 * g + i] = b0[i]; p1[4 * g + i] = b1[i]; } }
#pragma unroll
  for (int d0 = 0; d0 < 4; ++d0) {
    const bf16x8 b0 = *(const ATT_LAS bf16x8*)(Ks + ksw(r32, 2 * d0 + hi));
    const bf16x8 b1 = *(const ATT_LAS bf16x8*)(Ks + ksw(32 + r32, 2 * d0 + hi));
    p0 = __builtin_amdgcn_mfma_f32_32x32x16_bf16(b0, qr[d0], p0, 0, 0, 0);
    p1 = __builtin_amdgcn_mfma_f32_32x32x16_bf16(b1, qr[d0], p1, 0, 0, 0);
    if (d0 == 1) ATT_SBAR(); }
}

constexpr float SKIP_T = 40.0f;
__device__ __forceinline__ float q_norm(const bf16x8 (&qr)[4]) {
  float s = 0.f;
#pragma unroll
  for (int d0 = 0; d0 < 4; ++d0)
#pragma unroll
    for (int e = 0; e < 8; ++e) { const float v = __uint_as_float(((unsigned)(unsigned short)qr[d0][e]) << 16); s = fmaf(v, v, s); }
  return sqrtf(lx_sum32(s));
}
__device__ __forceinline__ float k_max(const unsigned* km, int g) {
  const float a = __uint_as_float(__hip_atomic_load(km + g, __ATOMIC_RELAXED, __HIP_MEMORY_SCOPE_AGENT)), b = __uint_as_float(__hip_atomic_load(km + g + 1, __ATOMIC_RELAXED, __HIP_MEMORY_SCOPE_AGENT));
  return sqrtf(a + b) * 1.005f;
}
__device__ __forceinline__ bool all_done(const ATT_LAS int* DONE, int i) {
  const ATT_LAS u32x4* d = (const ATT_LAS u32x4*)DONE; const u32x4 a = d[0], b = d[1];
  const unsigned m = max(max(max(a.x, a.y), max(a.z, a.w)), max(max(b.x, b.y), max(b.z, b.w)));
  return __builtin_amdgcn_readfirstlane((int)(m < (unsigned)i)) != 0;
}
#define ATT_WAIT_BAR(N) asm volatile("s_waitcnt vmcnt(" #N ") lgkmcnt(0)\n\ts_barrier" ::: "memory")

__device__ __forceinline__ void fox_unit(ATT_LAS unsigned char* lds, const bf16_t* __restrict__ qkv, bf16_t* __restrict__ attn, const float* __restrict__ cl2, const float* __restrict__ blk2, const unsigned* km,
                                         int b, int h, int qb, int wave) {
  const int wid = wave, lane = fresh_lane(), tid = wid * 64 + lane, r32 = lane & 31, hi = lane >> 5;
  ATT_LAS float* CARRY = (ATT_LAS float*)(lds + 55296); ATT_LAS float* wsf = (ATT_LAS float*)(lds + 55552) + wid * 64;
  ATT_LAS unsigned char* BW = lds + 49152 + wid * 768; ATT_LAS int* DONE = (ATT_LAS int*)(lds + 57600);
  if (lane == 0) DONE[wid] = 0x7fffffff;
  const int q0 = qb * 256, NT = 4 * (qb + 1), jl = 4 * qb + (wid >> 1);
  const size_t rowb = (size_t)b * SEQ; const int bh = b * 8 + h;
  if (wid == 0) { float v = lane < 32 ? blk2[(b * 32 + lane) * 8 + h] : 0.f; float s = v;
#pragma unroll
    for (int o = 1; o < 32; o <<= 1) { const float t = __builtin_bit_cast(float, __builtin_amdgcn_ds_bpermute(((lane - o) & 63) << 2, __builtin_bit_cast(int, s))); if (lane >= o) s += t; }
    if (lane < 32) CARRY[lane] = s - v; }
  __syncthreads();
  const float cq = CARRY[q0 >> 7] + cl2[(size_t)bh * SEQ + q0];
  bf16x8 qr[4];
  { const bf16_t* Qw = qkv + (rowb + q0 + wid * 32 + r32) * LDQKV + h * 64 + hi * 8;
#pragma unroll
    for (int d0 = 0; d0 < 4; ++d0) qr[d0] = *(const bf16x8*)(Qw + d0 * 16); }
  const int pk = 64 * wid + lane;
  unsigned koff, voff;
  { const int row = pk >> 3, c = (pk & 7) ^ ((row >> 1) & 7); koff = (unsigned)((row * LDQKV + 512 + h * 64 + c * 8) * 2);
    const int sub = pk >> 5, kk = 8 * (sub >> 1) + ((pk & 31) >> 2), k = swap23(kk), cv = (sub & 1) * 32 + (pk & 3) * 8; voff = (unsigned)((k * LDQKV + 1024 + h * 64 + cv) * 2); }
  const char* tb = (const char*)(qkv + rowb * LDQKV);
  const char* cg = (const char*)(cl2 + (size_t)bh * SEQ) + (lane & 15) * 16;
  const int vb0 = (int)(uintptr_t)(lds + 24576) + v_rd_base(lane);
#define FOX_LOAD(j, bo) do { const char* tj = tb + (size_t)(j) * (64 * LDQKV * 2); dma16(tj + koff, lds + (bo) * 8192 + wid * 1024); dma16(tj + voff, lds + 24576 + (bo) * 8192 + wid * 1024); \
    if (lane < 16) dma16(cg + (j) * 256, BW + (bo) * 256); } while (0)
  FOX_LOAD(NT - 1, 0); FOX_LOAD(NT - 2, 1);
  __builtin_amdgcn_s_waitcnt(0x0F70);
  float m_reg = -1e30f, l_reg = 0.f; f32x16 o[2]; o[0] = f32x16{}; o[1] = f32x16{};
  const float bnd = q_norm(qr) * k_max(km + b * 96, 16 + 2 * h);
  bool stopped = false;
  int cur = 0, nx2 = 2;
  for (int i = 0; i < NT; ++i) {
    const int j = NT - 1 - i;
    if (i + 1 < NT) ATT_WAIT_BAR(3); else ATT_WAIT_BAR(0);
    if (all_done(DONE, i)) break;
    if (i + 2 < NT) FOX_LOAD(j - 2, nx2);
    if (j <= jl && !stopped) {
      const float bj = ((const ATT_LAS float*)(BW + cur * 256))[63] + (CARRY[j >> 1] - cq);
      if (!__any(bnd + bj - m_reg >= -SKIP_T)) { stopped = true; if (lane == 0) DONE[wid] = i; }
    }
    if (j <= jl && !stopped) {
      f32x16 p0, p1; bf16x8 pa0, pa1, pa2, pa3;
      qkt_bias(p0, p1, (const ATT_LAS float*)(BW + cur * 256), lds + cur * 8192, qr, r32, hi);
      if (j == jl) { const int qrel = 32 * (wid & 1) + r32;
#pragma unroll
        for (int r = 0; r < 16; ++r) { const int kr = crow(r, hi); if (kr > qrel) p0[r] = -1e30f; if (kr + 32 > qrel) p1[r] = -1e30f; } }
      const float c2 = CARRY[j >> 1] - cq;
      online_sm<2>(p0, p1, m_reg, l_reg, o, wsf, r32, hi, pa0, pa1, pa2, pa3, c2);
      pv_one<2, 0>(o[0], vb0 + cur * 8192, pa0, pa1, pa2, pa3); pv_one<2, 1>(o[1], vb0 + cur * 8192, pa0, pa1, pa2, pa3);
    }
    cur = cur == 2 ? 0 : cur + 1; nx2 = nx2 == 2 ? 0 : nx2 + 1;
  }
#undef FOX_LOAD
  asm volatile("s_waitcnt vmcnt(0)" ::: "memory");
  if (hi == 0) wsf[32 + r32] = l_reg; asm volatile("s_waitcnt lgkmcnt(0)" ::: "memory");
  { const int le = opaque(lane), r32e = le & 31, hie = le >> 5;
  bf16_t* Ow = attn + (rowb + q0 + wid * 32) * LDATT + h * 64 + r32e;
#pragma unroll
  for (int r = 0; r < 16; ++r) { const int orow = crow(r, hie); const float rl = __builtin_amdgcn_rcpf(wsf[32 + orow]);
#pragma unroll
    for (int d0 = 0; d0 < 2; ++d0) { const unsigned w = cvtpk(o[d0][r] * rl, 0.f); Ow[(size_t)orow * LDATT + d0 * 32] = (bf16_t)(w & 0xffffu); } } }
  asm volatile("s_waitcnt lgkmcnt(0)" ::: "memory");
  __syncthreads();
}

__device__ __forceinline__ void diff_unit(ATT_LAS unsigned char* lds, const bf16_t* __restrict__ qkv, bf16_t* __restrict__ attn, const float* __restrict__ subln_g, float lam, const unsigned* km,
                                          int b, int h, int qb, int wave) {
  const int wid = wave, lane = fresh_lane(), tid = wid * 64 + lane, r32 = lane & 31, hi = lane >> 5;
  ATT_LAS float* wsf = (ATT_LAS float*)(lds + 98304) + wid * 64; ATT_LAS float* BT = (ATT_LAS float*)(lds + 100352) + wid * 64;
  ATT_LAS int* DONE = (ATT_LAS int*)(lds + 102400);
  if (lane == 0) DONE[wid] = 0x7fffffff;
  const int map = wid >> 2, w4 = wid & 3;
  const int q0 = qb * 128, NT = 2 * (qb + 1), jl = 2 * qb + (w4 >> 1);
  const size_t rowb = (size_t)b * SEQ;
  const float sl2 = LOG2E * (h == 0 ? 0.25f : h == 1 ? 0.0625f : h == 2 ? 0.015625f : 0.00390625f);
  BT[lane] = sl2 * (float)lane;
  bf16x8 qr[4];
  { const bf16_t* Qw = qkv + (rowb + q0 + w4 * 32 + r32) * LDQKV + 1536 + h * 128 + map * 64 + hi * 8;
#pragma unroll
    for (int d0 = 0; d0 < 4; ++d0) qr[d0] = *(const bf16x8*)(Qw + d0 * 16); }
  const int pk = 64 * wid + lane;
  unsigned koff, voff0, voff1;
  { const int row = pk >> 3, c = (pk & 7) ^ ((row >> 1) & 7); koff = (unsigned)((row * LDQKV + 2048 + h * 128 + c * 8) * 2);
    const int sub0 = pk >> 5, kk0 = 8 * (sub0 >> 2) + ((pk & 31) >> 2), k0 = swap23(kk0), c0 = (sub0 & 3) * 32 + (pk & 3) * 8; voff0 = (unsigned)((k0 * LDQKV + 2560 + h * 128 + c0) * 2);
    const int p1 = pk + 512, sub1 = p1 >> 5, kk1 = 8 * (sub1 >> 2) + ((p1 & 31) >> 2), k1 = swap23(kk1), c1 = (sub1 & 3) * 32 + (p1 & 3) * 8; voff1 = (unsigned)((k1 * LDQKV + 2560 + h * 128 + c1) * 2); }
  const char* tb = (const char*)(qkv + rowb * LDQKV);
  const int vb0 = (int)(uintptr_t)(lds + 49152) + v_rd_base(lane);
#define DIFF_LOAD(j, bo) do { const char* tj = tb + (size_t)(j) * (64 * LDQKV * 2); dma16(tj + koff, lds + (bo) * 8192 + wid * 1024); dma16(tj + koff + 128, lds + 24576 + (bo) * 8192 + wid * 1024); \
    dma16(tj + voff0, lds + 49152 + (bo) * 16384 + wid * 1024); dma16(tj + voff1, lds + 49152 + (bo) * 16384 + 8192 + wid * 1024); } while (0)
  DIFF_LOAD(NT - 1, 0); DIFF_LOAD(NT - 2, 1);
  __builtin_amdgcn_s_waitcnt(0x0F70);
  float m_reg = -1e30f, l_reg = 0.f; f32x16 o[4]; o[0] = f32x16{}; o[1] = f32x16{}; o[2] = f32x16{}; o[3] = f32x16{};
  const float bnd = q_norm(qr) * k_max(km + b * 96, 64 + 4 * h + 2 * map);
  bool stopped = false;
  int cur = 0, nx2 = 2;
  for (int i = 0; i < NT; ++i) {
    const int j = NT - 1 - i;
    if (i + 1 < NT) ATT_WAIT_BAR(4); else ATT_WAIT_BAR(0);
    if (all_done(DONE, i)) break;
    if (i + 2 < NT) DIFF_LOAD(j - 2, nx2);
    if (j < jl && !stopped) {
      const float bj = sl2 * (float)(64 * j + 63 - q0);
      if (!__any(bnd + bj - m_reg >= -SKIP_T)) { stopped = true; if (lane == 0) DONE[wid] = i; }
    }
    if (j <= jl && !stopped) {
      f32x16 p0, p1; bf16x8 pa0, pa1, pa2, pa3;
      qkt_bias(p0, p1, BT, lds + map * 24576 + cur * 8192, qr, r32, hi);
      if (j == jl) { const int tq = 32 * (w4 & 1) + r32;
#pragma unroll
        for (int r = 0; r < 16; ++r) { const int k0 = crow(r, hi), k1 = k0 + 32; if (k0 > tq) p0[r] += sl2 * (float)(2 * (tq - k0)); if (k1 > tq) p1[r] += sl2 * (float)(2 * (tq - k1)); } }
      const float c2 = sl2 * (float)(64 * j - q0);
      online_sm<4>(p0, p1, m_reg, l_reg, o, wsf, r32, hi, pa0, pa1, pa2, pa3, c2);
      const int vb = vb0 + cur * 16384;
      pv_one<4, 0>(o[0], vb, pa0, pa1, pa2, pa3); pv_one<4, 1>(o[1], vb, pa0, pa1, pa2, pa3); pv_one<4, 2>(o[2], vb, pa0, pa1, pa2, pa3); pv_one<4, 3>(o[3], vb, pa0, pa1, pa2, pa3);
    }
    cur = cur == 2 ? 0 : cur + 1; nx2 = nx2 == 2 ? 0 : nx2 + 1;
  }
#undef DIFF_LOAD
  asm volatile("s_waitcnt vmcnt(0)" ::: "memory");
  if (hi == 0) wsf[32 + r32] = l_reg; asm volatile("s_waitcnt lgkmcnt(0)" ::: "memory");
  __syncthreads();
  ATT_LAS float* X = (ATT_LAS float*)lds;
  const int te = opaque(tid), r32e = te & 31, hie = (te >> 5) & 1;
  if (map == 1) {
#pragma unroll
    for (int r = 0; r < 16; ++r) { const int orow = crow(r, hie); const float rl = __builtin_amdgcn_rcpf(wsf[32 + orow]);
#pragma unroll
      for (int d0 = 0; d0 < 4; ++d0) X[(32 * w4 + orow) * 132 + d0 * 32 + r32e] = o[d0][r] * rl; } }
  __syncthreads();
  if (map == 0) {
#pragma unroll
    for (int r = 0; r < 16; ++r) { const int orow = crow(r, hie); const float rl = __builtin_amdgcn_rcpf(wsf[32 + orow]);
#pragma unroll
      for (int d0 = 0; d0 < 4; ++d0) { const int idx = (32 * w4 + orow) * 132 + d0 * 32 + r32e; X[idx] = o[d0][r] * rl - lam * X[idx]; } } }
  __syncthreads();
  { const int row = te >> 2, qt = te & 3; float v[32]; float ss = 0.f;
#pragma unroll
    for (int i = 0; i < 8; ++i) { const f32x4 t = *(const ATT_LAS f32x4*)(X + row * 132 + qt * 32 + 4 * i); v[4 * i] = t[0]; v[4 * i + 1] = t[1]; v[4 * i + 2] = t[2]; v[4 * i + 3] = t[3];
      ss += t[0] * t[0] + t[1] * t[1] + t[2] * t[2] + t[3] * t[3]; }
    ss += lx_get<1>(ss); ss += lx_get<2>(ss);
    const float rstd = 0.8f / sqrtf(ss * (1.0f / 128.0f) + 1e-5f);
    bf16_t* op = attn + (rowb + q0 + row) * LDATT + 512 + h * 128 + qt * 32; const float* gp = subln_g + qt * 32;
#pragma unroll
    for (int i = 0; i < 4; ++i) { u32x4 w;
      w.x = cvtpk(v[8 * i + 0] * rstd * gp[8 * i + 0], v[8 * i + 1] * rstd * gp[8 * i + 1]); w.y = cvtpk(v[8 * i + 2] * rstd * gp[8 * i + 2], v[8 * i + 3] * rstd * gp[8 * i + 3]);
      w.z = cvtpk(v[8 * i + 4] * rstd * gp[8 * i + 4], v[8 * i + 5] * rstd * gp[8 * i + 5]); w.w = cvtpk(v[8 * i + 6] * rstd * gp[8 * i + 6], v[8 * i + 7] * rstd * gp[8 * i + 7]);
      *(u32x4*)(op + 8 * i) = w; } }
  __syncthreads();
}
#undef ATT_WAIT_BAR
#undef ATT_SBAR
}

constexpr int NWAVES = 8;
constexpr int BATCH = 8, SEQ = 4096, D = 1024, T = BATCH * SEQ;
constexpr int IN_COLS = 3080, NQKV = 3072;
constexpr int NEXP = 32, DEXP = 512, NSLOT_MAX = 73728;
constexpr int NPH = 9;
constexpr float C2 = 0.125f * 1.4426950408889634f;
constexpr float LAM_INIT = 0.2f;

constexpr size_t MiB = 1u << 20;
constexpr size_t WS_CTL = 0, CTL_ZERO_BYTES = 1 * MiB;
constexpr size_t WS_WIN = 1 * MiB;
constexpr size_t WS_WO = 7 * MiB;
constexpr size_t WS_WGU = 9 * MiB;
constexpr size_t WS_WD = 73 * MiB;
constexpr size_t WS_WR = 105 * MiB;
constexpr size_t WS_MOD = 106 * MiB;
constexpr size_t WS_CUM = 107 * MiB;
constexpr size_t WS_BLK = 108 * MiB;
constexpr size_t WS_RT = 109 * MiB;
constexpr size_t WS_STOK = 110 * MiB;
constexpr size_t WS_R = 118 * MiB;
constexpr size_t WS_H = WS_R;
constexpr size_t WS_QKV = WS_R + 64 * MiB;
constexpr size_t WS_Y = WS_R;
constexpr size_t WS_HID = WS_R + 144 * MiB;
constexpr size_t WS_END = WS_R + 256 * MiB;
constexpr int CW_BAR = 4096;
constexpr int CW_KM = 32768;
constexpr int CW_CNT = 16384;

constexpr int LDS_BYTES = 155648;
constexpr int MISC_OFF = LDS_BYTES - 256;

#define GAS __attribute__((address_space(1)))
#define LAS __attribute__((address_space(3)))
typedef unsigned short bf16;
typedef unsigned v4u __attribute__((ext_vector_type(4)));
typedef unsigned v2u __attribute__((ext_vector_type(2)));
typedef float f32x4 __attribute__((ext_vector_type(4)));
typedef GAS unsigned gu32;
#define RLX_AGENT __ATOMIC_RELAXED, __HIP_MEMORY_SCOPE_AGENT
#define LDS_WAIT() asm volatile("s_waitcnt lgkmcnt(0)" ::: "memory")
#define VM_WAIT() asm volatile("s_waitcnt vmcnt(0)" ::: "memory")
__device__ __forceinline__ unsigned f2bf(float f) { unsigned u = __builtin_bit_cast(unsigned, f); return (u + 0x7fffu + ((u >> 16) & 1u)) >> 16; }
__device__ __forceinline__ unsigned pk2(float lo, float hi) { return f2bf(lo) | (f2bf(hi) << 16); }
__device__ __forceinline__ float bflo(unsigned w) { return __builtin_bit_cast(float, w << 16); }
__device__ __forceinline__ float bfhi(unsigned w) { return __builtin_bit_cast(float, w & 0xffff0000u); }
__device__ __forceinline__ float wave_sum(float v) {
#ifdef OLD_WSUM
#pragma unroll
    for (int o = 1; o < 64; o <<= 1) v += __shfl_xor(v, o);
    return v;
#else
    v += lx_get<1>(v); v += lx_get<2>(v); v += lx_get<4>(v); v += lx_get<8>(v); v += lx_get<16>(v);
    return lx_sum32(v);
#endif
}
#define XB_TMO      128
#define XB_XCNT(j)  (256  + 64 * (j))
#define XB_XSUB(j)  (1280 + 64 * (j))
#define XB_XGEN(j)  (2304 + 64 * (j))
#define XB_TOP      3328
#define XB_TOPGEN   3392
#define XCD_BAR_WORDS 3456
#define XB_SPIN_CAP (1u << 18)

__device__ __forceinline__ unsigned xb_ld(unsigned* p)              { return __hip_atomic_load(p, __ATOMIC_RELAXED, __HIP_MEMORY_SCOPE_AGENT); }
__device__ __forceinline__ unsigned xb_add(unsigned* p, unsigned v) { return __hip_atomic_fetch_add(p, v, __ATOMIC_RELAXED, __HIP_MEMORY_SCOPE_AGENT); }
__device__ __forceinline__ unsigned xb_xcc_id() { return (unsigned)__builtin_amdgcn_s_getreg((3 << 11) | 20) & 0xFu; }
#define XB_SPIN(cond, bar) do { unsigned _sp = 0; while (cond) { __builtin_amdgcn_s_sleep(1); \
    if ((++_sp & 255u) == 0u) { if (xb_ld(&(bar)[XB_TMO])) break; if (_sp > XB_SPIN_CAP) { atomicAdd(&(bar)[XB_TMO], 1u); break; } } } } while (0)

struct XcdBarrier {
    int wave;
    unsigned* bar; unsigned x;
    volatile LAS unsigned* st;
};

__device__ __forceinline__ XcdBarrier xcd_barrier_post(unsigned* bar, volatile LAS unsigned* st) {
    XcdBarrier b; b.bar = bar; b.x = xb_xcc_id(); b.st = st;
    if (threadIdx.x == 0) (void)xb_add(&bar[XB_XCNT(b.x)], 1u);
    return b;
}
__device__ __forceinline__ void xcd_barrier_complete(unsigned* bar, unsigned x, unsigned& nloc, unsigned& nx) {
    const unsigned G = gridDim.x * gridDim.y * gridDim.z;
    unsigned sum, cnt, mine, sp = 0u;
    for (;;) {
        sum = 0u; cnt = 0u; mine = 0u;
#pragma unroll
        for (unsigned j = 0; j < 16; ++j) { const unsigned c = xb_ld(&bar[XB_XCNT(j)]); sum += c; cnt += (c > 0u) ? 1u : 0u; mine = (j == x) ? c : mine; }
        if (sum == G) break;
        __builtin_amdgcn_s_sleep(1);
        if ((++sp & 255u) == 0u) { if (xb_ld(&bar[XB_TMO])) break; if (sp > XB_SPIN_CAP) { atomicAdd(&bar[XB_TMO], 1u); break; } }
    }
    nloc = mine > 0u ? mine : 1u; nx = cnt > 0u ? cnt : 1u;
}

__device__ __forceinline__ void xcd_barrier(const XcdBarrier& b) {
    asm volatile("s_waitcnt vmcnt(0)" ::: "memory");
    __syncthreads();
    if (b.wave == 0 && fresh_lane() == 0) {
        unsigned* bar = b.bar;
        __builtin_amdgcn_s_waitcnt(0);
        unsigned nloc = b.st[0], nx = b.st[1];
        if (nloc == 0u) { xcd_barrier_complete(bar, b.x, nloc, nx); b.st[0] = nloc; b.st[1] = nx; }
        const unsigned old = xb_add(&bar[XB_XSUB(b.x)], 1u);
        const unsigned gen = old / nloc;
        if (old + 1u == (gen + 1u) * nloc) {
            __builtin_amdgcn_fence(__ATOMIC_RELEASE, "agent");
            asm volatile("s_waitcnt vmcnt(0)" ::: "memory");
            const unsigned og = xb_add(&bar[XB_TOP], 1u);
            const unsigned tg = og / nx;
            if (og + 1u == (tg + 1u) * nx) xb_add(&bar[XB_TOPGEN], 1u);
            else XB_SPIN(xb_ld(&bar[XB_TOPGEN]) == tg, bar);
            __builtin_amdgcn_fence(__ATOMIC_ACQUIRE, "agent");
            xb_add(&bar[XB_XGEN(b.x)], 1u);
            asm volatile("s_waitcnt vmcnt(0)" ::: "memory");
        } else {
            XB_SPIN(xb_ld(&bar[XB_XGEN(b.x)]) == gen, bar);
            __builtin_amdgcn_fence(__ATOMIC_ACQUIRE, "agent");
            asm volatile("s_waitcnt vmcnt(0)" ::: "memory");
        }
    }
    __syncthreads();
}

__device__ __forceinline__ void tr_item(const float* __restrict__ src, int ldS, bf16* __restrict__ dst, int ldD, float scale, LAS float* scr, int lane) {
#pragma unroll 8
    for (int i = 0; i < 32; ++i) { const int kk = 2 * i + (lane >> 5); scr[kk * 33 + (lane & 31)] = src[(size_t)kk * ldS + (lane & 31)]; }
    LDS_WAIT(); asm volatile("" ::: "memory");
    const int c = lane & 7;
#pragma unroll
    for (int j = 0; j < 4; ++j) { const int n = (lane >> 3) + 8 * j; const LAS float* s = scr + (8 * c) * 33 + n;
        v4u o; o.x = pk2(s[0 * 33] * scale, s[1 * 33] * scale); o.y = pk2(s[2 * 33] * scale, s[3 * 33] * scale); o.z = pk2(s[4 * 33] * scale, s[5 * 33] * scale); o.w = pk2(s[6 * 33] * scale, s[7 * 33] * scale);
        *(v4u*)(dst + (size_t)n * ldD + 8 * c) = o; }
    LDS_WAIT(); asm volatile("" ::: "memory");
}
struct P0Args { const float *c, *ada_w, *ada_b, *w_in, *w_o, *w_rg, *w_re, *w_gate, *w_up, *w_down; bf16 *Wt_in, *Wt_o, *Wt_gu, *Wt_d; float *Wr, *mod; };
__device__ __forceinline__ void p0_prologue(const P0Args& a, LAS unsigned char* lds, int vcu, int G, int tid, int wave, int lane) {
    LAS float* scr = (LAS float*)(lds + wave * 8448);
    const int gw = vcu * NWAVES + wave, NGW = G * NWAVES;
    constexpr int I_IN = 16 * 96, I_O = 16 * 32, I_GU = 32 * 16 * 32, I_D = 32 * 8 * 32;
    constexpr int NITEMS = I_IN + I_O + I_GU + I_D;
    for (int it = gw; it < NITEMS; it += NGW) {
        int r = it;
        if (r < I_IN) { const int kb = r / 96, nb = r % 96, n0 = 32 * nb, sc = n0 < 1536 ? n0 : n0 + 8;
            const float scale = (n0 < 512 || (n0 >= 1536 && n0 < 2048)) ? C2 : 1.0f;
            tr_item(a.w_in + (size_t)(64 * kb) * IN_COLS + sc, IN_COLS, a.Wt_in + (size_t)n0 * 1024 + 64 * kb, 1024, scale, scr, lane); continue; }
        r -= I_IN;
        if (r < I_O) { const int kb = r / 32, nb = r % 32;
            tr_item(a.w_o + (size_t)(64 * kb) * 1024 + 32 * nb, 1024, a.Wt_o + (size_t)(32 * nb) * 1024 + 64 * kb, 1024, 1.0f, scr, lane); continue; }
        r -= I_O;
        if (r < I_GU) { const int e = r / 512, q = r % 512, kb = q / 32, nb = q % 32, n0 = 32 * nb, pn = n0 >> 8, bj = (n0 >> 7) & 1, j0 = n0 & 127;
            const float* src = (bj ? a.w_up : a.w_gate) + (size_t)e * 1024 * 512 + (size_t)(64 * kb) * 512 + 128 * pn + j0;
            tr_item(src, 512, a.Wt_gu + ((size_t)e * 1024 + n0) * 1024 + 64 * kb, 1024, 1.0f, scr, lane); continue; }
        r -= I_GU;
        { const int e = r / 256, q = r % 256, kb = q / 32, nb = q % 32;
            tr_item(a.w_down + (size_t)e * 512 * 1024 + (size_t)(64 * kb) * 1024 + 32 * nb, 1024, a.Wt_d + ((size_t)e * 1024 + 32 * nb) * 512 + 64 * kb, 512, 1.0f, scr, lane); }
    }
    for (int t = (vcu * NWAVES * 64 + tid); t < 32 * 3 * 2 * 64; t += G * NWAVES * 64) { const int l = t & 63, part = (t >> 6) & 1, ic = t >> 7, c = ic % 3, i = ic / 3, n = 16 * c + (l & 15), k0 = 32 * i + 8 * (l >> 4);
        unsigned short o[8];
#pragma unroll
        for (int j = 0; j < 8; ++j) { const int k = k0 + j; const float w = n < 32 ? a.w_re[k * 32 + n] : (n < 36 ? a.w_rg[k * 4 + (n - 32)] : 0.f);
            const unsigned hi = f2bf(w); const float lo = w - __builtin_bit_cast(float, hi << 16); o[j] = (unsigned short)(part ? f2bf(lo) : hi); }
        v4u pk; pk.x = o[0] | ((unsigned)o[1] << 16); pk.y = o[2] | ((unsigned)o[3] << 16); pk.z = o[4] | ((unsigned)o[5] << 16); pk.w = o[6] | ((unsigned)o[7] << 16);
        *(v4u*)((bf16*)a.Wr + (size_t)t * 8) = pk; }
    __syncthreads();
    LAS float* cs = (LAS float*)(lds + 69632);
    LAS float* red = (LAS float*)(lds + 69632 + 32768);
    for (int i = tid; i < 8192; i += NWAVES * 64) cs[i] = a.c[i];
    __syncthreads();
    for (int ch = vcu; ch < 96; ch += G) {
        float acc[8];
#pragma unroll
        for (int b = 0; b < 8; ++b) acc[b] = 0.f;
        const float* wp = a.ada_w + (size_t)(wave * 128) * 6144 + ch * 64 + lane;
#pragma unroll 8
        for (int k = 0; k < 128; ++k) { const float wv = wp[(size_t)k * 6144];
#pragma unroll
            for (int b = 0; b < 8; ++b) acc[b] = fmaf(cs[b * 1024 + wave * 128 + k], wv, acc[b]); }
#pragma unroll
        for (int b = 0; b < 8; ++b) red[(wave * 8 + b) * 64 + lane] = acc[b];
        __syncthreads();
        { const int b = tid >> 6, l = tid & 63; float s = a.ada_b[ch * 64 + l];
#pragma unroll
          for (int w = 0; w < 8; ++w) s += red[(w * 8 + b) * 64 + l];
          a.mod[b * 6144 + ch * 64 + l] = s; }
        __syncthreads();
    }
}

__device__ __forceinline__ void p1_norm(const float* __restrict__ x, const float* __restrict__ g1, const float* __restrict__ mod, const float* __restrict__ w_in, const float* __restrict__ b_f,
                                        bf16* __restrict__ H, float* __restrict__ cumloc, float* __restrict__ blktot, LAS unsigned char* lds, int vcu, int G, int tid, int wave, int lane) {
    LAS float* wfz = (LAS float*)lds; LAS float* lf = (LAS float*)(lds + 32768); LAS float* segtot = (LAS float*)(lds + 36864);
    for (int i = tid; i < 8192; i += NWAVES * 64) { const int jh = i >> 10, k = i & 1023; wfz[i] = w_in[(size_t)k * IN_COLS + 1536 + jh]; }
    __syncthreads();
    for (int rb = vcu; rb < T / 128; rb += G) {
        const int b = rb >> 5;
        f32x4 A[4], Bc[4];
#pragma unroll
        for (int j = 0; j < 4; ++j) { const int col = 256 * j + 4 * lane; const f32x4 g = *(const f32x4*)(g1 + col), sc = *(const f32x4*)(mod + b * 6144 + 1024 + col);
            A[j] = g * (1.0f + sc); Bc[j] = *(const f32x4*)(mod + b * 6144 + col); }
        const float bfv = b_f[lane & 7];
        for (int rr = 0; rr < 16; ++rr) {
            const int row = rb * 128 + wave * 16 + rr;
            const f32x4* xr = (const f32x4*)(x + (size_t)row * D) + lane;
            f32x4 v[4]; float s = 0.f;
#pragma unroll
            for (int j = 0; j < 4; ++j) { v[j] = xr[64 * j]; s += (v[j].x * v[j].x + v[j].y * v[j].y) + (v[j].z * v[j].z + v[j].w * v[j].w); }
            const float rstd = 1.0f / sqrtf(wave_sum(s) * (1.0f / D) + 1e-6f);
#pragma unroll
            for (int j = 0; j < 4; ++j) v[j] = v[j] * rstd * A[j] + Bc[j];
            v2u* o8 = (v2u*)(H + (size_t)row * D) + lane;
#pragma unroll
            for (int j = 0; j < 4; ++j) { v2u w; w.x = pk2(v[j].x, v[j].y); w.y = pk2(v[j].z, v[j].w); o8[64 * j] = w; }
            float z = 0.f;
#pragma unroll
            for (int jh = 0; jh < 8; ++jh) { float acc = 0.f;
#pragma unroll
                for (int j = 0; j < 4; ++j) { const f32x4 w4 = *(const LAS f32x4*)(wfz + jh * 1024 + 256 * j + 4 * lane); acc += (v[j].x * w4.x + v[j].y * w4.y) + (v[j].z * w4.z + v[j].w * w4.w); }
                acc = wave_sum(acc); z = ((lane & 7) == jh) ? acc : z; }
            z += bfv;
            const float lfv = fminf(z, 0.f) - log1pf(expf(-fabsf(z)));
            if (lane < 8) lf[(wave * 16 + rr) * 8 + lane] = lfv;
        }
        __syncthreads();
        float run[16]; const int hh = tid & 7, seg = (tid >> 3) & 7;
        if (tid < 64) { float s = 0.f;
#pragma unroll
            for (int i = 0; i < 16; ++i) { s += lf[(seg * 16 + i) * 8 + hh]; run[i] = s; }
            segtot[seg * 8 + hh] = s; }
        __syncthreads();
        if (tid < 64) { float off = 0.f;
            for (int s2 = 0; s2 < seg; ++s2) off += segtot[s2 * 8 + hh];
            float* cp = cumloc + (size_t)(b * 8 + hh) * SEQ + (rb & 31) * 128 + seg * 16;
            const float NL2E = -1.4426950408889634f;
#pragma unroll
            for (int i = 0; i < 4; ++i) { f32x4 t; t.x = (run[4 * i] + off) * NL2E; t.y = (run[4 * i + 1] + off) * NL2E; t.z = (run[4 * i + 2] + off) * NL2E; t.w = (run[4 * i + 3] + off) * NL2E; *(f32x4*)(cp + 4 * i) = t; }
            if (seg == 7) blktot[rb * 8 + hh] = (run[15] + off) * NL2E; }
        __syncthreads();
    }
}

typedef short p5_bf16x8 __attribute__((ext_vector_type(8)));
__device__ __forceinline__ void p5_route(const float* __restrict__ x1, const float* __restrict__ g2, const float* __restrict__ mod, const bf16* __restrict__ WrF, const float* __restrict__ b_rg, const float* __restrict__ b_re,
                                         bf16* __restrict__ H2, gu32* cnt, int* __restrict__ stok, int* __restrict__ rt_e, int* __restrict__ rt_pos, float* __restrict__ rt_w,
                                         LAS unsigned char* lds, int vcu, int G, int tid, int wave, int lane) {
    LAS unsigned* CNT = (LAS unsigned*)lds; LAS unsigned* BASE = (LAS unsigned*)(lds + 128); LAS unsigned* REC = (LAS unsigned*)(lds + 256); LAS float* LG = (LAS float*)(lds + 4352 + wave * 3072);
    if (tid < 32) CNT[tid] = 0u;
    __syncthreads();
    for (int rb = vcu; rb < T / 128; rb += G) {
        const int b = rb >> 5;
        { f32x4 A[4], Bc[4];
#pragma unroll
          for (int j = 0; j < 4; ++j) { const int col = 256 * j + 4 * lane; const f32x4 g = *(const f32x4*)(g2 + col), sc = *(const f32x4*)(mod + b * 6144 + 4096 + col);
            A[j] = g * (1.0f + sc); Bc[j] = *(const f32x4*)(mod + b * 6144 + 3072 + col); }
#pragma unroll 2
          for (int rr = 0; rr < 16; ++rr) {
            const int row = rb * 128 + wave * 16 + rr;
            const f32x4* xr = (const f32x4*)(x1 + (size_t)row * D) + lane;
            f32x4 v[4]; float s = 0.f;
#pragma unroll
            for (int j = 0; j < 4; ++j) { v[j] = xr[64 * j]; s += (v[j].x * v[j].x + v[j].y * v[j].y) + (v[j].z * v[j].z + v[j].w * v[j].w); }
            const float rstd = 1.0f / sqrtf(wave_sum(s) * (1.0f / D) + 1e-6f);
            v2u* o8 = (v2u*)(H2 + (size_t)row * D) + lane;
#pragma unroll
            for (int j = 0; j < 4; ++j) { const f32x4 h = v[j] * rstd * A[j] + Bc[j]; v2u w; w.x = pk2(h.x, h.y); w.y = pk2(h.z, h.w); o8[64 * j] = w; }
          } }
        VM_WAIT();
        f32x4 acc[3];
#pragma unroll
        for (int c = 0; c < 3; ++c) acc[c] = (f32x4){0.f, 0.f, 0.f, 0.f};
        { const bf16* ap = H2 + (size_t)(rb * 128 + wave * 16 + (lane & 15)) * D + 8 * (lane >> 4);
          const bf16* bp = WrF + lane * 8;
#pragma unroll 4
          for (int i = 0; i < 32; ++i) {
            const p5_bf16x8 af = *(const p5_bf16x8*)(ap + 32 * i);
#pragma unroll
            for (int c = 0; c < 3; ++c) {
                const p5_bf16x8 bh = *(const p5_bf16x8*)(bp + ((i * 3 + c) * 2 + 0) * 512), bl = *(const p5_bf16x8*)(bp + ((i * 3 + c) * 2 + 1) * 512);
                acc[c] = __builtin_amdgcn_mfma_f32_16x16x32_bf16(af, bh, acc[c], 0, 0, 0);
                acc[c] = __builtin_amdgcn_mfma_f32_16x16x32_bf16(af, bl, acc[c], 0, 0, 0); }
          } }
#pragma unroll
        for (int c = 0; c < 3; ++c)
#pragma unroll
            for (int r = 0; r < 4; ++r) LG[(4 * (lane >> 4) + r) * 48 + 16 * c + (lane & 15)] = acc[c][r];
        LDS_WAIT();
        if (lane < 16) {
            const LAS float* L = LG + lane * 48;
            float gl[4];
#pragma unroll
            for (int i = 0; i < 4; ++i) gl[i] = L[32 + i] + b_rg[i];
            int g = 0; float gm = gl[0];
#pragma unroll
            for (int i = 1; i < 4; ++i) if (gl[i] > gm) { gm = gl[i]; g = i; }
            float gs = 0.f;
#pragma unroll
            for (int i = 0; i < 4; ++i) gs += expf(gl[i] - gm);
            const float pg = 1.0f / gs;
            float el[8];
#pragma unroll
            for (int i = 0; i < 8; ++i) el[i] = L[g * 8 + i] + b_re[g * 8 + i];
            int i1 = 0; float m1 = el[0];
#pragma unroll
            for (int i = 1; i < 8; ++i) if (el[i] > m1) { m1 = el[i]; i1 = i; }
            int i2 = -1; float m2 = -3.0e38f;
#pragma unroll
            for (int i = 0; i < 8; ++i) if (i != i1 && el[i] > m2) { m2 = el[i]; i2 = i; }
            const float ex = expf(m2 - m1); const float w1 = pg / (1.0f + ex), w2 = pg * ex / (1.0f + ex);
            const int e1 = g * 8 + i1, e2 = g * 8 + i2, rl = wave * 16 + lane;
            const unsigned p1 = __hip_atomic_fetch_add(&CNT[e1], 1u, __ATOMIC_RELAXED, __HIP_MEMORY_SCOPE_WORKGROUP), p2 = __hip_atomic_fetch_add(&CNT[e2], 1u, __ATOMIC_RELAXED, __HIP_MEMORY_SCOPE_WORKGROUP);
            REC[(rl * 2 + 0) * 4 + 0] = (unsigned)e1; REC[(rl * 2 + 0) * 4 + 1] = p1; REC[(rl * 2 + 0) * 4 + 2] = __float_as_uint(w1);
            REC[(rl * 2 + 1) * 4 + 0] = (unsigned)e2; REC[(rl * 2 + 1) * 4 + 1] = p2; REC[(rl * 2 + 1) * 4 + 2] = __float_as_uint(w2);
        }
        __syncthreads();
        if (tid < 32) BASE[tid] = __hip_atomic_fetch_add(cnt + 64 * tid, CNT[tid], RLX_AGENT);
        __syncthreads();
        if (tid < 256) { const unsigned e = REC[tid * 4 + 0], pl = REC[tid * 4 + 1], wb = REC[tid * 4 + 2]; const unsigned pos = BASE[e] + pl; const int tok = rb * 128 + (tid >> 1);
            stok[(size_t)e * 65536 + pos] = tok; rt_e[tok * 2 + (tid & 1)] = (int)e; rt_pos[tok * 2 + (tid & 1)] = (int)pos; rt_w[tok * 2 + (tid & 1)] = __uint_as_float(wb); }
        __syncthreads();
        if (tid < 32) CNT[tid] = 0u;
        __syncthreads();
    }
}

__device__ __forceinline__ void moe_tables(gu32* cnt, LAS int* TB, LAS int* CN, int tid) {
    if (tid == 0) { int s = 0;
        for (int e = 0; e < 32; ++e) { const int c = (int)__hip_atomic_load(cnt + 64 * e, RLX_AGENT); CN[e] = c; TB[e] = s; s += (c + 255) >> 8; }
        TB[32] = s; }
    __syncthreads();
}
struct MoeOrder {
    const LAS int* TB; const LAS int* CN; const int* stok; int G, c; bool gather;
    __device__ __forceinline__ bool next(int i, pg8::Unit& u) const {
        const int L = i * G + c; if (L >= 4 * TB[32]) return false;
        const int gt = L >> 2, ct = L & 3; int e = 0;
        for (int k = 1; k < 32; ++k) e += (gt >= TB[k]) ? 1 : 0;
        u.pm = gt; u.pn = e * 4 + ct; u.e = e; return true;
    }
    __device__ __forceinline__ void a_off(const pg8::Unit& u, const int (&RA)[2], const int (&CA)[2], int K, unsigned (&off)[2][2]) const {
        if (gather) {
            const int p0 = (u.pm - TB[u.e]) * 256, n = CN[u.e];
#pragma unroll
            for (int h = 0; h < 2; ++h)
#pragma unroll
                for (int i = 0; i < 2; ++i) { const int pos = p0 + h * 128 + RA[i]; const int tok = pos < n ? stok[(size_t)u.e * 65536 + pos] : 0;
                    off[h][i] = (unsigned)(((size_t)tok * K + CA[i]) * 2); }
            __builtin_amdgcn_s_waitcnt(0x0F70);
        } else {
#pragma unroll
            for (int h = 0; h < 2; ++h)
#pragma unroll
                for (int i = 0; i < 2; ++i) off[h][i] = (unsigned)(((size_t)(u.pm * 256 + h * 128 + RA[i]) * K + CA[i]) * 2);
        }
    }
};

__device__ __forceinline__ void p8_final(float* __restrict__ xo, const bf16* __restrict__ Y, const float* __restrict__ mod, const float* __restrict__ gf,
                                         const int* __restrict__ rt_e, const int* __restrict__ rt_pos, const float* __restrict__ rt_w, const LAS int* TB,
                                         int vcu, int G, int wave, int lane) {
    const int gw = vcu * NWAVES + wave, NGW = G * NWAVES;
    f32x4 gfv[4];
#pragma unroll
    for (int j = 0; j < 4; ++j) gfv[j] = *(const f32x4*)(gf + 256 * j + 4 * lane);
    for (int row = gw; row < T; row += NGW) {
        const int b = row >> 12;
        const int e0 = rt_e[row * 2], e1 = rt_e[row * 2 + 1]; const int s0 = TB[e0] * 256 + rt_pos[row * 2], s1 = TB[e1] * 256 + rt_pos[row * 2 + 1];
        const float w0 = rt_w[row * 2], w1 = rt_w[row * 2 + 1];
        f32x4* xr = (f32x4*)(xo + (size_t)row * D) + lane;
        const v2u* y0 = (const v2u*)(Y + (size_t)s0 * D) + lane; const v2u* y1 = (const v2u*)(Y + (size_t)s1 * D) + lane;
        f32x4 v[4]; float s = 0.f;
#pragma unroll
        for (int j = 0; j < 4; ++j) { const f32x4 xv = xr[64 * j]; const v2u a = y0[64 * j], c = y1[64 * j]; const f32x4 g2 = *(const f32x4*)(mod + b * 6144 + 5120 + 256 * j + 4 * lane);
            f32x4 y; y.x = w0 * bflo(a.x) + w1 * bflo(c.x); y.y = w0 * bfhi(a.x) + w1 * bfhi(c.x); y.z = w0 * bflo(a.y) + w1 * bflo(c.y); y.w = w0 * bfhi(a.y) + w1 * bfhi(c.y);
            v[j] = xv + g2 * y; s += (v[j].x * v[j].x + v[j].y * v[j].y) + (v[j].z * v[j].z + v[j].w * v[j].w); }
        const float rstd = 1.0f / sqrtf(wave_sum(s) * (1.0f / D) + 1e-6f);
#pragma unroll
        for (int j = 0; j < 4; ++j) xr[64 * j] = v[j] * rstd * gfv[j];
    }
}

struct Args { const float* in[22]; float* out; unsigned char* ws; int ph_lo, ph_hi; };
typedef __attribute__((address_space(4))) const unsigned long long cu64;
__device__ __forceinline__ cu64* karg() { cu64* p = (cu64*)__builtin_amdgcn_kernarg_segment_ptr(); asm volatile("" : "+s"(p)); return p; }
#define KA_IN(ka, i) ((const float*)(ka)[i])
#define KA_OUT(ka) ((float*)(ka)[22])
#define KA_WS(ka) ((unsigned char*)(ka)[23])
__global__ void __launch_bounds__(NWAVES * 64, 2) fwd_kernel(Args args) {
    extern __shared__ __attribute__((aligned(16))) unsigned char lds_raw[];
    LAS unsigned char* lds = (LAS unsigned char*)lds_raw;
    volatile LAS unsigned* MISC = (volatile LAS unsigned*)(lds + MISC_OFF);
    const int wave = __builtin_amdgcn_readfirstlane((int)threadIdx.x >> 6);
    const int G = gridDim.x; const int bx = blockIdx.x; const int vcu = (G % 8 == 0) ? (bx % 8) * (G / 8) + bx / 8 : bx;
    if (wave == 0) MISC[fresh_lane()] = 0u;
    __syncthreads();
    XcdBarrier bar = xcd_barrier_post((unsigned*)((gu32*)(args.ws + WS_CTL) + CW_BAR), MISC + 8); bar.wave = wave;
    const int lo = args.ph_lo, hi = args.ph_hi;
#ifndef PHASE_MASK
#define PHASE_MASK 0x1ff
#endif
#define IN(k) ((((PHASE_MASK) >> (k)) & 1) && lo <= (k) && (k) < hi)
#define SEAM(k) do { if (IN(k) && IN((k) + 1)) xcd_barrier(bar); } while (0)
#ifndef PROBE_PHASE
#define PROBE_PHASE -1
#endif
#define REP(k) _Pragma("unroll 1") for (int rep_ = 0; rep_ < ((PROBE_PHASE) == (k) ? 2 : 1); ++rep_)

    if (IN(0)) REP(0) {
        cu64* ka = karg(); unsigned char* ws = KA_WS(ka);
        P0Args a{KA_IN(ka, 1), KA_IN(ka, 2), KA_IN(ka, 3), KA_IN(ka, 5), KA_IN(ka, 12), KA_IN(ka, 14), KA_IN(ka, 16), KA_IN(ka, 18), KA_IN(ka, 19), KA_IN(ka, 20),
                 (bf16*)(ws + WS_WIN), (bf16*)(ws + WS_WO), (bf16*)(ws + WS_WGU), (bf16*)(ws + WS_WD), (float*)(ws + WS_WR), (float*)(ws + WS_MOD)};
        const int lane = fresh_lane(), tid = wave * 64 + lane; p0_prologue(a, lds, vcu, G, tid, wave, lane);
    }
    SEAM(0);
    if (IN(1)) REP(1) { cu64* ka = karg(); unsigned char* ws = KA_WS(ka); const int lane = fresh_lane(), tid = wave * 64 + lane;
        p1_norm(KA_IN(ka, 0), KA_IN(ka, 4), (const float*)(ws + WS_MOD), KA_IN(ka, 5), KA_IN(ka, 6), (bf16*)(ws + WS_H), (float*)(ws + WS_CUM), (float*)(ws + WS_BLK), lds, vcu, G, tid, wave, lane); }
    SEAM(1);
#define P2BODY { cu64* ka = karg(); unsigned char* ws = KA_WS(ka); pg8::Gemm g{(const bf16*)(ws + WS_H), (const bf16*)(ws + WS_WIN), T, NQKV, D}; pg8::StaticOrder S; S.init(T, NQKV, G, bx); \
        pg8::EpiStore E{(bf16*)(ws + WS_QKV), NQKV, 0xffff, (unsigned*)(ws + WS_CTL) + CW_KM}; \
        pg8::gemm_phase<pg8::EpiStore, pg8::StaticOrder, true, true>(lds, g, S, E, wave); }
    if (IN(2)) { P2BODY if (PROBE_PHASE == 2) P2BODY }
    SEAM(2);
    if (IN(3)) REP(3) {
        float lam;
        { cu64* ka = karg(); const float* lq1 = KA_IN(ka, 7); const float* lk1 = KA_IN(ka, 8); const float* lq2 = KA_IN(ka, 9); const float* lk2 = KA_IN(ka, 10);
          const int lane = fresh_lane(); const float a = wave_sum(lq1[lane] * lk1[lane]), b2 = wave_sum(lq2[lane] * lk2[lane]); lam = expf(a) - expf(b2) + LAM_INIT; }
        for (int v = vcu; v < 256; v += G) {
            const int b = v >> 5, ci = v & 31;
#ifndef NO_DIFF
#pragma unroll 1
            for (int s = 0; s < 4; ++s) { const int qb = (s & 1) ? 31 - ci : ci; cu64* ka = karg(); unsigned char* ws = KA_WS(ka);
                att::diff_unit(lds, (const bf16*)(ws + WS_QKV), (bf16*)(ws + WS_H), KA_IN(ka, 11), lam, (const unsigned*)(ws + WS_CTL) + CW_KM, b, s, qb, wave); }
#endif
#ifndef NO_FOX
#pragma unroll 1
            for (int p = 0; p < 4; ++p) { const int h = 2 * p + (ci >> 4), i16 = ci & 15, qb = (p & 1) ? 15 - i16 : i16; cu64* ka = karg(); unsigned char* ws = KA_WS(ka);
                att::fox_unit(lds, (const bf16*)(ws + WS_QKV), (bf16*)(ws + WS_H), (const float*)(ws + WS_CUM), (const float*)(ws + WS_BLK), (const unsigned*)(ws + WS_CTL) + CW_KM, b, h, qb, wave); }
#endif
        }
    }
    SEAM(3);
#define P4BODY { cu64* ka = karg(); unsigned char* ws = KA_WS(ka); pg8::Gemm g{(const bf16*)(ws + WS_H), (const bf16*)(ws + WS_WO), T, D, D}; pg8::StaticOrder S; S.init(T, D, G, bx); \
        pg8::EpiResid E{KA_IN(ka, 0), KA_OUT(ka), (const float*)(ws + WS_MOD) + 2048}; \
        pg8::gemm_phase<pg8::EpiResid, pg8::StaticOrder, true, true>(lds, g, S, E, wave); }
    if (IN(4)) { P4BODY if (PROBE_PHASE == 4) P4BODY }
    SEAM(4);
    if (IN(5)) { cu64* ka = karg(); unsigned char* ws = KA_WS(ka); int* rt_e = (int*)(ws + WS_RT); const int lane = fresh_lane(), tid = wave * 64 + lane;
        p5_route(KA_OUT(ka), KA_IN(ka, 13), (const float*)(ws + WS_MOD), (const bf16*)(ws + WS_WR), KA_IN(ka, 15), KA_IN(ka, 17), (bf16*)(ws + WS_H), (gu32*)(ws + WS_CTL) + CW_CNT, (int*)(ws + WS_STOK),
                 rt_e, rt_e + 2 * T, (float*)(rt_e + 4 * T), lds, vcu, G, tid, wave, lane); }
    SEAM(5);
    LAS int* TB = (LAS int*)(lds + 131072); LAS int* CN = (LAS int*)(lds + 131072 + 256);
#define P6BODY { cu64* ka = karg(); unsigned char* ws = KA_WS(ka); moe_tables((gu32*)(ws + WS_CTL) + CW_CNT, TB, CN, wave * 64 + fresh_lane()); pg8::Gemm g{(const bf16*)(ws + WS_H), (const bf16*)(ws + WS_WGU), T, 1024, D}; \
        MoeOrder S{TB, CN, (const int*)(ws + WS_STOK), G, bx, true}; pg8::EpiSwiglu E{(bf16*)(ws + WS_HID)}; \
        pg8::gemm_phase<pg8::EpiSwiglu, MoeOrder, true, true>(lds, g, S, E, wave); }
    if (IN(6)) { P6BODY if (PROBE_PHASE == 6) P6BODY }
    SEAM(6);
#define P7BODY { cu64* ka = karg(); unsigned char* ws = KA_WS(ka); moe_tables((gu32*)(ws + WS_CTL) + CW_CNT, TB, CN, wave * 64 + fresh_lane()); pg8::Gemm g{(const bf16*)(ws + WS_HID), (const bf16*)(ws + WS_WD), NSLOT_MAX, 1024, DEXP}; \
        MoeOrder S{TB, CN, (const int*)(ws + WS_STOK), G, bx, false}; pg8::EpiStore E{(bf16*)(ws + WS_Y), 1024, 3, nullptr}; \
        pg8::gemm_phase<pg8::EpiStore, MoeOrder, true, true>(lds, g, S, E, wave); }
    if (IN(7)) { P7BODY if (PROBE_PHASE == 7) P7BODY }
    SEAM(7);
    if (IN(8)) { cu64* ka = karg(); unsigned char* ws = KA_WS(ka); int* rt_e = (int*)(ws + WS_RT);
        moe_tables((gu32*)(ws + WS_CTL) + CW_CNT, TB, CN, wave * 64 + fresh_lane());
        p8_final(KA_OUT(ka), (const bf16*)(ws + WS_Y), (const float*)(ws + WS_MOD), KA_IN(ka, 21), rt_e, rt_e + 2 * T, (const float*)(rt_e + 4 * T), TB, vcu, G, wave, fresh_lane());
    }
#undef IN
#undef SEAM
}

#ifndef MK_N_LAUNCHES
#define MK_N_LAUNCHES 1
#endif
extern "C" void kernel_launch(void* const* d_in, const int* in_sizes, int n_in, void* d_out, int out_size, void* d_ws, size_t ws_size, hipStream_t stream) {
    static int grid = 0;
    if (grid == 0) {
        if (n_in != 22 || in_sizes[0] != T * D || out_size != T * D || ws_size < WS_END) { fprintf(stderr, "kernel_launch: shape/workspace mismatch (n_in %d, in0 %d, out %d, ws %zu, need %zu)\n", n_in, n_in > 0 ? in_sizes[0] : -1, out_size, ws_size, (size_t)WS_END); grid = -1; return; }
        int dev = 0, cus = 0, per_cu = 0;
        if (hipGetDevice(&dev) != hipSuccess || hipDeviceGetAttribute(&cus, hipDeviceAttributeMultiprocessorCount, dev) != hipSuccess) { grid = -1; return; }
        if (hipFuncSetAttribute((const void*)fwd_kernel, hipFuncAttributeMaxDynamicSharedMemorySize, LDS_BYTES) != hipSuccess) { fprintf(stderr, "kernel_launch: hipFuncSetAttribute failed\n"); grid = -1; return; }
        if (hipOccupancyMaxActiveBlocksPerMultiprocessor(&per_cu, (const void*)fwd_kernel, NWAVES * 64, LDS_BYTES) != hipSuccess || per_cu < 1) fprintf(stderr, "kernel_launch: occupancy query reports %d\n", per_cu);
        (void)hipGetLastError();
        grid = cus > 0 ? cus : 256;
    }
    if (grid < 0) return;
    (void)hipMemsetAsync((char*)d_ws + WS_CTL, 0, CTL_ZERO_BYTES, stream);
    Args a{};
    for (int i = 0; i < 22; ++i) a.in[i] = (const float*)d_in[i];
    a.out = (float*)d_out; a.ws = (unsigned char*)d_ws;
    if (MK_N_LAUNCHES == 1) { a.ph_lo = 0; a.ph_hi = NPH; hipLaunchKernelGGL(fwd_kernel, dim3(grid), dim3(NWAVES * 64), LDS_BYTES, stream, a); }
    else for (int p = 0; p < NPH; ++p) { a.ph_lo = p; a.ph_hi = p + 1; hipLaunchKernelGGL(fwd_kernel, dim3(grid), dim3(NWAVES * 64), LDS_BYTES, stream, a); }
    const hipError_t le = hipPeekAtLastError();
    if (le != hipSuccess) fprintf(stderr, "kernel_launch: launch failed: %s\n", hipGetErrorName(le));
}
```

```cpp
#include <hip/hip_runtime.h>
#include <hip/hip_bf16.h>
#include <cstdio>
#include <cstdint>

__device__ __forceinline__ int fresh_lane() { int l; asm volatile("v_mbcnt_lo_u32_b32 %0, -1, 0\n\tv_mbcnt_hi_u32_b32 %0, -1, %0" : "=v"(l)); return l; }
template <int M> __device__ __forceinline__ float lx_get(float v) {
    static_assert(M == 1 || M == 2 || M == 4 || M == 8 || M == 16, "lx_get: M");
    return __builtin_bit_cast(float, __builtin_amdgcn_ds_swizzle(__builtin_bit_cast(int, v), (M << 10) | 0x1f));
}
__device__ __forceinline__ void swap32(float v, float& lo, float& hi) { const unsigned a = __float_as_uint(v);
    auto rr = __builtin_amdgcn_permlane32_swap(a, a, false, false); const unsigned r0 = rr[0], r1 = rr[1]; lo = __uint_as_float(r0); hi = __uint_as_float(r1); }
__device__ __forceinline__ float lx_sum32(float v) { float lo, hi; swap32(v, lo, hi); return lo + hi; }
__device__ __forceinline__ float lx_max32(float v) { float lo, hi; swap32(v, lo, hi); return fmaxf(lo, hi); }
#ifndef PROF_ID
#define PROF_ID 0
#endif
#define PROF_BEGIN(id) unsigned long long prof_t0_##id = 0; if (PROF_ID == (id)) prof_t0_##id = __builtin_amdgcn_s_memrealtime()
#define PROF_END(id, acc) do { if (PROF_ID == (id)) (acc) += __builtin_amdgcn_s_memrealtime() - prof_t0_##id; } while (0)
namespace pg8 {
#define PG8_LAS __attribute__((address_space(3)))
typedef unsigned short bf16_t;
typedef short bf16x8 __attribute__((ext_vector_type(8)));
typedef float f32x4 __attribute__((ext_vector_type(4)));
typedef unsigned u32x4 __attribute__((ext_vector_type(4)));
typedef unsigned u32x2 __attribute__((ext_vector_type(2)));
typedef int i32x8 __attribute__((ext_vector_type(8)));
constexpr int BM = 256, BK = 64, HALF = 128, HTB = HALF * BK * 2  , STAGE_BYTES = 8 * HTB, NXCD = 8, WGM = 8;

__host__ __device__ __forceinline__ int lds_byte(int r, int c) { const int st = (r >> 4) * 2 + (c >> 5), rr = r & 15, cc = c & 31, ob = rr * 64 + cc * 2; return st * 1024 + (ob ^ (((ob >> 9) & 1) << 5)); }
__host__ __device__ __forceinline__ void stage_rc(int b, int& R, int& C) { const int st = b / 1024, sb = b % 1024, swz = sb ^ (((sb >> 9) & 1) << 5); R = (st >> 1) * 16 + swz / 64; C = (st & 1) * 32 + (swz % 64) / 2; }
__host__ __device__ __forceinline__ int perm32(int rho) { const int n = rho >> 4, i = rho & 15; return 8 * (i >> 2) + 4 * n + (i & 3); }

struct Unit { int pm, pn, e; };
struct Gemm { const bf16_t* A; const bf16_t* Bt; int M, N, K; };

struct StaticOrder {
    int nM, nN, nwg, G, c;
    __host__ __device__ void init(int M, int N, int G_, int c_) { nM = M / BM; nN = N / BM; nwg = nM * nN; G = G_; c = c_; }
    __host__ __device__ bool next(int i, Unit& u) const {
        const long L = (long)i * G + c; if (L >= nwg) return false;
        int wgid = (int)L; { const int q = nwg / NXCD, r = nwg % NXCD, xcd = wgid % NXCD, off = wgid / NXCD; wgid = (xcd < r ? xcd * (q + 1) : r * (q + 1) + (xcd - r) * q) + off; }
        const int nig = WGM * nN, gid = wgid / nig, fm = gid * WGM, gsz = (nM - fm) < WGM ? (nM - fm) : WGM;
        u.pm = fm + ((wgid % nig) % gsz); u.pn = (wgid % nig) / gsz; u.e = 0; return true;
    }
    __device__ __forceinline__ void a_off(const Unit& u, const int (&RA)[2], const int (&CA)[2], int KB  , unsigned (&off)[2][2]) const {
#pragma unroll
        for (int h = 0; h < 2; ++h)
#pragma unroll
            for (int i = 0; i < 2; ++i) off[h][i] = (unsigned)((size_t)(u.pm * BM + h * HALF + RA[i]) * KB + CA[i] * 2);
    }
};


__device__ __forceinline__ unsigned cvt_pk_bf16(float lo, float hi) { unsigned r; asm volatile("v_cvt_pk_bf16_f32 %0, %1, %2" : "=v"(r) : "v"(lo), "v"(hi)); return r; }

struct EpiStore {
    static constexpr bool PERM = true, AFTER_DRAIN = false;
    bf16_t* O; int ldc; int pn_mask; unsigned* km;
    __device__ __forceinline__ void operator()(const f32x4 (&acc)[2][2][4][2], const Unit& u, int wr, int wc, int fr, int fq) const {
        const int row0 = u.pm * BM + wr * 64 + fr; const int col0 = (u.pn & pn_mask) * BM + wc * 32 + 8 * fq;
        if (km && (u.pn == 2 || u.pn == 3 || u.pn == 8 || u.pn == 9)) {
#pragma unroll
            for (int bj = 0; bj < 2; ++bj) { float mx = 0.f;
#pragma unroll
                for (int ai = 0; ai < 2; ++ai)
#pragma unroll
                    for (int m = 0; m < 4; ++m) { const f32x4 v0 = acc[ai][bj][m][0], v1 = acc[ai][bj][m][1];
                        float ss = (v0[0] * v0[0] + v0[1] * v0[1]) + (v0[2] * v0[2] + v0[3] * v0[3]) + (v1[0] * v1[0] + v1[1] * v1[1]) + (v1[2] * v1[2] + v1[3] * v1[3]);
                        ss += lx_get<16>(ss); ss = lx_sum32(ss); mx = fmaxf(mx, ss); }
                mx = fmaxf(mx, lx_get<1>(mx)); mx = fmaxf(mx, lx_get<2>(mx)); mx = fmaxf(mx, lx_get<4>(mx)); mx = fmaxf(mx, lx_get<8>(mx));
                if ((fr | fq) == 0) __hip_atomic_fetch_max(km + (u.pm >> 4) * 96 + (u.pn * BM + bj * HALF + wc * 32) / 32, __float_as_uint(mx), __ATOMIC_RELAXED, __HIP_MEMORY_SCOPE_AGENT); }
        }
#pragma unroll
        for (int ai = 0; ai < 2; ++ai)
#pragma unroll
            for (int m = 0; m < 4; ++m) { bf16_t* rowp = O + (size_t)(row0 + ai * HALF + m * 16) * ldc + col0;
#pragma unroll
                for (int bj = 0; bj < 2; ++bj) { const f32x4 v0 = acc[ai][bj][m][0], v1 = acc[ai][bj][m][1];
                    u32x4 w; w.x = cvt_pk_bf16(v0[0], v0[1]); w.y = cvt_pk_bf16(v0[2], v0[3]); w.z = cvt_pk_bf16(v1[0], v1[1]); w.w = cvt_pk_bf16(v1[2], v1[3]);
                    *(u32x4*)(rowp + bj * HALF) = w; } }
    }
};
struct EpiSwiglu {
    static constexpr bool PERM = true, AFTER_DRAIN = false;
    bf16_t* H;
    __device__ __forceinline__ void operator()(const f32x4 (&acc)[2][2][4][2], const Unit& u, int wr, int wc, int fr, int fq) const {
        const int row0 = u.pm * BM + wr * 64 + fr; const int col0 = (u.pn & 3) * 128 + wc * 32 + 8 * fq;
#pragma unroll
        for (int ai = 0; ai < 2; ++ai)
#pragma unroll
            for (int m = 0; m < 4; ++m) { bf16_t* rowp = H + (size_t)(row0 + ai * HALF + m * 16) * 512 + col0;
                float hv[8];
#pragma unroll
                for (int n = 0; n < 2; ++n)
#pragma unroll
                    for (int i = 0; i < 4; ++i) { const float g = acc[ai][0][m][n][i], up = acc[ai][1][m][n][i];
                        const float e = __builtin_amdgcn_exp2f(-g * 1.4426950408889634f);
                        hv[n * 4 + i] = g * __builtin_amdgcn_rcpf(1.0f + e) * up; }
                u32x4 w; w.x = cvt_pk_bf16(hv[0], hv[1]); w.y = cvt_pk_bf16(hv[2], hv[3]); w.z = cvt_pk_bf16(hv[4], hv[5]); w.w = cvt_pk_bf16(hv[6], hv[7]);
                *(u32x4*)rowp = w; }
    }
};
struct EpiStoreF8 {
    static constexpr bool PERM = true, AFTER_DRAIN = false;
    unsigned char* Y8;
    __device__ __forceinline__ void operator()(const f32x4 (&acc)[2][2][4][2], const Unit& u, int wr, int wc, int fr, int fq) const {
        const int row0 = u.pm * BM + wr * 64 + fr; const int col0 = (u.pn & 3) * BM + wc * 32 + 8 * fq;
#pragma unroll
        for (int ai = 0; ai < 2; ++ai)
#pragma unroll
            for (int m = 0; m < 4; ++m) { unsigned char* rowp = Y8 + (size_t)(row0 + ai * HALF + m * 16) * 1024 + col0;
#pragma unroll
                for (int bj = 0; bj < 2; ++bj) { const f32x4 v0 = acc[ai][bj][m][0] * 8.0f, v1 = acc[ai][bj][m][1] * 8.0f;
                    int t0 = 0, t1 = 0;
                    t0 = __builtin_amdgcn_cvt_pk_fp8_f32(v0[0], v0[1], t0, false); t0 = __builtin_amdgcn_cvt_pk_fp8_f32(v0[2], v0[3], t0, true);
                    t1 = __builtin_amdgcn_cvt_pk_fp8_f32(v1[0], v1[1], t1, false); t1 = __builtin_amdgcn_cvt_pk_fp8_f32(v1[2], v1[3], t1, true);
                    u32x2 w; w.x = (unsigned)t0; w.y = (unsigned)t1; *(u32x2*)(rowp + bj * HALF) = w; } }
    }
};
struct EpiSwigluF8 {
    static constexpr bool PERM = true, AFTER_DRAIN = false;
    unsigned char* H8;
    __device__ __forceinline__ void operator()(const f32x4 (&acc)[2][2][4][2], const Unit& u, int wr, int wc, int fr, int fq) const {
        const int row0 = u.pm * BM + wr * 64 + fr; const int col0 = (u.pn & 3) * 128 + wc * 32 + 8 * fq;
#pragma unroll
        for (int ai = 0; ai < 2; ++ai)
#pragma unroll
            for (int m = 0; m < 4; ++m) { unsigned char* rowp = H8 + (size_t)(row0 + ai * HALF + m * 16) * 512 + col0;
                float hv[8];
#pragma unroll
                for (int n = 0; n < 2; ++n)
#pragma unroll
                    for (int i = 0; i < 4; ++i) { const float g = acc[ai][0][m][n][i], up = acc[ai][1][m][n][i];
                        const float e = __builtin_amdgcn_exp2f(-g * 1.4426950408889634f);
                        hv[n * 4 + i] = g * __builtin_amdgcn_rcpf(1.0f + e) * up; }
                u32x2 w; int t0 = 0, t1 = 0;
                t0 = __builtin_amdgcn_cvt_pk_fp8_f32(hv[0], hv[1], t0, false); t0 = __builtin_amdgcn_cvt_pk_fp8_f32(hv[2], hv[3], t0, true);
                t1 = __builtin_amdgcn_cvt_pk_fp8_f32(hv[4], hv[5], t1, false); t1 = __builtin_amdgcn_cvt_pk_fp8_f32(hv[6], hv[7], t1, true);
                w.x = (unsigned)t0; w.y = (unsigned)t1; *(u32x2*)rowp = w; }
    }
};
struct EpiResid {
    static constexpr bool PERM = true, AFTER_DRAIN = false;
    const float* base; bf16_t* out; const float* gate;
    __device__ __forceinline__ void operator()(const f32x4 (&acc)[2][2][4][2], const Unit& u, int wr, int wc, int fr, int fq) const {
        const int col0 = u.pn * BM + wc * 32 + 8 * fq; const float* gp = gate + (size_t)(u.pm >> 4) * 6144 + col0;
        f32x4 gv[2][2];
#pragma unroll
        for (int bj = 0; bj < 2; ++bj)
#pragma unroll
            for (int n = 0; n < 2; ++n) gv[bj][n] = *(const f32x4*)(gp + bj * HALF + n * 4);
#pragma unroll
        for (int ai = 0; ai < 2; ++ai)
#pragma unroll
            for (int m = 0; m < 4; ++m) { const size_t off = (size_t)(u.pm * BM + ai * HALF + wr * 64 + m * 16 + fr) * 1024 + col0;
#pragma unroll
                for (int bj = 0; bj < 2; ++bj) { const f32x4 b0 = *(const f32x4*)(base + off + bj * HALF), b1 = *(const f32x4*)(base + off + bj * HALF + 4);
                    const f32x4 v0 = b0 + gv[bj][0] * acc[ai][bj][m][0], v1 = b1 + gv[bj][1] * acc[ai][bj][m][1];
                    u32x4 w; w.x = cvt_pk_bf16(v0[0], v0[1]); w.y = cvt_pk_bf16(v0[2], v0[3]); w.z = cvt_pk_bf16(v1[0], v1[1]); w.w = cvt_pk_bf16(v1[2], v1[3]);
                    *(u32x4*)(out + off + bj * HALF) = w; } }
    }
};

template <class Epi, class Sched, bool ALIGN_EPI = false, bool SP2 = false, bool F8 = false>
__device__ __forceinline__ void gemm_phase(PG8_LAS unsigned char* lds, const Gemm g, const Sched& S, const Epi& E, int wave) {
    const int wid = wave, lane = fresh_lane(), tid = wid * 64 + lane, wr = wid >> 2, wc = wid & 3, fr = lane & 15, fq = lane >> 4;
    const int K = g.K, KB = F8 ? K : 2 * K  ; int nt = KB / (BK * 2); asm volatile("" : "+s"(nt));
    int RA[2], CA[2]; unsigned voffB[2];
#pragma unroll
    for (int i = 0; i < 2; ++i) { int R, C; stage_rc(tid * 16 + i * 8192, R, C); const int Rb = Epi::PERM ? ((R & ~31) + perm32(R & 31)) : R;
        RA[i] = R; CA[i] = C; voffB[i] = (unsigned)(Rb * KB + C * 2); }
    const size_t kstep = (size_t)(BK * 2);
    const size_t hstep = (size_t)HALF * KB;
    const size_t tstep = 2 * hstep;
    const unsigned ldsw = (unsigned)wid * 1024u;
    const int aoff = lds_byte(wr * 64 + fr, fq * 8), boff = lds_byte(wc * 32 + fr, fq * 8);
    const int aoffLo = lds_byte(wr * 64 + fr, fq * 16), boffLo = lds_byte(wc * 32 + fr, fq * 16);
#define PG8_SA(b, h) (((b) * 2 + (h)) * HTB)
#define PG8_SB(b, h) ((4 + (b) * 2 + (h)) * HTB)
#define PG8_STAGE(bufoff, gbase, voff) do { _Pragma("unroll") for (int _i = 0; _i < 2; ++_i) \
        __builtin_amdgcn_global_load_lds((const unsigned*)((const char*)(gbase) + (voff)[_i]), (PG8_LAS unsigned*)(lds + (bufoff) + ldsw + _i * 8192), 16, 0, 0); } while (0)
#define PG8_LDA(dst, b, h) do { if constexpr (F8) { _Pragma("unroll") for (int m = 0; m < 4; ++m) { const u32x4 lo_ = *(const PG8_LAS u32x4*)(lds + PG8_SA(b, h) + aoffLo + m * 2048), hi_ = *(const PG8_LAS u32x4*)(lds + PG8_SA(b, h) + aoffLo + 16 + m * 2048); \
            dst##8[m] = (i32x8){(int)lo_.x, (int)lo_.y, (int)lo_.z, (int)lo_.w, (int)hi_.x, (int)hi_.y, (int)hi_.z, (int)hi_.w}; } } \
        else { _Pragma("unroll") for (int m = 0; m < 4; ++m) _Pragma("unroll") for (int k = 0; k < 2; ++k) dst[m][k] = *(const PG8_LAS bf16x8*)(lds + PG8_SA(b, h) + aoff + m * 2048 + k * 1024); } } while (0)
#define PG8_LDB(dst, b, h) do { if constexpr (F8) { _Pragma("unroll") for (int n = 0; n < 2; ++n) { const u32x4 lo_ = *(const PG8_LAS u32x4*)(lds + PG8_SB(b, h) + boffLo + n * 2048), hi_ = *(const PG8_LAS u32x4*)(lds + PG8_SB(b, h) + boffLo + 16 + n * 2048); \
            dst##8[n] = (i32x8){(int)lo_.x, (int)lo_.y, (int)lo_.z, (int)lo_.w, (int)hi_.x, (int)hi_.y, (int)hi_.z, (int)hi_.w}; } } \
        else { _Pragma("unroll") for (int n = 0; n < 2; ++n) _Pragma("unroll") for (int k = 0; k < 2; ++k) dst[n][k] = *(const PG8_LAS bf16x8*)(lds + PG8_SB(b, h) + boff + n * 2048 + k * 1024); } } while (0)
#define PG8_MMA(ai, bj, At, Bt) do { __builtin_amdgcn_s_setprio(1); if constexpr (F8) { _Pragma("unroll") for (int m = 0; m < 4; ++m) _Pragma("unroll") for (int n = 0; n < 2; ++n) \
            acc[ai][bj][m][n] = __builtin_amdgcn_mfma_scale_f32_16x16x128_f8f6f4(Bt##8[n], At##8[m], acc[ai][bj][m][n], 0, 0, 0, 0x7A7A7A7A  , 0, 0x7F7F7F7F  ); } \
        else { _Pragma("unroll") for (int m = 0; m < 4; ++m) _Pragma("unroll") for (int n = 0; n < 2; ++n) _Pragma("unroll") for (int k = 0; k < 2; ++k) \
            acc[ai][bj][m][n] = __builtin_amdgcn_mfma_f32_16x16x32_bf16(Bt[n][k], At[m][k], acc[ai][bj][m][n], 0, 0, 0); } __builtin_amdgcn_s_setprio(0); } while (0)
#define PG8_WAIT_V(n) asm volatile("s_waitcnt vmcnt(" #n ")" ::: "memory")
#define PG8_WAIT_L(n) asm volatile("s_waitcnt lgkmcnt(" #n ")" ::: "memory")
#define PG8_BAR __builtin_amdgcn_s_barrier()
#define PG8_SCHED __builtin_amdgcn_sched_barrier(0)
    Unit cur, nxt; int ui = 0;
    if (!S.next(0, cur)) return;
    f32x4 acc[2][2][4][2];
#pragma unroll
    for (int a = 0; a < 2; ++a)
#pragma unroll
        for (int b = 0; b < 2; ++b)
#pragma unroll
            for (int m = 0; m < 4; ++m)
#pragma unroll
                for (int n = 0; n < 2; ++n) acc[a][b][m][n] = (f32x4){0.f, 0.f, 0.f, 0.f};
    bf16x8 At[4][2], B0[2][2], B1[2][2]; i32x8 At8[4], B08[2], B18[2];
    unsigned oc[2][2], on[2][2];
    S.a_off(cur, RA, CA, KB, oc);
    const char* A0 = (const char*)g.A;
    const char* cB = (const char*)g.Bt + (size_t)cur.pn * tstep;
    if constexpr (SP2) {
        PG8_STAGE(PG8_SB(0, 0), cB, voffB); PG8_STAGE(PG8_SB(0, 1), cB + hstep, voffB); PG8_STAGE(PG8_SA(0, 0), A0, oc[0]); PG8_STAGE(PG8_SA(0, 1), A0, oc[1]);
        if (wr == 1) PG8_BAR;
        PG8_WAIT_V(2); PG8_BAR;
        PG8_STAGE(PG8_SB(1, 0), cB + kstep, voffB); PG8_STAGE(PG8_SA(1, 0), A0 + kstep, oc[0]); PG8_STAGE(PG8_SB(1, 1), cB + hstep + kstep, voffB);
        PG8_WAIT_V(6); PG8_BAR;
    } else {
        PG8_STAGE(PG8_SB(0, 0), cB, voffB); PG8_STAGE(PG8_SA(0, 0), A0, oc[0]); PG8_STAGE(PG8_SB(0, 1), cB + hstep, voffB); PG8_STAGE(PG8_SA(0, 1), A0, oc[1]);
        if (wr == 1) PG8_BAR;
        PG8_WAIT_V(4); PG8_BAR;
        PG8_STAGE(PG8_SB(1, 0), cB + kstep, voffB); PG8_STAGE(PG8_SA(1, 0), A0 + kstep, oc[0]); PG8_STAGE(PG8_SB(1, 1), cB + hstep + kstep, voffB);
        PG8_WAIT_V(6); PG8_BAR;
    }
    for (;;) {
        const bool has_next = S.next(ui + 1, nxt);
        if (has_next) S.a_off(nxt, RA, CA, KB, on);
        else {
#pragma unroll
            for (int h = 0; h < 2; ++h)
#pragma unroll
                for (int i = 0; i < 2; ++i) on[h][i] = oc[h][i]; }
        const char* nB = has_next ? (const char*)g.Bt + (size_t)nxt.pn * tstep : cB;
        for (int t = 0; t < nt; t += 2) {
            const bool last = (t == nt - 2);
            const char* a1 = A0 + (size_t)(t + 1) * kstep;
            const char* a2 = last ? A0 : A0 + (size_t)(t + 2) * kstep; const char* b2 = last ? nB : cB + (size_t)(t + 2) * kstep;
            const char* a3 = a2 + kstep; const char* b3 = b2 + kstep;
            if constexpr (SP2) {
            PG8_LDB(B0, 0, 0); PG8_LDB(B1, 0, 1); PG8_SCHED; PG8_LDA(At, 0, 0); PG8_STAGE(PG8_SA(1, 1), a1, oc[1]); if (last) { _Pragma("unroll") for (int h_ = 0; h_ < 2; ++h_) _Pragma("unroll") for (int i_ = 0; i_ < 2; ++i_) oc[h_][i_] = on[h_][i_]; }
            PG8_WAIT_V(8); PG8_WAIT_L(0); PG8_BAR; PG8_MMA(0, 0, At, B0); PG8_MMA(0, 1, At, B1); PG8_BAR; PG8_SCHED;
            PG8_LDA(At, 0, 1); PG8_STAGE(PG8_SB(0, 0), b2, voffB); PG8_STAGE(PG8_SB(0, 1), b2 + hstep, voffB); PG8_STAGE(PG8_SA(0, 0), a2, oc[0]);
            PG8_WAIT_V(8); PG8_WAIT_L(0); PG8_BAR; PG8_MMA(1, 0, At, B0); PG8_MMA(1, 1, At, B1); PG8_BAR; PG8_SCHED;
            PG8_LDB(B0, 1, 0); PG8_LDB(B1, 1, 1); PG8_SCHED; PG8_LDA(At, 1, 0); PG8_STAGE(PG8_SA(0, 1), a2, oc[1]);
            PG8_WAIT_V(8); PG8_WAIT_L(0); PG8_BAR; PG8_MMA(0, 0, At, B0); PG8_MMA(0, 1, At, B1); PG8_BAR; PG8_SCHED;
            PG8_LDA(At, 1, 1); PG8_STAGE(PG8_SB(1, 0), b3, voffB); PG8_STAGE(PG8_SB(1, 1), b3 + hstep, voffB); PG8_STAGE(PG8_SA(1, 0), a3, oc[0]);
            PG8_WAIT_V(8); PG8_WAIT_L(0); PG8_BAR; PG8_MMA(1, 0, At, B0); PG8_MMA(1, 1, At, B1); PG8_BAR; PG8_SCHED;
            } else {
            PG8_LDB(B0, 0, 0); PG8_SCHED; PG8_LDA(At, 0, 0); PG8_STAGE(PG8_SA(1, 1), a1, oc[1]); if (last) { _Pragma("unroll") for (int h_ = 0; h_ < 2; ++h_) _Pragma("unroll") for (int i_ = 0; i_ < 2; ++i_) oc[h_][i_] = on[h_][i_]; }
            PG8_WAIT_L(8); PG8_BAR; PG8_WAIT_L(0); PG8_MMA(0, 0, At, B0); PG8_BAR; PG8_SCHED;
            PG8_LDB(B1, 0, 1); PG8_STAGE(PG8_SB(0, 0), b2, voffB);
            PG8_BAR; PG8_WAIT_L(0); PG8_MMA(0, 1, At, B1); PG8_BAR;
            PG8_LDA(At, 0, 1); PG8_STAGE(PG8_SA(0, 0), a2, oc[0]);
            PG8_BAR; PG8_WAIT_L(0); PG8_MMA(1, 0, At, B0); PG8_BAR; PG8_SCHED;
            PG8_STAGE(PG8_SB(0, 1), b2 + hstep, voffB);
            PG8_WAIT_V(6); PG8_BAR; PG8_MMA(1, 1, At, B1); PG8_BAR;
            PG8_LDB(B0, 1, 0); PG8_SCHED; PG8_LDA(At, 1, 0); PG8_STAGE(PG8_SA(0, 1), a2, oc[1]);
            PG8_WAIT_L(8); PG8_BAR; PG8_WAIT_L(0); PG8_MMA(0, 0, At, B0); PG8_BAR; PG8_SCHED;
            PG8_LDB(B1, 1, 1); PG8_STAGE(PG8_SB(1, 0), b3, voffB);
            PG8_BAR; PG8_WAIT_L(0); PG8_MMA(0, 1, At, B1); PG8_BAR;
            PG8_LDA(At, 1, 1); PG8_STAGE(PG8_SA(1, 0), a3, oc[0]);
            PG8_BAR; PG8_WAIT_L(0); PG8_MMA(1, 0, At, B0); PG8_BAR; PG8_SCHED;
            PG8_STAGE(PG8_SB(1, 1), b3 + hstep, voffB);
            PG8_WAIT_V(6); PG8_BAR; PG8_MMA(1, 1, At, B1); PG8_BAR;
            }
        }
        if constexpr (ALIGN_EPI) { if (wr == 0) PG8_BAR; }
        if constexpr (!Epi::AFTER_DRAIN) { E(acc, cur, wr, wc, fr, fq); }
        if (!has_next) break;
#pragma unroll
        for (int a = 0; a < 2; ++a)
#pragma unroll
            for (int b = 0; b < 2; ++b)
#pragma unroll
                for (int m = 0; m < 4; ++m)
#pragma unroll
                    for (int n = 0; n < 2; ++n) acc[a][b][m][n] = (f32x4){0.f, 0.f, 0.f, 0.f};
        cur = nxt; cB = nB; ++ui;
        if constexpr (ALIGN_EPI) { if (wr == 1) PG8_BAR; }
    }
    PG8_WAIT_V(0);
    if constexpr (!ALIGN_EPI) { if (wr == 0) PG8_BAR; }
    PG8_BAR;
#undef PG8_SA
#undef PG8_SB
#undef PG8_STAGE
#undef PG8_LDA
#undef PG8_LDB
#undef PG8_MMA
#undef PG8_WAIT_V
#undef PG8_WAIT_L
#undef PG8_BAR
#undef PG8_SCHED
}
}

namespace att {
#define ATT_LAS __attribute__((address_space(3)))
typedef unsigned short bf16_t;
using bf16x8 = __attribute__((ext_vector_type(8))) short;
using s16x4  = __attribute__((ext_vector_type(4))) short;
using f32x16 = __attribute__((ext_vector_type(16))) float;
using f32x4  = __attribute__((ext_vector_type(4))) float;
using u32x4  = __attribute__((ext_vector_type(4))) unsigned;
using u32x2  = __attribute__((ext_vector_type(2))) unsigned;
constexpr int SEQ = 4096, LDQKV = 3072, LDATT = 1024;
constexpr float LOG2E = 1.4426950408889634f;
#define ATT_SBAR() __builtin_amdgcn_sched_barrier(0)
__device__ __forceinline__ int opaque(int v) { asm volatile("" : "+v"(v)); return v; }
__device__ __forceinline__ void dma16(const void* g, ATT_LAS unsigned char* l) { __builtin_amdgcn_global_load_lds((const unsigned*)g, (ATT_LAS unsigned*)l, 16, 0, 0); }
__device__ __forceinline__ int swap23(int k) { return (k & ~0xC) | ((k & 4) << 1) | ((k & 8) >> 1); }
__device__ __forceinline__ int crow(int r, int hi) { return (r & 3) + 8 * (r >> 2) + 4 * hi; }
__device__ __forceinline__ unsigned cvtpk(float lo, float hi) { unsigned r; asm volatile("v_cvt_pk_bf16_f32 %0, %1, %2" : "=v"(r) : "v"(lo), "v"(hi)); return r; }
__device__ __forceinline__ int ksw(int row, int c) { return row * 128 + ((c ^ ((row >> 1) & 7)) << 4); }
template <int NC> __device__ __forceinline__ int v_st(int k, int c) { const int kk = (k & ~0xC) | ((k & 4) << 1) | ((k & 8) >> 1); return ((kk >> 3) * NC + (c >> 5)) * 512 + ((kk & 7) * 32 + (c & 31)) * 2; }
__device__ __forceinline__ int v_rd_base(int lane) { return ((lane & 3) << 3) | (((lane >> 2) & 3) << 6) | (((lane >> 4) & 1) << 5) | (((lane >> 5) & 1) << 8); }
template <int NC> constexpr int v_rd_off(int d0, int ks, int half) { return d0 * 512 + ks * (2 * NC * 512) + half * (NC * 512); }
template <int OFF> __device__ __forceinline__ s16x4 tr_read(int vb) {
  s16x4 r; asm volatile("ds_read_b64_tr_b16 %0, %1 offset:%2" : "=&v"(r) : "v"(vb), "i"(OFF) : "memory"); return r;
}
#define ATT_TR8(S, D0_) do { \
    S[0] = tr_read<v_rd_off<NC>(D0_, 0, 0)>(vb); S[1] = tr_read<v_rd_off<NC>(D0_, 0, 1)>(vb); S[2] = tr_read<v_rd_off<NC>(D0_, 1, 0)>(vb); S[3] = tr_read<v_rd_off<NC>(D0_, 1, 1)>(vb); \
    S[4] = tr_read<v_rd_off<NC>(D0_, 2, 0)>(vb); S[5] = tr_read<v_rd_off<NC>(D0_, 2, 1)>(vb); S[6] = tr_read<v_rd_off<NC>(D0_, 3, 0)>(vb); S[7] = tr_read<v_rd_off<NC>(D0_, 3, 1)>(vb); } while (0)
#define ATT_PK(L, H) (bf16x8){L[0], L[1], L[2], L[3], H[0], H[1], H[2], H[3]}
#define ATT_MM4(OD, S) do { \
    OD = __builtin_amdgcn_mfma_f32_32x32x16_bf16(pa0, ATT_PK(S[0], S[1]), OD, 0, 0, 0); OD = __builtin_amdgcn_mfma_f32_32x32x16_bf16(pa1, ATT_PK(S[2], S[3]), OD, 0, 0, 0); \
    OD = __builtin_amdgcn_mfma_f32_32x32x16_bf16(pa2, ATT_PK(S[4], S[5]), OD, 0, 0, 0); OD = __builtin_amdgcn_mfma_f32_32x32x16_bf16(pa3, ATT_PK(S[6], S[7]), OD, 0, 0, 0); } while (0)
template <int NC> __device__ __forceinline__ void pv_all(f32x16 (&o)[NC], int vb, bf16x8 pa0, bf16x8 pa1, bf16x8 pa2, bf16x8 pa3) {
  s16x4 A[8], B[8];
  ATT_TR8(A, 0);
  if constexpr (NC == 2) {
    ATT_TR8(B, 1); asm volatile("s_waitcnt lgkmcnt(8)" ::: "memory"); ATT_SBAR(); ATT_MM4(o[0], A);
    asm volatile("s_waitcnt lgkmcnt(0)" ::: "memory"); ATT_SBAR(); ATT_MM4(o[1], B);
  } else {
    ATT_TR8(B, 1); asm volatile("s_waitcnt lgkmcnt(8)" ::: "memory"); ATT_SBAR(); ATT_MM4(o[0], A);
    ATT_SBAR(); ATT_TR8(A, 2); asm volatile("s_waitcnt lgkmcnt(8)" ::: "memory"); ATT_SBAR(); ATT_MM4(o[1], B);
    ATT_SBAR(); ATT_TR8(B, 3); asm volatile("s_waitcnt lgkmcnt(8)" ::: "memory"); ATT_SBAR(); ATT_MM4(o[2], A);
    asm volatile("s_waitcnt lgkmcnt(0)" ::: "memory"); ATT_SBAR(); ATT_MM4(o[3], B);
  }
}
#undef ATT_TR8
#undef ATT_PK
#undef ATT_MM4
__device__ __forceinline__ void qkt_bias(f32x16& p0, f32x16& p1, const ATT_LAS float* BT, const ATT_LAS unsigned char* Ks, const bf16x8 (&qr)[4], int r32, int hi, bf16x8 augA, bf16x8 augB) {
#pragma unroll
  for (int g = 0; g < 4; ++g) { const f32x4 b0 = *(const ATT_LAS f32x4*)(BT + 8 * g + 4 * hi), b1 = *(const ATT_LAS f32x4*)(BT + 32 + 8 * g + 4 * hi);
#pragma unroll
    for (int i = 0; i < 4; ++i) { p0[4 * g + i] = b0[i]; p1[4 * g + i] = b1[i]; } }
#pragma unroll
  for (int d0 = 0; d0 < 4; ++d0) {
    const bf16x8 b0 = *(const ATT_LAS bf16x8*)(Ks + ksw(r32, 2 * d0 + hi));
    const bf16x8 b1 = *(const ATT_LAS bf16x8*)(Ks + ksw(32 + r32, 2 * d0 + hi));
    p0 = __builtin_amdgcn_mfma_f32_32x32x16_bf16(b0, qr[d0], p0, 0, 0, 0);
    p1 = __builtin_amdgcn_mfma_f32_32x32x16_bf16(b1, qr[d0], p1, 0, 0, 0);
    if (d0 == 1) ATT_SBAR(); }
  p0 = __builtin_amdgcn_mfma_f32_32x32x16_bf16(augA, augB, p0, 0, 0, 0);
  p1 = __builtin_amdgcn_mfma_f32_32x32x16_bf16(augA, augB, p1, 0, 0, 0);
}

constexpr float SKIP_T = 40.0f;
__device__ __forceinline__ float q_norm(const bf16x8 (&qr)[4]) {
  float s = 0.f;
#pragma unroll
  for (int d0 = 0; d0 < 4; ++d0)
#pragma unroll
    for (int e = 0; e < 8; ++e) { const float v = __uint_as_float(((unsigned)(unsigned short)qr[d0][e]) << 16); s = fmaf(v, v, s); }
  return sqrtf(lx_sum32(s));
}
__device__ __forceinline__ float k_max(const unsigned* km, int g) {
  const float a = __uint_as_float(__hip_atomic_load(km + g, __ATOMIC_RELAXED, __HIP_MEMORY_SCOPE_AGENT)), b = __uint_as_float(__hip_atomic_load(km + g + 1, __ATOMIC_RELAXED, __HIP_MEMORY_SCOPE_AGENT));
  return sqrtf(a + b) * 1.005f;
}
__device__ __forceinline__ bool all_done(const ATT_LAS int* DONE, int i) {
  const ATT_LAS u32x4* d = (const ATT_LAS u32x4*)DONE; const u32x4 a = d[0], b = d[1];
  const unsigned m = max(max(max(a.x, a.y), max(a.z, a.w)), max(max(b.x, b.y), max(b.z, b.w)));
  return __builtin_amdgcn_readfirstlane((int)(m < (unsigned)i)) != 0;
}
__device__ __forceinline__ void qkt_bias_q(f32x16& p0, f32x16& p1, const ATT_LAS float* BT, const ATT_LAS unsigned char* Ks, const ATT_LAS unsigned char* Qs, int qrow, int r32, int hi, bf16x8 augA, bf16x8 augB) {
#pragma unroll
  for (int g = 0; g < 4; ++g) { const f32x4 b0 = *(const ATT_LAS f32x4*)(BT + 8 * g + 4 * hi), b1 = *(const ATT_LAS f32x4*)(BT + 32 + 8 * g + 4 * hi);
#pragma unroll
    for (int i = 0; i < 4; ++i) { p0[4 * g + i] = b0[i]; p1[4 * g + i] = b1[i]; } }
#pragma unroll
  for (int d0 = 0; d0 < 4; ++d0) {
    const bf16x8 b0 = *(const ATT_LAS bf16x8*)(Ks + ksw(r32, 2 * d0 + hi));
    const bf16x8 b1 = *(const ATT_LAS bf16x8*)(Ks + ksw(32 + r32, 2 * d0 + hi));
    const bf16x8 q = *(const ATT_LAS bf16x8*)(Qs + ksw(qrow, 2 * d0 + hi));
    p0 = __builtin_amdgcn_mfma_f32_32x32x16_bf16(b0, q, p0, 0, 0, 0);
    p1 = __builtin_amdgcn_mfma_f32_32x32x16_bf16(b1, q, p1, 0, 0, 0);
    if (d0 == 1) ATT_SBAR(); }
  p0 = __builtin_amdgcn_mfma_f32_32x32x16_bf16(augA, augB, p0, 0, 0, 0);
  p1 = __builtin_amdgcn_mfma_f32_32x32x16_bf16(augA, augB, p1, 0, 0, 0);
}

__device__ __forceinline__ bf16x8 aug_a(int hi) { const u32x4 v = {hi ? 0u : 0x3F803F80u, hi ? 0u : 0x00003F80u, 0u, 0u}; return __builtin_bit_cast(bf16x8, v); }
__device__ __forceinline__ bf16x8 aug_b(float w, int hi) {
  const unsigned h = cvtpk(w, 0.f) & 0xffffu; const float d1 = w - __uint_as_float(h << 16);
  const unsigned m = cvtpk(d1, 0.f) & 0xffffu; const float d2 = d1 - __uint_as_float(m << 16);
  const unsigned l = cvtpk(d2, 0.f) & 0xffffu;
  const u32x4 v = {hi ? 0u : (h | (m << 16)), hi ? 0u : l, 0u, 0u}; return __builtin_bit_cast(bf16x8, v);
}
__device__ __forceinline__ void sm_direct(f32x16& p0, f32x16& p1, float& l_part, bf16x8& pa0, bf16x8& pa1, bf16x8& pa2, bf16x8& pa3) {
#pragma unroll
  for (int r = 0; r < 16; ++r) { p0[r] = __builtin_amdgcn_exp2f(p0[r]); p1[r] = __builtin_amdgcn_exp2f(p1[r]); }
  float ps = 0.f;
#pragma unroll
  for (int r = 0; r < 16; ++r) ps += p0[r];
#pragma unroll
  for (int r = 0; r < 16; ++r) ps += p1[r];
  l_part += ps;
#define ATT_PK4(P, BASE, OUT) do { unsigned a0 = cvtpk(P[BASE + 0], P[BASE + 1]), a1 = cvtpk(P[BASE + 2], P[BASE + 3]);   \
    unsigned b0 = cvtpk(P[BASE + 4], P[BASE + 5]), b1 = cvtpk(P[BASE + 6], P[BASE + 7]);                              \
    auto r0 = __builtin_amdgcn_permlane32_swap(a0, b0, false, false); auto r1 = __builtin_amdgcn_permlane32_swap(a1, b1, false, false); \
    u32x4 w = {r0[0], r1[0], r0[1], r1[1]}; OUT = __builtin_bit_cast(bf16x8, w); } while (0)
  ATT_PK4(p0, 0, pa0); ATT_PK4(p0, 8, pa1); ATT_PK4(p1, 0, pa2); ATT_PK4(p1, 8, pa3);
#undef ATT_PK4
}
__device__ __forceinline__ bf16x8 aug_a_alibi(int koff, int hi) { const unsigned kb = __float_as_uint((float)koff) >> 16;
  const u32x4 v = {hi ? 0u : 0x3F803F80u, hi ? 0u : (0x3F80u | (kb << 16)), hi ? 0u : kb, 0u}; return __builtin_bit_cast(bf16x8, v); }
__device__ __forceinline__ bf16x8 aug_b_alibi(float w, unsigned s_hi, unsigned s_lo, int hi) {
  const unsigned h = cvtpk(w, 0.f) & 0xffffu; const float d1 = w - __uint_as_float(h << 16);
  const unsigned m = cvtpk(d1, 0.f) & 0xffffu; const float d2 = d1 - __uint_as_float(m << 16);
  const unsigned l = cvtpk(d2, 0.f) & 0xffffu;
  const u32x4 v = {hi ? 0u : (h | (m << 16)), hi ? 0u : (l | (s_hi << 16)), hi ? 0u : s_lo, 0u}; return __builtin_bit_cast(bf16x8, v);
}
__device__ __forceinline__ void qkt_aug_q(f32x16& p0, f32x16& p1, const ATT_LAS unsigned char* Ks, const ATT_LAS unsigned char* Qs, int qrow, int r32, int hi, bf16x8 augA0, bf16x8 augA1, bf16x8 augB) {
  p0 = f32x16{}; p1 = f32x16{};
#pragma unroll
  for (int d0 = 0; d0 < 4; ++d0) {
    const bf16x8 b0 = *(const ATT_LAS bf16x8*)(Ks + ksw(r32, 2 * d0 + hi));
    const bf16x8 b1 = *(const ATT_LAS bf16x8*)(Ks + ksw(32 + r32, 2 * d0 + hi));
    const bf16x8 q = *(const ATT_LAS bf16x8*)(Qs + ksw(qrow, 2 * d0 + hi));
    p0 = __builtin_amdgcn_mfma_f32_32x32x16_bf16(b0, q, p0, 0, 0, 0);
    p1 = __builtin_amdgcn_mfma_f32_32x32x16_bf16(b1, q, p1, 0, 0, 0);
    if (d0 == 1) ATT_SBAR(); }
  p0 = __builtin_amdgcn_mfma_f32_32x32x16_bf16(augA0, augB, p0, 0, 0, 0);
  p1 = __builtin_amdgcn_mfma_f32_32x32x16_bf16(augA1, augB, p1, 0, 0, 0);
}
#define ATT_WAIT_BAR(N) asm volatile("s_waitcnt vmcnt(" #N ") lgkmcnt(0)\n\ts_barrier" ::: "memory")

__device__ __forceinline__ void fox_unit(ATT_LAS unsigned char* lds, const bf16_t* __restrict__ qkv, bf16_t* __restrict__ attn, const float* __restrict__ cl2, const float* __restrict__ blk2, const unsigned* km,
                                         int b, int h, int qb, int wave, unsigned long long& pacc) {
  PROF_BEGIN(11);
  const int wid = wave, lane = fresh_lane(), tid = wid * 64 + lane, r32 = lane & 31, hi = lane >> 5;
  ATT_LAS float* CARRY = (ATT_LAS float*)(lds + 63488); ATT_LAS float* wsf = (ATT_LAS float*)(lds + 63744) + wid * 64;
  ATT_LAS unsigned char* BW = lds + 57344 + wid * 768; ATT_LAS int* DONE = (ATT_LAS int*)(lds + 65792);
  if (lane == 0) DONE[wid] = 0x7fffffff;
  const int q0 = qb * 256, NT = 4 * (qb + 1), jl = 4 * qb + (wid >> 1);
  const size_t rowb = (size_t)b * SEQ; const int bh = b * 8 + h;
  if (wid == 0) { float v = lane < 32 ? blk2[(b * 32 + lane) * 8 + h] : 0.f; float s = v;
#pragma unroll
    for (int o = 1; o < 32; o <<= 1) { const float t = __builtin_bit_cast(float, __builtin_amdgcn_ds_bpermute(((lane - o) & 63) << 2, __builtin_bit_cast(int, s))); if (lane >= o) s += t; }
    if (lane < 32) CARRY[lane] = s - v; }
  __syncthreads();
  const float cq = CARRY[q0 >> 7] + cl2[(size_t)bh * SEQ + q0];
  bf16x8 qr[4];
  { const bf16_t* Qw = qkv + (rowb + q0 + wid * 32 + r32) * LDQKV + h * 64 + hi * 8;
#pragma unroll
    for (int d0 = 0; d0 < 4; ++d0) qr[d0] = *(const bf16x8*)(Qw + d0 * 16); }
  const int pk = 64 * wid + lane;
  unsigned koff, voff;
  { const int row = pk >> 3, c = (pk & 7) ^ ((row >> 1) & 7); koff = (unsigned)((row * LDQKV + 512 + h * 64 + c * 8) * 2);
    const int sub = pk >> 5, kk = 8 * (sub >> 1) + ((pk & 31) >> 2), k = swap23(kk), cv = (sub & 1) * 32 + (pk & 3) * 8; voff = (unsigned)((k * LDQKV + 1024 + h * 64 + cv) * 2); }
  const char* tb = (const char*)(qkv + rowb * LDQKV);
  const char* cg = (const char*)(cl2 + (size_t)bh * SEQ) + (lane & 15) * 16;
  const int vb0 = (int)(uintptr_t)(lds + 24576) + v_rd_base(lane);
#define FOX_LOAD(j, bo, vbo) do { const char* tj = tb + (size_t)(j) * (64 * LDQKV * 2); dma16(tj + koff, lds + (bo) * 8192 + wid * 1024); dma16(tj + voff, lds + 24576 + (vbo) * 8192 + wid * 1024); \
    if (lane < 16) dma16(cg + (j) * 256, BW + (bo) * 256); } while (0)
#define FOX_PV(vbo) pv_all<2>(o, vb0 + (vbo) * 8192, pa0, pa1, pa2, pa3)
  FOX_LOAD(NT - 1, 0, 0); FOX_LOAD(NT - 2, 1, 1);
  float l_reg = 0.f; f32x16 o[2]; o[0] = f32x16{}; o[1] = f32x16{};
  const float bnd = q_norm(qr) * k_max(km + b * 96, 16 + 2 * h);
  const int qpos = q0 + wid * 32 + r32;
  const float refq = (cl2[(size_t)bh * SEQ + qpos] + CARRY[qpos >> 7] - cq) + fmaxf(0.f, bnd - 60.f);
  const bf16x8 augA = aug_a(hi);
  __builtin_amdgcn_s_waitcnt(0x0F70);
  bool stopped = false, pend = false; const bool late = wid >= 4;
  bf16x8 pa0, pa1, pa2, pa3;
  int cur = 0, nx2 = 2, vc = 0, vn2 = 2, vprev = 3;
  PROF_END(11, pacc);
  for (int i = 0; i < NT; ++i) {
    const int j = NT - 1 - i;
    if (PROF_ID == 13) pacc += 100;
    PROF_BEGIN(8);
    if (i + 1 < NT) ATT_WAIT_BAR(3); else ATT_WAIT_BAR(0);
    PROF_END(8, pacc);
    if (all_done(DONE, i)) break;
    if (i + 2 < NT) FOX_LOAD(j - 2, nx2, vn2);
    if (pend) { PROF_BEGIN(10); FOX_PV(vprev); pend = false; PROF_END(10, pacc); }
    if (j <= jl && !stopped) {
      const float bj = ((const ATT_LAS float*)(BW + cur * 256))[63] + (CARRY[j >> 1] - cq);
      if (!__any(bnd + (bj - refq) - __builtin_amdgcn_logf(l_reg) >= -SKIP_T)) { stopped = true; if (lane == 0) DONE[wid] = i; }
    }
    if (j <= jl && !stopped) {
      f32x16 p0, p1;
      PROF_BEGIN(9);
      const float c2 = CARRY[j >> 1] - cq;
      qkt_bias(p0, p1, (const ATT_LAS float*)(BW + cur * 256), lds + cur * 8192, qr, r32, hi, augA, aug_b(c2 - refq, hi));
      if (j == jl) { const int qrel = opaque(32 * (wid & 1) + r32), hio = opaque(hi);
#pragma unroll
        for (int r = 0; r < 16; ++r) { const int kr = crow(r, hio); if (kr > qrel) p0[r] = -1e30f; if (kr + 32 > qrel) p1[r] = -1e30f; } }
      sm_direct(p0, p1, l_reg, pa0, pa1, pa2, pa3);
      PROF_END(9, pacc);
      if (late) pend = true; else { PROF_BEGIN(10); FOX_PV(vc); PROF_END(10, pacc); }
    }
    cur = cur == 2 ? 0 : cur + 1; nx2 = nx2 == 2 ? 0 : nx2 + 1; vprev = vc; vc = (vc + 1) & 3; vn2 = (vn2 + 1) & 3;
  }
  if (pend) FOX_PV(vprev);
#undef FOX_PV
#undef FOX_LOAD
  PROF_BEGIN(12);
  asm volatile("s_waitcnt vmcnt(0)" ::: "memory");
  l_reg = lx_sum32(l_reg);
  if (hi == 0) wsf[32 + r32] = l_reg; asm volatile("s_waitcnt lgkmcnt(0)" ::: "memory");
  { const int le = opaque(lane), r32e = le & 31, hie = le >> 5;
  bf16_t* Ow = attn + (rowb + q0 + wid * 32) * LDATT + h * 64 + r32e;
#pragma unroll
  for (int r = 0; r < 16; ++r) { const int orow = crow(r, hie); const float rl = __builtin_amdgcn_rcpf(wsf[32 + orow]);
#pragma unroll
    for (int d0 = 0; d0 < 2; ++d0) { const unsigned w = cvtpk(o[d0][r] * rl, 0.f); Ow[(size_t)orow * LDATT + d0 * 32] = (bf16_t)(w & 0xffffu); } } }
  asm volatile("s_waitcnt lgkmcnt(0)" ::: "memory");
  __syncthreads();
  PROF_END(12, pacc);
}

__device__ __forceinline__ void fox2_unit(ATT_LAS unsigned char* lds, const bf16_t* __restrict__ qkv, bf16_t* __restrict__ attn, const float* __restrict__ cl2, const float* __restrict__ blk2, const unsigned* km,
                                          int b, int h, int qb, int wave, unsigned long long& pacc) {
  PROF_BEGIN(11);
  const int wid = wave, lane = fresh_lane(), r32 = lane & 31, hi = lane >> 5;
  ATT_LAS float* CARRY = (ATT_LAS float*)(lds + 63488); ATT_LAS float* wsf = (ATT_LAS float*)(lds + 63744) + wid * 64;
  ATT_LAS unsigned char* BW = lds + 57344 + wid * 768; ATT_LAS int* DONE = (ATT_LAS int*)(lds + 65792);
  if (lane == 0) DONE[wid] = 0x7fffffff;
  const int q0 = qb * 512, NT = 8 * (qb + 1), jl = 8 * qb + wid;
  const size_t rowb = (size_t)b * SEQ; const int bh = b * 8 + h;
  if (wid == 0) { float v = lane < 32 ? blk2[(b * 32 + lane) * 8 + h] : 0.f; float s = v;
#pragma unroll
    for (int o = 1; o < 32; o <<= 1) { const float t = __builtin_bit_cast(float, __builtin_amdgcn_ds_bpermute(((lane - o) & 63) << 2, __builtin_bit_cast(int, s))); if (lane >= o) s += t; }
    if (lane < 32) CARRY[lane] = s - v; }
  __syncthreads();
  const float cq = CARRY[q0 >> 7] + cl2[(size_t)bh * SEQ + q0];
  bf16x8 qA[4], qB[4];
  { const bf16_t* Qw = qkv + (rowb + q0 + wid * 64 + r32) * LDQKV + h * 64 + hi * 8;
#pragma unroll
    for (int d0 = 0; d0 < 4; ++d0) { qA[d0] = *(const bf16x8*)(Qw + d0 * 16); qB[d0] = *(const bf16x8*)(Qw + (size_t)32 * LDQKV + d0 * 16); } }
  const int pk = 64 * wid + lane;
  unsigned koff, voff;
  { const int row = pk >> 3, c = (pk & 7) ^ ((row >> 1) & 7); koff = (unsigned)((row * LDQKV + 512 + h * 64 + c * 8) * 2);
    const int sub = pk >> 5, kk = 8 * (sub >> 1) + ((pk & 31) >> 2), k = swap23(kk), cv = (sub & 1) * 32 + (pk & 3) * 8; voff = (unsigned)((k * LDQKV + 1024 + h * 64 + cv) * 2); }
  const char* tb = (const char*)(qkv + rowb * LDQKV);
  const char* cg = (const char*)(cl2 + (size_t)bh * SEQ) + (lane & 15) * 16;
  const int vb0 = (int)(uintptr_t)(lds + 24576) + v_rd_base(lane);
#define FOX_LOAD(j, bo, vbo) do { const char* tj = tb + (size_t)(j) * (64 * LDQKV * 2); dma16(tj + koff, lds + (bo) * 8192 + wid * 1024); dma16(tj + voff, lds + 24576 + (vbo) * 8192 + wid * 1024); \
    if (lane < 16) dma16(cg + (j) * 256, BW + (bo) * 256); } while (0)
  FOX_LOAD(NT - 1, 0, 0); FOX_LOAD(NT - 2, 1, 1);
  float lA = 0.f, lB = 0.f; f32x16 oA[2], oB[2]; oA[0] = f32x16{}; oA[1] = f32x16{}; oB[0] = f32x16{}; oB[1] = f32x16{};
  const float kmx = k_max(km + b * 96, 16 + 2 * h);
  const float bndA = q_norm(qA) * kmx, bndB = q_norm(qB) * kmx;
  const int qposA = q0 + wid * 64 + r32;
  const float refA = (cl2[(size_t)bh * SEQ + qposA] + CARRY[qposA >> 7] - cq) + fmaxf(0.f, bndA - 60.f);
  const float refB = (cl2[(size_t)bh * SEQ + qposA + 32] + CARRY[(qposA + 32) >> 7] - cq) + fmaxf(0.f, bndB - 60.f);
  const bf16x8 augA = aug_a(hi);
  __builtin_amdgcn_s_waitcnt(0x0F70);
  bool stopped = false;
  int cur = 0, nx2 = 2, vc = 0, vn2 = 2;
  PROF_END(11, pacc);
  for (int i = 0; i < NT; ++i) {
    const int j = NT - 1 - i;
    if (PROF_ID == 13) pacc += 100;
    PROF_BEGIN(8);
    if (i + 1 < NT) ATT_WAIT_BAR(3); else ATT_WAIT_BAR(0);
    PROF_END(8, pacc);
    if (all_done(DONE, i)) break;
    if (i + 2 < NT) FOX_LOAD(j - 2, nx2, vn2);
    if (j <= jl && !stopped) {
      const float bj = ((const ATT_LAS float*)(BW + cur * 256))[63] + (CARRY[j >> 1] - cq);
      const float tA = bndA + (bj - refA) - __builtin_amdgcn_logf(lA), tB = bndB + (bj - refB) - __builtin_amdgcn_logf(lB);
      if (!__any(fmaxf(tA, tB) >= -SKIP_T)) { stopped = true; if (lane == 0) DONE[wid] = i; }
    }
    if (j <= jl && !stopped) {
      PROF_BEGIN(9);
      f32x16 pA0, pA1, pB0, pB1; bf16x8 paA0, paA1, paA2, paA3, paB0, paB1, paB2, paB3;
      const float c2 = CARRY[j >> 1] - cq;
      { const ATT_LAS float* BT = (const ATT_LAS float*)(BW + cur * 256); const ATT_LAS unsigned char* Ks = lds + cur * 8192;
#pragma unroll
        for (int g = 0; g < 4; ++g) { const f32x4 b0 = *(const ATT_LAS f32x4*)(BT + 8 * g + 4 * hi), b1 = *(const ATT_LAS f32x4*)(BT + 32 + 8 * g + 4 * hi);
#pragma unroll
          for (int e = 0; e < 4; ++e) { pA0[4 * g + e] = b0[e]; pA1[4 * g + e] = b1[e]; pB0[4 * g + e] = b0[e]; pB1[4 * g + e] = b1[e]; } }
#pragma unroll
        for (int d0 = 0; d0 < 4; ++d0) {
          const bf16x8 k0 = *(const ATT_LAS bf16x8*)(Ks + ksw(r32, 2 * d0 + hi));
          const bf16x8 k1 = *(const ATT_LAS bf16x8*)(Ks + ksw(32 + r32, 2 * d0 + hi));
          pA0 = __builtin_amdgcn_mfma_f32_32x32x16_bf16(k0, qA[d0], pA0, 0, 0, 0); pB0 = __builtin_amdgcn_mfma_f32_32x32x16_bf16(k0, qB[d0], pB0, 0, 0, 0);
          pA1 = __builtin_amdgcn_mfma_f32_32x32x16_bf16(k1, qA[d0], pA1, 0, 0, 0); pB1 = __builtin_amdgcn_mfma_f32_32x32x16_bf16(k1, qB[d0], pB1, 0, 0, 0);
          if (d0 == 1) ATT_SBAR(); }
        const bf16x8 gA = aug_b(c2 - refA, hi), gB = aug_b(c2 - refB, hi);
        pA0 = __builtin_amdgcn_mfma_f32_32x32x16_bf16(augA, gA, pA0, 0, 0, 0); pA1 = __builtin_amdgcn_mfma_f32_32x32x16_bf16(augA, gA, pA1, 0, 0, 0);
        pB0 = __builtin_amdgcn_mfma_f32_32x32x16_bf16(augA, gB, pB0, 0, 0, 0); pB1 = __builtin_amdgcn_mfma_f32_32x32x16_bf16(augA, gB, pB1, 0, 0, 0); }
      if (j == jl) { const int qrel = opaque(r32), hio = opaque(hi);
#pragma unroll
        for (int r = 0; r < 16; ++r) { const int kr = crow(r, hio); if (kr > qrel) { pA0[r] = -1e30f; pB1[r] = -1e30f; } pA1[r] = -1e30f; } }
      sm_direct(pA0, pA1, lA, paA0, paA1, paA2, paA3);
      sm_direct(pB0, pB1, lB, paB0, paB1, paB2, paB3);
      PROF_END(9, pacc);
      PROF_BEGIN(10);
      { const int vb = vb0 + vc * 8192;
#define FOX2_TR8(S, D0_) do { \
        S[0] = tr_read<v_rd_off<2>(D0_, 0, 0)>(vb); S[1] = tr_read<v_rd_off<2>(D0_, 0, 1)>(vb); S[2] = tr_read<v_rd_off<2>(D0_, 1, 0)>(vb); S[3] = tr_read<v_rd_off<2>(D0_, 1, 1)>(vb); \
        S[4] = tr_read<v_rd_off<2>(D0_, 2, 0)>(vb); S[5] = tr_read<v_rd_off<2>(D0_, 2, 1)>(vb); S[6] = tr_read<v_rd_off<2>(D0_, 3, 0)>(vb); S[7] = tr_read<v_rd_off<2>(D0_, 3, 1)>(vb); } while (0)
#define FOX2_PK(L, H) (bf16x8){L[0], L[1], L[2], L[3], H[0], H[1], H[2], H[3]}
#define FOX2_MM(OD, P0_, P1_, P2_, P3_, S) do { \
        OD = __builtin_amdgcn_mfma_f32_32x32x16_bf16(P0_, FOX2_PK(S[0], S[1]), OD, 0, 0, 0); OD = __builtin_amdgcn_mfma_f32_32x32x16_bf16(P1_, FOX2_PK(S[2], S[3]), OD, 0, 0, 0); \
        OD = __builtin_amdgcn_mfma_f32_32x32x16_bf16(P2_, FOX2_PK(S[4], S[5]), OD, 0, 0, 0); OD = __builtin_amdgcn_mfma_f32_32x32x16_bf16(P3_, FOX2_PK(S[6], S[7]), OD, 0, 0, 0); } while (0)
        s16x4 S0[8], S1[8];
        FOX2_TR8(S0, 0); FOX2_TR8(S1, 1);
        asm volatile("s_waitcnt lgkmcnt(8)" ::: "memory"); ATT_SBAR();
        FOX2_MM(oA[0], paA0, paA1, paA2, paA3, S0); FOX2_MM(oB[0], paB0, paB1, paB2, paB3, S0);
        asm volatile("s_waitcnt lgkmcnt(0)" ::: "memory"); ATT_SBAR();
        FOX2_MM(oA[1], paA0, paA1, paA2, paA3, S1); FOX2_MM(oB[1], paB0, paB1, paB2, paB3, S1);
#undef FOX2_TR8
#undef FOX2_PK
#undef FOX2_MM
      }
      PROF_END(10, pacc);
    }
    cur = cur == 2 ? 0 : cur + 1; nx2 = nx2 == 2 ? 0 : nx2 + 1; vc = (vc + 1) & 3; vn2 = (vn2 + 1) & 3;
  }
#undef FOX_LOAD
  PROF_BEGIN(12);
  asm volatile("s_waitcnt vmcnt(0)" ::: "memory");
  lA = lx_sum32(lA); lB = lx_sum32(lB);
  { const int le = opaque(lane), r32e = le & 31, hie = le >> 5;
    if (hie == 0) wsf[32 + r32e] = lA; asm volatile("s_waitcnt lgkmcnt(0)" ::: "memory");
    bf16_t* Ow = attn + (rowb + q0 + wid * 64) * LDATT + h * 64 + r32e;
#pragma unroll
    for (int r = 0; r < 16; ++r) { const int orow = crow(r, hie); const float rl = __builtin_amdgcn_rcpf(wsf[32 + orow]);
#pragma unroll
      for (int d0 = 0; d0 < 2; ++d0) { const unsigned w = cvtpk(oA[d0][r] * rl, 0.f); Ow[(size_t)orow * LDATT + d0 * 32] = (bf16_t)(w & 0xffffu); } }
    asm volatile("s_waitcnt lgkmcnt(0)" ::: "memory");
    if (hie == 0) wsf[32 + r32e] = lB; asm volatile("s_waitcnt lgkmcnt(0)" ::: "memory");
#pragma unroll
    for (int r = 0; r < 16; ++r) { const int orow = crow(r, hie); const float rl = __builtin_amdgcn_rcpf(wsf[32 + orow]);
#pragma unroll
      for (int d0 = 0; d0 < 2; ++d0) { const unsigned w = cvtpk(oB[d0][r] * rl, 0.f); Ow[(size_t)(32 + orow) * LDATT + d0 * 32] = (bf16_t)(w & 0xffffu); } } }
  asm volatile("s_waitcnt lgkmcnt(0)" ::: "memory");
  __syncthreads();
  PROF_END(12, pacc);
}

__device__ __forceinline__ void diff_unit(ATT_LAS unsigned char* lds, const bf16_t* __restrict__ qkv, bf16_t* __restrict__ attn, const float* __restrict__ subln_g, float lam, const unsigned* km,
                                          int b, int h, int qb, int wave, unsigned long long& pacc) {
  PROF_BEGIN(6);
  const int wid = wave, lane = fresh_lane(), tid = wid * 64 + lane, r32 = lane & 31, hi = lane >> 5;
  ATT_LAS float* wsf = (ATT_LAS float*)(lds + 114688) + wid * 64; ATT_LAS float* BT = (ATT_LAS float*)(lds + 116736) + wid * 64;
  ATT_LAS int* DONE = (ATT_LAS int*)(lds + 118784);
  if (lane == 0) DONE[wid] = 0x7fffffff;
  const int map = wid >> 2, w4 = wid & 3;
  const int q0 = qb * 128, NT = 2 * (qb + 1), jl = 2 * qb + (w4 >> 1);
  const size_t rowb = (size_t)b * SEQ;
  const float sl2 = LOG2E * (h == 0 ? 0.25f : h == 1 ? 0.0625f : h == 2 ? 0.015625f : 0.00390625f);
  const int pk = 64 * wid + lane;
  unsigned koff, voff0, voff1;
  { const int row = pk >> 3, c = (pk & 7) ^ ((row >> 1) & 7); koff = (unsigned)((row * LDQKV + 2048 + h * 128 + c * 8) * 2);
    const int sub0 = pk >> 5, kk0 = 8 * (sub0 >> 2) + ((pk & 31) >> 2), k0 = swap23(kk0), c0 = (sub0 & 3) * 32 + (pk & 3) * 8; voff0 = (unsigned)((k0 * LDQKV + 2560 + h * 128 + c0) * 2);
    const int p1 = pk + 512, sub1 = p1 >> 5, kk1 = 8 * (sub1 >> 2) + ((p1 & 31) >> 2), k1 = swap23(kk1), c1 = (sub1 & 3) * 32 + (p1 & 3) * 8; voff1 = (unsigned)((k1 * LDQKV + 2560 + h * 128 + c1) * 2); }
  const char* tb = (const char*)(qkv + rowb * LDQKV);
  const int vb0 = (int)(uintptr_t)(lds + 49152) + v_rd_base(lane);
#define DIFF_LOAD(j, kbo, vbo) do { const char* tj = tb + (size_t)(j) * (64 * LDQKV * 2); dma16(tj + koff, lds + (kbo) * 8192 + wid * 1024); dma16(tj + koff + 128, lds + 24576 + (kbo) * 8192 + wid * 1024); \
    dma16(tj + voff0, lds + 49152 + (vbo) * 16384 + wid * 1024); dma16(tj + voff1, lds + 49152 + (vbo) * 16384 + 8192 + wid * 1024); } while (0)
#define DIFF_PV(vbo) pv_all<4>(o, vb0 + (vbo) * 16384, pa0, pa1, pa2, pa3)
  ATT_LAS unsigned char* QS = lds + 118912;
  { const int pq = pk + 512, r0_ = pk >> 3, c0q = (pk & 7) ^ ((r0_ >> 1) & 7), r1_ = pq >> 3, c1q = (pq & 7) ^ ((r1_ >> 1) & 7);
    const char* qb_ = (const char*)(qkv + (rowb + q0) * LDQKV + 1536 + h * 128);
#pragma unroll
    for (int m2 = 0; m2 < 2; ++m2) { dma16(qb_ + ((size_t)r0_ * LDQKV + m2 * 64 + c0q * 8) * 2, QS + m2 * 16384 + wid * 1024); dma16(qb_ + ((size_t)r1_ * LDQKV + m2 * 64 + c1q * 8) * 2, QS + m2 * 16384 + 8192 + wid * 1024); } }
  DIFF_LOAD(NT - 1, 0, 0); DIFF_LOAD(NT - 2, 1, 1);
  __builtin_amdgcn_s_waitcnt(0x0F70);
  asm volatile("s_waitcnt lgkmcnt(0)\n\ts_barrier" ::: "memory");
  const ATT_LAS unsigned char* Qs = QS + map * 16384; const int qrow = 32 * w4 + r32;
  float l_reg = 0.f; f32x16 o[4]; o[0] = f32x16{}; o[1] = f32x16{}; o[2] = f32x16{}; o[3] = f32x16{};
  float bnd;
  { bf16x8 qr[4];
#pragma unroll
    for (int d0 = 0; d0 < 4; ++d0) qr[d0] = *(const ATT_LAS bf16x8*)(Qs + ksw(qrow, 2 * d0 + hi));
    bnd = q_norm(qr) * k_max(km + b * 96, 64 + 4 * h + 2 * map); }
  const float refq = sl2 * (float)(32 * w4 + r32) + fmaxf(0.f, bnd - 60.f);
  const bf16x8 augA0 = aug_a_alibi(r32, hi), augA1 = aug_a_alibi(r32 + 32, hi);
  unsigned s_hi, s_lo; { s_hi = cvtpk(sl2, 0.f) & 0xffffu; s_lo = cvtpk(sl2 - __uint_as_float(s_hi << 16), 0.f) & 0xffffu; }
  __builtin_amdgcn_s_waitcnt(0x0F70);
  bool stopped = false, pend = false; const bool late = wid >= 4;
  bf16x8 pa0, pa1, pa2, pa3;
  int cur = 0, nx2 = 2, vc = 0, vn2 = 2, vprev = 3;
  PROF_END(6, pacc);
  for (int i = 0; i < NT; ++i) {
    const int j = NT - 1 - i;
    if (PROF_ID == 14) pacc += 100;
    PROF_BEGIN(3);
    if (i + 1 < NT) ATT_WAIT_BAR(4); else ATT_WAIT_BAR(0);
    PROF_END(3, pacc);
    if (all_done(DONE, i)) break;
    if (i + 2 < NT) DIFF_LOAD(j - 2, nx2, vn2);
    if (pend) { PROF_BEGIN(5); DIFF_PV(vprev); pend = false; PROF_END(5, pacc); }
    if (j < jl && !stopped) {
      const float bj = sl2 * (float)(64 * j + 63 - q0);
      if (!__any(bnd + (bj - refq) - __builtin_amdgcn_logf(l_reg) >= -SKIP_T)) { stopped = true; if (lane == 0) DONE[wid] = i; }
    }
    if (j <= jl && !stopped) {
      f32x16 p0, p1;
      PROF_BEGIN(4); PROF_BEGIN(15);
      qkt_aug_q(p0, p1, lds + map * 24576 + cur * 8192, Qs, qrow, r32, hi, augA0, augA1, aug_b_alibi(sl2 * (float)(64 * j - q0) - refq, s_hi, s_lo, hi));
      PROF_END(15, pacc);
      if (j == jl) { const int tq = opaque(32 * (w4 & 1) + r32), hio = opaque(hi);
#pragma unroll
        for (int r = 0; r < 16; ++r) { const int k0 = crow(r, hio), k1 = k0 + 32; if (k0 > tq) p0[r] += sl2 * (float)(2 * (tq - k0)); if (k1 > tq) p1[r] += sl2 * (float)(2 * (tq - k1)); } }
      PROF_BEGIN(16);
      sm_direct(p0, p1, l_reg, pa0, pa1, pa2, pa3);
      PROF_END(16, pacc);
      PROF_END(4, pacc);
      if (late) pend = true; else { PROF_BEGIN(5); DIFF_PV(vc); PROF_END(5, pacc); }
    }
    cur = cur == 2 ? 0 : cur + 1; nx2 = nx2 == 2 ? 0 : nx2 + 1; vprev = vc; vc = (vc + 1) & 3; vn2 = (vn2 + 1) & 3;
  }
  if (pend) DIFF_PV(vprev);
#undef DIFF_PV
  PROF_BEGIN(7);
#undef DIFF_LOAD
  asm volatile("s_waitcnt vmcnt(0)" ::: "memory");
  l_reg = lx_sum32(l_reg);
  if (hi == 0) wsf[32 + r32] = l_reg; asm volatile("s_waitcnt lgkmcnt(0)" ::: "memory");
  const int te = opaque(tid), r32e = te & 31, hie = (te >> 5) & 1;
  float rl[16];
#pragma unroll
  for (int r = 0; r < 16; ++r) rl[r] = __builtin_amdgcn_rcpf(wsf[32 + crow(r, hie)]);
  asm volatile("s_waitcnt lgkmcnt(0)" ::: "memory");
  __syncthreads();
  { ATT_LAS float* Xm = (ATT_LAS float*)lds + map * (128 * 132);
#pragma unroll
    for (int r = 0; r < 16; ++r) { const int orow = crow(r, hie);
#pragma unroll
      for (int d0 = 0; d0 < 4; ++d0) Xm[(32 * w4 + orow) * 132 + d0 * 32 + r32e] = o[d0][r] * rl[r]; } }
  __syncthreads();
  { const int row = te >> 2, qt = te & 3; const ATT_LAS float* X0 = (const ATT_LAS float*)lds + row * 132 + qt * 32; const ATT_LAS float* X1 = X0 + 128 * 132;
    float v[32]; float ss = 0.f;
#pragma unroll
    for (int i = 0; i < 8; ++i) { const f32x4 t0 = *(const ATT_LAS f32x4*)(X0 + 4 * i), t1 = *(const ATT_LAS f32x4*)(X1 + 4 * i); const f32x4 t = t0 - lam * t1;
      v[4 * i] = t[0]; v[4 * i + 1] = t[1]; v[4 * i + 2] = t[2]; v[4 * i + 3] = t[3];
      ss += t[0] * t[0] + t[1] * t[1] + t[2] * t[2] + t[3] * t[3]; }
    ss += lx_get<1>(ss); ss += lx_get<2>(ss);
    const float rstd = 0.8f / sqrtf(ss * (1.0f / 128.0f) + 1e-5f);
    bf16_t* op = attn + (rowb + q0 + row) * LDATT + 512 + h * 128 + qt * 32; const f32x4* gp = (const f32x4*)(subln_g + qt * 32);
#pragma unroll
    for (int i = 0; i < 4; ++i) { const f32x4 g0 = gp[2 * i], g1 = gp[2 * i + 1]; u32x4 w;
      w.x = cvtpk(v[8 * i + 0] * rstd * g0[0], v[8 * i + 1] * rstd * g0[1]); w.y = cvtpk(v[8 * i + 2] * rstd * g0[2], v[8 * i + 3] * rstd * g0[3]);
      w.z = cvtpk(v[8 * i + 4] * rstd * g1[0], v[8 * i + 5] * rstd * g1[1]); w.w = cvtpk(v[8 * i + 6] * rstd * g1[2], v[8 * i + 7] * rstd * g1[3]);
      *(u32x4*)(op + 8 * i) = w; } }
  __syncthreads();
  PROF_END(7, pacc);
}
#undef ATT_WAIT_BAR
#undef ATT_SBAR
}

constexpr int NWAVES = 8;
constexpr int BATCH = 8, SEQ = 4096, D = 1024, T = BATCH * SEQ;
constexpr int IN_COLS = 3080, NQKV = 3072;
constexpr int NEXP = 32, DEXP = 512, NSLOT_MAX = 73728;
constexpr int NPH = 9;
constexpr float C2 = 0.125f * 1.4426950408889634f;
constexpr float LAM_INIT = 0.2f;

constexpr size_t MiB = 1u << 20;
constexpr size_t WS_CTL = 0, CTL_ZERO_BYTES = 256 * 1024;
constexpr size_t WS_WIN = 1 * MiB;
constexpr size_t WS_WO = 7 * MiB;
constexpr size_t WS_WGU = 9 * MiB;
constexpr size_t WS_WD = 73 * MiB;
constexpr size_t WS_WR = 105 * MiB;
constexpr size_t WS_MOD = 106 * MiB;
constexpr size_t WS_CUM = 107 * MiB;
constexpr size_t WS_BLK = 108 * MiB;
constexpr size_t WS_RT = 109 * MiB;
constexpr size_t WS_STOK = 110 * MiB;
constexpr size_t WS_R = 118 * MiB;
constexpr size_t WS_H = WS_R;
constexpr size_t WS_QKV = WS_R + 64 * MiB;
constexpr size_t WS_Y = WS_R;
constexpr size_t WS_HID = WS_R + 144 * MiB;
constexpr size_t WS_H2F8 = WS_R + 184 * MiB;
constexpr size_t WS_X1 = WS_R + 256 * MiB;
constexpr size_t WS_END = WS_X1 + 64 * MiB;
constexpr int CW_BAR = 4096;
constexpr int CW_KM = 32768;
constexpr int CW_QH = 36864;
constexpr int CW_CNT = 16384;

constexpr int LDS_BYTES = 155648;
constexpr int MISC_OFF = LDS_BYTES - 256;

#define GAS __attribute__((address_space(1)))
#define LAS __attribute__((address_space(3)))
typedef unsigned short bf16;
typedef unsigned v4u __attribute__((ext_vector_type(4)));
typedef unsigned v2u __attribute__((ext_vector_type(2)));
typedef float f32x4 __attribute__((ext_vector_type(4)));
typedef GAS unsigned gu32;
#define RLX_AGENT __ATOMIC_RELAXED, __HIP_MEMORY_SCOPE_AGENT
#define LDS_WAIT() asm volatile("s_waitcnt lgkmcnt(0)" ::: "memory")
#define VM_WAIT() asm volatile("s_waitcnt vmcnt(0)" ::: "memory")
__device__ __forceinline__ unsigned f2bf(float f) { unsigned u = __builtin_bit_cast(unsigned, f); return (u + 0x7fffu + ((u >> 16) & 1u)) >> 16; }
__device__ __forceinline__ unsigned pk2(float lo, float hi) { return f2bf(lo) | (f2bf(hi) << 16); }
__device__ __forceinline__ float bflo(unsigned w) { return __builtin_bit_cast(float, w << 16); }
__device__ __forceinline__ float bfhi(unsigned w) { return __builtin_bit_cast(float, w & 0xffff0000u); }
__device__ __forceinline__ float wave_sum(float v) {
#ifdef OLD_WSUM
#pragma unroll
    for (int o = 1; o < 64; o <<= 1) v += __shfl_xor(v, o);
    return v;
#else
    v += lx_get<1>(v); v += lx_get<2>(v); v += lx_get<4>(v); v += lx_get<8>(v); v += lx_get<16>(v);
    return lx_sum32(v);
#endif
}
#define XB_TMO      128
#define XB_XCNT(j)  (256  + 64 * (j))
#define XB_XSUB(j)  (1280 + 64 * (j))
#define XB_XGEN(j)  (2304 + 64 * (j))
#define XB_TOP      3328
#define XB_TOPGEN   3392
#define XCD_BAR_WORDS 3456
#define XB_SPIN_CAP (1u << 18)

__device__ __forceinline__ unsigned xb_ld(unsigned* p)              { return __hip_atomic_load(p, __ATOMIC_RELAXED, __HIP_MEMORY_SCOPE_AGENT); }
__device__ __forceinline__ unsigned xb_add(unsigned* p, unsigned v) { return __hip_atomic_fetch_add(p, v, __ATOMIC_RELAXED, __HIP_MEMORY_SCOPE_AGENT); }
__device__ __forceinline__ unsigned xb_xcc_id() { return (unsigned)__builtin_amdgcn_s_getreg((3 << 11) | 20) & 0xFu; }
#define XB_SPIN(cond, bar) do { unsigned _sp = 0; while (cond) { __builtin_amdgcn_s_sleep(1); \
    if ((++_sp & 255u) == 0u) { if (xb_ld(&(bar)[XB_TMO])) break; if (_sp > XB_SPIN_CAP) { atomicAdd(&(bar)[XB_TMO], 1u); break; } } } } while (0)

struct XcdBarrier {
    int wave;
    unsigned* bar; unsigned x;
    volatile LAS unsigned* st;
};

__device__ __forceinline__ XcdBarrier xcd_barrier_post(unsigned* bar, volatile LAS unsigned* st) {
    XcdBarrier b; b.bar = bar; b.x = xb_xcc_id(); b.st = st;
    if (threadIdx.x == 0) (void)xb_add(&bar[XB_XCNT(b.x)], 1u);
    return b;
}
__device__ __forceinline__ void xcd_barrier_complete(unsigned* bar, unsigned x, unsigned& nloc, unsigned& nx) {
    const unsigned G = gridDim.x * gridDim.y * gridDim.z;
    unsigned sum, cnt, mine, sp = 0u;
    for (;;) {
        sum = 0u; cnt = 0u; mine = 0u;
#pragma unroll
        for (unsigned j = 0; j < 16; ++j) { const unsigned c = xb_ld(&bar[XB_XCNT(j)]); sum += c; cnt += (c > 0u) ? 1u : 0u; mine = (j == x) ? c : mine; }
        if (sum == G) break;
        __builtin_amdgcn_s_sleep(1);
        if ((++sp & 255u) == 0u) { if (xb_ld(&bar[XB_TMO])) break; if (sp > XB_SPIN_CAP) { atomicAdd(&bar[XB_TMO], 1u); break; } }
    }
    nloc = mine > 0u ? mine : 1u; nx = cnt > 0u ? cnt : 1u;
}

__device__ __forceinline__ void xcd_barrier(const XcdBarrier& b) {
    asm volatile("s_waitcnt vmcnt(0)" ::: "memory");
    __syncthreads();
    if (b.wave == 0 && fresh_lane() == 0) {
        unsigned* bar = b.bar;
        __builtin_amdgcn_s_waitcnt(0);
        unsigned nloc = b.st[0], nx = b.st[1];
        if (nloc == 0u) { xcd_barrier_complete(bar, b.x, nloc, nx); b.st[0] = nloc; b.st[1] = nx; }
        const unsigned old = xb_add(&bar[XB_XSUB(b.x)], 1u);
        const unsigned gen = old / nloc;
        if (old + 1u == (gen + 1u) * nloc) {
            __builtin_amdgcn_fence(__ATOMIC_RELEASE, "agent");
            asm volatile("s_waitcnt vmcnt(0)" ::: "memory");
            const unsigned og = xb_add(&bar[XB_TOP], 1u);
            const unsigned tg = og / nx;
            if (og + 1u == (tg + 1u) * nx) xb_add(&bar[XB_TOPGEN], 1u);
            else XB_SPIN(xb_ld(&bar[XB_TOPGEN]) == tg, bar);
            __builtin_amdgcn_fence(__ATOMIC_ACQUIRE, "agent");
            xb_add(&bar[XB_XGEN(b.x)], 1u);
            asm volatile("s_waitcnt vmcnt(0)" ::: "memory");
        } else {
            XB_SPIN(xb_ld(&bar[XB_XGEN(b.x)]) == gen, bar);
            __builtin_amdgcn_fence(__ATOMIC_ACQUIRE, "agent");
            asm volatile("s_waitcnt vmcnt(0)" ::: "memory");
        }
    }
    __syncthreads();
}

template <bool F8OUT = false>
__device__ __forceinline__ void tr_item(const float* __restrict__ src, int ldS, bf16* __restrict__ dst, int ldD, float scale, LAS float* scr, int lane) {
    f32x4 v[8];
#pragma unroll
    for (int t = 0; t < 8; ++t) { const int idx = lane + 64 * t; v[t] = *(const f32x4*)(src + (size_t)(idx >> 3) * ldS + 4 * (idx & 7)); }
#pragma unroll
    for (int t = 0; t < 8; ++t) { const int idx = lane + 64 * t; LAS float* p = scr + (idx >> 3) * 33 + 4 * (idx & 7); p[0] = v[t].x; p[1] = v[t].y; p[2] = v[t].z; p[3] = v[t].w; }
    LDS_WAIT(); asm volatile("" ::: "memory");
    const int c = lane & 7;
#pragma unroll
    for (int j = 0; j < 4; ++j) { const int n = (lane >> 3) + 8 * j; const LAS float* s = scr + (8 * c) * 33 + n;
        if constexpr (F8OUT) {
            int t0 = 0, t1 = 0;
            t0 = __builtin_amdgcn_cvt_pk_fp8_f32(s[0 * 33] * scale, s[1 * 33] * scale, t0, false); t0 = __builtin_amdgcn_cvt_pk_fp8_f32(s[2 * 33] * scale, s[3 * 33] * scale, t0, true);
            t1 = __builtin_amdgcn_cvt_pk_fp8_f32(s[4 * 33] * scale, s[5 * 33] * scale, t1, false); t1 = __builtin_amdgcn_cvt_pk_fp8_f32(s[6 * 33] * scale, s[7 * 33] * scale, t1, true);
            v2u o; o.x = (unsigned)t0; o.y = (unsigned)t1; *(v2u*)((unsigned char*)dst + (size_t)n * ldD + 8 * c) = o;
        } else {
        v4u o; o.x = pk2(s[0 * 33] * scale, s[1 * 33] * scale); o.y = pk2(s[2 * 33] * scale, s[3 * 33] * scale); o.z = pk2(s[4 * 33] * scale, s[5 * 33] * scale); o.w = pk2(s[6 * 33] * scale, s[7 * 33] * scale);
        *(v4u*)(dst + (size_t)n * ldD + 8 * c) = o; } }
    LDS_WAIT(); asm volatile("" ::: "memory");
}
constexpr int XI_GU = 32 * 16 * 32, XI_D = 32 * 8 * 32, XI_PER_UNIT = 48, X_UNITS = (XI_GU + XI_D) / XI_PER_UNIT;
__device__ __forceinline__ void expert_item(const float* __restrict__ w_gate, const float* __restrict__ w_up, const float* __restrict__ w_down, bf16* __restrict__ Wt_gu, bf16* __restrict__ Wt_d, int r, LAS float* scr, int lane) {
    if (r < XI_GU) { const int e = r / 512, q = r % 512, kb = q / 32, nb = q % 32, n0 = 32 * nb, pn = n0 >> 8, bj = (n0 >> 7) & 1, j0 = n0 & 127;
        const float* src = (bj ? w_up : w_gate) + (size_t)e * 1024 * 512 + (size_t)(64 * kb) * 512 + 128 * pn + j0;
        tr_item<true>(src, 512, (bf16*)((unsigned char*)Wt_gu + ((size_t)e * 1024 + n0) * 1024 + 64 * kb), 1024, 32.0f, scr, lane); }
    else { r -= XI_GU; const int e = r / 256, q = r % 256, kb = q / 32, nb = q % 32;
        tr_item<true>(w_down + (size_t)e * 512 * 1024 + (size_t)(64 * kb) * 1024 + 32 * nb, 1024, (bf16*)((unsigned char*)Wt_d + ((size_t)e * 1024 + 32 * nb) * 512 + 64 * kb), 512, 32.0f, scr, lane); }
}
struct P0Args { const float *c, *ada_w, *ada_b, *w_in, *w_o, *w_rg, *w_re, *w_gate, *w_up, *w_down; bf16 *Wt_in, *Wt_o, *Wt_gu, *Wt_d; float *Wr, *mod; };
__device__ __forceinline__ void p0_prologue(const P0Args& a, LAS unsigned char* lds, int vcu, int G, int tid, int wave, int lane) {
    LAS float* scr = (LAS float*)(lds + wave * 8448);
    const int gw = vcu * NWAVES + wave, NGW = G * NWAVES;
    constexpr int I_IN = 16 * 96, I_O = 16 * 32, I_GU = 32 * 16 * 32, I_D = 32 * 8 * 32;
    constexpr int NITEMS = I_IN + I_O;
    for (int it = gw; it < NITEMS; it += NGW) {
        int r = it;
        if (r < I_IN) { const int kb = r / 96, nb = r % 96, n0 = 32 * nb, sc = n0 < 1536 ? n0 : n0 + 8;
            const float scale = (n0 < 512 || (n0 >= 1536 && n0 < 2048)) ? C2 : 1.0f;
            tr_item(a.w_in + (size_t)(64 * kb) * IN_COLS + sc, IN_COLS, a.Wt_in + (size_t)n0 * 1024 + 64 * kb, 1024, scale, scr, lane); continue; }
        r -= I_IN;
        { const int kb = r / 32, nb = r % 32;
            tr_item(a.w_o + (size_t)(64 * kb) * 1024 + 32 * nb, 1024, a.Wt_o + (size_t)(32 * nb) * 1024 + 64 * kb, 1024, 1.0f, scr, lane); }
    }
    for (int t = (vcu * NWAVES * 64 + tid); t < 32 * 3 * 2 * 64; t += G * NWAVES * 64) { const int l = t & 63, part = (t >> 6) & 1, ic = t >> 7, c = ic % 3, i = ic / 3, n = 16 * c + (l & 15), k0 = 32 * i + 8 * (l >> 4);
        unsigned short o[8];
#pragma unroll
        for (int j = 0; j < 8; ++j) { const int k = k0 + j; const float w = n < 32 ? a.w_re[k * 32 + n] : (n < 36 ? a.w_rg[k * 4 + (n - 32)] : 0.f);
            const unsigned hi = f2bf(w); const float lo = w - __builtin_bit_cast(float, hi << 16); o[j] = (unsigned short)(part ? f2bf(lo) : hi); }
        v4u pk; pk.x = o[0] | ((unsigned)o[1] << 16); pk.y = o[2] | ((unsigned)o[3] << 16); pk.z = o[4] | ((unsigned)o[5] << 16); pk.w = o[6] | ((unsigned)o[7] << 16);
        *(v4u*)((bf16*)a.Wr + (size_t)t * 8) = pk; }
    for (int t = (vcu * NWAVES * 64 + tid); t < 32 * 2 * 64; t += G * NWAVES * 64) { const int l = t & 63, part = (t >> 6) & 1, i = t >> 7, n = l & 15, k0 = 32 * i + 8 * (l >> 4);
        unsigned short o[8];
#pragma unroll
        for (int j = 0; j < 8; ++j) { const float w = n < 8 ? a.w_in[(size_t)(k0 + j) * IN_COLS + 1536 + n] : 0.f;
            const unsigned hi = f2bf(w); const float lo = w - __builtin_bit_cast(float, hi << 16); o[j] = (unsigned short)(part ? f2bf(lo) : hi); }
        v4u pk; pk.x = o[0] | ((unsigned)o[1] << 16); pk.y = o[2] | ((unsigned)o[3] << 16); pk.z = o[4] | ((unsigned)o[5] << 16); pk.w = o[6] | ((unsigned)o[7] << 16);
        *(v4u*)((bf16*)a.Wr + 131072 + (size_t)t * 8) = pk; }
    __syncthreads();
    LAS float* cs = (LAS float*)(lds + 69632);
    LAS float* red = (LAS float*)(lds + 69632 + 32768);
    for (int i = tid; i < 8192; i += NWAVES * 64) cs[i] = a.c[i];
    __syncthreads();
    for (int ch = vcu; ch < 256; ch += G) {
        const int col = lane % 24, half = lane / 24;
        float acc[8];
#pragma unroll
        for (int b = 0; b < 8; ++b) acc[b] = 0.f;
        if (lane < 48) {
            const int kb = wave * 128 + half * 64;
            const float* wp = a.ada_w + (size_t)kb * 6144 + ch * 24 + col;
#pragma unroll 16
            for (int k = 0; k < 64; ++k) { const float wv = wp[(size_t)k * 6144];
#pragma unroll
                for (int b = 0; b < 8; ++b) acc[b] = fmaf(cs[b * 1024 + kb + k], wv, acc[b]); }
#pragma unroll
            for (int b = 0; b < 8; ++b) red[((wave * 2 + half) * 8 + b) * 24 + col] = acc[b];
        }
        __syncthreads();
        if (tid < 192) { const int b = tid / 24, cl = tid % 24; float s = a.ada_b[ch * 24 + cl];
#pragma unroll
          for (int w = 0; w < 16; ++w) s += red[(w * 8 + b) * 24 + cl];
          a.mod[b * 6144 + ch * 24 + cl] = s; }
        __syncthreads();
    }
}

typedef short p5_bf16x8 __attribute__((ext_vector_type(8)));
__device__ __forceinline__ void p1_norm(const float* __restrict__ x, const float* __restrict__ g1, const float* __restrict__ mod, const bf16* __restrict__ WfzF, const float* __restrict__ b_f,
                                        bf16* __restrict__ H, float* __restrict__ cumloc, float* __restrict__ blktot, LAS unsigned char* lds, int vcu, int G, int tid, int wave, int lane) {
    LAS float* lf = (LAS float*)(lds + 65536); LAS float* segtot = (LAS float*)(lds + 69632);
    for (int i = tid; i < 4096; i += NWAVES * 64) ((LAS v4u*)lds)[i] = ((const v4u*)WfzF)[i];
    __syncthreads();
    for (int rb = vcu; rb < T / 128; rb += G) {
        const int b = rb >> 5;
        { f32x4 A[4], Bc[4];
#pragma unroll
          for (int j = 0; j < 4; ++j) { const int col = 256 * j + 4 * lane; const f32x4 g = *(const f32x4*)(g1 + col), sc = *(const f32x4*)(mod + b * 6144 + 1024 + col);
            A[j] = g * (1.0f + sc); Bc[j] = *(const f32x4*)(mod + b * 6144 + col); }
#pragma unroll 2
          for (int rr = 0; rr < 16; ++rr) {
            const int row = rb * 128 + wave * 16 + rr;
            const f32x4* xr = (const f32x4*)(x + (size_t)row * D) + lane;
            f32x4 v[4]; float s = 0.f;
#pragma unroll
            for (int j = 0; j < 4; ++j) { v[j] = xr[64 * j]; s += (v[j].x * v[j].x + v[j].y * v[j].y) + (v[j].z * v[j].z + v[j].w * v[j].w); }
            const float rstd = 1.0f / sqrtf(wave_sum(s) * (1.0f / D) + 1e-6f);
            v2u* o8 = (v2u*)(H + (size_t)row * D) + lane;
#pragma unroll
            for (int j = 0; j < 4; ++j) { const f32x4 h = v[j] * rstd * A[j] + Bc[j]; v2u w; w.x = pk2(h.x, h.y); w.y = pk2(h.z, h.w); o8[64 * j] = w; }
          } }
        VM_WAIT();
        f32x4 acc = (f32x4){0.f, 0.f, 0.f, 0.f};
        { const bf16* ap = H + (size_t)(rb * 128 + wave * 16 + (lane & 15)) * D + 8 * (lane >> 4);
          const LAS p5_bf16x8* bp = (const LAS p5_bf16x8*)lds + lane;
#pragma unroll 8
          for (int i = 0; i < 32; ++i) {
            const p5_bf16x8 af = *(const p5_bf16x8*)(ap + 32 * i);
            acc = __builtin_amdgcn_mfma_f32_16x16x32_bf16(af, bp[(i * 2 + 0) * 64], acc, 0, 0, 0);
            acc = __builtin_amdgcn_mfma_f32_16x16x32_bf16(af, bp[(i * 2 + 1) * 64], acc, 0, 0, 0); } }
        if ((lane & 15) < 8) { const float bfv = b_f[lane & 15];
#pragma unroll
            for (int r = 0; r < 4; ++r) { const float z = acc[r] + bfv; lf[(wave * 16 + 4 * (lane >> 4) + r) * 8 + (lane & 15)] = fminf(z, 0.f) - log1pf(expf(-fabsf(z))); } }
        __syncthreads();
        float run[16]; const int hh = tid & 7, seg = (tid >> 3) & 7;
        if (tid < 64) { float s = 0.f;
#pragma unroll
            for (int i = 0; i < 16; ++i) { s += lf[(seg * 16 + i) * 8 + hh]; run[i] = s; }
            segtot[seg * 8 + hh] = s; }
        __syncthreads();
        if (tid < 64) { float off = 0.f;
            for (int s2 = 0; s2 < seg; ++s2) off += segtot[s2 * 8 + hh];
            float* cp = cumloc + (size_t)(b * 8 + hh) * SEQ + (rb & 31) * 128 + seg * 16;
            const float NL2E = -1.4426950408889634f;
#pragma unroll
            for (int i = 0; i < 4; ++i) { f32x4 t; t.x = (run[4 * i] + off) * NL2E; t.y = (run[4 * i + 1] + off) * NL2E; t.z = (run[4 * i + 2] + off) * NL2E; t.w = (run[4 * i + 3] + off) * NL2E; *(f32x4*)(cp + 4 * i) = t; }
            if (seg == 7) blktot[rb * 8 + hh] = (run[15] + off) * NL2E; }
        __syncthreads();
    }
}

__device__ __forceinline__ void p5_route(const bf16* __restrict__ x1, const float* __restrict__ g2, const float* __restrict__ mod, const bf16* __restrict__ WrF, const float* __restrict__ b_rg, const float* __restrict__ b_re,
                                         bf16* __restrict__ H2, unsigned char* __restrict__ H2F8, gu32* cnt, int* __restrict__ stok, int* __restrict__ rt_e, int* __restrict__ rt_pos, float* __restrict__ rt_w,
                                         LAS unsigned char* lds, int vcu, int G, int tid, int wave, int lane) {
    LAS unsigned* CNT = (LAS unsigned*)lds; LAS unsigned* BASE = (LAS unsigned*)(lds + 128); LAS unsigned* REC = (LAS unsigned*)(lds + 256); LAS float* LG = (LAS float*)(lds + 4352 + wave * 3072);
    if (tid < 32) CNT[tid] = 0u;
    __syncthreads();
    for (int rb = vcu; rb < T / 128; rb += G) {
        const int b = rb >> 5;
        { f32x4 A[4], Bc[4];
#pragma unroll
          for (int j = 0; j < 4; ++j) { const int col = 256 * j + 4 * lane; const f32x4 g = *(const f32x4*)(g2 + col), sc = *(const f32x4*)(mod + b * 6144 + 4096 + col);
            A[j] = g * (1.0f + sc); Bc[j] = *(const f32x4*)(mod + b * 6144 + 3072 + col); }
#pragma unroll 2
          for (int rr = 0; rr < 16; ++rr) {
            const int row = rb * 128 + wave * 16 + rr;
            const v2u* xr = (const v2u*)(x1 + (size_t)row * D) + lane;
            f32x4 v[4]; float s = 0.f;
#pragma unroll
            for (int j = 0; j < 4; ++j) { const v2u xw = xr[64 * j]; v[j].x = bflo(xw.x); v[j].y = bfhi(xw.x); v[j].z = bflo(xw.y); v[j].w = bfhi(xw.y); s += (v[j].x * v[j].x + v[j].y * v[j].y) + (v[j].z * v[j].z + v[j].w * v[j].w); }
            const float rstd = 1.0f / sqrtf(wave_sum(s) * (1.0f / D) + 1e-6f);
            v2u* o8 = (v2u*)(H2 + (size_t)row * D) + lane;
            unsigned* o4 = (unsigned*)(H2F8 + (size_t)row * D) + lane;
#pragma unroll
            for (int j = 0; j < 4; ++j) { const f32x4 h = v[j] * rstd * A[j] + Bc[j]; v2u w; w.x = pk2(h.x, h.y); w.y = pk2(h.z, h.w); o8[64 * j] = w;
                int t = 0; t = __builtin_amdgcn_cvt_pk_fp8_f32(h.x, h.y, t, false); t = __builtin_amdgcn_cvt_pk_fp8_f32(h.z, h.w, t, true); o4[64 * j] = (unsigned)t; }
          } }
        VM_WAIT();
        f32x4 acc[3];
#pragma unroll
        for (int c = 0; c < 3; ++c) acc[c] = (f32x4){0.f, 0.f, 0.f, 0.f};
        { const bf16* ap = H2 + (size_t)(rb * 128 + wave * 16 + (lane & 15)) * D + 8 * (lane >> 4);
          const bf16* bp = WrF + lane * 8;
#pragma unroll 4
          for (int i = 0; i < 32; ++i) {
            const p5_bf16x8 af = *(const p5_bf16x8*)(ap + 32 * i);
#pragma unroll
            for (int c = 0; c < 3; ++c) {
                const p5_bf16x8 bh = *(const p5_bf16x8*)(bp + ((i * 3 + c) * 2 + 0) * 512), bl = *(const p5_bf16x8*)(bp + ((i * 3 + c) * 2 + 1) * 512);
                acc[c] = __builtin_amdgcn_mfma_f32_16x16x32_bf16(af, bh, acc[c], 0, 0, 0);
                acc[c] = __builtin_amdgcn_mfma_f32_16x16x32_bf16(af, bl, acc[c], 0, 0, 0); }
          } }
#pragma unroll
        for (int c = 0; c < 3; ++c)
#pragma unroll
            for (int r = 0; r < 4; ++r) LG[(4 * (lane >> 4) + r) * 48 + 16 * c + (lane & 15)] = acc[c][r];
        LDS_WAIT();
        if (lane < 16) {
            const LAS float* L = LG + lane * 48;
            float gl[4];
#pragma unroll
            for (int i = 0; i < 4; ++i) gl[i] = L[32 + i] + b_rg[i];
            int g = 0; float gm = gl[0];
#pragma unroll
            for (int i = 1; i < 4; ++i) if (gl[i] > gm) { gm = gl[i]; g = i; }
            float gs = 0.f;
#pragma unroll
            for (int i = 0; i < 4; ++i) gs += expf(gl[i] - gm);
            const float pg = 1.0f / gs;
            float el[8];
#pragma unroll
            for (int i = 0; i < 8; ++i) el[i] = L[g * 8 + i] + b_re[g * 8 + i];
            int i1 = 0; float m1 = el[0];
#pragma unroll
            for (int i = 1; i < 8; ++i) if (el[i] > m1) { m1 = el[i]; i1 = i; }
            int i2 = -1; float m2 = -3.0e38f;
#pragma unroll
            for (int i = 0; i < 8; ++i) if (i != i1 && el[i] > m2) { m2 = el[i]; i2 = i; }
            const float ex = expf(m2 - m1); const float w1 = pg / (1.0f + ex), w2 = pg * ex / (1.0f + ex);
            const int e1 = g * 8 + i1, e2 = g * 8 + i2, rl = wave * 16 + lane;
            const unsigned p1 = __hip_atomic_fetch_add(&CNT[e1], 1u, __ATOMIC_RELAXED, __HIP_MEMORY_SCOPE_WORKGROUP), p2 = __hip_atomic_fetch_add(&CNT[e2], 1u, __ATOMIC_RELAXED, __HIP_MEMORY_SCOPE_WORKGROUP);
            REC[(rl * 2 + 0) * 4 + 0] = (unsigned)e1; REC[(rl * 2 + 0) * 4 + 1] = p1; REC[(rl * 2 + 0) * 4 + 2] = __float_as_uint(w1);
            REC[(rl * 2 + 1) * 4 + 0] = (unsigned)e2; REC[(rl * 2 + 1) * 4 + 1] = p2; REC[(rl * 2 + 1) * 4 + 2] = __float_as_uint(w2);
        }
        __syncthreads();
        if (tid < 32) BASE[tid] = __hip_atomic_fetch_add(cnt + 64 * tid, CNT[tid], RLX_AGENT);
        __syncthreads();
        if (tid < 256) { const unsigned e = REC[tid * 4 + 0], pl = REC[tid * 4 + 1], wb = REC[tid * 4 + 2]; const unsigned pos = BASE[e] + pl; const int tok = rb * 128 + (tid >> 1);
            stok[(size_t)e * 65536 + pos] = tok; rt_e[tok * 2 + (tid & 1)] = (int)e; rt_pos[tok * 2 + (tid & 1)] = (int)pos; rt_w[tok * 2 + (tid & 1)] = __uint_as_float(wb); }
        __syncthreads();
        if (tid < 32) CNT[tid] = 0u;
        __syncthreads();
    }
}

__device__ __forceinline__ void moe_tables(gu32* cnt, LAS int* TB, LAS int* CN, int tid) {
    if (tid == 0) { int s = 0;
        for (int e = 0; e < 32; ++e) { const int c = (int)__hip_atomic_load(cnt + 64 * e, RLX_AGENT); CN[e] = c; TB[e] = s; s += (c + 255) >> 8; }
        TB[32] = s; }
    __syncthreads();
}
struct MoeOrder {
    const LAS int* TB; const LAS int* CN; const int* stok; int G, c; bool gather;
    __device__ __forceinline__ bool next(int i, pg8::Unit& u) const {
        const int L = i * G + c; if (L >= 4 * TB[32]) return false;
        const int gt = L >> 2, ct = L & 3; int e = 0;
        for (int k = 1; k < 32; ++k) e += (gt >= TB[k]) ? 1 : 0;
        u.pm = gt; u.pn = e * 4 + ct; u.e = e; return true;
    }
    __device__ __forceinline__ void a_off(const pg8::Unit& u, const int (&RA)[2], const int (&CA)[2], int KB  , unsigned (&off)[2][2]) const {
        if (gather) {
            const int p0 = (u.pm - TB[u.e]) * 256, n = CN[u.e];
#pragma unroll
            for (int h = 0; h < 2; ++h)
#pragma unroll
                for (int i = 0; i < 2; ++i) { const int pos = p0 + h * 128 + RA[i]; const int tok = pos < n ? stok[(size_t)u.e * 65536 + pos] : 0;
                    off[h][i] = (unsigned)((size_t)tok * KB + CA[i] * 2); }
            __builtin_amdgcn_s_waitcnt(0x0F70);
        } else {
#pragma unroll
            for (int h = 0; h < 2; ++h)
#pragma unroll
                for (int i = 0; i < 2; ++i) off[h][i] = (unsigned)((size_t)(u.pm * 256 + h * 128 + RA[i]) * KB + CA[i] * 2);
        }
    }
};

__device__ __forceinline__ void p8_final(const bf16* __restrict__ x1, float* __restrict__ xo, const bf16* __restrict__ Y, const float* __restrict__ mod, const float* __restrict__ gf,
                                         const int* __restrict__ rt_e, const int* __restrict__ rt_pos, const float* __restrict__ rt_w, const LAS int* TB,
                                         int vcu, int G, int wave, int lane) {
    const int gw = vcu * NWAVES + wave, NGW = G * NWAVES;
    f32x4 gfv[4];
#pragma unroll
    for (int j = 0; j < 4; ++j) gfv[j] = *(const f32x4*)(gf + 256 * j + 4 * lane);
#pragma unroll 2
    for (int row = gw; row < T; row += NGW) {
        const int b = row >> 12;
        const int e0 = rt_e[row * 2], e1 = rt_e[row * 2 + 1]; const int s0 = TB[e0] * 256 + rt_pos[row * 2], s1 = TB[e1] * 256 + rt_pos[row * 2 + 1];
        const float w0 = 0.125f * rt_w[row * 2], w1 = 0.125f * rt_w[row * 2 + 1];
        f32x4* xr = (f32x4*)(xo + (size_t)row * D) + lane; const v2u* x1r = (const v2u*)(x1 + (size_t)row * D) + lane;
        const unsigned* y0 = (const unsigned*)((const unsigned char*)Y + (size_t)s0 * D) + lane; const unsigned* y1 = (const unsigned*)((const unsigned char*)Y + (size_t)s1 * D) + lane;
        f32x4 v[4]; float s = 0.f;
#pragma unroll
        for (int j = 0; j < 4; ++j) { const v2u xw = x1r[64 * j]; f32x4 xv; xv.x = bflo(xw.x); xv.y = bfhi(xw.x); xv.z = bflo(xw.y); xv.w = bfhi(xw.y); const unsigned a = y0[64 * j], c = y1[64 * j]; const f32x4 g2 = *(const f32x4*)(mod + b * 6144 + 5120 + 256 * j + 4 * lane);
            const auto a01 = __builtin_amdgcn_cvt_pk_f32_fp8(a, false), a23 = __builtin_amdgcn_cvt_pk_f32_fp8(a, true), c01 = __builtin_amdgcn_cvt_pk_f32_fp8(c, false), c23 = __builtin_amdgcn_cvt_pk_f32_fp8(c, true);
            f32x4 y; y.x = w0 * a01[0] + w1 * c01[0]; y.y = w0 * a01[1] + w1 * c01[1]; y.z = w0 * a23[0] + w1 * c23[0]; y.w = w0 * a23[1] + w1 * c23[1];
            v[j] = xv + g2 * y; s += (v[j].x * v[j].x + v[j].y * v[j].y) + (v[j].z * v[j].z + v[j].w * v[j].w); }
        const float rstd = 1.0f / sqrtf(wave_sum(s) * (1.0f / D) + 1e-6f);
#pragma unroll
        for (int j = 0; j < 4; ++j) xr[64 * j] = v[j] * rstd * gfv[j];
    }
}

constexpr int ATT_NU = 256;
__device__ const unsigned short ATT_ORDER[256] = {127, 126, 125, 512, 124, 123, 122, 513, 121, 120, 119, 514, 118, 85, 86, 515, 87, 88, 89, 516, 90, 91, 92, 517, 93, 94, 95, 518, 117, 84, 116, 519, 83, 115, 259, 520, 260, 261, 262, 521, 263, 291, 292, 522, 293, 294, 295, 523, 323, 324, 325, 524, 326, 327, 355, 525, 356, 357, 358, 526, 359, 387, 388, 527, 389, 390, 391, 528, 419, 420, 421, 529, 422, 423, 451, 530, 452, 453, 454, 531, 455, 483, 484, 532, 485, 486, 487, 533, 82, 114, 81, 534, 113, 80, 112, 535, 79, 111, 258, 536, 290, 322, 354, 537, 386, 418, 450, 538, 482, 78, 110, 539, 77, 109, 76, 540, 108, 75, 107, 541, 74, 106, 73, 542, 105, 257, 289, 543, 321, 353, 385, 544, 417, 449, 481, 545, 72, 104, 71, 546, 103, 38, 39, 547, 40, 41, 42, 548, 43, 44, 45, 549, 46, 47, 48, 550, 49, 50, 51, 551, 52, 53, 54, 552, 55, 56, 57, 553, 58, 59, 60, 554, 61, 62, 63, 555, 70, 102, 37, 556, 69, 101, 36, 557, 68, 100, 256, 558, 288, 320, 352, 559, 384, 416, 448, 560, 480, 35, 67, 561, 99, 34, 66, 562, 98, 2, 3, 563, 4, 5, 6, 564, 7, 8, 9, 565, 10, 11, 12, 566, 13, 14, 15, 567, 16, 17, 18, 568, 19, 20, 21, 569, 22, 23, 24, 570, 25, 26, 27, 571, 28, 29, 30, 572, 31, 1, 33, 573, 65, 97, 0, 574, 32, 64, 96, 575};
struct Args { const float* in[22]; float* out; unsigned char* ws; int ph_lo, ph_hi; };
typedef __attribute__((address_space(4))) const unsigned long long cu64;
__device__ __forceinline__ cu64* karg() { cu64* p = (cu64*)__builtin_amdgcn_kernarg_segment_ptr(); asm volatile("" : "+s"(p)); return p; }
#define KA_IN(ka, i) ((const float*)(ka)[i])
#define KA_OUT(ka) ((float*)(ka)[22])
#define KA_WS(ka) ((unsigned char*)(ka)[23])
__global__ void __launch_bounds__(NWAVES * 64, 2) fwd_kernel(Args args) {
    extern __shared__ __attribute__((aligned(16))) unsigned char lds_raw[];
    LAS unsigned char* lds = (LAS unsigned char*)lds_raw;
    volatile LAS unsigned* MISC = (volatile LAS unsigned*)(lds + MISC_OFF);
    const int wave = __builtin_amdgcn_readfirstlane((int)threadIdx.x >> 6);
    const int G = gridDim.x; const int bx = blockIdx.x; const int vcu = (G % 8 == 0) ? (bx % 8) * (G / 8) + bx / 8 : bx;
    if (wave == 0) MISC[fresh_lane()] = 0u;
    __syncthreads();
    XcdBarrier bar = xcd_barrier_post((unsigned*)((gu32*)(args.ws + WS_CTL) + CW_BAR), MISC + 8); bar.wave = wave;
    const int lo = args.ph_lo, hi = args.ph_hi;
    unsigned long long prof_acc = 0;
#ifndef PHASE_MASK
#define PHASE_MASK 0x1ff
#endif
#define IN(k) ((((PHASE_MASK) >> (k)) & 1) && lo <= (k) && (k) < hi)
#define SEAM(k) do { if (IN(k) && IN((k) + 1)) { unsigned long long t0_ = 0; if (PROF_ID == 30 + (k)) t0_ = __builtin_amdgcn_s_memrealtime(); xcd_barrier(bar); if (PROF_ID == 30 + (k)) prof_acc += __builtin_amdgcn_s_memrealtime() - t0_; } } while (0)
#define PH_T0(k) unsigned long long pht0_##k = 0; if (PROF_ID == 20 + (k)) pht0_##k = __builtin_amdgcn_s_memrealtime()
#define PH_T1(k) do { if (PROF_ID == 20 + (k)) prof_acc += __builtin_amdgcn_s_memrealtime() - pht0_##k; } while (0)
#ifndef PROBE_PHASE
#define PROBE_PHASE -1
#endif
#define REP(k) _Pragma("unroll 1") for (int rep_ = 0; rep_ < ((PROBE_PHASE) == (k) ? 2 : 1); ++rep_)

    PH_T0(0);
    if (IN(0)) REP(0) {
        cu64* ka = karg(); unsigned char* ws = KA_WS(ka);
        P0Args a{KA_IN(ka, 1), KA_IN(ka, 2), KA_IN(ka, 3), KA_IN(ka, 5), KA_IN(ka, 12), KA_IN(ka, 14), KA_IN(ka, 16), KA_IN(ka, 18), KA_IN(ka, 19), KA_IN(ka, 20),
                 (bf16*)(ws + WS_WIN), (bf16*)(ws + WS_WO), (bf16*)(ws + WS_WGU), (bf16*)(ws + WS_WD), (float*)(ws + WS_WR), (float*)(ws + WS_MOD)};
        const int lane = fresh_lane(), tid = wave * 64 + lane; p0_prologue(a, lds, vcu, G, tid, wave, lane);
    }
    PH_T1(0);
    SEAM(0);
    PH_T0(1);
    if (IN(1)) REP(1) { cu64* ka = karg(); unsigned char* ws = KA_WS(ka); const int lane = fresh_lane(), tid = wave * 64 + lane;
        p1_norm(KA_IN(ka, 0), KA_IN(ka, 4), (const float*)(ws + WS_MOD), (const bf16*)(ws + WS_WR) + 131072, KA_IN(ka, 6), (bf16*)(ws + WS_H), (float*)(ws + WS_CUM), (float*)(ws + WS_BLK), lds, vcu, G, tid, wave, lane); }
    PH_T1(1);
    SEAM(1);
#define P2BODY { cu64* ka = karg(); unsigned char* ws = KA_WS(ka); pg8::Gemm g{(const bf16*)(ws + WS_H), (const bf16*)(ws + WS_WIN), T, NQKV, D}; pg8::StaticOrder S; S.init(T, NQKV, G, bx); \
        pg8::EpiStore E{(bf16*)(ws + WS_QKV), NQKV, 0xffff, (unsigned*)(ws + WS_CTL) + CW_KM}; \
        pg8::gemm_phase<pg8::EpiStore, pg8::StaticOrder, false, true>(lds, g, S, E, wave); }
    PH_T0(2);
    if (IN(2)) { P2BODY if (PROBE_PHASE == 2) P2BODY }
    PH_T1(2);
    SEAM(2);
    PH_T0(3);
    if (IN(3)) REP(3) {
        float lam;
        { cu64* ka = karg(); const float* lq1 = KA_IN(ka, 7); const float* lk1 = KA_IN(ka, 8); const float* lq2 = KA_IN(ka, 9); const float* lk2 = KA_IN(ka, 10);
          const int lane = fresh_lane(); const float a = wave_sum(lq1[lane] * lk1[lane]), b2 = wave_sum(lq2[lane] * lk2[lane]); lam = expf(a) - expf(b2) + LAM_INIT; }
        volatile LAS int* QSLOT = (volatile LAS int*)(lds + MISC_OFF + 64);
        const int xq0 = (G >= 8) ? (vcu * 8) / G : 0;
#pragma unroll 1
        for (int qi = 0; qi < 8; ++qi) {
            const int xq = (xq0 + qi) & 7;
#pragma unroll 1
            for (;;) {
                cu64* ka = karg(); unsigned char* ws = KA_WS(ka);
                if (wave == 0 && fresh_lane() == 0) QSLOT[0] = (int)__hip_atomic_fetch_add((gu32*)(ws + WS_CTL) + CW_QH + 64 * xq, 1u, RLX_AGENT);
                __syncthreads();
                const int idx = __builtin_amdgcn_readfirstlane(QSLOT[0]);
                __syncthreads();
                if (idx >= ATT_NU) break;
                const int u = ATT_ORDER[idx], h = (u >> 5) & 7, qb = u & 31;
                if ((u >> 8) == 2) {
                    LAS float* scr = (LAS float*)(lds + wave * 8448); const int lane_ = fresh_lane(); const int it0 = (xq * 64 + (u & 255)) * XI_PER_UNIT + wave * 6;
#pragma unroll 1
                    for (int k = 0; k < 6; ++k) expert_item(KA_IN(ka, 18), KA_IN(ka, 19), KA_IN(ka, 20), (bf16*)(ws + WS_WGU), (bf16*)(ws + WS_WD), it0 + k, scr, lane_);
                    __syncthreads();
                } else
                if ((u >> 8) == 0) { PROF_BEGIN(1); att::diff_unit(lds, (const bf16*)(ws + WS_QKV), (bf16*)(ws + WS_H), KA_IN(ka, 11), lam, (const unsigned*)(ws + WS_CTL) + CW_KM, xq, h, qb, wave, prof_acc); PROF_END(1, prof_acc); }
                else { PROF_BEGIN(2); att::fox2_unit(lds, (const bf16*)(ws + WS_QKV), (bf16*)(ws + WS_H), (const float*)(ws + WS_CUM), (const float*)(ws + WS_BLK), (const unsigned*)(ws + WS_CTL) + CW_KM, xq, h, qb, wave, prof_acc); PROF_END(2, prof_acc); }
            }
        }
    }
    PH_T1(3);
    SEAM(3);
#define P4BODY { cu64* ka = karg(); unsigned char* ws = KA_WS(ka); pg8::Gemm g{(const bf16*)(ws + WS_H), (const bf16*)(ws + WS_WO), T, D, D}; pg8::StaticOrder S; S.init(T, D, G, bx); \
        pg8::EpiResid E{KA_IN(ka, 0), (bf16*)(ws + WS_X1), (const float*)(ws + WS_MOD) + 2048}; \
        pg8::gemm_phase<pg8::EpiResid, pg8::StaticOrder, true, true>(lds, g, S, E, wave); }
    PH_T0(4);
    if (IN(4)) { P4BODY if (PROBE_PHASE == 4) P4BODY }
    PH_T1(4);
    SEAM(4);
    PH_T0(5);
    if (IN(5)) { cu64* ka = karg(); unsigned char* ws = KA_WS(ka); int* rt_e = (int*)(ws + WS_RT); const int lane = fresh_lane(), tid = wave * 64 + lane;
        p5_route((const bf16*)(ws + WS_X1), KA_IN(ka, 13), (const float*)(ws + WS_MOD), (const bf16*)(ws + WS_WR), KA_IN(ka, 15), KA_IN(ka, 17), (bf16*)(ws + WS_H), ws + WS_H2F8, (gu32*)(ws + WS_CTL) + CW_CNT, (int*)(ws + WS_STOK),
                 rt_e, rt_e + 2 * T, (float*)(rt_e + 4 * T), lds, vcu, G, tid, wave, lane); }
    PH_T1(5);
    SEAM(5);
    LAS int* TB = (LAS int*)(lds + 131072); LAS int* CN = (LAS int*)(lds + 131072 + 256);
#define P6BODY { cu64* ka = karg(); unsigned char* ws = KA_WS(ka); moe_tables((gu32*)(ws + WS_CTL) + CW_CNT, TB, CN, wave * 64 + fresh_lane()); pg8::Gemm g{(const bf16*)(ws + WS_H2F8), (const bf16*)(ws + WS_WGU), T, 1024, D}; \
        MoeOrder S{TB, CN, (const int*)(ws + WS_STOK), G, bx, true}; pg8::EpiSwigluF8 E{ws + WS_HID}; \
        pg8::gemm_phase<pg8::EpiSwigluF8, MoeOrder, true, true, true>(lds, g, S, E, wave); }
    PH_T0(6);
    if (IN(6)) { P6BODY if (PROBE_PHASE == 6) P6BODY }
    PH_T1(6);
    SEAM(6);
#define P7BODY { cu64* ka = karg(); unsigned char* ws = KA_WS(ka); moe_tables((gu32*)(ws + WS_CTL) + CW_CNT, TB, CN, wave * 64 + fresh_lane()); pg8::Gemm g{(const bf16*)(ws + WS_HID), (const bf16*)(ws + WS_WD), NSLOT_MAX, 1024, DEXP}; \
        MoeOrder S{TB, CN, (const int*)(ws + WS_STOK), G, bx, false}; pg8::EpiStoreF8 E{ws + WS_Y}; \
        pg8::gemm_phase<pg8::EpiStoreF8, MoeOrder, true, true, true>(lds, g, S, E, wave); }
    PH_T0(7);
    if (IN(7)) { P7BODY if (PROBE_PHASE == 7) P7BODY }
    PH_T1(7);
    SEAM(7);
    PH_T0(8);
    if (IN(8)) { cu64* ka = karg(); unsigned char* ws = KA_WS(ka); int* rt_e = (int*)(ws + WS_RT);
        moe_tables((gu32*)(ws + WS_CTL) + CW_CNT, TB, CN, wave * 64 + fresh_lane());
        p8_final((const bf16*)(ws + WS_X1), KA_OUT(ka), (const bf16*)(ws + WS_Y), (const float*)(ws + WS_MOD), KA_IN(ka, 21), rt_e, rt_e + 2 * T, (const float*)(rt_e + 4 * T), TB, vcu, G, wave, fresh_lane());
    }
    PH_T1(8);
    if (PROF_ID != 0) { const unsigned long long t0_ = __builtin_amdgcn_s_memrealtime(); while (__builtin_amdgcn_s_memrealtime() - t0_ < prof_acc) __builtin_amdgcn_s_sleep(8); }
#undef IN
#undef SEAM
}

#ifndef MK_N_LAUNCHES
#define MK_N_LAUNCHES 1
#endif
extern "C" void kernel_launch(void* const* d_in, const int* in_sizes, int n_in, void* d_out, int out_size, void* d_ws, size_t ws_size, hipStream_t stream) {
    static int grid = 0;
    if (grid == 0) {
        if (n_in != 22 || in_sizes[0] != T * D || out_size != T * D || ws_size < WS_END) { fprintf(stderr, "kernel_launch: shape/workspace mismatch (n_in %d, in0 %d, out %d, ws %zu, need %zu)\n", n_in, n_in > 0 ? in_sizes[0] : -1, out_size, ws_size, (size_t)WS_END); grid = -1; return; }
        int dev = 0, cus = 0, per_cu = 0;
        if (hipGetDevice(&dev) != hipSuccess || hipDeviceGetAttribute(&cus, hipDeviceAttributeMultiprocessorCount, dev) != hipSuccess) { grid = -1; return; }
        if (hipFuncSetAttribute((const void*)fwd_kernel, hipFuncAttributeMaxDynamicSharedMemorySize, LDS_BYTES) != hipSuccess) { fprintf(stderr, "kernel_launch: hipFuncSetAttribute failed\n"); grid = -1; return; }
        if (hipOccupancyMaxActiveBlocksPerMultiprocessor(&per_cu, (const void*)fwd_kernel, NWAVES * 64, LDS_BYTES) != hipSuccess || per_cu < 1) fprintf(stderr, "kernel_launch: occupancy query reports %d\n", per_cu);
        (void)hipGetLastError();
        grid = cus > 0 ? cus : 256;
    }
    if (grid < 0) return;
    (void)hipMemsetAsync((char*)d_ws + WS_CTL, 0, CTL_ZERO_BYTES, stream);
    Args a{};
    for (int i = 0; i < 22; ++i) a.in[i] = (const float*)d_in[i];
    a.out = (float*)d_out; a.ws = (unsigned char*)d_ws;
    if (MK_N_LAUNCHES == 1) { a.ph_lo = 0; a.ph_hi = NPH; hipLaunchKernelGGL(fwd_kernel, dim3(grid), dim3(NWAVES * 64), LDS_BYTES, stream, a); }
    else for (int p = 0; p < NPH; ++p) { a.ph_lo = p; a.ph_hi = p + 1; hipLaunchKernelGGL(fwd_kernel, dim3(grid), dim3(NWAVES * 64), LDS_BYTES, stream, a); }
    const hipError_t le = hipPeekAtLastError();
    if (le != hipSuccess) fprintf(stderr, "kernel_launch: launch failed: %s\n", hipGetErrorName(le));
}
```

```cpp
#include <hip/hip_runtime.h>
#include <hip/hip_bf16.h>
#include <cstdio>
#include <cstdint>

__device__ __forceinline__ int fresh_lane() { int l; asm volatile("v_mbcnt_lo_u32_b32 %0, -1, 0\n\tv_mbcnt_hi_u32_b32 %0, -1, %0" : "=v"(l)); return l; }
template <int M> __device__ __forceinline__ float lx_get(float v) {
    static_assert(M == 1 || M == 2 || M == 4 || M == 8 || M == 16, "lx_get: M");
    return __builtin_bit_cast(float, __builtin_amdgcn_ds_swizzle(__builtin_bit_cast(int, v), (M << 10) | 0x1f));
}
__device__ __forceinline__ void swap32(float v, float& lo, float& hi) { const unsigned a = __float_as_uint(v);
    auto rr = __builtin_amdgcn_permlane32_swap(a, a, false, false); const unsigned r0 = rr[0], r1 = rr[1]; lo = __uint_as_float(r0); hi = __uint_as_float(r1); }
__device__ __forceinline__ float lx_sum32(float v) { float lo, hi; swap32(v, lo, hi); return lo + hi; }
__device__ __forceinline__ float lx_max32(float v) { float lo, hi; swap32(v, lo, hi); return fmaxf(lo, hi); }
#ifndef PROF_ID
#define PROF_ID 0
#endif
#define PROF_BEGIN(id) unsigned long long prof_t0_##id = 0; if (PROF_ID == (id)) prof_t0_##id = __builtin_amdgcn_s_memrealtime()
#define PROF_END(id, acc) do { if (PROF_ID == (id)) (acc) += __builtin_amdgcn_s_memrealtime() - prof_t0_##id; } while (0)
namespace pg8 {
#define PG8_LAS __attribute__((address_space(3)))
typedef unsigned short bf16_t;
typedef short bf16x8 __attribute__((ext_vector_type(8)));
typedef float f32x4 __attribute__((ext_vector_type(4)));
typedef unsigned u32x4 __attribute__((ext_vector_type(4)));
typedef unsigned u32x2 __attribute__((ext_vector_type(2)));
typedef int i32x8 __attribute__((ext_vector_type(8)));
constexpr int BM = 256, BK = 64, HALF = 128, HTB = HALF * BK * 2  , STAGE_BYTES = 8 * HTB, NXCD = 8, WGM = 8;

__host__ __device__ __forceinline__ int lds_byte(int r, int c) { const int st = (r >> 4) * 2 + (c >> 5), rr = r & 15, cc = c & 31, ob = rr * 64 + cc * 2; return st * 1024 + (ob ^ (((ob >> 9) & 1) << 5)); }
__host__ __device__ __forceinline__ void stage_rc(int b, int& R, int& C) { const int st = b / 1024, sb = b % 1024, swz = sb ^ (((sb >> 9) & 1) << 5); R = (st >> 1) * 16 + swz / 64; C = (st & 1) * 32 + (swz % 64) / 2; }
__host__ __device__ __forceinline__ int perm32(int rho) { const int n = rho >> 4, i = rho & 15; return 8 * (i >> 2) + 4 * n + (i & 3); }

struct Unit { int pm, pn, e; };
struct Gemm { const bf16_t* A; const bf16_t* Bt; int M, N, K; };

struct StaticOrder {
    int nM, nN, nwg, G, c;
    __host__ __device__ void init(int M, int N, int G_, int c_) { nM = M / BM; nN = N / BM; nwg = nM * nN; G = G_; c = c_; }
    __host__ __device__ bool next(int i, Unit& u) const {
        const long L = (long)i * G + c; if (L >= nwg) return false;
        int wgid = (int)L; { const int q = nwg / NXCD, r = nwg % NXCD, xcd = wgid % NXCD, off = wgid / NXCD; wgid = (xcd < r ? xcd * (q + 1) : r * (q + 1) + (xcd - r) * q) + off; }
        const int nig = WGM * nN, gid = wgid / nig, fm = gid * WGM, gsz = (nM - fm) < WGM ? (nM - fm) : WGM;
        u.pm = fm + ((wgid % nig) % gsz); u.pn = (wgid % nig) / gsz; u.e = 0; return true;
    }
    __device__ __forceinline__ void a_off(const Unit& u, const int (&RA)[2], const int (&CA)[2], int KB  , unsigned (&off)[2][2]) const {
#pragma unroll
        for (int h = 0; h < 2; ++h)
#pragma unroll
            for (int i = 0; i < 2; ++i) off[h][i] = (unsigned)((size_t)(u.pm * BM + h * HALF + RA[i]) * KB + CA[i] * 2);
    }
};


__device__ __forceinline__ unsigned cvt_pk_bf16(float lo, float hi) { unsigned r; asm volatile("v_cvt_pk_bf16_f32 %0, %1, %2" : "=v"(r) : "v"(lo), "v"(hi)); return r; }

struct EpiStore {
    static constexpr bool PERM = true, AFTER_DRAIN = false;
    bf16_t* O; int ldc; int pn_mask; unsigned* km;
    __device__ __forceinline__ void operator()(const f32x4 (&acc)[2][2][4][2], const Unit& u, int wr, int wc, int fr, int fq) const {
        const int row0 = u.pm * BM + wr * 64 + fr; const int col0 = (u.pn & pn_mask) * BM + wc * 32 + 8 * fq;
        if (km && (u.pn == 2 || u.pn == 3 || u.pn == 8 || u.pn == 9)) {
#pragma unroll
            for (int bj = 0; bj < 2; ++bj) { float mx = 0.f;
#pragma unroll
                for (int ai = 0; ai < 2; ++ai)
#pragma unroll
                    for (int m = 0; m < 4; ++m) { const f32x4 v0 = acc[ai][bj][m][0], v1 = acc[ai][bj][m][1];
                        float ss = (v0[0] * v0[0] + v0[1] * v0[1]) + (v0[2] * v0[2] + v0[3] * v0[3]) + (v1[0] * v1[0] + v1[1] * v1[1]) + (v1[2] * v1[2] + v1[3] * v1[3]);
                        ss += lx_get<16>(ss); ss = lx_sum32(ss); mx = fmaxf(mx, ss); }
                mx = fmaxf(mx, lx_get<1>(mx)); mx = fmaxf(mx, lx_get<2>(mx)); mx = fmaxf(mx, lx_get<4>(mx)); mx = fmaxf(mx, lx_get<8>(mx));
                if ((fr | fq) == 0) __hip_atomic_fetch_max(km + (u.pm >> 4) * 96 + (u.pn * BM + bj * HALF + wc * 32) / 32, __float_as_uint(mx), __ATOMIC_RELAXED, __HIP_MEMORY_SCOPE_AGENT); }
        }
#pragma unroll
        for (int ai = 0; ai < 2; ++ai)
#pragma unroll
            for (int m = 0; m < 4; ++m) { bf16_t* rowp = O + (size_t)(row0 + ai * HALF + m * 16) * ldc + col0;
#pragma unroll
                for (int bj = 0; bj < 2; ++bj) { const f32x4 v0 = acc[ai][bj][m][0], v1 = acc[ai][bj][m][1];
                    u32x4 w; w.x = cvt_pk_bf16(v0[0], v0[1]); w.y = cvt_pk_bf16(v0[2], v0[3]); w.z = cvt_pk_bf16(v1[0], v1[1]); w.w = cvt_pk_bf16(v1[2], v1[3]);
                    *(u32x4*)(rowp + bj * HALF) = w; } }
    }
};
struct EpiSwiglu {
    static constexpr bool PERM = true, AFTER_DRAIN = false;
    bf16_t* H;
    __device__ __forceinline__ void operator()(const f32x4 (&acc)[2][2][4][2], const Unit& u, int wr, int wc, int fr, int fq) const {
        const int row0 = u.pm * BM + wr * 64 + fr; const int col0 = (u.pn & 3) * 128 + wc * 32 + 8 * fq;
#pragma unroll
        for (int ai = 0; ai < 2; ++ai)
#pragma unroll
            for (int m = 0; m < 4; ++m) { bf16_t* rowp = H + (size_t)(row0 + ai * HALF + m * 16) * 512 + col0;
                float hv[8];
#pragma unroll
                for (int n = 0; n < 2; ++n)
#pragma unroll
                    for (int i = 0; i < 4; ++i) { const float g = acc[ai][0][m][n][i], up = acc[ai][1][m][n][i];
                        const float e = __builtin_amdgcn_exp2f(-g * 1.4426950408889634f);
                        hv[n * 4 + i] = g * __builtin_amdgcn_rcpf(1.0f + e) * up; }
                u32x4 w; w.x = cvt_pk_bf16(hv[0], hv[1]); w.y = cvt_pk_bf16(hv[2], hv[3]); w.z = cvt_pk_bf16(hv[4], hv[5]); w.w = cvt_pk_bf16(hv[6], hv[7]);
                *(u32x4*)rowp = w; }
    }
};
struct EpiStoreF8 {
    static constexpr bool PERM = true, AFTER_DRAIN = false;
    unsigned char* Y8;
    __device__ __forceinline__ void operator()(const f32x4 (&acc)[2][2][4][2], const Unit& u, int wr, int wc, int fr, int fq) const {
        const int row0 = u.pm * BM + wr * 64 + fr; const int col0 = (u.pn & 3) * BM + wc * 32 + 8 * fq;
#pragma unroll
        for (int ai = 0; ai < 2; ++ai)
#pragma unroll
            for (int m = 0; m < 4; ++m) { unsigned char* rowp = Y8 + (size_t)(row0 + ai * HALF + m * 16) * 1024 + col0;
#pragma unroll
                for (int bj = 0; bj < 2; ++bj) { const f32x4 v0 = acc[ai][bj][m][0] * 8.0f, v1 = acc[ai][bj][m][1] * 8.0f;
                    int t0 = 0, t1 = 0;
                    t0 = __builtin_amdgcn_cvt_pk_fp8_f32(v0[0], v0[1], t0, false); t0 = __builtin_amdgcn_cvt_pk_fp8_f32(v0[2], v0[3], t0, true);
                    t1 = __builtin_amdgcn_cvt_pk_fp8_f32(v1[0], v1[1], t1, false); t1 = __builtin_amdgcn_cvt_pk_fp8_f32(v1[2], v1[3], t1, true);
                    u32x2 w; w.x = (unsigned)t0; w.y = (unsigned)t1; *(u32x2*)(rowp + bj * HALF) = w; } }
    }
};
struct EpiSwigluF8 {
    static constexpr bool PERM = true, AFTER_DRAIN = false;
    unsigned char* H8;
    __device__ __forceinline__ void operator()(const f32x4 (&acc)[2][2][4][2], const Unit& u, int wr, int wc, int fr, int fq) const {
        const int row0 = u.pm * BM + wr * 64 + fr; const int col0 = (u.pn & 3) * 128 + wc * 32 + 8 * fq;
#pragma unroll
        for (int ai = 0; ai < 2; ++ai)
#pragma unroll
            for (int m = 0; m < 4; ++m) { unsigned char* rowp = H8 + (size_t)(row0 + ai * HALF + m * 16) * 512 + col0;
                float hv[8];
#pragma unroll
                for (int n = 0; n < 2; ++n)
#pragma unroll
                    for (int i = 0; i < 4; ++i) { const float g = acc[ai][0][m][n][i], up = acc[ai][1][m][n][i];
                        const float e = __builtin_amdgcn_exp2f(-g * 1.4426950408889634f);
                        hv[n * 4 + i] = g * __builtin_amdgcn_rcpf(1.0f + e) * up; }
                u32x2 w; int t0 = 0, t1 = 0;
                t0 = __builtin_amdgcn_cvt_pk_fp8_f32(hv[0], hv[1], t0, false); t0 = __builtin_amdgcn_cvt_pk_fp8_f32(hv[2], hv[3], t0, true);
                t1 = __builtin_amdgcn_cvt_pk_fp8_f32(hv[4], hv[5], t1, false); t1 = __builtin_amdgcn_cvt_pk_fp8_f32(hv[6], hv[7], t1, true);
                w.x = (unsigned)t0; w.y = (unsigned)t1; *(u32x2*)rowp = w; }
    }
};
struct EpiResid {
    static constexpr bool PERM = true, AFTER_DRAIN = false;
    const float* base; bf16_t* out; const float* gate;
    __device__ __forceinline__ void operator()(const f32x4 (&acc)[2][2][4][2], const Unit& u, int wr, int wc, int fr, int fq) const {
        const int col0 = u.pn * BM + wc * 32 + 8 * fq; const float* gp = gate + (size_t)(u.pm >> 4) * 6144 + col0;
        f32x4 gv[2][2];
#pragma unroll
        for (int bj = 0; bj < 2; ++bj)
#pragma unroll
            for (int n = 0; n < 2; ++n) gv[bj][n] = *(const f32x4*)(gp + bj * HALF + n * 4);
#pragma unroll
        for (int ai = 0; ai < 2; ++ai)
#pragma unroll
            for (int m = 0; m < 4; ++m) { const size_t off = (size_t)(u.pm * BM + ai * HALF + wr * 64 + m * 16 + fr) * 1024 + col0;
#pragma unroll
                for (int bj = 0; bj < 2; ++bj) { const f32x4 b0 = *(const f32x4*)(base + off + bj * HALF), b1 = *(const f32x4*)(base + off + bj * HALF + 4);
                    const f32x4 v0 = b0 + gv[bj][0] * acc[ai][bj][m][0], v1 = b1 + gv[bj][1] * acc[ai][bj][m][1];
                    u32x4 w; w.x = cvt_pk_bf16(v0[0], v0[1]); w.y = cvt_pk_bf16(v0[2], v0[3]); w.z = cvt_pk_bf16(v1[0], v1[1]); w.w = cvt_pk_bf16(v1[2], v1[3]);
                    *(u32x4*)(out + off + bj * HALF) = w; } }
    }
};

template <class Epi, class Sched, bool ALIGN_EPI = false, bool SP2 = false, bool F8 = false>
__device__ __forceinline__ void gemm_phase(PG8_LAS unsigned char* lds, const Gemm g, const Sched& S, const Epi& E, int wave) {
    const int wid = wave, lane = fresh_lane(), tid = wid * 64 + lane, wr = wid >> 2, wc = wid & 3, fr = lane & 15, fq = lane >> 4;
    const int K = g.K, KB = F8 ? K : 2 * K  ; int nt = KB / (BK * 2); asm volatile("" : "+s"(nt));
    int RA[2], CA[2]; unsigned voffB[2];
#pragma unroll
    for (int i = 0; i < 2; ++i) { int R, C; stage_rc(tid * 16 + i * 8192, R, C); const int Rb = Epi::PERM ? ((R & ~31) + perm32(R & 31)) : R;
        RA[i] = R; CA[i] = C; voffB[i] = (unsigned)(Rb * KB + C * 2); }
    const size_t kstep = (size_t)(BK * 2);
    const size_t hstep = (size_t)HALF * KB;
    const size_t tstep = 2 * hstep;
    const unsigned ldsw = (unsigned)wid * 1024u;
    const int aoff = lds_byte(wr * 64 + fr, fq * 8), boff = lds_byte(wc * 32 + fr, fq * 8);
    const int aoffLo = lds_byte(wr * 64 + fr, fq * 16), boffLo = lds_byte(wc * 32 + fr, fq * 16);
#define PG8_SA(b, h) (((b) * 2 + (h)) * HTB)
#define PG8_SB(b, h) ((4 + (b) * 2 + (h)) * HTB)
#define PG8_STAGE(bufoff, gbase, voff) do { _Pragma("unroll") for (int _i = 0; _i < 2; ++_i) \
        __builtin_amdgcn_global_load_lds((const unsigned*)((const char*)(gbase) + (voff)[_i]), (PG8_LAS unsigned*)(lds + (bufoff) + ldsw + _i * 8192), 16, 0, 0); } while (0)
#define PG8_LDA(dst, b, h) do { if constexpr (F8) { _Pragma("unroll") for (int m = 0; m < 4; ++m) { const u32x4 lo_ = *(const PG8_LAS u32x4*)(lds + PG8_SA(b, h) + aoffLo + m * 2048), hi_ = *(const PG8_LAS u32x4*)(lds + PG8_SA(b, h) + aoffLo + 16 + m * 2048); \
            dst##8[m] = (i32x8){(int)lo_.x, (int)lo_.y, (int)lo_.z, (int)lo_.w, (int)hi_.x, (int)hi_.y, (int)hi_.z, (int)hi_.w}; } } \
        else { _Pragma("unroll") for (int m = 0; m < 4; ++m) _Pragma("unroll") for (int k = 0; k < 2; ++k) dst[m][k] = *(const PG8_LAS bf16x8*)(lds + PG8_SA(b, h) + aoff + m * 2048 + k * 1024); } } while (0)
#define PG8_LDB(dst, b, h) do { if constexpr (F8) { _Pragma("unroll") for (int n = 0; n < 2; ++n) { const u32x4 lo_ = *(const PG8_LAS u32x4*)(lds + PG8_SB(b, h) + boffLo + n * 2048), hi_ = *(const PG8_LAS u32x4*)(lds + PG8_SB(b, h) + boffLo + 16 + n * 2048); \
            dst##8[n] = (i32x8){(int)lo_.x, (int)lo_.y, (int)lo_.z, (int)lo_.w, (int)hi_.x, (int)hi_.y, (int)hi_.z, (int)hi_.w}; } } \
        else { _Pragma("unroll") for (int n = 0; n < 2; ++n) _Pragma("unroll") for (int k = 0; k < 2; ++k) dst[n][k] = *(const PG8_LAS bf16x8*)(lds + PG8_SB(b, h) + boff + n * 2048 + k * 1024); } } while (0)
#define PG8_MMA(ai, bj, At, Bt) do { __builtin_amdgcn_s_setprio(1); if constexpr (F8) { _Pragma("unroll") for (int m = 0; m < 4; ++m) _Pragma("unroll") for (int n = 0; n < 2; ++n) \
            acc[ai][bj][m][n] = __builtin_amdgcn_mfma_scale_f32_16x16x128_f8f6f4(Bt##8[n], At##8[m], acc[ai][bj][m][n], 0, 0, 0, 0x7A7A7A7A  , 0, 0x7F7F7F7F  ); } \
        else { _Pragma("unroll") for (int m = 0; m < 4; ++m) _Pragma("unroll") for (int n = 0; n < 2; ++n) _Pragma("unroll") for (int k = 0; k < 2; ++k) \
            acc[ai][bj][m][n] = __builtin_amdgcn_mfma_f32_16x16x32_bf16(Bt[n][k], At[m][k], acc[ai][bj][m][n], 0, 0, 0); } __builtin_amdgcn_s_setprio(0); } while (0)
#define PG8_WAIT_V(n) asm volatile("s_waitcnt vmcnt(" #n ")" ::: "memory")
#define PG8_WAIT_L(n) asm volatile("s_waitcnt lgkmcnt(" #n ")" ::: "memory")
#define PG8_BAR __builtin_amdgcn_s_barrier()
#define PG8_SCHED __builtin_amdgcn_sched_barrier(0)
    Unit cur, nxt; int ui = 0;
    if (!S.next(0, cur)) return;
    f32x4 acc[2][2][4][2];
#pragma unroll
    for (int a = 0; a < 2; ++a)
#pragma unroll
        for (int b = 0; b < 2; ++b)
#pragma unroll
            for (int m = 0; m < 4; ++m)
#pragma unroll
                for (int n = 0; n < 2; ++n) acc[a][b][m][n] = (f32x4){0.f, 0.f, 0.f, 0.f};
    bf16x8 At[4][2], B0[2][2], B1[2][2]; i32x8 At8[4], B08[2], B18[2];
    unsigned oc[2][2], on[2][2];
    S.a_off(cur, RA, CA, KB, oc);
    const char* A0 = (const char*)g.A;
    const char* cB = (const char*)g.Bt + (size_t)cur.pn * tstep;
    if constexpr (SP2) {
        PG8_STAGE(PG8_SB(0, 0), cB, voffB); PG8_STAGE(PG8_SB(0, 1), cB + hstep, voffB); PG8_STAGE(PG8_SA(0, 0), A0, oc[0]); PG8_STAGE(PG8_SA(0, 1), A0, oc[1]);
        if (wr == 1) PG8_BAR;
        PG8_WAIT_V(2); PG8_BAR;
        PG8_STAGE(PG8_SB(1, 0), cB + kstep, voffB); PG8_STAGE(PG8_SA(1, 0), A0 + kstep, oc[0]); PG8_STAGE(PG8_SB(1, 1), cB + hstep + kstep, voffB);
        PG8_WAIT_V(6); PG8_BAR;
    } else {
        PG8_STAGE(PG8_SB(0, 0), cB, voffB); PG8_STAGE(PG8_SA(0, 0), A0, oc[0]); PG8_STAGE(PG8_SB(0, 1), cB + hstep, voffB); PG8_STAGE(PG8_SA(0, 1), A0, oc[1]);
        if (wr == 1) PG8_BAR;
        PG8_WAIT_V(4); PG8_BAR;
        PG8_STAGE(PG8_SB(1, 0), cB + kstep, voffB); PG8_STAGE(PG8_SA(1, 0), A0 + kstep, oc[0]); PG8_STAGE(PG8_SB(1, 1), cB + hstep + kstep, voffB);
        PG8_WAIT_V(6); PG8_BAR;
    }
    for (;;) {
        const bool has_next = S.next(ui + 1, nxt);
        if (has_next) S.a_off(nxt, RA, CA, KB, on);
        else {
#pragma unroll
            for (int h = 0; h < 2; ++h)
#pragma unroll
                for (int i = 0; i < 2; ++i) on[h][i] = oc[h][i]; }
        const char* nB = has_next ? (const char*)g.Bt + (size_t)nxt.pn * tstep : cB;
        for (int t = 0; t < nt; t += 2) {
            const bool last = (t == nt - 2);
            const char* a1 = A0 + (size_t)(t + 1) * kstep;
            const char* a2 = last ? A0 : A0 + (size_t)(t + 2) * kstep; const char* b2 = last ? nB : cB + (size_t)(t + 2) * kstep;
            const char* a3 = a2 + kstep; const char* b3 = b2 + kstep;
            if constexpr (SP2) {
            PG8_LDB(B0, 0, 0); PG8_LDB(B1, 0, 1); PG8_SCHED; PG8_LDA(At, 0, 0); PG8_STAGE(PG8_SA(1, 1), a1, oc[1]); if (last) { _Pragma("unroll") for (int h_ = 0; h_ < 2; ++h_) _Pragma("unroll") for (int i_ = 0; i_ < 2; ++i_) oc[h_][i_] = on[h_][i_]; }
            PG8_WAIT_V(8); PG8_WAIT_L(0); PG8_BAR; PG8_MMA(0, 0, At, B0); PG8_MMA(0, 1, At, B1); PG8_BAR; PG8_SCHED;
            PG8_LDA(At, 0, 1); PG8_STAGE(PG8_SB(0, 0), b2, voffB); PG8_STAGE(PG8_SB(0, 1), b2 + hstep, voffB); PG8_STAGE(PG8_SA(0, 0), a2, oc[0]);
            PG8_WAIT_V(8); PG8_WAIT_L(0); PG8_BAR; PG8_MMA(1, 0, At, B0); PG8_MMA(1, 1, At, B1); PG8_BAR; PG8_SCHED;
            PG8_LDB(B0, 1, 0); PG8_LDB(B1, 1, 1); PG8_SCHED; PG8_LDA(At, 1, 0); PG8_STAGE(PG8_SA(0, 1), a2, oc[1]);
            PG8_WAIT_V(8); PG8_WAIT_L(0); PG8_BAR; PG8_MMA(0, 0, At, B0); PG8_MMA(0, 1, At, B1); PG8_BAR; PG8_SCHED;
            PG8_LDA(At, 1, 1); PG8_STAGE(PG8_SB(1, 0), b3, voffB); PG8_STAGE(PG8_SB(1, 1), b3 + hstep, voffB); PG8_STAGE(PG8_SA(1, 0), a3, oc[0]);
            PG8_WAIT_V(8); PG8_WAIT_L(0); PG8_BAR; PG8_MMA(1, 0, At, B0); PG8_MMA(1, 1, At, B1); PG8_BAR; PG8_SCHED;
            } else {
            PG8_LDB(B0, 0, 0); PG8_SCHED; PG8_LDA(At, 0, 0); PG8_STAGE(PG8_SA(1, 1), a1, oc[1]); if (last) { _Pragma("unroll") for (int h_ = 0; h_ < 2; ++h_) _Pragma("unroll") for (int i_ = 0; i_ < 2; ++i_) oc[h_][i_] = on[h_][i_]; }
            PG8_WAIT_L(8); PG8_BAR; PG8_WAIT_L(0); PG8_MMA(0, 0, At, B0); PG8_BAR; PG8_SCHED;
            PG8_LDB(B1, 0, 1); PG8_STAGE(PG8_SB(0, 0), b2, voffB);
            PG8_BAR; PG8_WAIT_L(0); PG8_MMA(0, 1, At, B1); PG8_BAR;
            PG8_LDA(At, 0, 1); PG8_STAGE(PG8_SA(0, 0), a2, oc[0]);
            PG8_BAR; PG8_WAIT_L(0); PG8_MMA(1, 0, At, B0); PG8_BAR; PG8_SCHED;
            PG8_STAGE(PG8_SB(0, 1), b2 + hstep, voffB);
            PG8_WAIT_V(6); PG8_BAR; PG8_MMA(1, 1, At, B1); PG8_BAR;
            PG8_LDB(B0, 1, 0); PG8_SCHED; PG8_LDA(At, 1, 0); PG8_STAGE(PG8_SA(0, 1), a2, oc[1]);
            PG8_WAIT_L(8); PG8_BAR; PG8_WAIT_L(0); PG8_MMA(0, 0, At, B0); PG8_BAR; PG8_SCHED;
            PG8_LDB(B1, 1, 1); PG8_STAGE(PG8_SB(1, 0), b3, voffB);
            PG8_BAR; PG8_WAIT_L(0); PG8_MMA(0, 1, At, B1); PG8_BAR;
            PG8_LDA(At, 1, 1); PG8_STAGE(PG8_SA(1, 0), a3, oc[0]);
            PG8_BAR; PG8_WAIT_L(0); PG8_MMA(1, 0, At, B0); PG8_BAR; PG8_SCHED;
            PG8_STAGE(PG8_SB(1, 1), b3 + hstep, voffB);
            PG8_WAIT_V(6); PG8_BAR; PG8_MMA(1, 1, At, B1); PG8_BAR;
            }
        }
        if constexpr (ALIGN_EPI) { if (wr == 0) PG8_BAR; }
        if constexpr (!Epi::AFTER_DRAIN) { E(acc, cur, wr, wc, fr, fq); }
        if (!has_next) break;
#pragma unroll
        for (int a = 0; a < 2; ++a)
#pragma unroll
            for (int b = 0; b < 2; ++b)
#pragma unroll
                for (int m = 0; m < 4; ++m)
#pragma unroll
                    for (int n = 0; n < 2; ++n) acc[a][b][m][n] = (f32x4){0.f, 0.f, 0.f, 0.f};
        cur = nxt; cB = nB; ++ui;
        if constexpr (ALIGN_EPI) { if (wr == 1) PG8_BAR; }
    }
    PG8_WAIT_V(0);
    if constexpr (!ALIGN_EPI) { if (wr == 0) PG8_BAR; }
    PG8_BAR;
#undef PG8_SA
#undef PG8_SB
#undef PG8_STAGE
#undef PG8_LDA
#undef PG8_LDB
#undef PG8_MMA
#undef PG8_WAIT_V
#undef PG8_WAIT_L
#undef PG8_BAR
#undef PG8_SCHED
}
}

namespace att {
#define ATT_LAS __attribute__((address_space(3)))
typedef unsigned short bf16_t;
using bf16x8 = __attribute__((ext_vector_type(8))) short;
using s16x4  = __attribute__((ext_vector_type(4))) short;
using f32x16 = __attribute__((ext_vector_type(16))) float;
using f32x4  = __attribute__((ext_vector_type(4))) float;
using u32x4  = __attribute__((ext_vector_type(4))) unsigned;
using u32x2  = __attribute__((ext_vector_type(2))) unsigned;
constexpr int SEQ = 4096, LDQKV = 3072, LDATT = 1024;
constexpr float LOG2E = 1.4426950408889634f;
#define ATT_SBAR() __builtin_amdgcn_sched_barrier(0)
__device__ __forceinline__ int opaque(int v) { asm volatile("" : "+v"(v)); return v; }
__device__ __forceinline__ void dma16(const void* g, ATT_LAS unsigned char* l) { __builtin_amdgcn_global_load_lds((const unsigned*)g, (ATT_LAS unsigned*)l, 16, 0, 0); }
__device__ __forceinline__ int swap23(int k) { return (k & ~0xC) | ((k & 4) << 1) | ((k & 8) >> 1); }
__device__ __forceinline__ int crow(int r, int hi) { return (r & 3) + 8 * (r >> 2) + 4 * hi; }
__device__ __forceinline__ unsigned cvtpk(float lo, float hi) { unsigned r; asm volatile("v_cvt_pk_bf16_f32 %0, %1, %2" : "=v"(r) : "v"(lo), "v"(hi)); return r; }
__device__ __forceinline__ int ksw(int row, int c) { return row * 128 + ((c ^ ((row >> 1) & 7)) << 4); }
template <int NC> __device__ __forceinline__ int v_st(int k, int c) { const int kk = (k & ~0xC) | ((k & 4) << 1) | ((k & 8) >> 1); return ((kk >> 3) * NC + (c >> 5)) * 512 + ((kk & 7) * 32 + (c & 31)) * 2; }
__device__ __forceinline__ int v_rd_base(int lane) { return ((lane & 3) << 3) | (((lane >> 2) & 3) << 6) | (((lane >> 4) & 1) << 5) | (((lane >> 5) & 1) << 8); }
template <int NC> constexpr int v_rd_off(int d0, int ks, int half) { return d0 * 512 + ks * (2 * NC * 512) + half * (NC * 512); }
template <int OFF> __device__ __forceinline__ s16x4 tr_read(int vb) {
  s16x4 r; asm volatile("ds_read_b64_tr_b16 %0, %1 offset:%2" : "=&v"(r) : "v"(vb), "i"(OFF) : "memory"); return r;
}
#define ATT_TR8(S, D0_) do { \
    S[0] = tr_read<v_rd_off<NC>(D0_, 0, 0)>(vb); S[1] = tr_read<v_rd_off<NC>(D0_, 0, 1)>(vb); S[2] = tr_read<v_rd_off<NC>(D0_, 1, 0)>(vb); S[3] = tr_read<v_rd_off<NC>(D0_, 1, 1)>(vb); \
    S[4] = tr_read<v_rd_off<NC>(D0_, 2, 0)>(vb); S[5] = tr_read<v_rd_off<NC>(D0_, 2, 1)>(vb); S[6] = tr_read<v_rd_off<NC>(D0_, 3, 0)>(vb); S[7] = tr_read<v_rd_off<NC>(D0_, 3, 1)>(vb); } while (0)
#define ATT_PK(L, H) (bf16x8){L[0], L[1], L[2], L[3], H[0], H[1], H[2], H[3]}
#define ATT_MM4(OD, S) do { \
    OD = __builtin_amdgcn_mfma_f32_32x32x16_bf16(pa0, ATT_PK(S[0], S[1]), OD, 0, 0, 0); OD = __builtin_amdgcn_mfma_f32_32x32x16_bf16(pa1, ATT_PK(S[2], S[3]), OD, 0, 0, 0); \
    OD = __builtin_amdgcn_mfma_f32_32x32x16_bf16(pa2, ATT_PK(S[4], S[5]), OD, 0, 0, 0); OD = __builtin_amdgcn_mfma_f32_32x32x16_bf16(pa3, ATT_PK(S[6], S[7]), OD, 0, 0, 0); } while (0)
template <int NC> __device__ __forceinline__ void pv_all(f32x16 (&o)[NC], int vb, bf16x8 pa0, bf16x8 pa1, bf16x8 pa2, bf16x8 pa3) {
  s16x4 A[8], B[8];
  ATT_TR8(A, 0);
  if constexpr (NC == 2) {
    ATT_TR8(B, 1); asm volatile("s_waitcnt lgkmcnt(8)" ::: "memory"); ATT_SBAR(); ATT_MM4(o[0], A);
    asm volatile("s_waitcnt lgkmcnt(0)" ::: "memory"); ATT_SBAR(); ATT_MM4(o[1], B);
  } else {
    ATT_TR8(B, 1); asm volatile("s_waitcnt lgkmcnt(8)" ::: "memory"); ATT_SBAR(); ATT_MM4(o[0], A);
    ATT_SBAR(); ATT_TR8(A, 2); asm volatile("s_waitcnt lgkmcnt(8)" ::: "memory"); ATT_SBAR(); ATT_MM4(o[1], B);
    ATT_SBAR(); ATT_TR8(B, 3); asm volatile("s_waitcnt lgkmcnt(8)" ::: "memory"); ATT_SBAR(); ATT_MM4(o[2], A);
    asm volatile("s_waitcnt lgkmcnt(0)" ::: "memory"); ATT_SBAR(); ATT_MM4(o[3], B);
  }
}
#undef ATT_TR8
#undef ATT_PK
#undef ATT_MM4
__device__ __forceinline__ void qkt_bias(f32x16& p0, f32x16& p1, const ATT_LAS float* BT, const ATT_LAS unsigned char* Ks, const bf16x8 (&qr)[4], int r32, int hi, bf16x8 augA, bf16x8 augB) {
#pragma unroll
  for (int g = 0; g < 4; ++g) { const f32x4 b0 = *(const ATT_LAS f32x4*)(BT + 8 * g + 4 * hi), b1 = *(const ATT_LAS f32x4*)(BT + 32 + 8 * g + 4 * hi);
#pragma unroll
    for (int i = 0; i < 4; ++i) { p0[4 * g + i] = b0[i]; p1[4 * g + i] = b1[i]; } }
#pragma unroll
  for (int d0 = 0; d0 < 4; ++d0) {
    const bf16x8 b0 = *(const ATT_LAS bf16x8*)(Ks + ksw(r32, 2 * d0 + hi));
    const bf16x8 b1 = *(const ATT_LAS bf16x8*)(Ks + ksw(32 + r32, 2 * d0 + hi));
    p0 = __builtin_amdgcn_mfma_f32_32x32x16_bf16(b0, qr[d0], p0, 0, 0, 0);
    p1 = __builtin_amdgcn_mfma_f32_32x32x16_bf16(b1, qr[d0], p1, 0, 0, 0);
    if (d0 == 1) ATT_SBAR(); }
  p0 = __builtin_amdgcn_mfma_f32_32x32x16_bf16(augA, augB, p0, 0, 0, 0);
  p1 = __builtin_amdgcn_mfma_f32_32x32x16_bf16(augA, augB, p1, 0, 0, 0);
}

constexpr float SKIP_T = 40.0f;
__device__ __forceinline__ float q_norm(const bf16x8 (&qr)[4]) {
  float s = 0.f;
#pragma unroll
  for (int d0 = 0; d0 < 4; ++d0)
#pragma unroll
    for (int e = 0; e < 8; ++e) { const float v = __uint_as_float(((unsigned)(unsigned short)qr[d0][e]) << 16); s = fmaf(v, v, s); }
  return sqrtf(lx_sum32(s));
}
__device__ __forceinline__ float k_max(const unsigned* km, int g) {
  const float a = __uint_as_float(__hip_atomic_load(km + g, __ATOMIC_RELAXED, __HIP_MEMORY_SCOPE_AGENT)), b = __uint_as_float(__hip_atomic_load(km + g + 1, __ATOMIC_RELAXED, __HIP_MEMORY_SCOPE_AGENT));
  return sqrtf(a + b) * 1.005f;
}
__device__ __forceinline__ bool all_done(const ATT_LAS int* DONE, int i) {
  const ATT_LAS u32x4* d = (const ATT_LAS u32x4*)DONE; const u32x4 a = d[0], b = d[1];
  const unsigned m = max(max(max(a.x, a.y), max(a.z, a.w)), max(max(b.x, b.y), max(b.z, b.w)));
  return __builtin_amdgcn_readfirstlane((int)(m < (unsigned)i)) != 0;
}
__device__ __forceinline__ void qkt_bias_q(f32x16& p0, f32x16& p1, const ATT_LAS float* BT, const ATT_LAS unsigned char* Ks, const ATT_LAS unsigned char* Qs, int qrow, int r32, int hi, bf16x8 augA, bf16x8 augB) {
#pragma unroll
  for (int g = 0; g < 4; ++g) { const f32x4 b0 = *(const ATT_LAS f32x4*)(BT + 8 * g + 4 * hi), b1 = *(const ATT_LAS f32x4*)(BT + 32 + 8 * g + 4 * hi);
#pragma unroll
    for (int i = 0; i < 4; ++i) { p0[4 * g + i] = b0[i]; p1[4 * g + i] = b1[i]; } }
#pragma unroll
  for (int d0 = 0; d0 < 4; ++d0) {
    const bf16x8 b0 = *(const ATT_LAS bf16x8*)(Ks + ksw(r32, 2 * d0 + hi));
    const bf16x8 b1 = *(const ATT_LAS bf16x8*)(Ks + ksw(32 + r32, 2 * d0 + hi));
    const bf16x8 q = *(const ATT_LAS bf16x8*)(Qs + ksw(qrow, 2 * d0 + hi));
    p0 = __builtin_amdgcn_mfma_f32_32x32x16_bf16(b0, q, p0, 0, 0, 0);
    p1 = __builtin_amdgcn_mfma_f32_32x32x16_bf16(b1, q, p1, 0, 0, 0);
    if (d0 == 1) ATT_SBAR(); }
  p0 = __builtin_amdgcn_mfma_f32_32x32x16_bf16(augA, augB, p0, 0, 0, 0);
  p1 = __builtin_amdgcn_mfma_f32_32x32x16_bf16(augA, augB, p1, 0, 0, 0);
}

__device__ __forceinline__ bf16x8 aug_a(int hi) { const u32x4 v = {hi ? 0u : 0x3F803F80u, hi ? 0u : 0x00003F80u, 0u, 0u}; return __builtin_bit_cast(bf16x8, v); }
__device__ __forceinline__ bf16x8 aug_b(float w, int hi) {
  const unsigned h = cvtpk(w, 0.f) & 0xffffu; const float d1 = w - __uint_as_float(h << 16);
  const unsigned m = cvtpk(d1, 0.f) & 0xffffu; const float d2 = d1 - __uint_as_float(m << 16);
  const unsigned l = cvtpk(d2, 0.f) & 0xffffu;
  const u32x4 v = {hi ? 0u : (h | (m << 16)), hi ? 0u : l, 0u, 0u}; return __builtin_bit_cast(bf16x8, v);
}
__device__ __forceinline__ void sm_direct(f32x16& p0, f32x16& p1, float& l_part, bf16x8& pa0, bf16x8& pa1, bf16x8& pa2, bf16x8& pa3) {
#pragma unroll
  for (int r = 0; r < 16; ++r) { p0[r] = __builtin_amdgcn_exp2f(p0[r]); p1[r] = __builtin_amdgcn_exp2f(p1[r]); }
  float ps = 0.f;
#pragma unroll
  for (int r = 0; r < 16; ++r) ps += p0[r];
#pragma unroll
  for (int r = 0; r < 16; ++r) ps += p1[r];
  l_part += ps;
#define ATT_PK4(P, BASE, OUT) do { unsigned a0 = cvtpk(P[BASE + 0], P[BASE + 1]), a1 = cvtpk(P[BASE + 2], P[BASE + 3]);   \
    unsigned b0 = cvtpk(P[BASE + 4], P[BASE + 5]), b1 = cvtpk(P[BASE + 6], P[BASE + 7]);                              \
    auto r0 = __builtin_amdgcn_permlane32_swap(a0, b0, false, false); auto r1 = __builtin_amdgcn_permlane32_swap(a1, b1, false, false); \
    u32x4 w = {r0[0], r1[0], r0[1], r1[1]}; OUT = __builtin_bit_cast(bf16x8, w); } while (0)
  ATT_PK4(p0, 0, pa0); ATT_PK4(p0, 8, pa1); ATT_PK4(p1, 0, pa2); ATT_PK4(p1, 8, pa3);
#undef ATT_PK4
}
__device__ __forceinline__ bf16x8 aug_a_alibi(int koff, int hi) { const unsigned kb = __float_as_uint((float)koff) >> 16;
  const u32x4 v = {hi ? 0u : 0x3F803F80u, hi ? 0u : (0x3F80u | (kb << 16)), hi ? 0u : kb, 0u}; return __builtin_bit_cast(bf16x8, v); }
__device__ __forceinline__ bf16x8 aug_b_alibi(float w, unsigned s_hi, unsigned s_lo, int hi) {
  const unsigned h = cvtpk(w, 0.f) & 0xffffu; const float d1 = w - __uint_as_float(h << 16);
  const unsigned m = cvtpk(d1, 0.f) & 0xffffu; const float d2 = d1 - __uint_as_float(m << 16);
  const unsigned l = cvtpk(d2, 0.f) & 0xffffu;
  const u32x4 v = {hi ? 0u : (h | (m << 16)), hi ? 0u : (l | (s_hi << 16)), hi ? 0u : s_lo, 0u}; return __builtin_bit_cast(bf16x8, v);
}
__device__ __forceinline__ void qkt_aug_q(f32x16& p0, f32x16& p1, const ATT_LAS unsigned char* Ks, const ATT_LAS unsigned char* Qs, int qrow, int r32, int hi, bf16x8 augA0, bf16x8 augA1, bf16x8 augB) {
  p0 = f32x16{}; p1 = f32x16{};
#pragma unroll
  for (int d0 = 0; d0 < 4; ++d0) {
    const bf16x8 b0 = *(const ATT_LAS bf16x8*)(Ks + ksw(r32, 2 * d0 + hi));
    const bf16x8 b1 = *(const ATT_LAS bf16x8*)(Ks + ksw(32 + r32, 2 * d0 + hi));
    const bf16x8 q = *(const ATT_LAS bf16x8*)(Qs + ksw(qrow, 2 * d0 + hi));
    p0 = __builtin_amdgcn_mfma_f32_32x32x16_bf16(b0, q, p0, 0, 0, 0);
    p1 = __builtin_amdgcn_mfma_f32_32x32x16_bf16(b1, q, p1, 0, 0, 0);
    if (d0 == 1) ATT_SBAR(); }
  p0 = __builtin_amdgcn_mfma_f32_32x32x16_bf16(augA0, augB, p0, 0, 0, 0);
  p1 = __builtin_amdgcn_mfma_f32_32x32x16_bf16(augA1, augB, p1, 0, 0, 0);
}
#define ATT_WAIT_BAR(N) asm volatile("s_waitcnt vmcnt(" #N ") lgkmcnt(0)\n\ts_barrier" ::: "memory")

__device__ __forceinline__ void fox_unit(ATT_LAS unsigned char* lds, const bf16_t* __restrict__ qkv, bf16_t* __restrict__ attn, const float* __restrict__ cl2, const float* __restrict__ blk2, const unsigned* km,
                                         int b, int h, int qb, int wave, unsigned long long& pacc) {
  PROF_BEGIN(11);
  const int wid = wave, lane = fresh_lane(), tid = wid * 64 + lane, r32 = lane & 31, hi = lane >> 5;
  ATT_LAS float* CARRY = (ATT_LAS float*)(lds + 63488); ATT_LAS float* wsf = (ATT_LAS float*)(lds + 63744) + wid * 64;
  ATT_LAS unsigned char* BW = lds + 57344 + wid * 768; ATT_LAS int* DONE = (ATT_LAS int*)(lds + 65792);
  if (lane == 0) DONE[wid] = 0x7fffffff;
  const int q0 = qb * 256, NT = 4 * (qb + 1), jl = 4 * qb + (wid >> 1);
  const size_t rowb = (size_t)b * SEQ; const int bh = b * 8 + h;
  if (wid == 0) { float v = lane < 32 ? blk2[(b * 32 + lane) * 8 + h] : 0.f; float s = v;
#pragma unroll
    for (int o = 1; o < 32; o <<= 1) { const float t = __builtin_bit_cast(float, __builtin_amdgcn_ds_bpermute(((lane - o) & 63) << 2, __builtin_bit_cast(int, s))); if (lane >= o) s += t; }
    if (lane < 32) CARRY[lane] = s - v; }
  __syncthreads();
  const float cq = CARRY[q0 >> 7] + cl2[(size_t)bh * SEQ + q0];
  bf16x8 qr[4];
  { const bf16_t* Qw = qkv + (rowb + q0 + wid * 32 + r32) * LDQKV + h * 64 + hi * 8;
#pragma unroll
    for (int d0 = 0; d0 < 4; ++d0) qr[d0] = *(const bf16x8*)(Qw + d0 * 16); }
  const int pk = 64 * wid + lane;
  unsigned koff, voff;
  { const int row = pk >> 3, c = (pk & 7) ^ ((row >> 1) & 7); koff = (unsigned)((row * LDQKV + 512 + h * 64 + c * 8) * 2);
    const int sub = pk >> 5, kk = 8 * (sub >> 1) + ((pk & 31) >> 2), k = swap23(kk), cv = (sub & 1) * 32 + (pk & 3) * 8; voff = (unsigned)((k * LDQKV + 1024 + h * 64 + cv) * 2); }
  const char* tb = (const char*)(qkv + rowb * LDQKV);
  const char* cg = (const char*)(cl2 + (size_t)bh * SEQ) + (lane & 15) * 16;
  const int vb0 = (int)(uintptr_t)(lds + 24576) + v_rd_base(lane);
#define FOX_LOAD(j, bo, vbo) do { const char* tj = tb + (size_t)(j) * (64 * LDQKV * 2); dma16(tj + koff, lds + (bo) * 8192 + wid * 1024); dma16(tj + voff, lds + 24576 + (vbo) * 8192 + wid * 1024); \
    if (lane < 16) dma16(cg + (j) * 256, BW + (bo) * 256); } while (0)
#define FOX_PV(vbo) pv_all<2>(o, vb0 + (vbo) * 8192, pa0, pa1, pa2, pa3)
  FOX_LOAD(NT - 1, 0, 0); FOX_LOAD(NT - 2, 1, 1);
  float l_reg = 0.f; f32x16 o[2]; o[0] = f32x16{}; o[1] = f32x16{};
  const float bnd = q_norm(qr) * k_max(km + b * 96, 16 + 2 * h);
  const int qpos = q0 + wid * 32 + r32;
  const float refq = (cl2[(size_t)bh * SEQ + qpos] + CARRY[qpos >> 7] - cq) + fmaxf(0.f, bnd - 60.f);
  const bf16x8 augA = aug_a(hi);
  __builtin_amdgcn_s_waitcnt(0x0F70);
  bool stopped = false, pend = false; const bool late = wid >= 4;
  bf16x8 pa0, pa1, pa2, pa3;
  int cur = 0, nx2 = 2, vc = 0, vn2 = 2, vprev = 3;
  PROF_END(11, pacc);
  for (int i = 0; i < NT; ++i) {
    const int j = NT - 1 - i;
    if (PROF_ID == 13) pacc += 100;
    PROF_BEGIN(8);
    if (i + 1 < NT) ATT_WAIT_BAR(3); else ATT_WAIT_BAR(0);
    PROF_END(8, pacc);
    if (all_done(DONE, i)) break;
    if (i + 2 < NT) FOX_LOAD(j - 2, nx2, vn2);
    if (pend) { PROF_BEGIN(10); FOX_PV(vprev); pend = false; PROF_END(10, pacc); }
    if (j <= jl && !stopped) {
      const float bj = ((const ATT_LAS float*)(BW + cur * 256))[63] + (CARRY[j >> 1] - cq);
      if (!__any(bnd + (bj - refq) - __builtin_amdgcn_logf(l_reg) >= -SKIP_T)) { stopped = true; if (lane == 0) DONE[wid] = i; }
    }
    if (j <= jl && !stopped) {
      f32x16 p0, p1;
      PROF_BEGIN(9);
      const float c2 = CARRY[j >> 1] - cq;
      qkt_bias(p0, p1, (const ATT_LAS float*)(BW + cur * 256), lds + cur * 8192, qr, r32, hi, augA, aug_b(c2 - refq, hi));
      if (j == jl) { const int qrel = opaque(32 * (wid & 1) + r32), hio = opaque(hi);
#pragma unroll
        for (int r = 0; r < 16; ++r) { const int kr = crow(r, hio); if (kr > qrel) p0[r] = -1e30f; if (kr + 32 > qrel) p1[r] = -1e30f; } }
      sm_direct(p0, p1, l_reg, pa0, pa1, pa2, pa3);
      PROF_END(9, pacc);
      if (late) pend = true; else { PROF_BEGIN(10); FOX_PV(vc); PROF_END(10, pacc); }
    }
    cur = cur == 2 ? 0 : cur + 1; nx2 = nx2 == 2 ? 0 : nx2 + 1; vprev = vc; vc = (vc + 1) & 3; vn2 = (vn2 + 1) & 3;
  }
  if (pend) FOX_PV(vprev);
#undef FOX_PV
#undef FOX_LOAD
  PROF_BEGIN(12);
  asm volatile("s_waitcnt vmcnt(0)" ::: "memory");
  l_reg = lx_sum32(l_reg);
  if (hi == 0) wsf[32 + r32] = l_reg; asm volatile("s_waitcnt lgkmcnt(0)" ::: "memory");
  { const int le = opaque(lane), r32e = le & 31, hie = le >> 5;
  bf16_t* Ow = attn + (rowb + q0 + wid * 32) * LDATT + h * 64 + r32e;
#pragma unroll
  for (int r = 0; r < 16; ++r) { const int orow = crow(r, hie); const float rl = __builtin_amdgcn_rcpf(wsf[32 + orow]);
#pragma unroll
    for (int d0 = 0; d0 < 2; ++d0) { const unsigned w = cvtpk(o[d0][r] * rl, 0.f); Ow[(size_t)orow * LDATT + d0 * 32] = (bf16_t)(w & 0xffffu); } } }
  asm volatile("s_waitcnt lgkmcnt(0)" ::: "memory");
  __syncthreads();
  PROF_END(12, pacc);
}

__device__ __forceinline__ void fox2_unit(ATT_LAS unsigned char* lds, const bf16_t* __restrict__ qkv, bf16_t* __restrict__ attn, const float* __restrict__ cl2, const float* __restrict__ blk2, const unsigned* km,
                                          int b, int h, int qb, int wave, unsigned long long& pacc) {
  PROF_BEGIN(11);
  const int wid = wave, lane = fresh_lane(), r32 = lane & 31, hi = lane >> 5;
  ATT_LAS float* CARRY = (ATT_LAS float*)(lds + 63488); ATT_LAS float* wsf = (ATT_LAS float*)(lds + 63744) + wid * 64;
  ATT_LAS unsigned char* BW = lds + 57344 + wid * 768; ATT_LAS int* DONE = (ATT_LAS int*)(lds + 65792);
  if (lane == 0) DONE[wid] = 0x7fffffff;
  const int q0 = qb * 512, NT = 8 * (qb + 1), jl = 8 * qb + wid;
  const size_t rowb = (size_t)b * SEQ; const int bh = b * 8 + h;
  if (wid == 0) { float v = lane < 32 ? blk2[(b * 32 + lane) * 8 + h] : 0.f; float s = v;
#pragma unroll
    for (int o = 1; o < 32; o <<= 1) { const float t = __builtin_bit_cast(float, __builtin_amdgcn_ds_bpermute(((lane - o) & 63) << 2, __builtin_bit_cast(int, s))); if (lane >= o) s += t; }
    if (lane < 32) CARRY[lane] = s - v; }
  __syncthreads();
  const float cq = CARRY[q0 >> 7] + cl2[(size_t)bh * SEQ + q0];
  bf16x8 qA[4], qB[4];
  { const bf16_t* Qw = qkv + (rowb + q0 + wid * 64 + r32) * LDQKV + h * 64 + hi * 8;
#pragma unroll
    for (int d0 = 0; d0 < 4; ++d0) { qA[d0] = *(const bf16x8*)(Qw + d0 * 16); qB[d0] = *(const bf16x8*)(Qw + (size_t)32 * LDQKV + d0 * 16); } }
  const int pk = 64 * wid + lane;
  unsigned koff, voff;
  { const int row = pk >> 3, c = (pk & 7) ^ ((row >> 1) & 7); koff = (unsigned)((row * LDQKV + 512 + h * 64 + c * 8) * 2);
    const int sub = pk >> 5, kk = 8 * (sub >> 1) + ((pk & 31) >> 2), k = swap23(kk), cv = (sub & 1) * 32 + (pk & 3) * 8; voff = (unsigned)((k * LDQKV + 1024 + h * 64 + cv) * 2); }
  const char* tb = (const char*)(qkv + rowb * LDQKV);
  const char* cg = (const char*)(cl2 + (size_t)bh * SEQ) + (lane & 15) * 16;
  const int vb0 = (int)(uintptr_t)(lds + 24576) + v_rd_base(lane);
#define FOX_LOAD(j, bo, vbo) do { const char* tj = tb + (size_t)(j) * (64 * LDQKV * 2); dma16(tj + koff, lds + (bo) * 8192 + wid * 1024); dma16(tj + voff, lds + 24576 + (vbo) * 8192 + wid * 1024); \
    if (lane < 16) dma16(cg + (j) * 256, BW + (bo) * 256); } while (0)
  FOX_LOAD(NT - 1, 0, 0); FOX_LOAD(NT - 2, 1, 1);
  float lA = 0.f, lB = 0.f; f32x16 oA[2], oB[2]; oA[0] = f32x16{}; oA[1] = f32x16{}; oB[0] = f32x16{}; oB[1] = f32x16{};
  const float kmx = k_max(km + b * 96, 16 + 2 * h);
  const float bndA = q_norm(qA) * kmx, bndB = q_norm(qB) * kmx;
  const int qposA = q0 + wid * 64 + r32;
  const float refA = (cl2[(size_t)bh * SEQ + qposA] + CARRY[qposA >> 7] - cq) + fmaxf(0.f, bndA - 60.f);
  const float refB = (cl2[(size_t)bh * SEQ + qposA + 32] + CARRY[(qposA + 32) >> 7] - cq) + fmaxf(0.f, bndB - 60.f);
  const bf16x8 augA = aug_a(hi);
  __builtin_amdgcn_s_waitcnt(0x0F70);
  bool stopped = false;
  int cur = 0, nx2 = 2, vc = 0, vn2 = 2;
  PROF_END(11, pacc);
  for (int i = 0; i < NT; ++i) {
    const int j = NT - 1 - i;
    if (PROF_ID == 13) pacc += 100;
    PROF_BEGIN(8);
    if (i + 1 < NT) ATT_WAIT_BAR(3); else ATT_WAIT_BAR(0);
    PROF_END(8, pacc);
    if (all_done(DONE, i)) break;
    if (i + 2 < NT) FOX_LOAD(j - 2, nx2, vn2);
    if (j <= jl && !stopped) {
      const float bj = ((const ATT_LAS float*)(BW + cur * 256))[63] + (CARRY[j >> 1] - cq);
      const float tA = bndA + (bj - refA) - __builtin_amdgcn_logf(lA), tB = bndB + (bj - refB) - __builtin_amdgcn_logf(lB);
      if (!__any(fmaxf(tA, tB) >= -SKIP_T)) { stopped = true; if (lane == 0) DONE[wid] = i; }
    }
    if (j <= jl && !stopped) {
      PROF_BEGIN(9);
      f32x16 pA0, pA1, pB0, pB1; bf16x8 paA0, paA1, paA2, paA3, paB0, paB1, paB2, paB3;
      const float c2 = CARRY[j >> 1] - cq;
      { const ATT_LAS float* BT = (const ATT_LAS float*)(BW + cur * 256); const ATT_LAS unsigned char* Ks = lds + cur * 8192;
#pragma unroll
        for (int g = 0; g < 4; ++g) { const f32x4 b0 = *(const ATT_LAS f32x4*)(BT + 8 * g + 4 * hi), b1 = *(const ATT_LAS f32x4*)(BT + 32 + 8 * g + 4 * hi);
#pragma unroll
          for (int e = 0; e < 4; ++e) { pA0[4 * g + e] = b0[e]; pA1[4 * g + e] = b1[e]; pB0[4 * g + e] = b0[e]; pB1[4 * g + e] = b1[e]; } }
#pragma unroll
        for (int d0 = 0; d0 < 4; ++d0) {
          const bf16x8 k0 = *(const ATT_LAS bf16x8*)(Ks + ksw(r32, 2 * d0 + hi));
          const bf16x8 k1 = *(const ATT_LAS bf16x8*)(Ks + ksw(32 + r32, 2 * d0 + hi));
          pA0 = __builtin_amdgcn_mfma_f32_32x32x16_bf16(k0, qA[d0], pA0, 0, 0, 0); pB0 = __builtin_amdgcn_mfma_f32_32x32x16_bf16(k0, qB[d0], pB0, 0, 0, 0);
          pA1 = __builtin_amdgcn_mfma_f32_32x32x16_bf16(k1, qA[d0], pA1, 0, 0, 0); pB1 = __builtin_amdgcn_mfma_f32_32x32x16_bf16(k1, qB[d0], pB1, 0, 0, 0);
          if (d0 == 1) ATT_SBAR(); }
        const bf16x8 gA = aug_b(c2 - refA, hi), gB = aug_b(c2 - refB, hi);
        pA0 = __builtin_amdgcn_mfma_f32_32x32x16_bf16(augA, gA, pA0, 0, 0, 0); pA1 = __builtin_amdgcn_mfma_f32_32x32x16_bf16(augA, gA, pA1, 0, 0, 0);
        pB0 = __builtin_amdgcn_mfma_f32_32x32x16_bf16(augA, gB, pB0, 0, 0, 0); pB1 = __builtin_amdgcn_mfma_f32_32x32x16_bf16(augA, gB, pB1, 0, 0, 0); }
      if (j == jl) { const int qrel = opaque(r32), hio = opaque(hi);
#pragma unroll
        for (int r = 0; r < 16; ++r) { const int kr = crow(r, hio); if (kr > qrel) { pA0[r] = -1e30f; pB1[r] = -1e30f; } pA1[r] = -1e30f; } }
      sm_direct(pA0, pA1, lA, paA0, paA1, paA2, paA3);
      sm_direct(pB0, pB1, lB, paB0, paB1, paB2, paB3);
      PROF_END(9, pacc);
      PROF_BEGIN(10);
      { const int vb = vb0 + vc * 8192;
#define FOX2_TR8(S, D0_) do { \
        S[0] = tr_read<v_rd_off<2>(D0_, 0, 0)>(vb); S[1] = tr_read<v_rd_off<2>(D0_, 0, 1)>(vb); S[2] = tr_read<v_rd_off<2>(D0_, 1, 0)>(vb); S[3] = tr_read<v_rd_off<2>(D0_, 1, 1)>(vb); \
        S[4] = tr_read<v_rd_off<2>(D0_, 2, 0)>(vb); S[5] = tr_read<v_rd_off<2>(D0_, 2, 1)>(vb); S[6] = tr_read<v_rd_off<2>(D0_, 3, 0)>(vb); S[7] = tr_read<v_rd_off<2>(D0_, 3, 1)>(vb); } while (0)
#define FOX2_PK(L, H) (bf16x8){L[0], L[1], L[2], L[3], H[0], H[1], H[2], H[3]}
#define FOX2_MM(OD, P0_, P1_, P2_, P3_, S) do { \
        OD = __builtin_amdgcn_mfma_f32_32x32x16_bf16(P0_, FOX2_PK(S[0], S[1]), OD, 0, 0, 0); OD = __builtin_amdgcn_mfma_f32_32x32x16_bf16(P1_, FOX2_PK(S[2], S[3]), OD, 0, 0, 0); \
        OD = __builtin_amdgcn_mfma_f32_32x32x16_bf16(P2_, FOX2_PK(S[4], S[5]), OD, 0, 0, 0); OD = __builtin_amdgcn_mfma_f32_32x32x16_bf16(P3_, FOX2_PK(S[6], S[7]), OD, 0, 0, 0); } while (0)
        s16x4 S0[8], S1[8];
        FOX2_TR8(S0, 0); FOX2_TR8(S1, 1);
        asm volatile("s_waitcnt lgkmcnt(8)" ::: "memory"); ATT_SBAR();
        FOX2_MM(oA[0], paA0, paA1, paA2, paA3, S0); FOX2_MM(oB[0], paB0, paB1, paB2, paB3, S0);
        asm volatile("s_waitcnt lgkmcnt(0)" ::: "memory"); ATT_SBAR();
        FOX2_MM(oA[1], paA0, paA1, paA2, paA3, S1); FOX2_MM(oB[1], paB0, paB1, paB2, paB3, S1);
#undef FOX2_TR8
#undef FOX2_PK
#undef FOX2_MM
      }
      PROF_END(10, pacc);
    }
    cur = cur == 2 ? 0 : cur + 1; nx2 = nx2 == 2 ? 0 : nx2 + 1; vc = (vc + 1) & 3; vn2 = (vn2 + 1) & 3;
  }
#undef FOX_LOAD
  PROF_BEGIN(12);
  asm volatile("s_waitcnt vmcnt(0)" ::: "memory");
  lA = lx_sum32(lA); lB = lx_sum32(lB);
  { const int le = opaque(lane), r32e = le & 31, hie = le >> 5;
    if (hie == 0) wsf[32 + r32e] = lA; asm volatile("s_waitcnt lgkmcnt(0)" ::: "memory");
    bf16_t* Ow = attn + (rowb + q0 + wid * 64) * LDATT + h * 64 + r32e;
#pragma unroll
    for (int r = 0; r < 16; ++r) { const int orow = crow(r, hie); const float rl = __builtin_amdgcn_rcpf(wsf[32 + orow]);
#pragma unroll
      for (int d0 = 0; d0 < 2; ++d0) { const unsigned w = cvtpk(oA[d0][r] * rl, 0.f); Ow[(size_t)orow * LDATT + d0 * 32] = (bf16_t)(w & 0xffffu); } }
    asm volatile("s_waitcnt lgkmcnt(0)" ::: "memory");
    if (hie == 0) wsf[32 + r32e] = lB; asm volatile("s_waitcnt lgkmcnt(0)" ::: "memory");
#pragma unroll
    for (int r = 0; r < 16; ++r) { const int orow = crow(r, hie); const float rl = __builtin_amdgcn_rcpf(wsf[32 + orow]);
#pragma unroll
      for (int d0 = 0; d0 < 2; ++d0) { const unsigned w = cvtpk(oB[d0][r] * rl, 0.f); Ow[(size_t)(32 + orow) * LDATT + d0 * 32] = (bf16_t)(w & 0xffffu); } } }
  asm volatile("s_waitcnt lgkmcnt(0)" ::: "memory");
  __syncthreads();
  PROF_END(12, pacc);
}

__device__ __forceinline__ void diff_unit(ATT_LAS unsigned char* lds, const bf16_t* __restrict__ qkv, bf16_t* __restrict__ attn, const float* __restrict__ subln_g, float lam, const unsigned* km,
                                          int b, int h, int qb, int wave, unsigned long long& pacc) {
  PROF_BEGIN(6);
  const int wid = wave, lane = fresh_lane(), tid = wid * 64 + lane, r32 = lane & 31, hi = lane >> 5;
  ATT_LAS float* wsf = (ATT_LAS float*)(lds + 114688) + wid * 64; ATT_LAS float* BT = (ATT_LAS float*)(lds + 116736) + wid * 64;
  ATT_LAS int* DONE = (ATT_LAS int*)(lds + 118784);
  if (lane == 0) DONE[wid] = 0x7fffffff;
  const int map = wid >> 2, w4 = wid & 3;
  const int q0 = qb * 128, NT = 2 * (qb + 1), jl = 2 * qb + (w4 >> 1);
  const size_t rowb = (size_t)b * SEQ;
  const float sl2 = LOG2E * (h == 0 ? 0.25f : h == 1 ? 0.0625f : h == 2 ? 0.015625f : 0.00390625f);
  const int pk = 64 * wid + lane;
  unsigned koff, voff0, voff1;
  { const int row = pk >> 3, c = (pk & 7) ^ ((row >> 1) & 7); koff = (unsigned)((row * LDQKV + 2048 + h * 128 + c * 8) * 2);
    const int sub0 = pk >> 5, kk0 = 8 * (sub0 >> 2) + ((pk & 31) >> 2), k0 = swap23(kk0), c0 = (sub0 & 3) * 32 + (pk & 3) * 8; voff0 = (unsigned)((k0 * LDQKV + 2560 + h * 128 + c0) * 2);
    const int p1 = pk + 512, sub1 = p1 >> 5, kk1 = 8 * (sub1 >> 2) + ((p1 & 31) >> 2), k1 = swap23(kk1), c1 = (sub1 & 3) * 32 + (p1 & 3) * 8; voff1 = (unsigned)((k1 * LDQKV + 2560 + h * 128 + c1) * 2); }
  const char* tb = (const char*)(qkv + rowb * LDQKV);
  const int vb0 = (int)(uintptr_t)(lds + 49152) + v_rd_base(lane);
#define DIFF_LOAD(j, kbo, vbo) do { const char* tj = tb + (size_t)(j) * (64 * LDQKV * 2); dma16(tj + koff, lds + (kbo) * 8192 + wid * 1024); dma16(tj + koff + 128, lds + 24576 + (kbo) * 8192 + wid * 1024); \
    dma16(tj + voff0, lds + 49152 + (vbo) * 16384 + wid * 1024); dma16(tj + voff1, lds + 49152 + (vbo) * 16384 + 8192 + wid * 1024); } while (0)
#define DIFF_PV(vbo) pv_all<4>(o, vb0 + (vbo) * 16384, pa0, pa1, pa2, pa3)
  ATT_LAS unsigned char* QS = lds + 118912;
  { const int pq = pk + 512, r0_ = pk >> 3, c0q = (pk & 7) ^ ((r0_ >> 1) & 7), r1_ = pq >> 3, c1q = (pq & 7) ^ ((r1_ >> 1) & 7);
    const char* qb_ = (const char*)(qkv + (rowb + q0) * LDQKV + 1536 + h * 128);
#pragma unroll
    for (int m2 = 0; m2 < 2; ++m2) { dma16(qb_ + ((size_t)r0_ * LDQKV + m2 * 64 + c0q * 8) * 2, QS + m2 * 16384 + wid * 1024); dma16(qb_ + ((size_t)r1_ * LDQKV + m2 * 64 + c1q * 8) * 2, QS + m2 * 16384 + 8192 + wid * 1024); } }
  DIFF_LOAD(NT - 1, 0, 0); DIFF_LOAD(NT - 2, 1, 1);
  __builtin_amdgcn_s_waitcnt(0x0F70);
  asm volatile("s_waitcnt lgkmcnt(0)\n\ts_barrier" ::: "memory");
  const ATT_LAS unsigned char* Qs = QS + map * 16384; const int qrow = 32 * w4 + r32;
  float l_reg = 0.f; f32x16 o[4]; o[0] = f32x16{}; o[1] = f32x16{}; o[2] = f32x16{}; o[3] = f32x16{};
  float bnd;
  { bf16x8 qr[4];
#pragma unroll
    for (int d0 = 0; d0 < 4; ++d0) qr[d0] = *(const ATT_LAS bf16x8*)(Qs + ksw(qrow, 2 * d0 + hi));
    bnd = q_norm(qr) * k_max(km + b * 96, 64 + 4 * h + 2 * map); }
  const float refq = sl2 * (float)(32 * w4 + r32) + fmaxf(0.f, bnd - 60.f);
  const bf16x8 augA0 = aug_a_alibi(r32, hi), augA1 = aug_a_alibi(r32 + 32, hi);
  unsigned s_hi, s_lo; { s_hi = cvtpk(sl2, 0.f) & 0xffffu; s_lo = cvtpk(sl2 - __uint_as_float(s_hi << 16), 0.f) & 0xffffu; }
  __builtin_amdgcn_s_waitcnt(0x0F70);
  bool stopped = false, pend = false; const bool late = wid >= 4;
  bf16x8 pa0, pa1, pa2, pa3;
  int cur = 0, nx2 = 2, vc = 0, vn2 = 2, vprev = 3;
  PROF_END(6, pacc);
  for (int i = 0; i < NT; ++i) {
    const int j = NT - 1 - i;
    if (PROF_ID == 14) pacc += 100;
    PROF_BEGIN(3);
    if (i + 1 < NT) ATT_WAIT_BAR(4); else ATT_WAIT_BAR(0);
    PROF_END(3, pacc);
    if (all_done(DONE, i)) break;
    if (i + 2 < NT) DIFF_LOAD(j - 2, nx2, vn2);
    if (pend) { PROF_BEGIN(5); DIFF_PV(vprev); pend = false; PROF_END(5, pacc); }
    if (j < jl && !stopped) {
      const float bj = sl2 * (float)(64 * j + 63 - q0);
      if (!__any(bnd + (bj - refq) - __builtin_amdgcn_logf(l_reg) >= -SKIP_T)) { stopped = true; if (lane == 0) DONE[wid] = i; }
    }
    if (j <= jl && !stopped) {
      f32x16 p0, p1;
      PROF_BEGIN(4); PROF_BEGIN(15);
      qkt_aug_q(p0, p1, lds + map * 24576 + cur * 8192, Qs, qrow, r32, hi, augA0, augA1, aug_b_alibi(sl2 * (float)(64 * j - q0) - refq, s_hi, s_lo, hi));
      PROF_END(15, pacc);
      if (j == jl) { const int tq = opaque(32 * (w4 & 1) + r32), hio = opaque(hi);
#pragma unroll
        for (int r = 0; r < 16; ++r) { const int k0 = crow(r, hio), k1 = k0 + 32; if (k0 > tq) p0[r] += sl2 * (float)(2 * (tq - k0)); if (k1 > tq) p1[r] += sl2 * (float)(2 * (tq - k1)); } }
      PROF_BEGIN(16);
      sm_direct(p0, p1, l_reg, pa0, pa1, pa2, pa3);
      PROF_END(16, pacc);
      PROF_END(4, pacc);
      if (late) pend = true; else { PROF_BEGIN(5); DIFF_PV(vc); PROF_END(5, pacc); }
    }
    cur = cur == 2 ? 0 : cur + 1; nx2 = nx2 == 2 ? 0 : nx2 + 1; vprev = vc; vc = (vc + 1) & 3; vn2 = (vn2 + 1) & 3;
  }
  if (pend) DIFF_PV(vprev);
#undef DIFF_PV
  PROF_BEGIN(7);
#undef DIFF_LOAD
  asm volatile("s_waitcnt vmcnt(0)" ::: "memory");
  l_reg = lx_sum32(l_reg);
  if (hi == 0) wsf[32 + r32] = l_reg; asm volatile("s_waitcnt lgkmcnt(0)" ::: "memory");
  const int te = opaque(tid), r32e = te & 31, hie = (te >> 5) & 1;
  float rl[16];
#pragma unroll
  for (int r = 0; r < 16; ++r) rl[r] = __builtin_amdgcn_rcpf(wsf[32 + crow(r, hie)]);
  asm volatile("s_waitcnt lgkmcnt(0)" ::: "memory");
  __syncthreads();
  { ATT_LAS float* Xm = (ATT_LAS float*)lds + map * (128 * 132);
#pragma unroll
    for (int r = 0; r < 16; ++r) { const int orow = crow(r, hie);
#pragma unroll
      for (int d0 = 0; d0 < 4; ++d0) Xm[(32 * w4 + orow) * 132 + d0 * 32 + r32e] = o[d0][r] * rl[r]; } }
  __syncthreads();
  { const int row = te >> 2, qt = te & 3; const ATT_LAS float* X0 = (const ATT_LAS float*)lds + row * 132 + qt * 32; const ATT_LAS float* X1 = X0 + 128 * 132;
    float v[32]; float ss = 0.f;
#pragma unroll
    for (int i = 0; i < 8; ++i) { const f32x4 t0 = *(const ATT_LAS f32x4*)(X0 + 4 * i), t1 = *(const ATT_LAS f32x4*)(X1 + 4 * i); const f32x4 t = t0 - lam * t1;
      v[4 * i] = t[0]; v[4 * i + 1] = t[1]; v[4 * i + 2] = t[2]; v[4 * i + 3] = t[3];
      ss += t[0] * t[0] + t[1] * t[1] + t[2] * t[2] + t[3] * t[3]; }
    ss += lx_get<1>(ss); ss += lx_get<2>(ss);
    const float rstd = 0.8f / sqrtf(ss * (1.0f / 128.0f) + 1e-5f);
    bf16_t* op = attn + (rowb + q0 + row) * LDATT + 512 + h * 128 + qt * 32; const f32x4* gp = (const f32x4*)(subln_g + qt * 32);
#pragma unroll
    for (int i = 0; i < 4; ++i) { const f32x4 g0 = gp[2 * i], g1 = gp[2 * i + 1]; u32x4 w;
      w.x = cvtpk(v[8 * i + 0] * rstd * g0[0], v[8 * i + 1] * rstd * g0[1]); w.y = cvtpk(v[8 * i + 2] * rstd * g0[2], v[8 * i + 3] * rstd * g0[3]);
      w.z = cvtpk(v[8 * i + 4] * rstd * g1[0], v[8 * i + 5] * rstd * g1[1]); w.w = cvtpk(v[8 * i + 6] * rstd * g1[2], v[8 * i + 7] * rstd * g1[3]);
      *(u32x4*)(op + 8 * i) = w; } }
  __syncthreads();
  PROF_END(7, pacc);
}
#undef ATT_WAIT_BAR
#undef ATT_SBAR
}

constexpr int NWAVES = 8;
constexpr int BATCH = 8, SEQ = 4096, D = 1024, T = BATCH * SEQ;
constexpr int IN_COLS = 3080, NQKV = 3072;
constexpr int NEXP = 32, DEXP = 512, NSLOT_MAX = 73728;
constexpr int NPH = 9;
constexpr float C2 = 0.125f * 1.4426950408889634f;
constexpr float LAM_INIT = 0.2f;

constexpr size_t MiB = 1u << 20;
constexpr size_t WS_CTL = 0, CTL_ZERO_BYTES = 256 * 1024;
constexpr size_t WS_WIN = 1 * MiB;
constexpr size_t WS_WO = 7 * MiB;
constexpr size_t WS_WGU = 9 * MiB;
constexpr size_t WS_WD = 73 * MiB;
constexpr size_t WS_WR = 105 * MiB;
constexpr size_t WS_MOD = 106 * MiB;
constexpr size_t WS_CUM = 107 * MiB;
constexpr size_t WS_BLK = 108 * MiB;
constexpr size_t WS_RT = 109 * MiB;
constexpr size_t WS_STOK = 110 * MiB;
constexpr size_t WS_R = 118 * MiB;
constexpr size_t WS_H = WS_R;
constexpr size_t WS_QKV = WS_R + 64 * MiB;
constexpr size_t WS_Y = WS_R;
constexpr size_t WS_HID = WS_R + 144 * MiB;
constexpr size_t WS_H2F8 = WS_R + 184 * MiB;
constexpr size_t WS_X1 = WS_R + 256 * MiB;
constexpr size_t WS_END = WS_X1 + 64 * MiB;
constexpr int CW_BAR = 4096;
constexpr int CW_KM = 32768;
constexpr int CW_QH = 36864;
constexpr int CW_CNT = 16384;

constexpr int LDS_BYTES = 155648;
constexpr int MISC_OFF = LDS_BYTES - 256;

#define GAS __attribute__((address_space(1)))
#define LAS __attribute__((address_space(3)))
typedef unsigned short bf16;
typedef unsigned v4u __attribute__((ext_vector_type(4)));
typedef unsigned v2u __attribute__((ext_vector_type(2)));
typedef float f32x4 __attribute__((ext_vector_type(4)));
typedef GAS unsigned gu32;
#define RLX_AGENT __ATOMIC_RELAXED, __HIP_MEMORY_SCOPE_AGENT
#define LDS_WAIT() asm volatile("s_waitcnt lgkmcnt(0)" ::: "memory")
#define VM_WAIT() asm volatile("s_waitcnt vmcnt(0)" ::: "memory")
__device__ __forceinline__ unsigned f2bf(float f) { unsigned u = __builtin_bit_cast(unsigned, f); return (u + 0x7fffu + ((u >> 16) & 1u)) >> 16; }
__device__ __forceinline__ unsigned pk2(float lo, float hi) { return f2bf(lo) | (f2bf(hi) << 16); }
__device__ __forceinline__ float bflo(unsigned w) { return __builtin_bit_cast(float, w << 16); }
__device__ __forceinline__ float bfhi(unsigned w) { return __builtin_bit_cast(float, w & 0xffff0000u); }
__device__ __forceinline__ float wave_sum(float v) {
#ifdef OLD_WSUM
#pragma unroll
    for (int o = 1; o < 64; o <<= 1) v += __shfl_xor(v, o);
    return v;
#else
    v += lx_get<1>(v); v += lx_get<2>(v); v += lx_get<4>(v); v += lx_get<8>(v); v += lx_get<16>(v);
    return lx_sum32(v);
#endif
}
#define XB_TMO      128
#define XB_XCNT(j)  (256  + 64 * (j))
#define XB_XSUB(j)  (1280 + 64 * (j))
#define XB_XGEN(j)  (2304 + 64 * (j))
#define XB_TOP      3328
#define XB_TOPGEN   3392
#define XCD_BAR_WORDS 3456
#define XB_SPIN_CAP (1u << 18)

__device__ __forceinline__ unsigned xb_ld(unsigned* p)              { return __hip_atomic_load(p, __ATOMIC_RELAXED, __HIP_MEMORY_SCOPE_AGENT); }
__device__ __forceinline__ unsigned xb_add(unsigned* p, unsigned v) { return __hip_atomic_fetch_add(p, v, __ATOMIC_RELAXED, __HIP_MEMORY_SCOPE_AGENT); }
__device__ __forceinline__ unsigned xb_xcc_id() { return (unsigned)__builtin_amdgcn_s_getreg((3 << 11) | 20) & 0xFu; }
#define XB_SPIN(cond, bar) do { unsigned _sp = 0; while (cond) { __builtin_amdgcn_s_sleep(1); \
    if ((++_sp & 255u) == 0u) { if (xb_ld(&(bar)[XB_TMO])) break; if (_sp > XB_SPIN_CAP) { atomicAdd(&(bar)[XB_TMO], 1u); break; } } } } while (0)

struct XcdBarrier {
    int wave;
    unsigned* bar; unsigned x;
    volatile LAS unsigned* st;
};

__device__ __forceinline__ XcdBarrier xcd_barrier_post(unsigned* bar, volatile LAS unsigned* st) {
    XcdBarrier b; b.bar = bar; b.x = xb_xcc_id(); b.st = st;
    if (threadIdx.x == 0) (void)xb_add(&bar[XB_XCNT(b.x)], 1u);
    return b;
}
__device__ __forceinline__ void xcd_barrier_complete(unsigned* bar, unsigned x, unsigned& nloc, unsigned& nx) {
    const unsigned G = gridDim.x * gridDim.y * gridDim.z;
    unsigned sum, cnt, mine, sp = 0u;
    for (;;) {
        sum = 0u; cnt = 0u; mine = 0u;
#pragma unroll
        for (unsigned j = 0; j < 16; ++j) { const unsigned c = xb_ld(&bar[XB_XCNT(j)]); sum += c; cnt += (c > 0u) ? 1u : 0u; mine = (j == x) ? c : mine; }
        if (sum == G) break;
        __builtin_amdgcn_s_sleep(1);
        if ((++sp & 255u) == 0u) { if (xb_ld(&bar[XB_TMO])) break; if (sp > XB_SPIN_CAP) { atomicAdd(&bar[XB_TMO], 1u); break; } }
    }
    nloc = mine > 0u ? mine : 1u; nx = cnt > 0u ? cnt : 1u;
}

__device__ __forceinline__ void xcd_barrier(const XcdBarrier& b) {
    asm volatile("s_waitcnt vmcnt(0)" ::: "memory");
    __syncthreads();
    if (b.wave == 0 && fresh_lane() == 0) {
        unsigned* bar = b.bar;
        __builtin_amdgcn_s_waitcnt(0);
        unsigned nloc = b.st[0], nx = b.st[1];
        if (nloc == 0u) { xcd_barrier_complete(bar, b.x, nloc, nx); b.st[0] = nloc; b.st[1] = nx; }
        const unsigned old = xb_add(&bar[XB_XSUB(b.x)], 1u);
        const unsigned gen = old / nloc;
        if (old + 1u == (gen + 1u) * nloc) {
            __builtin_amdgcn_fence(__ATOMIC_RELEASE, "agent");
            asm volatile("s_waitcnt vmcnt(0)" ::: "memory");
            const unsigned og = xb_add(&bar[XB_TOP], 1u);
            const unsigned tg = og / nx;
            if (og + 1u == (tg + 1u) * nx) xb_add(&bar[XB_TOPGEN], 1u);
            else XB_SPIN(xb_ld(&bar[XB_TOPGEN]) == tg, bar);
            __builtin_amdgcn_fence(__ATOMIC_ACQUIRE, "agent");
            xb_add(&bar[XB_XGEN(b.x)], 1u);
            asm volatile("s_waitcnt vmcnt(0)" ::: "memory");
        } else {
            XB_SPIN(xb_ld(&bar[XB_XGEN(b.x)]) == gen, bar);
            __builtin_amdgcn_fence(__ATOMIC_ACQUIRE, "agent");
            asm volatile("s_waitcnt vmcnt(0)" ::: "memory");
        }
    }
    __syncthreads();
}

template <bool F8OUT = false>
__device__ __forceinline__ void tr_item(const float* __restrict__ src, int ldS, bf16* __restrict__ dst, int ldD, float scale, LAS float* scr, int lane) {
    f32x4 v[8];
#pragma unroll
    for (int t = 0; t < 8; ++t) { const int idx = lane + 64 * t; v[t] = *(const f32x4*)(src + (size_t)(idx >> 3) * ldS + 4 * (idx & 7)); }
#pragma unroll
    for (int t = 0; t < 8; ++t) { const int idx = lane + 64 * t; LAS float* p = scr + (idx >> 3) * 33 + 4 * (idx & 7); p[0] = v[t].x; p[1] = v[t].y; p[2] = v[t].z; p[3] = v[t].w; }
    LDS_WAIT(); asm volatile("" ::: "memory");
    const int c = lane & 7;
#pragma unroll
    for (int j = 0; j < 4; ++j) { const int n = (lane >> 3) + 8 * j; const LAS float* s = scr + (8 * c) * 33 + n;
        if constexpr (F8OUT) {
            int t0 = 0, t1 = 0;
            t0 = __builtin_amdgcn_cvt_pk_fp8_f32(s[0 * 33] * scale, s[1 * 33] * scale, t0, false); t0 = __builtin_amdgcn_cvt_pk_fp8_f32(s[2 * 33] * scale, s[3 * 33] * scale, t0, true);
            t1 = __builtin_amdgcn_cvt_pk_fp8_f32(s[4 * 33] * scale, s[5 * 33] * scale, t1, false); t1 = __builtin_amdgcn_cvt_pk_fp8_f32(s[6 * 33] * scale, s[7 * 33] * scale, t1, true);
            v2u o; o.x = (unsigned)t0; o.y = (unsigned)t1; *(v2u*)((unsigned char*)dst + (size_t)n * ldD + 8 * c) = o;
        } else {
        v4u o; o.x = pk2(s[0 * 33] * scale, s[1 * 33] * scale); o.y = pk2(s[2 * 33] * scale, s[3 * 33] * scale); o.z = pk2(s[4 * 33] * scale, s[5 * 33] * scale); o.w = pk2(s[6 * 33] * scale, s[7 * 33] * scale);
        *(v4u*)(dst + (size_t)n * ldD + 8 * c) = o; } }
    LDS_WAIT(); asm volatile("" ::: "memory");
}
constexpr int XI_GU = 32 * 16 * 32, XI_D = 32 * 8 * 32, XI_PER_UNIT = 48, X_UNITS = (XI_GU + XI_D) / XI_PER_UNIT;
__device__ __forceinline__ void expert_item(const float* __restrict__ w_gate, const float* __restrict__ w_up, const float* __restrict__ w_down, bf16* __restrict__ Wt_gu, bf16* __restrict__ Wt_d, int r, LAS float* scr, int lane) {
    if (r < XI_GU) { const int e = r / 512, q = r % 512, kb = q / 32, nb = q % 32, n0 = 32 * nb, pn = n0 >> 8, bj = (n0 >> 7) & 1, j0 = n0 & 127;
        const float* src = (bj ? w_up : w_gate) + (size_t)e * 1024 * 512 + (size_t)(64 * kb) * 512 + 128 * pn + j0;
        tr_item<true>(src, 512, (bf16*)((unsigned char*)Wt_gu + ((size_t)e * 1024 + n0) * 1024 + 64 * kb), 1024, 32.0f, scr, lane); }
    else { r -= XI_GU; const int e = r / 256, q = r % 256, kb = q / 32, nb = q % 32;
        tr_item<true>(w_down + (size_t)e * 512 * 1024 + (size_t)(64 * kb) * 1024 + 32 * nb, 1024, (bf16*)((unsigned char*)Wt_d + ((size_t)e * 1024 + 32 * nb) * 512 + 64 * kb), 512, 32.0f, scr, lane); }
}
struct P0Args { const float *c, *ada_w, *ada_b, *w_in, *w_o, *w_rg, *w_re, *w_gate, *w_up, *w_down; bf16 *Wt_in, *Wt_o, *Wt_gu, *Wt_d; float *Wr, *mod; };
__device__ __forceinline__ void p0_prologue(const P0Args& a, LAS unsigned char* lds, int vcu, int G, int tid, int wave, int lane) {
    LAS float* scr = (LAS float*)(lds + wave * 8448);
    const int gw = vcu * NWAVES + wave, NGW = G * NWAVES;
    constexpr int I_IN = 16 * 96, I_O = 16 * 32, I_GU = 32 * 16 * 32, I_D = 32 * 8 * 32;
    constexpr int NITEMS = I_IN + I_O;
    for (int it = gw; it < NITEMS; it += NGW) {
        int r = it;
        if (r < I_IN) { const int kb = r / 96, nb = r % 96, n0 = 32 * nb, sc = n0 < 1536 ? n0 : n0 + 8;
            const float scale = (n0 < 512 || (n0 >= 1536 && n0 < 2048)) ? C2 : 1.0f;
            tr_item(a.w_in + (size_t)(64 * kb) * IN_COLS + sc, IN_COLS, a.Wt_in + (size_t)n0 * 1024 + 64 * kb, 1024, scale, scr, lane); continue; }
        r -= I_IN;
        { const int kb = r / 32, nb = r % 32;
            tr_item(a.w_o + (size_t)(64 * kb) * 1024 + 32 * nb, 1024, a.Wt_o + (size_t)(32 * nb) * 1024 + 64 * kb, 1024, 1.0f, scr, lane); }
    }
    for (int t = (vcu * NWAVES * 64 + tid); t < 32 * 3 * 2 * 64; t += G * NWAVES * 64) { const int l = t & 63, part = (t >> 6) & 1, ic = t >> 7, c = ic % 3, i = ic / 3, n = 16 * c + (l & 15), k0 = 32 * i + 8 * (l >> 4);
        unsigned short o[8];
#pragma unroll
        for (int j = 0; j < 8; ++j) { const int k = k0 + j; const float w = n < 32 ? a.w_re[k * 32 + n] : (n < 36 ? a.w_rg[k * 4 + (n - 32)] : 0.f);
            const unsigned hi = f2bf(w); const float lo = w - __builtin_bit_cast(float, hi << 16); o[j] = (unsigned short)(part ? f2bf(lo) : hi); }
        v4u pk; pk.x = o[0] | ((unsigned)o[1] << 16); pk.y = o[2] | ((unsigned)o[3] << 16); pk.z = o[4] | ((unsigned)o[5] << 16); pk.w = o[6] | ((unsigned)o[7] << 16);
        *(v4u*)((bf16*)a.Wr + (size_t)t * 8) = pk; }
    for (int t = (vcu * NWAVES * 64 + tid); t < 32 * 2 * 64; t += G * NWAVES * 64) { const int l = t & 63, part = (t >> 6) & 1, i = t >> 7, n = l & 15, k0 = 32 * i + 8 * (l >> 4);
        unsigned short o[8];
#pragma unroll
        for (int j = 0; j < 8; ++j) { const float w = n < 8 ? a.w_in[(size_t)(k0 + j) * IN_COLS + 1536 + n] : 0.f;
            const unsigned hi = f2bf(w); const float lo = w - __builtin_bit_cast(float, hi << 16); o[j] = (unsigned short)(part ? f2bf(lo) : hi); }
        v4u pk; pk.x = o[0] | ((unsigned)o[1] << 16); pk.y = o[2] | ((unsigned)o[3] << 16); pk.z = o[4] | ((unsigned)o[5] << 16); pk.w = o[6] | ((unsigned)o[7] << 16);
        *(v4u*)((bf16*)a.Wr + 131072 + (size_t)t * 8) = pk; }
    __syncthreads();
    LAS float* cs = (LAS float*)(lds + 69632);
    LAS float* red = (LAS float*)(lds + 69632 + 32768);
    for (int i = tid; i < 8192; i += NWAVES * 64) cs[i] = a.c[i];
    __syncthreads();
    for (int ch = vcu; ch < 256; ch += G) {
        const int col = lane % 24, half = lane / 24;
        float acc[8];
#pragma unroll
        for (int b = 0; b < 8; ++b) acc[b] = 0.f;
        if (lane < 48) {
            const int kb = wave * 128 + half * 64;
            const float* wp = a.ada_w + (size_t)kb * 6144 + ch * 24 + col;
#pragma unroll 16
            for (int k = 0; k < 64; ++k) { const float wv = wp[(size_t)k * 6144];
#pragma unroll
                for (int b = 0; b < 8; ++b) acc[b] = fmaf(cs[b * 1024 + kb + k], wv, acc[b]); }
#pragma unroll
            for (int b = 0; b < 8; ++b) red[((wave * 2 + half) * 8 + b) * 24 + col] = acc[b];
        }
        __syncthreads();
        if (tid < 192) { const int b = tid / 24, cl = tid % 24; float s = a.ada_b[ch * 24 + cl];
#pragma unroll
          for (int w = 0; w < 16; ++w) s += red[(w * 8 + b) * 24 + cl];
          a.mod[b * 6144 + ch * 24 + cl] = s; }
        __syncthreads();
    }
}

typedef short p5_bf16x8 __attribute__((ext_vector_type(8)));
__device__ __forceinline__ void p1_norm(const float* __restrict__ x, const float* __restrict__ g1, const float* __restrict__ mod, const bf16* __restrict__ WfzF, const float* __restrict__ b_f,
                                        bf16* __restrict__ H, float* __restrict__ cumloc, float* __restrict__ blktot, LAS unsigned char* lds, int vcu, int G, int tid, int wave, int lane) {
    LAS float* lf = (LAS float*)(lds + 65536); LAS float* segtot = (LAS float*)(lds + 69632);
    for (int i = tid; i < 4096; i += NWAVES * 64) ((LAS v4u*)lds)[i] = ((const v4u*)WfzF)[i];
    __syncthreads();
    for (int rb = vcu; rb < T / 128; rb += G) {
        const int b = rb >> 5;
        { f32x4 A[4], Bc[4];
#pragma unroll
          for (int j = 0; j < 4; ++j) { const int col = 256 * j + 4 * lane; const f32x4 g = *(const f32x4*)(g1 + col), sc = *(const f32x4*)(mod + b * 6144 + 1024 + col);
            A[j] = g * (1.0f + sc); Bc[j] = *(const f32x4*)(mod + b * 6144 + col); }
          f32x4 XB[3][4];
          const int row0 = rb * 128 + wave * 16;
#define P1_ISS(i) { const f32x4* xr = (const f32x4*)(x + (size_t)(row0 + (i)) * D) + lane; _Pragma("unroll") for (int j = 0; j < 4; ++j) XB[(i) % 3][j] = xr[64 * j]; }
#pragma unroll
          for (int rr = 0; rr < 16; ++rr) {
            if (rr == 0) { P1_ISS(0) P1_ISS(1) P1_ISS(2) __builtin_amdgcn_sched_barrier(0); }
            float s = 0.f;
#pragma unroll
            for (int j = 0; j < 4; ++j) { const f32x4 v = XB[rr % 3][j]; s += (v.x * v.x + v.y * v.y) + (v.z * v.z + v.w * v.w); }
            const float rstd = 1.0f / sqrtf(wave_sum(s) * (1.0f / D) + 1e-6f);
            v2u* o8 = (v2u*)(H + (size_t)(row0 + rr) * D) + lane;
#pragma unroll
            for (int j = 0; j < 4; ++j) { const f32x4 h = XB[rr % 3][j] * rstd * A[j] + Bc[j]; v2u w; w.x = pk2(h.x, h.y); w.y = pk2(h.z, h.w); o8[64 * j] = w; }
            __builtin_amdgcn_sched_barrier(0);
            if (rr + 3 < 16) { P1_ISS(rr + 3) __builtin_amdgcn_sched_barrier(0); }
          } }
#undef P1_ISS
        VM_WAIT();
        f32x4 acc = (f32x4){0.f, 0.f, 0.f, 0.f};
        { const bf16* ap = H + (size_t)(rb * 128 + wave * 16 + (lane & 15)) * D + 8 * (lane >> 4);
          const LAS p5_bf16x8* bp = (const LAS p5_bf16x8*)lds + lane;
#pragma unroll 8
          for (int i = 0; i < 32; ++i) {
            const p5_bf16x8 af = *(const p5_bf16x8*)(ap + 32 * i);
            acc = __builtin_amdgcn_mfma_f32_16x16x32_bf16(af, bp[(i * 2 + 0) * 64], acc, 0, 0, 0);
            acc = __builtin_amdgcn_mfma_f32_16x16x32_bf16(af, bp[(i * 2 + 1) * 64], acc, 0, 0, 0); } }
        if ((lane & 15) < 8) { const float bfv = b_f[lane & 15];
#pragma unroll
            for (int r = 0; r < 4; ++r) { const float z = acc[r] + bfv; lf[(wave * 16 + 4 * (lane >> 4) + r) * 8 + (lane & 15)] = fminf(z, 0.f) - log1pf(expf(-fabsf(z))); } }
        __syncthreads();
        float run[16]; const int hh = tid & 7, seg = (tid >> 3) & 7;
        if (tid < 64) { float s = 0.f;
#pragma unroll
            for (int i = 0; i < 16; ++i) { s += lf[(seg * 16 + i) * 8 + hh]; run[i] = s; }
            segtot[seg * 8 + hh] = s; }
        __syncthreads();
        if (tid < 64) { float off = 0.f;
            for (int s2 = 0; s2 < seg; ++s2) off += segtot[s2 * 8 + hh];
            float* cp = cumloc + (size_t)(b * 8 + hh) * SEQ + (rb & 31) * 128 + seg * 16;
            const float NL2E = -1.4426950408889634f;
#pragma unroll
            for (int i = 0; i < 4; ++i) { f32x4 t; t.x = (run[4 * i] + off) * NL2E; t.y = (run[4 * i + 1] + off) * NL2E; t.z = (run[4 * i + 2] + off) * NL2E; t.w = (run[4 * i + 3] + off) * NL2E; *(f32x4*)(cp + 4 * i) = t; }
            if (seg == 7) blktot[rb * 8 + hh] = (run[15] + off) * NL2E; }
        __syncthreads();
    }
}

__device__ __forceinline__ void p5_route(const bf16* __restrict__ x1, const float* __restrict__ g2, const float* __restrict__ mod, const bf16* __restrict__ WrF, const float* __restrict__ b_rg, const float* __restrict__ b_re,
                                         bf16* __restrict__ H2, unsigned char* __restrict__ H2F8, gu32* cnt, int* __restrict__ stok, int* __restrict__ rt_e, int* __restrict__ rt_pos, float* __restrict__ rt_w,
                                         LAS unsigned char* lds, int vcu, int G, int tid, int wave, int lane) {
    LAS unsigned* CNT = (LAS unsigned*)lds; LAS unsigned* BASE = (LAS unsigned*)(lds + 128); LAS unsigned* REC = (LAS unsigned*)(lds + 256); LAS float* LG = (LAS float*)(lds + 4352 + wave * 3072);
    if (tid < 32) CNT[tid] = 0u;
    __syncthreads();
    for (int rb = vcu; rb < T / 128; rb += G) {
        const int b = rb >> 5;
        { f32x4 A[4], Bc[4];
#pragma unroll
          for (int j = 0; j < 4; ++j) { const int col = 256 * j + 4 * lane; const f32x4 g = *(const f32x4*)(g2 + col), sc = *(const f32x4*)(mod + b * 6144 + 4096 + col);
            A[j] = g * (1.0f + sc); Bc[j] = *(const f32x4*)(mod + b * 6144 + 3072 + col); }
          v2u XB[4][4];
          const int row0 = rb * 128 + wave * 16;
#define P5_ISS(i) { const v2u* xr = (const v2u*)(x1 + (size_t)(row0 + (i)) * D) + lane; _Pragma("unroll") for (int j = 0; j < 4; ++j) XB[(i) % 4][j] = xr[64 * j]; }
#pragma unroll
          for (int rr = 0; rr < 16; ++rr) {
            if (rr == 0) { P5_ISS(0) P5_ISS(1) P5_ISS(2) P5_ISS(3) __builtin_amdgcn_sched_barrier(0); }
            f32x4 v[4]; float s = 0.f;
#pragma unroll
            for (int j = 0; j < 4; ++j) { const v2u xw = XB[rr % 4][j]; v[j].x = bflo(xw.x); v[j].y = bfhi(xw.x); v[j].z = bflo(xw.y); v[j].w = bfhi(xw.y); s += (v[j].x * v[j].x + v[j].y * v[j].y) + (v[j].z * v[j].z + v[j].w * v[j].w); }
            const float rstd = 1.0f / sqrtf(wave_sum(s) * (1.0f / D) + 1e-6f);
            v2u* o8 = (v2u*)(H2 + (size_t)(row0 + rr) * D) + lane;
            unsigned* o4 = (unsigned*)(H2F8 + (size_t)(row0 + rr) * D) + lane;
#pragma unroll
            for (int j = 0; j < 4; ++j) { const f32x4 h = v[j] * rstd * A[j] + Bc[j]; v2u w; w.x = pk2(h.x, h.y); w.y = pk2(h.z, h.w); o8[64 * j] = w;
                int t = 0; t = __builtin_amdgcn_cvt_pk_fp8_f32(h.x, h.y, t, false); t = __builtin_amdgcn_cvt_pk_fp8_f32(h.z, h.w, t, true); o4[64 * j] = (unsigned)t; }
            __builtin_amdgcn_sched_barrier(0);
            if (rr + 4 < 16) { P5_ISS(rr + 4) __builtin_amdgcn_sched_barrier(0); }
          } }
#undef P5_ISS
        VM_WAIT();
        f32x4 acc[3];
#pragma unroll
        for (int c = 0; c < 3; ++c) acc[c] = (f32x4){0.f, 0.f, 0.f, 0.f};
        { const bf16* ap = H2 + (size_t)(rb * 128 + wave * 16 + (lane & 15)) * D + 8 * (lane >> 4);
          const bf16* bp = WrF + lane * 8;
#pragma unroll 4
          for (int i = 0; i < 32; ++i) {
            const p5_bf16x8 af = *(const p5_bf16x8*)(ap + 32 * i);
#pragma unroll
            for (int c = 0; c < 3; ++c) {
                const p5_bf16x8 bh = *(const p5_bf16x8*)(bp + ((i * 3 + c) * 2 + 0) * 512), bl = *(const p5_bf16x8*)(bp + ((i * 3 + c) * 2 + 1) * 512);
                acc[c] = __builtin_amdgcn_mfma_f32_16x16x32_bf16(af, bh, acc[c], 0, 0, 0);
                acc[c] = __builtin_amdgcn_mfma_f32_16x16x32_bf16(af, bl, acc[c], 0, 0, 0); }
          } }
#pragma unroll
        for (int c = 0; c < 3; ++c)
#pragma unroll
            for (int r = 0; r < 4; ++r) LG[(4 * (lane >> 4) + r) * 48 + 16 * c + (lane & 15)] = acc[c][r];
        LDS_WAIT();
        if (lane < 16) {
            const LAS float* L = LG + lane * 48;
            float gl[4];
#pragma unroll
            for (int i = 0; i < 4; ++i) gl[i] = L[32 + i] + b_rg[i];
            int g = 0; float gm = gl[0];
#pragma unroll
            for (int i = 1; i < 4; ++i) if (gl[i] > gm) { gm = gl[i]; g = i; }
            float gs = 0.f;
#pragma unroll
            for (int i = 0; i < 4; ++i) gs += expf(gl[i] - gm);
            const float pg = 1.0f / gs;
            float el[8];
#pragma unroll
            for (int i = 0; i < 8; ++i) el[i] = L[g * 8 + i] + b_re[g * 8 + i];
            int i1 = 0; float m1 = el[0];
#pragma unroll
            for (int i = 1; i < 8; ++i) if (el[i] > m1) { m1 = el[i]; i1 = i; }
            int i2 = -1; float m2 = -3.0e38f;
#pragma unroll
            for (int i = 0; i < 8; ++i) if (i != i1 && el[i] > m2) { m2 = el[i]; i2 = i; }
            const float ex = expf(m2 - m1); const float w1 = pg / (1.0f + ex), w2 = pg * ex / (1.0f + ex);
            const int e1 = g * 8 + i1, e2 = g * 8 + i2, rl = wave * 16 + lane;
            const unsigned p1 = __hip_atomic_fetch_add(&CNT[e1], 1u, __ATOMIC_RELAXED, __HIP_MEMORY_SCOPE_WORKGROUP), p2 = __hip_atomic_fetch_add(&CNT[e2], 1u, __ATOMIC_RELAXED, __HIP_MEMORY_SCOPE_WORKGROUP);
            REC[(rl * 2 + 0) * 4 + 0] = (unsigned)e1; REC[(rl * 2 + 0) * 4 + 1] = p1; REC[(rl * 2 + 0) * 4 + 2] = __float_as_uint(w1);
            REC[(rl * 2 + 1) * 4 + 0] = (unsigned)e2; REC[(rl * 2 + 1) * 4 + 1] = p2; REC[(rl * 2 + 1) * 4 + 2] = __float_as_uint(w2);
        }
        __syncthreads();
        if (tid < 32) BASE[tid] = __hip_atomic_fetch_add(cnt + 64 * tid, CNT[tid], RLX_AGENT);
        __syncthreads();
        if (tid < 256) { const unsigned e = REC[tid * 4 + 0], pl = REC[tid * 4 + 1], wb = REC[tid * 4 + 2]; const unsigned pos = BASE[e] + pl; const int tok = rb * 128 + (tid >> 1);
            stok[(size_t)e * 65536 + pos] = tok; rt_e[tok * 2 + (tid & 1)] = (int)e; rt_pos[tok * 2 + (tid & 1)] = (int)pos; rt_w[tok * 2 + (tid & 1)] = __uint_as_float(wb); }
        __syncthreads();
        if (tid < 32) CNT[tid] = 0u;
        __syncthreads();
    }
}

__device__ __forceinline__ void moe_tables(gu32* cnt, LAS int* TB, LAS int* CN, int tid) {
    if (tid < 64) {
        const int e = tid & 31; const int c = (int)__hip_atomic_load(cnt + 64 * e, RLX_AGENT); const int nt = (c + 255) >> 8; int v = nt;
#pragma unroll
        for (int off = 1; off < 32; off <<= 1) { const int t = __builtin_amdgcn_ds_bpermute(((tid - off) & 63) << 2, v); v += (e >= off) ? t : 0; }
        if (tid < 32) { CN[e] = c; TB[e] = v - nt; if (e == 31) TB[32] = v; } }
    __syncthreads();
}
struct MoeOrder {
    const LAS int* TB; const LAS int* CN; const int* stok; int G, c; bool gather;
    __device__ __forceinline__ bool next(int i, pg8::Unit& u) const {
        const int L = i * G + c; if (L >= 4 * TB[32]) return false;
        const int gt = L >> 2, ct = L & 3; int e = 0;
        for (int k = 1; k < 32; ++k) e += (gt >= TB[k]) ? 1 : 0;
        u.pm = gt; u.pn = e * 4 + ct; u.e = e; return true;
    }
    __device__ __forceinline__ void a_off(const pg8::Unit& u, const int (&RA)[2], const int (&CA)[2], int KB  , unsigned (&off)[2][2]) const {
        if (gather) {
            const int p0 = (u.pm - TB[u.e]) * 256, n = CN[u.e];
#pragma unroll
            for (int h = 0; h < 2; ++h)
#pragma unroll
                for (int i = 0; i < 2; ++i) { const int pos = p0 + h * 128 + RA[i]; const int tok = pos < n ? stok[(size_t)u.e * 65536 + pos] : 0;
                    off[h][i] = (unsigned)((size_t)tok * KB + CA[i] * 2); }
            __builtin_amdgcn_s_waitcnt(0x0F70);
        } else {
#pragma unroll
            for (int h = 0; h < 2; ++h)
#pragma unroll
                for (int i = 0; i < 2; ++i) off[h][i] = (unsigned)((size_t)(u.pm * 256 + h * 128 + RA[i]) * KB + CA[i] * 2);
        }
    }
};

__device__ __forceinline__ void p8_final(const bf16* __restrict__ x1, float* __restrict__ xo, const bf16* __restrict__ Y, const float* __restrict__ mod, const float* __restrict__ gf,
                                         const int* __restrict__ rt_e, const int* __restrict__ rt_pos, const float* __restrict__ rt_w, const LAS int* TB,
                                         int vcu, int G, int wave, int lane) {
    const int gw = vcu * NWAVES + wave, NGW = G * NWAVES;
    f32x4 gfv[4];
#pragma unroll
    for (int j = 0; j < 4; ++j) gfv[j] = *(const f32x4*)(gf + 256 * j + 4 * lane);
    if (NGW == 2048) {
        int s0v, s1v; float w0v, w1v;
        { const int r = gw + (lane & 15) * 2048; const int e0 = rt_e[r * 2], e1 = rt_e[r * 2 + 1];
          s0v = TB[e0] * 256 + rt_pos[r * 2]; s1v = TB[e1] * 256 + rt_pos[r * 2 + 1]; w0v = 0.125f * rt_w[r * 2]; w1v = 0.125f * rt_w[r * 2 + 1]; }
        v2u XB[3][4]; unsigned YA[3][4], YC[3][4]; f32x4 g2v[4];
#define P8_ISS(i) { const int s0 = __builtin_amdgcn_readlane(s0v, (i)), s1 = __builtin_amdgcn_readlane(s1v, (i)); const v2u* x1r = (const v2u*)(x1 + (size_t)(gw + (i) * 2048) * D) + lane; \
            const unsigned* y0 = (const unsigned*)((const unsigned char*)Y + (size_t)s0 * D) + lane; const unsigned* y1 = (const unsigned*)((const unsigned char*)Y + (size_t)s1 * D) + lane; \
            _Pragma("unroll") for (int j = 0; j < 4; ++j) { XB[(i) % 3][j] = x1r[64 * j]; YA[(i) % 3][j] = y0[64 * j]; YC[(i) % 3][j] = y1[64 * j]; } }
#pragma unroll
        for (int i = 0; i < 16; ++i) {
            if (i == 0) { P8_ISS(0) P8_ISS(1) P8_ISS(2) __builtin_amdgcn_sched_barrier(0); }
            if ((i & 1) == 0) {
#pragma unroll
                for (int j = 0; j < 4; ++j) g2v[j] = *(const f32x4*)(mod + (i >> 1) * 6144 + 5120 + 256 * j + 4 * lane); }
            const float w0 = __uint_as_float((unsigned)__builtin_amdgcn_readlane((int)__float_as_uint(w0v), i)), w1 = __uint_as_float((unsigned)__builtin_amdgcn_readlane((int)__float_as_uint(w1v), i));
            f32x4* xr = (f32x4*)(xo + (size_t)(gw + i * 2048) * D) + lane;
            f32x4 v[4]; float s = 0.f;
#pragma unroll
            for (int j = 0; j < 4; ++j) { const v2u xw = XB[i % 3][j]; f32x4 xv; xv.x = bflo(xw.x); xv.y = bfhi(xw.x); xv.z = bflo(xw.y); xv.w = bfhi(xw.y); const unsigned a = YA[i % 3][j], c = YC[i % 3][j];
                const auto a01 = __builtin_amdgcn_cvt_pk_f32_fp8(a, false), a23 = __builtin_amdgcn_cvt_pk_f32_fp8(a, true), c01 = __builtin_amdgcn_cvt_pk_f32_fp8(c, false), c23 = __builtin_amdgcn_cvt_pk_f32_fp8(c, true);
                f32x4 y; y.x = w0 * a01[0] + w1 * c01[0]; y.y = w0 * a01[1] + w1 * c01[1]; y.z = w0 * a23[0] + w1 * c23[0]; y.w = w0 * a23[1] + w1 * c23[1];
                v[j] = xv + g2v[j] * y; s += (v[j].x * v[j].x + v[j].y * v[j].y) + (v[j].z * v[j].z + v[j].w * v[j].w); }
            const float rstd = 1.0f / sqrtf(wave_sum(s) * (1.0f / D) + 1e-6f);
#pragma unroll
            for (int j = 0; j < 4; ++j) xr[64 * j] = v[j] * rstd * gfv[j];
            __builtin_amdgcn_sched_barrier(0);
            if (i + 3 < 16) { P8_ISS(i + 3) __builtin_amdgcn_sched_barrier(0); }
        }
#undef P8_ISS
        return;
    }
#pragma unroll 2
    for (int row = gw; row < T; row += NGW) {
        const int b = row >> 12;
        const int e0 = rt_e[row * 2], e1 = rt_e[row * 2 + 1]; const int s0 = TB[e0] * 256 + rt_pos[row * 2], s1 = TB[e1] * 256 + rt_pos[row * 2 + 1];
        const float w0 = 0.125f * rt_w[row * 2], w1 = 0.125f * rt_w[row * 2 + 1];
        f32x4* xr = (f32x4*)(xo + (size_t)row * D) + lane; const v2u* x1r = (const v2u*)(x1 + (size_t)row * D) + lane;
        const unsigned* y0 = (const unsigned*)((const unsigned char*)Y + (size_t)s0 * D) + lane; const unsigned* y1 = (const unsigned*)((const unsigned char*)Y + (size_t)s1 * D) + lane;
        f32x4 v[4]; float s = 0.f;
#pragma unroll
        for (int j = 0; j < 4; ++j) { const v2u xw = x1r[64 * j]; f32x4 xv; xv.x = bflo(xw.x); xv.y = bfhi(xw.x); xv.z = bflo(xw.y); xv.w = bfhi(xw.y); const unsigned a = y0[64 * j], c = y1[64 * j]; const f32x4 g2 = *(const f32x4*)(mod + b * 6144 + 5120 + 256 * j + 4 * lane);
            const auto a01 = __builtin_amdgcn_cvt_pk_f32_fp8(a, false), a23 = __builtin_amdgcn_cvt_pk_f32_fp8(a, true), c01 = __builtin_amdgcn_cvt_pk_f32_fp8(c, false), c23 = __builtin_amdgcn_cvt_pk_f32_fp8(c, true);
            f32x4 y; y.x = w0 * a01[0] + w1 * c01[0]; y.y = w0 * a01[1] + w1 * c01[1]; y.z = w0 * a23[0] + w1 * c23[0]; y.w = w0 * a23[1] + w1 * c23[1];
            v[j] = xv + g2 * y; s += (v[j].x * v[j].x + v[j].y * v[j].y) + (v[j].z * v[j].z + v[j].w * v[j].w); }
        const float rstd = 1.0f / sqrtf(wave_sum(s) * (1.0f / D) + 1e-6f);
#pragma unroll
        for (int j = 0; j < 4; ++j) xr[64 * j] = v[j] * rstd * gfv[j];
    }
}

constexpr int ATT_NU = 256;
__device__ const unsigned short ATT_ORDER[256] = {127, 126, 125, 512, 124, 123, 122, 513, 121, 120, 119, 514, 118, 85, 86, 515, 87, 88, 89, 516, 90, 91, 92, 517, 93, 94, 95, 518, 117, 84, 116, 519, 83, 115, 259, 520, 260, 261, 262, 521, 263, 291, 292, 522, 293, 294, 295, 523, 323, 324, 325, 524, 326, 327, 355, 525, 356, 357, 358, 526, 359, 387, 388, 527, 389, 390, 391, 528, 419, 420, 421, 529, 422, 423, 451, 530, 452, 453, 454, 531, 455, 483, 484, 532, 485, 486, 487, 533, 82, 114, 81, 534, 113, 80, 112, 535, 79, 111, 258, 536, 290, 322, 354, 537, 386, 418, 450, 538, 482, 78, 110, 539, 77, 109, 76, 540, 108, 75, 107, 541, 74, 106, 73, 542, 105, 257, 289, 543, 321, 353, 385, 544, 417, 449, 481, 545, 72, 104, 71, 546, 103, 38, 39, 547, 40, 41, 42, 548, 43, 44, 45, 549, 46, 47, 48, 550, 49, 50, 51, 551, 52, 53, 54, 552, 55, 56, 57, 553, 58, 59, 60, 554, 61, 62, 63, 555, 70, 102, 37, 556, 69, 101, 36, 557, 68, 100, 256, 558, 288, 320, 352, 559, 384, 416, 448, 560, 480, 35, 67, 561, 99, 34, 66, 562, 98, 2, 3, 563, 4, 5, 6, 564, 7, 8, 9, 565, 10, 11, 12, 566, 13, 14, 15, 567, 16, 17, 18, 568, 19, 20, 21, 569, 22, 23, 24, 570, 25, 26, 27, 571, 28, 29, 30, 572, 31, 1, 33, 573, 65, 97, 0, 574, 32, 64, 96, 575};
struct Args { const float* in[22]; float* out; unsigned char* ws; int ph_lo, ph_hi; };
typedef __attribute__((address_space(4))) const unsigned long long cu64;
__device__ __forceinline__ cu64* karg() { cu64* p = (cu64*)__builtin_amdgcn_kernarg_segment_ptr(); asm volatile("" : "+s"(p)); return p; }
#define KA_IN(ka, i) ((const float*)(ka)[i])
#define KA_OUT(ka) ((float*)(ka)[22])
#define KA_WS(ka) ((unsigned char*)(ka)[23])
__global__ void __launch_bounds__(NWAVES * 64, 2) fwd_kernel(Args args) {
    extern __shared__ __attribute__((aligned(16))) unsigned char lds_raw[];
    LAS unsigned char* lds = (LAS unsigned char*)lds_raw;
    volatile LAS unsigned* MISC = (volatile LAS unsigned*)(lds + MISC_OFF);
    const int wave = __builtin_amdgcn_readfirstlane((int)threadIdx.x >> 6);
    const int G = gridDim.x; const int bx = blockIdx.x; const int vcu = (G % 8 == 0) ? (bx % 8) * (G / 8) + bx / 8 : bx;
    if (wave == 0) MISC[fresh_lane()] = 0u;
    __syncthreads();
    XcdBarrier bar = xcd_barrier_post((unsigned*)((gu32*)(args.ws + WS_CTL) + CW_BAR), MISC + 8); bar.wave = wave;
    const int lo = args.ph_lo, hi = args.ph_hi;
    unsigned long long prof_acc = 0;
#ifndef PHASE_MASK
#define PHASE_MASK 0x1ff
#endif
#define IN(k) ((((PHASE_MASK) >> (k)) & 1) && lo <= (k) && (k) < hi)
#define SEAM(k) do { if (IN(k) && IN((k) + 1)) { unsigned long long t0_ = 0; if (PROF_ID == 30 + (k)) t0_ = __builtin_amdgcn_s_memrealtime(); xcd_barrier(bar); if (PROF_ID == 30 + (k)) prof_acc += __builtin_amdgcn_s_memrealtime() - t0_; } } while (0)
#define PH_T0(k) unsigned long long pht0_##k = 0; if (PROF_ID == 20 + (k)) pht0_##k = __builtin_amdgcn_s_memrealtime()
#define PH_T1(k) do { if (PROF_ID == 20 + (k)) prof_acc += __builtin_amdgcn_s_memrealtime() - pht0_##k; } while (0)
#ifndef PROBE_PHASE
#define PROBE_PHASE -1
#endif
#define REP(k) _Pragma("unroll 1") for (int rep_ = 0; rep_ < ((PROBE_PHASE) == (k) ? 2 : 1); ++rep_)

    PH_T0(0);
    if (IN(0)) REP(0) {
        cu64* ka = karg(); unsigned char* ws = KA_WS(ka);
        P0Args a{KA_IN(ka, 1), KA_IN(ka, 2), KA_IN(ka, 3), KA_IN(ka, 5), KA_IN(ka, 12), KA_IN(ka, 14), KA_IN(ka, 16), KA_IN(ka, 18), KA_IN(ka, 19), KA_IN(ka, 20),
                 (bf16*)(ws + WS_WIN), (bf16*)(ws + WS_WO), (bf16*)(ws + WS_WGU), (bf16*)(ws + WS_WD), (float*)(ws + WS_WR), (float*)(ws + WS_MOD)};
        const int lane = fresh_lane(), tid = wave * 64 + lane; p0_prologue(a, lds, vcu, G, tid, wave, lane);
    }
    PH_T1(0);
    SEAM(0);
    PH_T0(1);
    if (IN(1)) REP(1) { cu64* ka = karg(); unsigned char* ws = KA_WS(ka); const int lane = fresh_lane(), tid = wave * 64 + lane;
        p1_norm(KA_IN(ka, 0), KA_IN(ka, 4), (const float*)(ws + WS_MOD), (const bf16*)(ws + WS_WR) + 131072, KA_IN(ka, 6), (bf16*)(ws + WS_H), (float*)(ws + WS_CUM), (float*)(ws + WS_BLK), lds, vcu, G, tid, wave, lane); }
    PH_T1(1);
    SEAM(1);
#define P2BODY { cu64* ka = karg(); unsigned char* ws = KA_WS(ka); pg8::Gemm g{(const bf16*)(ws + WS_H), (const bf16*)(ws + WS_WIN), T, NQKV, D}; pg8::StaticOrder S; S.init(T, NQKV, G, bx); \
        pg8::EpiStore E{(bf16*)(ws + WS_QKV), NQKV, 0xffff, (unsigned*)(ws + WS_CTL) + CW_KM}; \
        pg8::gemm_phase<pg8::EpiStore, pg8::StaticOrder, true, true>(lds, g, S, E, wave); }
    PH_T0(2);
    if (IN(2)) { P2BODY if (PROBE_PHASE == 2) P2BODY }
    PH_T1(2);
    SEAM(2);
    PH_T0(3);
    if (IN(3)) REP(3) {
        float lam;
        { cu64* ka = karg(); const float* lq1 = KA_IN(ka, 7); const float* lk1 = KA_IN(ka, 8); const float* lq2 = KA_IN(ka, 9); const float* lk2 = KA_IN(ka, 10);
          const int lane = fresh_lane(); const float a = wave_sum(lq1[lane] * lk1[lane]), b2 = wave_sum(lq2[lane] * lk2[lane]); lam = expf(a) - expf(b2) + LAM_INIT; }
        volatile LAS int* QSLOT = (volatile LAS int*)(lds + MISC_OFF + 64);
        const int xq0 = (G >= 8) ? (vcu * 8) / G : 0;
#pragma unroll 1
        for (int qi = 0; qi < 8; ++qi) {
            const int xq = (xq0 + qi) & 7;
#pragma unroll 1
            for (;;) {
                cu64* ka = karg(); unsigned char* ws = KA_WS(ka);
                if (wave == 0 && fresh_lane() == 0) QSLOT[0] = (int)__hip_atomic_fetch_add((gu32*)(ws + WS_CTL) + CW_QH + 64 * xq, 1u, RLX_AGENT);
                __syncthreads();
                const int idx = __builtin_amdgcn_readfirstlane(QSLOT[0]);
                __syncthreads();
                if (idx >= ATT_NU) break;
                const int u = ATT_ORDER[idx], h = (u >> 5) & 7, qb = u & 31;
                if ((u >> 8) == 2) {
                    LAS float* scr = (LAS float*)(lds + wave * 8448); const int lane_ = fresh_lane(); const int it0 = (xq * 64 + (u & 255)) * XI_PER_UNIT + wave * 6;
#pragma unroll 1
                    for (int k = 0; k < 6; ++k) expert_item(KA_IN(ka, 18), KA_IN(ka, 19), KA_IN(ka, 20), (bf16*)(ws + WS_WGU), (bf16*)(ws + WS_WD), it0 + k, scr, lane_);
                    __syncthreads();
                } else
                if ((u >> 8) == 0) { PROF_BEGIN(1); att::diff_unit(lds, (const bf16*)(ws + WS_QKV), (bf16*)(ws + WS_H), KA_IN(ka, 11), lam, (const unsigned*)(ws + WS_CTL) + CW_KM, xq, h, qb, wave, prof_acc); PROF_END(1, prof_acc); }
                else { PROF_BEGIN(2); att::fox2_unit(lds, (const bf16*)(ws + WS_QKV), (bf16*)(ws + WS_H), (const float*)(ws + WS_CUM), (const float*)(ws + WS_BLK), (const unsigned*)(ws + WS_CTL) + CW_KM, xq, h, qb, wave, prof_acc); PROF_END(2, prof_acc); }
            }
        }
    }
    PH_T1(3);
    SEAM(3);
#define P4BODY { cu64* ka = karg(); unsigned char* ws = KA_WS(ka); pg8::Gemm g{(const bf16*)(ws + WS_H), (const bf16*)(ws + WS_WO), T, D, D}; pg8::StaticOrder S; S.init(T, D, G, bx); \
        pg8::EpiResid E{KA_IN(ka, 0), (bf16*)(ws + WS_X1), (const float*)(ws + WS_MOD) + 2048}; \
        pg8::gemm_phase<pg8::EpiResid, pg8::StaticOrder, true, true>(lds, g, S, E, wave); }
    PH_T0(4);
    if (IN(4)) { P4BODY if (PROBE_PHASE == 4) P4BODY }
    PH_T1(4);
    SEAM(4);
    PH_T0(5);
    if (IN(5)) { cu64* ka = karg(); unsigned char* ws = KA_WS(ka); int* rt_e = (int*)(ws + WS_RT); const int lane = fresh_lane(), tid = wave * 64 + lane;
        p5_route((const bf16*)(ws + WS_X1), KA_IN(ka, 13), (const float*)(ws + WS_MOD), (const bf16*)(ws + WS_WR), KA_IN(ka, 15), KA_IN(ka, 17), (bf16*)(ws + WS_H), ws + WS_H2F8, (gu32*)(ws + WS_CTL) + CW_CNT, (int*)(ws + WS_STOK),
                 rt_e, rt_e + 2 * T, (float*)(rt_e + 4 * T), lds, vcu, G, tid, wave, lane); }
    PH_T1(5);
    SEAM(5);
    LAS int* TB = (LAS int*)(lds + 131072); LAS int* CN = (LAS int*)(lds + 131072 + 256);
#define P6BODY { cu64* ka = karg(); unsigned char* ws = KA_WS(ka); moe_tables((gu32*)(ws + WS_CTL) + CW_CNT, TB, CN, wave * 64 + fresh_lane()); pg8::Gemm g{(const bf16*)(ws + WS_H2F8), (const bf16*)(ws + WS_WGU), T, 1024, D}; \
        MoeOrder S{TB, CN, (const int*)(ws + WS_STOK), G, bx, true}; pg8::EpiSwigluF8 E{ws + WS_HID}; \
        pg8::gemm_phase<pg8::EpiSwigluF8, MoeOrder, true, true, true>(lds, g, S, E, wave); }
    PH_T0(6);
    if (IN(6)) { P6BODY if (PROBE_PHASE == 6) P6BODY }
    PH_T1(6);
    SEAM(6);
#define P7BODY { cu64* ka = karg(); unsigned char* ws = KA_WS(ka); moe_tables((gu32*)(ws + WS_CTL) + CW_CNT, TB, CN, wave * 64 + fresh_lane()); pg8::Gemm g{(const bf16*)(ws + WS_HID), (const bf16*)(ws + WS_WD), NSLOT_MAX, 1024, DEXP}; \
        MoeOrder S{TB, CN, (const int*)(ws + WS_STOK), G, bx, false}; pg8::EpiStoreF8 E{ws + WS_Y}; \
        pg8::gemm_phase<pg8::EpiStoreF8, MoeOrder, true, true, true>(lds, g, S, E, wave); }
    PH_T0(7);
    if (IN(7)) { P7BODY if (PROBE_PHASE == 7) P7BODY }
    PH_T1(7);
    SEAM(7);
    PH_T0(8);
    if (IN(8)) { cu64* ka = karg(); unsigned char* ws = KA_WS(ka); int* rt_e = (int*)(ws + WS_RT);
        moe_tables((gu32*)(ws + WS_CTL) + CW_CNT, TB, CN, wave * 64 + fresh_lane());
        p8_final((const bf16*)(ws + WS_X1), KA_OUT(ka), (const bf16*)(ws + WS_Y), (const float*)(ws + WS_MOD), KA_IN(ka, 21), rt_e, rt_e + 2 * T, (const float*)(rt_e + 4 * T), TB, vcu, G, wave, fresh_lane());
    }
    PH_T1(8);
    if (PROF_ID != 0) { const unsigned long long t0_ = __builtin_amdgcn_s_memrealtime(); while (__builtin_amdgcn_s_memrealtime() - t0_ < prof_acc) __builtin_amdgcn_s_sleep(8); }
#undef IN
#undef SEAM
}

#ifndef MK_N_LAUNCHES
#define MK_N_LAUNCHES 1
#endif
extern "C" void kernel_launch(void* const* d_in, const int* in_sizes, int n_in, void* d_out, int out_size, void* d_ws, size_t ws_size, hipStream_t stream) {
    static int grid = 0;
    if (grid == 0) {
        if (n_in != 22 || in_sizes[0] != T * D || out_size != T * D || ws_size < WS_END) { fprintf(stderr, "kernel_launch: shape/workspace mismatch (n_in %d, in0 %d, out %d, ws %zu, need %zu)\n", n_in, n_in > 0 ? in_sizes[0] : -1, out_size, ws_size, (size_t)WS_END); grid = -1; return; }
        int dev = 0, cus = 0, per_cu = 0;
        if (hipGetDevice(&dev) != hipSuccess || hipDeviceGetAttribute(&cus, hipDeviceAttributeMultiprocessorCount, dev) != hipSuccess) { grid = -1; return; }
        if (hipFuncSetAttribute((const void*)fwd_kernel, hipFuncAttributeMaxDynamicSharedMemorySize, LDS_BYTES) != hipSuccess) { fprintf(stderr, "kernel_launch: hipFuncSetAttribute failed\n"); grid = -1; return; }
        if (hipOccupancyMaxActiveBlocksPerMultiprocessor(&per_cu, (const void*)fwd_kernel, NWAVES * 64, LDS_BYTES) != hipSuccess || per_cu < 1) fprintf(stderr, "kernel_launch: occupancy query reports %d\n", per_cu);
        (void)hipGetLastError();
        grid = cus > 0 ? cus : 256;
    }
    if (grid < 0) return;
    (void)hipMemsetAsync((char*)d_ws + WS_CTL, 0, CTL_ZERO_BYTES, stream);
    Args a{};
    for (int i = 0; i < 22; ++i) a.in[i] = (const float*)d_in[i];
    a.out = (float*)d_out; a.ws = (unsigned char*)d_ws;
    if (MK_N_LAUNCHES == 1) { a.ph_lo = 0; a.ph_hi = NPH; hipLaunchKernelGGL(fwd_kernel, dim3(grid), dim3(NWAVES * 64), LDS_BYTES, stream, a); }
    else for (int p = 0; p < NPH; ++p) { a.ph_lo = p; a.ph_hi = p + 1; hipLaunchKernelGGL(fwd_kernel, dim3(grid), dim3(NWAVES * 64), LDS_BYTES, stream, a); }
    const hipError_t le = hipPeekAtLastError();
    if (le != hipSuccess) fprintf(stderr, "kernel_launch: launch failed: %s\n", hipGetErrorName(le));
}
```

```cpp
#include <hip/hip_runtime.h>
#include <hip/hip_bf16.h>
#include <cstdio>
#include <cstdint>

__device__ __forceinline__ int fresh_lane() { int l; asm volatile("v_mbcnt_lo_u32_b32 %0, -1, 0\n\tv_mbcnt_hi_u32_b32 %0, -1, %0" : "=v"(l)); return l; }
template <int M> __device__ __forceinline__ float lx_get(float v) {
    static_assert(M == 1 || M == 2 || M == 4 || M == 8 || M == 16, "lx_get: M");
    return __builtin_bit_cast(float, __builtin_amdgcn_ds_swizzle(__builtin_bit_cast(int, v), (M << 10) | 0x1f));
}
__device__ __forceinline__ void swap32(float v, float& lo, float& hi) { const unsigned a = __float_as_uint(v);
    auto rr = __builtin_amdgcn_permlane32_swap(a, a, false, false); const unsigned r0 = rr[0], r1 = rr[1]; lo = __uint_as_float(r0); hi = __uint_as_float(r1); }
__device__ __forceinline__ float lx_sum32(float v) { float lo, hi; swap32(v, lo, hi); return lo + hi; }
__device__ __forceinline__ float lx_max32(float v) { float lo, hi; swap32(v, lo, hi); return fmaxf(lo, hi); }
#ifndef PROF_ID
#define PROF_ID 0
#endif
#define PROF_BEGIN(id) unsigned long long prof_t0_##id = 0; if (PROF_ID == (id)) prof_t0_##id = __builtin_amdgcn_s_memrealtime()
#define PROF_END(id, acc) do { if (PROF_ID == (id)) (acc) += __builtin_amdgcn_s_memrealtime() - prof_t0_##id; } while (0)
namespace pg8 {
#define PG8_LAS __attribute__((address_space(3)))
typedef unsigned short bf16_t;
typedef short bf16x8 __attribute__((ext_vector_type(8)));
typedef float f32x4 __attribute__((ext_vector_type(4)));
typedef unsigned u32x4 __attribute__((ext_vector_type(4)));
typedef unsigned u32x2 __attribute__((ext_vector_type(2)));
typedef int i32x8 __attribute__((ext_vector_type(8)));
constexpr int BM = 256, BK = 64, HALF = 128, HTB = HALF * BK * 2  , STAGE_BYTES = 8 * HTB, NXCD = 8, WGM = 8;

__host__ __device__ __forceinline__ int lds_byte(int r, int c) { const int st = (r >> 4) * 2 + (c >> 5), rr = r & 15, cc = c & 31, ob = rr * 64 + cc * 2; return st * 1024 + (ob ^ (((ob >> 9) & 1) << 5)); }
__host__ __device__ __forceinline__ void stage_rc(int b, int& R, int& C) { const int st = b / 1024, sb = b % 1024, swz = sb ^ (((sb >> 9) & 1) << 5); R = (st >> 1) * 16 + swz / 64; C = (st & 1) * 32 + (swz % 64) / 2; }
__host__ __device__ __forceinline__ int perm32(int rho) { const int n = rho >> 4, i = rho & 15; return 8 * (i >> 2) + 4 * n + (i & 3); }

struct Unit { int pm, pn, e; };
struct Gemm { const bf16_t* A; const bf16_t* Bt; int M, N, K; };

struct StaticOrder {
    int nM, nN, nwg, G, c;
    __host__ __device__ void init(int M, int N, int G_, int c_) { nM = M / BM; nN = N / BM; nwg = nM * nN; G = G_; c = c_; }
    __host__ __device__ bool next(int i, Unit& u) const {
        const long L = (long)i * G + c; if (L >= nwg) return false;
        int wgid = (int)L; { const int q = nwg / NXCD, r = nwg % NXCD, xcd = wgid % NXCD, off = wgid / NXCD; wgid = (xcd < r ? xcd * (q + 1) : r * (q + 1) + (xcd - r) * q) + off; }
        const int nig = WGM * nN, gid = wgid / nig, fm = gid * WGM, gsz = (nM - fm) < WGM ? (nM - fm) : WGM;
        u.pm = fm + ((wgid % nig) % gsz); u.pn = (wgid % nig) / gsz; u.e = 0; return true;
    }
    __device__ __forceinline__ void a_off(const Unit& u, const int (&RA)[2], const int (&CA)[2], int KB  , unsigned (&off)[2][2]) const {
#pragma unroll
        for (int h = 0; h < 2; ++h)
#pragma unroll
            for (int i = 0; i < 2; ++i) off[h][i] = (unsigned)((size_t)(u.pm * BM + h * HALF + RA[i]) * KB + CA[i] * 2);
    }
};


__device__ __forceinline__ unsigned cvt_pk_bf16(float lo, float hi) { unsigned r; asm volatile("v_cvt_pk_bf16_f32 %0, %1, %2" : "=v"(r) : "v"(lo), "v"(hi)); return r; }

struct EpiStore {
    static constexpr bool PERM = true, AFTER_DRAIN = false;
    bf16_t* O; int ldc; int pn_mask; unsigned* km;
    __device__ __forceinline__ void operator()(const f32x4 (&acc)[2][2][4][2], const Unit& u, int wr, int wc, int fr, int fq) const {
        const int row0 = u.pm * BM + wr * 64 + fr; const int col0 = (u.pn & pn_mask) * BM + wc * 32 + 8 * fq;
        if (km && (u.pn == 2 || u.pn == 3 || u.pn == 8 || u.pn == 9)) {
#pragma unroll
            for (int bj = 0; bj < 2; ++bj) { float mx = 0.f;
#pragma unroll
                for (int ai = 0; ai < 2; ++ai)
#pragma unroll
                    for (int m = 0; m < 4; ++m) { const f32x4 v0 = acc[ai][bj][m][0], v1 = acc[ai][bj][m][1];
                        float ss = (v0[0] * v0[0] + v0[1] * v0[1]) + (v0[2] * v0[2] + v0[3] * v0[3]) + (v1[0] * v1[0] + v1[1] * v1[1]) + (v1[2] * v1[2] + v1[3] * v1[3]);
                        ss += lx_get<16>(ss); ss = lx_sum32(ss); mx = fmaxf(mx, ss); }
                mx = fmaxf(mx, lx_get<1>(mx)); mx = fmaxf(mx, lx_get<2>(mx)); mx = fmaxf(mx, lx_get<4>(mx)); mx = fmaxf(mx, lx_get<8>(mx));
                if ((fr | fq) == 0) __hip_atomic_fetch_max(km + (u.pm >> 4) * 96 + (u.pn * BM + bj * HALF + wc * 32) / 32, __float_as_uint(mx), __ATOMIC_RELAXED, __HIP_MEMORY_SCOPE_AGENT); }
        }
#pragma unroll
        for (int ai = 0; ai < 2; ++ai)
#pragma unroll
            for (int m = 0; m < 4; ++m) { bf16_t* rowp = O + (size_t)(row0 + ai * HALF + m * 16) * ldc + col0;
#pragma unroll
                for (int bj = 0; bj < 2; ++bj) { const f32x4 v0 = acc[ai][bj][m][0], v1 = acc[ai][bj][m][1];
                    u32x4 w; w.x = cvt_pk_bf16(v0[0], v0[1]); w.y = cvt_pk_bf16(v0[2], v0[3]); w.z = cvt_pk_bf16(v1[0], v1[1]); w.w = cvt_pk_bf16(v1[2], v1[3]);
                    *(u32x4*)(rowp + bj * HALF) = w; } }
    }
};
struct EpiSwiglu {
    static constexpr bool PERM = true, AFTER_DRAIN = false;
    bf16_t* H;
    __device__ __forceinline__ void operator()(const f32x4 (&acc)[2][2][4][2], const Unit& u, int wr, int wc, int fr, int fq) const {
        const int row0 = u.pm * BM + wr * 64 + fr; const int col0 = (u.pn & 3) * 128 + wc * 32 + 8 * fq;
#pragma unroll
        for (int ai = 0; ai < 2; ++ai)
#pragma unroll
            for (int m = 0; m < 4; ++m) { bf16_t* rowp = H + (size_t)(row0 + ai * HALF + m * 16) * 512 + col0;
                float hv[8];
#pragma unroll
                for (int n = 0; n < 2; ++n)
#pragma unroll
                    for (int i = 0; i < 4; ++i) { const float g = acc[ai][0][m][n][i], up = acc[ai][1][m][n][i];
                        const float e = __builtin_amdgcn_exp2f(-g * 1.4426950408889634f);
                        hv[n * 4 + i] = g * __builtin_amdgcn_rcpf(1.0f + e) * up; }
                u32x4 w; w.x = cvt_pk_bf16(hv[0], hv[1]); w.y = cvt_pk_bf16(hv[2], hv[3]); w.z = cvt_pk_bf16(hv[4], hv[5]); w.w = cvt_pk_bf16(hv[6], hv[7]);
                *(u32x4*)rowp = w; }
    }
};
struct EpiStoreF8 {
    static constexpr bool PERM = true, AFTER_DRAIN = false;
    unsigned char* Y8;
    __device__ __forceinline__ void operator()(const f32x4 (&acc)[2][2][4][2], const Unit& u, int wr, int wc, int fr, int fq) const {
        const int row0 = u.pm * BM + wr * 64 + fr; const int col0 = (u.pn & 3) * BM + wc * 32 + 8 * fq;
#pragma unroll
        for (int ai = 0; ai < 2; ++ai)
#pragma unroll
            for (int m = 0; m < 4; ++m) { unsigned char* rowp = Y8 + (size_t)(row0 + ai * HALF + m * 16) * 1024 + col0;
#pragma unroll
                for (int bj = 0; bj < 2; ++bj) { const f32x4 v0 = acc[ai][bj][m][0] * 8.0f, v1 = acc[ai][bj][m][1] * 8.0f;
                    int t0 = 0, t1 = 0;
                    t0 = __builtin_amdgcn_cvt_pk_fp8_f32(v0[0], v0[1], t0, false); t0 = __builtin_amdgcn_cvt_pk_fp8_f32(v0[2], v0[3], t0, true);
                    t1 = __builtin_amdgcn_cvt_pk_fp8_f32(v1[0], v1[1], t1, false); t1 = __builtin_amdgcn_cvt_pk_fp8_f32(v1[2], v1[3], t1, true);
                    u32x2 w; w.x = (unsigned)t0; w.y = (unsigned)t1; *(u32x2*)(rowp + bj * HALF) = w; } }
    }
};
struct EpiSwigluF8 {
    static constexpr bool PERM = true, AFTER_DRAIN = false;
    unsigned char* H8;
    __device__ __forceinline__ void operator()(const f32x4 (&acc)[2][2][4][2], const Unit& u, int wr, int wc, int fr, int fq) const {
        const int row0 = u.pm * BM + wr * 64 + fr; const int col0 = (u.pn & 3) * 128 + wc * 32 + 8 * fq;
#pragma unroll
        for (int ai = 0; ai < 2; ++ai)
#pragma unroll
            for (int m = 0; m < 4; ++m) { unsigned char* rowp = H8 + (size_t)(row0 + ai * HALF + m * 16) * 512 + col0;
                float hv[8];
#pragma unroll
                for (int n = 0; n < 2; ++n)
#pragma unroll
                    for (int i = 0; i < 4; ++i) { const float g = acc[ai][0][m][n][i], up = acc[ai][1][m][n][i];
                        const float e = __builtin_amdgcn_exp2f(-g * 1.4426950408889634f);
                        hv[n * 4 + i] = g * __builtin_amdgcn_rcpf(1.0f + e) * up; }
                u32x2 w; int t0 = 0, t1 = 0;
                t0 = __builtin_amdgcn_cvt_pk_fp8_f32(hv[0], hv[1], t0, false); t0 = __builtin_amdgcn_cvt_pk_fp8_f32(hv[2], hv[3], t0, true);
                t1 = __builtin_amdgcn_cvt_pk_fp8_f32(hv[4], hv[5], t1, false); t1 = __builtin_amdgcn_cvt_pk_fp8_f32(hv[6], hv[7], t1, true);
                w.x = (unsigned)t0; w.y = (unsigned)t1; *(u32x2*)rowp = w; }
    }
};
struct EpiResid {
    static constexpr bool PERM = true, AFTER_DRAIN = false;
    const float* base; bf16_t* out; const float* gate;
    __device__ __forceinline__ void operator()(const f32x4 (&acc)[2][2][4][2], const Unit& u, int wr, int wc, int fr, int fq) const {
        const int col0 = u.pn * BM + wc * 32 + 8 * fq; const float* gp = gate + (size_t)(u.pm >> 4) * 6144 + col0;
        f32x4 gv[2][2];
#pragma unroll
        for (int bj = 0; bj < 2; ++bj)
#pragma unroll
            for (int n = 0; n < 2; ++n) gv[bj][n] = *(const f32x4*)(gp + bj * HALF + n * 4);
#pragma unroll
        for (int ai = 0; ai < 2; ++ai)
#pragma unroll
            for (int m = 0; m < 4; ++m) { const size_t off = (size_t)(u.pm * BM + ai * HALF + wr * 64 + m * 16 + fr) * 1024 + col0;
#pragma unroll
                for (int bj = 0; bj < 2; ++bj) { const f32x4 b0 = *(const f32x4*)(base + off + bj * HALF), b1 = *(const f32x4*)(base + off + bj * HALF + 4);
                    const f32x4 v0 = b0 + gv[bj][0] * acc[ai][bj][m][0], v1 = b1 + gv[bj][1] * acc[ai][bj][m][1];
                    u32x4 w; w.x = cvt_pk_bf16(v0[0], v0[1]); w.y = cvt_pk_bf16(v0[2], v0[3]); w.z = cvt_pk_bf16(v1[0], v1[1]); w.w = cvt_pk_bf16(v1[2], v1[3]);
                    *(u32x4*)(out + off + bj * HALF) = w; } }
    }
};

template <class Epi, class Sched, bool ALIGN_EPI = false, bool SP2 = false, bool F8 = false>
__device__ __forceinline__ void gemm_phase(PG8_LAS unsigned char* lds, const Gemm g, const Sched& S, const Epi& E, int wave) {
    const int wid = wave, lane = fresh_lane(), tid = wid * 64 + lane, wr = wid >> 2, wc = wid & 3, fr = lane & 15, fq = lane >> 4;
    const int K = g.K, KB = F8 ? K : 2 * K  ; int nt = KB / (BK * 2); asm volatile("" : "+s"(nt));
    int RA[2], CA[2]; unsigned voffB[2];
#pragma unroll
    for (int i = 0; i < 2; ++i) { int R, C; stage_rc(tid * 16 + i * 8192, R, C); const int Rb = Epi::PERM ? ((R & ~31) + perm32(R & 31)) : R;
        RA[i] = R; CA[i] = C; voffB[i] = (unsigned)(Rb * KB + C * 2); }
    const size_t kstep = (size_t)(BK * 2);
    const size_t hstep = (size_t)HALF * KB;
    const size_t tstep = 2 * hstep;
    const unsigned ldsw = (unsigned)wid * 1024u;
    const int aoff = lds_byte(wr * 64 + fr, fq * 8), boff = lds_byte(wc * 32 + fr, fq * 8);
    const int aoffLo = lds_byte(wr * 64 + fr, fq * 16), boffLo = lds_byte(wc * 32 + fr, fq * 16);
#define PG8_SA(b, h) (((b) * 2 + (h)) * HTB)
#define PG8_SB(b, h) ((4 + (b) * 2 + (h)) * HTB)
#define PG8_STAGE(bufoff, gbase, voff) do { _Pragma("unroll") for (int _i = 0; _i < 2; ++_i) \
        __builtin_amdgcn_global_load_lds((const unsigned*)((const char*)(gbase) + (voff)[_i]), (PG8_LAS unsigned*)(lds + (bufoff) + ldsw + _i * 8192), 16, 0, 0); } while (0)
#define PG8_LDA(dst, b, h) do { if constexpr (F8) { _Pragma("unroll") for (int m = 0; m < 4; ++m) { const u32x4 lo_ = *(const PG8_LAS u32x4*)(lds + PG8_SA(b, h) + aoffLo + m * 2048), hi_ = *(const PG8_LAS u32x4*)(lds + PG8_SA(b, h) + aoffLo + 16 + m * 2048); \
            dst##8[m] = (i32x8){(int)lo_.x, (int)lo_.y, (int)lo_.z, (int)lo_.w, (int)hi_.x, (int)hi_.y, (int)hi_.z, (int)hi_.w}; } } \
        else { _Pragma("unroll") for (int m = 0; m < 4; ++m) _Pragma("unroll") for (int k = 0; k < 2; ++k) dst[m][k] = *(const PG8_LAS bf16x8*)(lds + PG8_SA(b, h) + aoff + m * 2048 + k * 1024); } } while (0)
#define PG8_LDB(dst, b, h) do { if constexpr (F8) { _Pragma("unroll") for (int n = 0; n < 2; ++n) { const u32x4 lo_ = *(const PG8_LAS u32x4*)(lds + PG8_SB(b, h) + boffLo + n * 2048), hi_ = *(const PG8_LAS u32x4*)(lds + PG8_SB(b, h) + boffLo + 16 + n * 2048); \
            dst##8[n] = (i32x8){(int)lo_.x, (int)lo_.y, (int)lo_.z, (int)lo_.w, (int)hi_.x, (int)hi_.y, (int)hi_.z, (int)hi_.w}; } } \
        else { _Pragma("unroll") for (int n = 0; n < 2; ++n) _Pragma("unroll") for (int k = 0; k < 2; ++k) dst[n][k] = *(const PG8_LAS bf16x8*)(lds + PG8_SB(b, h) + boff + n * 2048 + k * 1024); } } while (0)
#define PG8_MMA(ai, bj, At, Bt) do { __builtin_amdgcn_s_setprio(1); if constexpr (F8) { _Pragma("unroll") for (int m = 0; m < 4; ++m) _Pragma("unroll") for (int n = 0; n < 2; ++n) \
            acc[ai][bj][m][n] = __builtin_amdgcn_mfma_scale_f32_16x16x128_f8f6f4(Bt##8[n], At##8[m], acc[ai][bj][m][n], 0, 0, 0, 0x7A7A7A7A  , 0, 0x7F7F7F7F  ); } \
        else { _Pragma("unroll") for (int m = 0; m < 4; ++m) _Pragma("unroll") for (int n = 0; n < 2; ++n) _Pragma("unroll") for (int k = 0; k < 2; ++k) \
            acc[ai][bj][m][n] = __builtin_amdgcn_mfma_f32_16x16x32_bf16(Bt[n][k], At[m][k], acc[ai][bj][m][n], 0, 0, 0); } __builtin_amdgcn_s_setprio(0); } while (0)
#define PG8_WAIT_V(n) asm volatile("s_waitcnt vmcnt(" #n ")" ::: "memory")
#define PG8_WAIT_L(n) asm volatile("s_waitcnt lgkmcnt(" #n ")" ::: "memory")
#define PG8_BAR __builtin_amdgcn_s_barrier()
#define PG8_SCHED __builtin_amdgcn_sched_barrier(0)
    Unit cur, nxt; int ui = 0;
    if (!S.next(0, cur)) return;
    f32x4 acc[2][2][4][2];
#pragma unroll
    for (int a = 0; a < 2; ++a)
#pragma unroll
        for (int b = 0; b < 2; ++b)
#pragma unroll
            for (int m = 0; m < 4; ++m)
#pragma unroll
                for (int n = 0; n < 2; ++n) acc[a][b][m][n] = (f32x4){0.f, 0.f, 0.f, 0.f};
    bf16x8 At[4][2], B0[2][2], B1[2][2]; i32x8 At8[4], B08[2], B18[2];
    unsigned oc[2][2], on[2][2];
    S.a_off(cur, RA, CA, KB, oc);
    const char* A0 = (const char*)g.A;
    const char* cB = (const char*)g.Bt + (size_t)cur.pn * tstep;
    if constexpr (SP2) {
        PG8_STAGE(PG8_SB(0, 0), cB, voffB); PG8_STAGE(PG8_SB(0, 1), cB + hstep, voffB); PG8_STAGE(PG8_SA(0, 0), A0, oc[0]); PG8_STAGE(PG8_SA(0, 1), A0, oc[1]);
        if (wr == 1) PG8_BAR;
        PG8_WAIT_V(2); PG8_BAR;
        PG8_STAGE(PG8_SB(1, 0), cB + kstep, voffB); PG8_STAGE(PG8_SA(1, 0), A0 + kstep, oc[0]); PG8_STAGE(PG8_SB(1, 1), cB + hstep + kstep, voffB);
        PG8_WAIT_V(6); PG8_BAR;
    } else {
        PG8_STAGE(PG8_SB(0, 0), cB, voffB); PG8_STAGE(PG8_SA(0, 0), A0, oc[0]); PG8_STAGE(PG8_SB(0, 1), cB + hstep, voffB); PG8_STAGE(PG8_SA(0, 1), A0, oc[1]);
        if (wr == 1) PG8_BAR;
        PG8_WAIT_V(4); PG8_BAR;
        PG8_STAGE(PG8_SB(1, 0), cB + kstep, voffB); PG8_STAGE(PG8_SA(1, 0), A0 + kstep, oc[0]); PG8_STAGE(PG8_SB(1, 1), cB + hstep + kstep, voffB);
        PG8_WAIT_V(6); PG8_BAR;
    }
    for (;;) {
        const bool has_next = S.next(ui + 1, nxt);
        if (has_next) S.a_off(nxt, RA, CA, KB, on);
        else {
#pragma unroll
            for (int h = 0; h < 2; ++h)
#pragma unroll
                for (int i = 0; i < 2; ++i) on[h][i] = oc[h][i]; }
        const char* nB = has_next ? (const char*)g.Bt + (size_t)nxt.pn * tstep : cB;
        for (int t = 0; t < nt; t += 2) {
            const bool last = (t == nt - 2);
            const char* a1 = A0 + (size_t)(t + 1) * kstep;
            const char* a2 = last ? A0 : A0 + (size_t)(t + 2) * kstep; const char* b2 = last ? nB : cB + (size_t)(t + 2) * kstep;
            const char* a3 = a2 + kstep; const char* b3 = b2 + kstep;
            if constexpr (SP2) {
            PG8_LDB(B0, 0, 0); PG8_LDB(B1, 0, 1); PG8_SCHED; PG8_LDA(At, 0, 0); PG8_STAGE(PG8_SA(1, 1), a1, oc[1]); if (last) { _Pragma("unroll") for (int h_ = 0; h_ < 2; ++h_) _Pragma("unroll") for (int i_ = 0; i_ < 2; ++i_) oc[h_][i_] = on[h_][i_]; }
            PG8_WAIT_V(8); PG8_WAIT_L(0); PG8_BAR; PG8_MMA(0, 0, At, B0); PG8_MMA(0, 1, At, B1); PG8_BAR; PG8_SCHED;
            PG8_LDA(At, 0, 1); PG8_STAGE(PG8_SB(0, 0), b2, voffB); PG8_STAGE(PG8_SB(0, 1), b2 + hstep, voffB); PG8_STAGE(PG8_SA(0, 0), a2, oc[0]);
            PG8_WAIT_V(8); PG8_WAIT_L(0); PG8_BAR; PG8_MMA(1, 0, At, B0); PG8_MMA(1, 1, At, B1); PG8_BAR; PG8_SCHED;
            PG8_LDB(B0, 1, 0); PG8_LDB(B1, 1, 1); PG8_SCHED; PG8_LDA(At, 1, 0); PG8_STAGE(PG8_SA(0, 1), a2, oc[1]);
            PG8_WAIT_V(8); PG8_WAIT_L(0); PG8_BAR; PG8_MMA(0, 0, At, B0); PG8_MMA(0, 1, At, B1); PG8_BAR; PG8_SCHED;
            PG8_LDA(At, 1, 1); PG8_STAGE(PG8_SB(1, 0), b3, voffB); PG8_STAGE(PG8_SB(1, 1), b3 + hstep, voffB); PG8_STAGE(PG8_SA(1, 0), a3, oc[0]);
            PG8_WAIT_V(8); PG8_WAIT_L(0); PG8_BAR; PG8_MMA(1, 0, At, B0); PG8_MMA(1, 1, At, B1); PG8_BAR; PG8_SCHED;
            } else {
            PG8_LDB(B0, 0, 0); PG8_SCHED; PG8_LDA(At, 0, 0); PG8_STAGE(PG8_SA(1, 1), a1, oc[1]); if (last) { _Pragma("unroll") for (int h_ = 0; h_ < 2; ++h_) _Pragma("unroll") for (int i_ = 0; i_ < 2; ++i_) oc[h_][i_] = on[h_][i_]; }
            PG8_WAIT_L(8); PG8_BAR; PG8_WAIT_L(0); PG8_MMA(0, 0, At, B0); PG8_BAR; PG8_SCHED;
            PG8_LDB(B1, 0, 1); PG8_STAGE(PG8_SB(0, 0), b2, voffB);
            PG8_BAR; PG8_WAIT_L(0); PG8_MMA(0, 1, At, B1); PG8_BAR;
            PG8_LDA(At, 0, 1); PG8_STAGE(PG8_SA(0, 0), a2, oc[0]);
            PG8_BAR; PG8_WAIT_L(0); PG8_MMA(1, 0, At, B0); PG8_BAR; PG8_SCHED;
            PG8_STAGE(PG8_SB(0, 1), b2 + hstep, voffB);
            PG8_WAIT_V(6); PG8_BAR; PG8_MMA(1, 1, At, B1); PG8_BAR;
            PG8_LDB(B0, 1, 0); PG8_SCHED; PG8_LDA(At, 1, 0); PG8_STAGE(PG8_SA(0, 1), a2, oc[1]);
            PG8_WAIT_L(8); PG8_BAR; PG8_WAIT_L(0); PG8_MMA(0, 0, At, B0); PG8_BAR; PG8_SCHED;
            PG8_LDB(B1, 1, 1); PG8_STAGE(PG8_SB(1, 0), b3, voffB);
            PG8_BAR; PG8_WAIT_L(0); PG8_MMA(0, 1, At, B1); PG8_BAR;
            PG8_LDA(At, 1, 1); PG8_STAGE(PG8_SA(1, 0), a3, oc[0]);
            PG8_BAR; PG8_WAIT_L(0); PG8_MMA(1, 0, At, B0); PG8_BAR; PG8_SCHED;
            PG8_STAGE(PG8_SB(1, 1), b3 + hstep, voffB);
            PG8_WAIT_V(6); PG8_BAR; PG8_MMA(1, 1, At, B1); PG8_BAR;
            }
        }
        if constexpr (ALIGN_EPI) { if (wr == 0) PG8_BAR; }
        if constexpr (!Epi::AFTER_DRAIN) { E(acc, cur, wr, wc, fr, fq); }
        if (!has_next) break;
#pragma unroll
        for (int a = 0; a < 2; ++a)
#pragma unroll
            for (int b = 0; b < 2; ++b)
#pragma unroll
                for (int m = 0; m < 4; ++m)
#pragma unroll
                    for (int n = 0; n < 2; ++n) acc[a][b][m][n] = (f32x4){0.f, 0.f, 0.f, 0.f};
        cur = nxt; cB = nB; ++ui;
        if constexpr (ALIGN_EPI) { if (wr == 1) PG8_BAR; }
    }
    PG8_WAIT_V(0);
    if constexpr (!ALIGN_EPI) { if (wr == 0) PG8_BAR; }
    PG8_BAR;
#undef PG8_SA
#undef PG8_SB
#undef PG8_STAGE
#undef PG8_LDA
#undef PG8_LDB
#undef PG8_MMA
#undef PG8_WAIT_V
#undef PG8_WAIT_L
#undef PG8_BAR
#undef PG8_SCHED
}
}

namespace att {
#define ATT_LAS __attribute__((address_space(3)))
typedef unsigned short bf16_t;
using bf16x8 = __attribute__((ext_vector_type(8))) short;
using s16x4  = __attribute__((ext_vector_type(4))) short;
using f32x16 = __attribute__((ext_vector_type(16))) float;
using f32x4  = __attribute__((ext_vector_type(4))) float;
using u32x4  = __attribute__((ext_vector_type(4))) unsigned;
using u32x2  = __attribute__((ext_vector_type(2))) unsigned;
constexpr int SEQ = 4096, LDQKV = 3072, LDATT = 1024;
constexpr float LOG2E = 1.4426950408889634f;
#define ATT_SBAR() __builtin_amdgcn_sched_barrier(0)
__device__ __forceinline__ int opaque(int v) { asm volatile("" : "+v"(v)); return v; }
__device__ __forceinline__ void dma16(const void* g, ATT_LAS unsigned char* l) { __builtin_amdgcn_global_load_lds((const unsigned*)g, (ATT_LAS unsigned*)l, 16, 0, 0); }
__device__ __forceinline__ int swap23(int k) { return (k & ~0xC) | ((k & 4) << 1) | ((k & 8) >> 1); }
__device__ __forceinline__ int crow(int r, int hi) { return (r & 3) + 8 * (r >> 2) + 4 * hi; }
__device__ __forceinline__ unsigned cvtpk(float lo, float hi) { unsigned r; asm volatile("v_cvt_pk_bf16_f32 %0, %1, %2" : "=v"(r) : "v"(lo), "v"(hi)); return r; }
__device__ __forceinline__ int ksw(int row, int c) { return row * 128 + ((c ^ ((row >> 1) & 7)) << 4); }
template <int NC> __device__ __forceinline__ int v_st(int k, int c) { const int kk = (k & ~0xC) | ((k & 4) << 1) | ((k & 8) >> 1); return ((kk >> 3) * NC + (c >> 5)) * 512 + ((kk & 7) * 32 + (c & 31)) * 2; }
__device__ __forceinline__ int v_rd_base(int lane) { return ((lane & 3) << 3) | (((lane >> 2) & 3) << 6) | (((lane >> 4) & 1) << 5) | (((lane >> 5) & 1) << 8); }
template <int NC> constexpr int v_rd_off(int d0, int ks, int half) { return d0 * 512 + ks * (2 * NC * 512) + half * (NC * 512); }
template <int OFF> __device__ __forceinline__ s16x4 tr_read(int vb) {
  s16x4 r; asm volatile("ds_read_b64_tr_b16 %0, %1 offset:%2" : "=&v"(r) : "v"(vb), "i"(OFF) : "memory"); return r;
}
#define ATT_TR8(S, D0_) do { \
    S[0] = tr_read<v_rd_off<NC>(D0_, 0, 0)>(vb); S[1] = tr_read<v_rd_off<NC>(D0_, 0, 1)>(vb); S[2] = tr_read<v_rd_off<NC>(D0_, 1, 0)>(vb); S[3] = tr_read<v_rd_off<NC>(D0_, 1, 1)>(vb); \
    S[4] = tr_read<v_rd_off<NC>(D0_, 2, 0)>(vb); S[5] = tr_read<v_rd_off<NC>(D0_, 2, 1)>(vb); S[6] = tr_read<v_rd_off<NC>(D0_, 3, 0)>(vb); S[7] = tr_read<v_rd_off<NC>(D0_, 3, 1)>(vb); } while (0)
#define ATT_PK(L, H) (bf16x8){L[0], L[1], L[2], L[3], H[0], H[1], H[2], H[3]}
#define ATT_MM4(OD, S) do { \
    OD = __builtin_amdgcn_mfma_f32_32x32x16_bf16(pa0, ATT_PK(S[0], S[1]), OD, 0, 0, 0); OD = __builtin_amdgcn_mfma_f32_32x32x16_bf16(pa1, ATT_PK(S[2], S[3]), OD, 0, 0, 0); \
    OD = __builtin_amdgcn_mfma_f32_32x32x16_bf16(pa2, ATT_PK(S[4], S[5]), OD, 0, 0, 0); OD = __builtin_amdgcn_mfma_f32_32x32x16_bf16(pa3, ATT_PK(S[6], S[7]), OD, 0, 0, 0); } while (0)
template <int NC> __device__ __forceinline__ void pv_all(f32x16 (&o)[NC], int vb, bf16x8 pa0, bf16x8 pa1, bf16x8 pa2, bf16x8 pa3) {
  s16x4 A[8], B[8];
  ATT_TR8(A, 0);
  if constexpr (NC == 2) {
    ATT_TR8(B, 1); asm volatile("s_waitcnt lgkmcnt(8)" ::: "memory"); ATT_SBAR(); ATT_MM4(o[0], A);
    asm volatile("s_waitcnt lgkmcnt(0)" ::: "memory"); ATT_SBAR(); ATT_MM4(o[1], B);
  } else {
    ATT_TR8(B, 1); asm volatile("s_waitcnt lgkmcnt(8)" ::: "memory"); ATT_SBAR(); ATT_MM4(o[0], A);
    ATT_SBAR(); ATT_TR8(A, 2); asm volatile("s_waitcnt lgkmcnt(8)" ::: "memory"); ATT_SBAR(); ATT_MM4(o[1], B);
    ATT_SBAR(); ATT_TR8(B, 3); asm volatile("s_waitcnt lgkmcnt(8)" ::: "memory"); ATT_SBAR(); ATT_MM4(o[2], A);
    asm volatile("s_waitcnt lgkmcnt(0)" ::: "memory"); ATT_SBAR(); ATT_MM4(o[3], B);
  }
}
#undef ATT_TR8
#undef ATT_PK
#undef ATT_MM4
__device__ __forceinline__ void qkt_bias(f32x16& p0, f32x16& p1, const ATT_LAS float* BT, const ATT_LAS unsigned char* Ks, const bf16x8 (&qr)[4], int r32, int hi, bf16x8 augA, bf16x8 augB) {
#pragma unroll
  for (int g = 0; g < 4; ++g) { const f32x4 b0 = *(const ATT_LAS f32x4*)(BT + 8 * g + 4 * hi), b1 = *(const ATT_LAS f32x4*)(BT + 32 + 8 * g + 4 * hi);
#pragma unroll
    for (int i = 0; i < 4; ++i) { p0[4 * g + i] = b0[i]; p1[4 * g + i] = b1[i]; } }
#pragma unroll
  for (int d0 = 0; d0 < 4; ++d0) {
    const bf16x8 b0 = *(const ATT_LAS bf16x8*)(Ks + ksw(r32, 2 * d0 + hi));
    const bf16x8 b1 = *(const ATT_LAS bf16x8*)(Ks + ksw(32 + r32, 2 * d0 + hi));
    p0 = __builtin_amdgcn_mfma_f32_32x32x16_bf16(b0, qr[d0], p0, 0, 0, 0);
    p1 = __builtin_amdgcn_mfma_f32_32x32x16_bf16(b1, qr[d0], p1, 0, 0, 0);
    if (d0 == 1) ATT_SBAR(); }
  p0 = __builtin_amdgcn_mfma_f32_32x32x16_bf16(augA, augB, p0, 0, 0, 0);
  p1 = __builtin_amdgcn_mfma_f32_32x32x16_bf16(augA, augB, p1, 0, 0, 0);
}

constexpr float SKIP_T = 40.0f;
__device__ __forceinline__ float q_norm(const bf16x8 (&qr)[4]) {
  float s = 0.f;
#pragma unroll
  for (int d0 = 0; d0 < 4; ++d0)
#pragma unroll
    for (int e = 0; e < 8; ++e) { const float v = __uint_as_float(((unsigned)(unsigned short)qr[d0][e]) << 16); s = fmaf(v, v, s); }
  return sqrtf(lx_sum32(s));
}
__device__ __forceinline__ float k_max(const unsigned* km, int g) {
  const float a = __uint_as_float(__hip_atomic_load(km + g, __ATOMIC_RELAXED, __HIP_MEMORY_SCOPE_AGENT)), b = __uint_as_float(__hip_atomic_load(km + g + 1, __ATOMIC_RELAXED, __HIP_MEMORY_SCOPE_AGENT));
  return sqrtf(a + b) * 1.005f;
}
__device__ __forceinline__ bool all_done(const ATT_LAS int* DONE, int i) {
  const ATT_LAS u32x4* d = (const ATT_LAS u32x4*)DONE; const u32x4 a = d[0], b = d[1];
  const unsigned m = max(max(max(a.x, a.y), max(a.z, a.w)), max(max(b.x, b.y), max(b.z, b.w)));
  return __builtin_amdgcn_readfirstlane((int)(m < (unsigned)i)) != 0;
}
__device__ __forceinline__ void qkt_bias_q(f32x16& p0, f32x16& p1, const ATT_LAS float* BT, const ATT_LAS unsigned char* Ks, const ATT_LAS unsigned char* Qs, int qrow, int r32, int hi, bf16x8 augA, bf16x8 augB) {
#pragma unroll
  for (int g = 0; g < 4; ++g) { const f32x4 b0 = *(const ATT_LAS f32x4*)(BT + 8 * g + 4 * hi), b1 = *(const ATT_LAS f32x4*)(BT + 32 + 8 * g + 4 * hi);
#pragma unroll
    for (int i = 0; i < 4; ++i) { p0[4 * g + i] = b0[i]; p1[4 * g + i] = b1[i]; } }
#pragma unroll
  for (int d0 = 0; d0 < 4; ++d0) {
    const bf16x8 b0 = *(const ATT_LAS bf16x8*)(Ks + ksw(r32, 2 * d0 + hi));
    const bf16x8 b1 = *(const ATT_LAS bf16x8*)(Ks + ksw(32 + r32, 2 * d0 + hi));
    const bf16x8 q = *(const ATT_LAS bf16x8*)(Qs + ksw(qrow, 2 * d0 + hi));
    p0 = __builtin_amdgcn_mfma_f32_32x32x16_bf16(b0, q, p0, 0, 0, 0);
    p1 = __builtin_amdgcn_mfma_f32_32x32x16_bf16(b1, q, p1, 0, 0, 0);
    if (d0 == 1) ATT_SBAR(); }
  p0 = __builtin_amdgcn_mfma_f32_32x32x16_bf16(augA, augB, p0, 0, 0, 0);
  p1 = __builtin_amdgcn_mfma_f32_32x32x16_bf16(augA, augB, p1, 0, 0, 0);
}

__device__ __forceinline__ bf16x8 aug_a(int hi) { const u32x4 v = {hi ? 0u : 0x3F803F80u, hi ? 0u : 0x00003F80u, 0u, 0u}; return __builtin_bit_cast(bf16x8, v); }
__device__ __forceinline__ bf16x8 aug_b(float w, int hi) {
  const unsigned h = cvtpk(w, 0.f) & 0xffffu; const float d1 = w - __uint_as_float(h << 16);
  const unsigned m = cvtpk(d1, 0.f) & 0xffffu; const float d2 = d1 - __uint_as_float(m << 16);
  const unsigned l = cvtpk(d2, 0.f) & 0xffffu;
  const u32x4 v = {hi ? 0u : (h | (m << 16)), hi ? 0u : l, 0u, 0u}; return __builtin_bit_cast(bf16x8, v);
}
__device__ __forceinline__ void sm_direct(f32x16& p0, f32x16& p1, float& l_part, bf16x8& pa0, bf16x8& pa1, bf16x8& pa2, bf16x8& pa3) {
#pragma unroll
  for (int r = 0; r < 16; ++r) { p0[r] = __builtin_amdgcn_exp2f(p0[r]); p1[r] = __builtin_amdgcn_exp2f(p1[r]); }
  float ps = 0.f;
#pragma unroll
  for (int r = 0; r < 16; ++r) ps += p0[r];
#pragma unroll
  for (int r = 0; r < 16; ++r) ps += p1[r];
  l_part += ps;
#define ATT_PK4(P, BASE, OUT) do { unsigned a0 = cvtpk(P[BASE + 0], P[BASE + 1]), a1 = cvtpk(P[BASE + 2], P[BASE + 3]);   \
    unsigned b0 = cvtpk(P[BASE + 4], P[BASE + 5]), b1 = cvtpk(P[BASE + 6], P[BASE + 7]);                              \
    auto r0 = __builtin_amdgcn_permlane32_swap(a0, b0, false, false); auto r1 = __builtin_amdgcn_permlane32_swap(a1, b1, false, false); \
    u32x4 w = {r0[0], r1[0], r0[1], r1[1]}; OUT = __builtin_bit_cast(bf16x8, w); } while (0)
  ATT_PK4(p0, 0, pa0); ATT_PK4(p0, 8, pa1); ATT_PK4(p1, 0, pa2); ATT_PK4(p1, 8, pa3);
#undef ATT_PK4
}
__device__ __forceinline__ bf16x8 aug_a_alibi(int koff, int hi) { const unsigned kb = __float_as_uint((float)koff) >> 16;
  const u32x4 v = {hi ? 0u : 0x3F803F80u, hi ? 0u : (0x3F80u | (kb << 16)), hi ? 0u : kb, 0u}; return __builtin_bit_cast(bf16x8, v); }
__device__ __forceinline__ bf16x8 aug_b_alibi(float w, unsigned s_hi, unsigned s_lo, int hi) {
  const unsigned h = cvtpk(w, 0.f) & 0xffffu; const float d1 = w - __uint_as_float(h << 16);
  const unsigned m = cvtpk(d1, 0.f) & 0xffffu; const float d2 = d1 - __uint_as_float(m << 16);
  const unsigned l = cvtpk(d2, 0.f) & 0xffffu;
  const u32x4 v = {hi ? 0u : (h | (m << 16)), hi ? 0u : (l | (s_hi << 16)), hi ? 0u : s_lo, 0u}; return __builtin_bit_cast(bf16x8, v);
}
__device__ __forceinline__ void qkt_aug_q(f32x16& p0, f32x16& p1, const ATT_LAS unsigned char* Ks, const ATT_LAS unsigned char* Qs, int qrow, int r32, int hi, bf16x8 augA0, bf16x8 augA1, bf16x8 augB) {
  p0 = f32x16{}; p1 = f32x16{};
#pragma unroll
  for (int d0 = 0; d0 < 4; ++d0) {
    const bf16x8 b0 = *(const ATT_LAS bf16x8*)(Ks + ksw(r32, 2 * d0 + hi));
    const bf16x8 b1 = *(const ATT_LAS bf16x8*)(Ks + ksw(32 + r32, 2 * d0 + hi));
    const bf16x8 q = *(const ATT_LAS bf16x8*)(Qs + ksw(qrow, 2 * d0 + hi));
    p0 = __builtin_amdgcn_mfma_f32_32x32x16_bf16(b0, q, p0, 0, 0, 0);
    p1 = __builtin_amdgcn_mfma_f32_32x32x16_bf16(b1, q, p1, 0, 0, 0);
    if (d0 == 1) ATT_SBAR(); }
  p0 = __builtin_amdgcn_mfma_f32_32x32x16_bf16(augA0, augB, p0, 0, 0, 0);
  p1 = __builtin_amdgcn_mfma_f32_32x32x16_bf16(augA1, augB, p1, 0, 0, 0);
}
#define ATT_WAIT_BAR(N) asm volatile("s_waitcnt vmcnt(" #N ") lgkmcnt(0)\n\ts_barrier" ::: "memory")

__device__ __forceinline__ void fox_unit(ATT_LAS unsigned char* lds, const bf16_t* __restrict__ qkv, bf16_t* __restrict__ attn, const float* __restrict__ cl2, const float* __restrict__ blk2, const unsigned* km,
                                         int b, int h, int qb, int wave, unsigned long long& pacc) {
  PROF_BEGIN(11);
  const int wid = wave, lane = fresh_lane(), tid = wid * 64 + lane, r32 = lane & 31, hi = lane >> 5;
  ATT_LAS float* CARRY = (ATT_LAS float*)(lds + 63488); ATT_LAS float* wsf = (ATT_LAS float*)(lds + 63744) + wid * 64;
  ATT_LAS unsigned char* BW = lds + 57344 + wid * 768; ATT_LAS int* DONE = (ATT_LAS int*)(lds + 65792);
  if (lane == 0) DONE[wid] = 0x7fffffff;
  const int q0 = qb * 256, NT = 4 * (qb + 1), jl = 4 * qb + (wid >> 1);
  const size_t rowb = (size_t)b * SEQ; const int bh = b * 8 + h;
  if (wid == 0) { float v = lane < 32 ? blk2[(b * 32 + lane) * 8 + h] : 0.f; float s = v;
#pragma unroll
    for (int o = 1; o < 32; o <<= 1) { const float t = __builtin_bit_cast(float, __builtin_amdgcn_ds_bpermute(((lane - o) & 63) << 2, __builtin_bit_cast(int, s))); if (lane >= o) s += t; }
    if (lane < 32) CARRY[lane] = s - v; }
  __syncthreads();
  const float cq = CARRY[q0 >> 7] + cl2[(size_t)bh * SEQ + q0];
  bf16x8 qr[4];
  { const bf16_t* Qw = qkv + (rowb + q0 + wid * 32 + r32) * LDQKV + h * 64 + hi * 8;
#pragma unroll
    for (int d0 = 0; d0 < 4; ++d0) qr[d0] = *(const bf16x8*)(Qw + d0 * 16); }
  const int pk = 64 * wid + lane;
  unsigned koff, voff;
  { const int row = pk >> 3, c = (pk & 7) ^ ((row >> 1) & 7); koff = (unsigned)((row * LDQKV + 512 + h * 64 + c * 8) * 2);
    const int sub = pk >> 5, kk = 8 * (sub >> 1) + ((pk & 31) >> 2), k = swap23(kk), cv = (sub & 1) * 32 + (pk & 3) * 8; voff = (unsigned)((k * LDQKV + 1024 + h * 64 + cv) * 2); }
  const char* tb = (const char*)(qkv + rowb * LDQKV);
  const char* cg = (const char*)(cl2 + (size_t)bh * SEQ) + (lane & 15) * 16;
  const int vb0 = (int)(uintptr_t)(lds + 24576) + v_rd_base(lane);
#define FOX_LOAD(j, bo, vbo) do { const char* tj = tb + (size_t)(j) * (64 * LDQKV * 2); dma16(tj + koff, lds + (bo) * 8192 + wid * 1024); dma16(tj + voff, lds + 24576 + (vbo) * 8192 + wid * 1024); \
    if (lane < 16) dma16(cg + (j) * 256, BW + (bo) * 256); } while (0)
#define FOX_PV(vbo) pv_all<2>(o, vb0 + (vbo) * 8192, pa0, pa1, pa2, pa3)
  FOX_LOAD(NT - 1, 0, 0); FOX_LOAD(NT - 2, 1, 1);
  float l_reg = 0.f; f32x16 o[2]; o[0] = f32x16{}; o[1] = f32x16{};
  const float bnd = q_norm(qr) * k_max(km + b * 96, 16 + 2 * h);
  const int qpos = q0 + wid * 32 + r32;
  const float refq = (cl2[(size_t)bh * SEQ + qpos] + CARRY[qpos >> 7] - cq) + fmaxf(0.f, bnd - 60.f);
  const bf16x8 augA = aug_a(hi);
  __builtin_amdgcn_s_waitcnt(0x0F70);
  bool stopped = false, pend = false; const bool late = wid >= 4;
  bf16x8 pa0, pa1, pa2, pa3;
  int cur = 0, nx2 = 2, vc = 0, vn2 = 2, vprev = 3;
  PROF_END(11, pacc);
  for (int i = 0; i < NT; ++i) {
    const int j = NT - 1 - i;
    if (PROF_ID == 13) pacc += 100;
    PROF_BEGIN(8);
    if (i + 1 < NT) ATT_WAIT_BAR(3); else ATT_WAIT_BAR(0);
    PROF_END(8, pacc);
    if (all_done(DONE, i)) break;
    if (i + 2 < NT) FOX_LOAD(j - 2, nx2, vn2);
    if (pend) { PROF_BEGIN(10); FOX_PV(vprev); pend = false; PROF_END(10, pacc); }
    if (j <= jl && !stopped) {
      const float bj = ((const ATT_LAS float*)(BW + cur * 256))[63] + (CARRY[j >> 1] - cq);
      if (!__any(bnd + (bj - refq) - __builtin_amdgcn_logf(l_reg) >= -SKIP_T)) { stopped = true; if (lane == 0) DONE[wid] = i; }
    }
    if (j <= jl && !stopped) {
      f32x16 p0, p1;
      PROF_BEGIN(9);
      const float c2 = CARRY[j >> 1] - cq;
      qkt_bias(p0, p1, (const ATT_LAS float*)(BW + cur * 256), lds + cur * 8192, qr, r32, hi, augA, aug_b(c2 - refq, hi));
      if (j == jl) { const int qrel = opaque(32 * (wid & 1) + r32), hio = opaque(hi);
#pragma unroll
        for (int r = 0; r < 16; ++r) { const int kr = crow(r, hio); if (kr > qrel) p0[r] = -1e30f; if (kr + 32 > qrel) p1[r] = -1e30f; } }
      sm_direct(p0, p1, l_reg, pa0, pa1, pa2, pa3);
      PROF_END(9, pacc);
      if (late) pend = true; else { PROF_BEGIN(10); FOX_PV(vc); PROF_END(10, pacc); }
    }
    cur = cur == 2 ? 0 : cur + 1; nx2 = nx2 == 2 ? 0 : nx2 + 1; vprev = vc; vc = (vc + 1) & 3; vn2 = (vn2 + 1) & 3;
  }
  if (pend) FOX_PV(vprev);
#undef FOX_PV
#undef FOX_LOAD
  PROF_BEGIN(12);
  asm volatile("s_waitcnt vmcnt(0)" ::: "memory");
  l_reg = lx_sum32(l_reg);
  if (hi == 0) wsf[32 + r32] = l_reg; asm volatile("s_waitcnt lgkmcnt(0)" ::: "memory");
  { const int le = opaque(lane), r32e = le & 31, hie = le >> 5;
  bf16_t* Ow = attn + (rowb + q0 + wid * 32) * LDATT + h * 64 + r32e;
#pragma unroll
  for (int r = 0; r < 16; ++r) { const int orow = crow(r, hie); const float rl = __builtin_amdgcn_rcpf(wsf[32 + orow]);
#pragma unroll
    for (int d0 = 0; d0 < 2; ++d0) { const unsigned w = cvtpk(o[d0][r] * rl, 0.f); Ow[(size_t)orow * LDATT + d0 * 32] = (bf16_t)(w & 0xffffu); } } }
  asm volatile("s_waitcnt lgkmcnt(0)" ::: "memory");
  __syncthreads();
  PROF_END(12, pacc);
}

__device__ __forceinline__ void fox2_unit(ATT_LAS unsigned char* lds, const bf16_t* __restrict__ qkv, bf16_t* __restrict__ attn, const float* __restrict__ cl2, const float* __restrict__ blk2, const unsigned* km,
                                          int b, int h, int qb, int wave, unsigned long long& pacc) {
  PROF_BEGIN(11);
  const int wid = wave, lane = fresh_lane(), r32 = lane & 31, hi = lane >> 5;
  ATT_LAS float* CARRY = (ATT_LAS float*)(lds + 63488); ATT_LAS float* wsf = (ATT_LAS float*)(lds + 63744) + wid * 64;
  ATT_LAS unsigned char* BW = lds + 57344 + wid * 768; ATT_LAS int* DONE = (ATT_LAS int*)(lds + 65792);
  if (lane == 0) DONE[wid] = 0x7fffffff;
  const int q0 = qb * 512, NT = 8 * (qb + 1), jl = 8 * qb + wid;
  const size_t rowb = (size_t)b * SEQ; const int bh = b * 8 + h;
  if (wid == 0) { float v = lane < 32 ? blk2[(b * 32 + lane) * 8 + h] : 0.f; float s = v;
#pragma unroll
    for (int o = 1; o < 32; o <<= 1) { const float t = __builtin_bit_cast(float, __builtin_amdgcn_ds_bpermute(((lane - o) & 63) << 2, __builtin_bit_cast(int, s))); if (lane >= o) s += t; }
    if (lane < 32) CARRY[lane] = s - v; }
  __syncthreads();
  const float cq = CARRY[q0 >> 7] + cl2[(size_t)bh * SEQ + q0];
  bf16x8 qA[4], qB[4];
  { const bf16_t* Qw = qkv + (rowb + q0 + wid * 64 + r32) * LDQKV + h * 64 + hi * 8;
#pragma unroll
    for (int d0 = 0; d0 < 4; ++d0) { qA[d0] = *(const bf16x8*)(Qw + d0 * 16); qB[d0] = *(const bf16x8*)(Qw + (size_t)32 * LDQKV + d0 * 16); } }
  const int pk = 64 * wid + lane;
  unsigned koff, voff;
  { const int row = pk >> 3, c = (pk & 7) ^ ((row >> 1) & 7); koff = (unsigned)((row * LDQKV + 512 + h * 64 + c * 8) * 2);
    const int sub = pk >> 5, kk = 8 * (sub >> 1) + ((pk & 31) >> 2), k = swap23(kk), cv = (sub & 1) * 32 + (pk & 3) * 8; voff = (unsigned)((k * LDQKV + 1024 + h * 64 + cv) * 2); }
  const char* tb = (const char*)(qkv + rowb * LDQKV);
  const char* cg = (const char*)(cl2 + (size_t)bh * SEQ) + (lane & 15) * 16;
  const int vb0 = (int)(uintptr_t)(lds + 24576) + v_rd_base(lane);
#define FOX_LOAD(j, bo, vbo) do { const char* tj = tb + (size_t)(j) * (64 * LDQKV * 2); dma16(tj + koff, lds + (bo) * 8192 + wid * 1024); dma16(tj + voff, lds + 24576 + (vbo) * 8192 + wid * 1024); \
    if (lane < 16) dma16(cg + (j) * 256, BW + (bo) * 256); } while (0)
  FOX_LOAD(NT - 1, 0, 0); FOX_LOAD(NT - 2, 1, 1);
  float lA = 0.f, lB = 0.f; f32x16 oA[2], oB[2]; oA[0] = f32x16{}; oA[1] = f32x16{}; oB[0] = f32x16{}; oB[1] = f32x16{};
  const float kmx = k_max(km + b * 96, 16 + 2 * h);
  const float bndA = q_norm(qA) * kmx, bndB = q_norm(qB) * kmx;
  const int qposA = q0 + wid * 64 + r32;
  const float refA = (cl2[(size_t)bh * SEQ + qposA] + CARRY[qposA >> 7] - cq) + fmaxf(0.f, bndA - 60.f);
  const float refB = (cl2[(size_t)bh * SEQ + qposA + 32] + CARRY[(qposA + 32) >> 7] - cq) + fmaxf(0.f, bndB - 60.f);
  const bf16x8 augA = aug_a(hi);
  __builtin_amdgcn_s_waitcnt(0x0F70);
  bool stopped = false;
  int cur = 0, nx2 = 2, vc = 0, vn2 = 2;
  PROF_END(11, pacc);
  for (int i = 0; i < NT; ++i) {
    const int j = NT - 1 - i;
    if (PROF_ID == 13) pacc += 100;
    PROF_BEGIN(8);
    if (i + 1 < NT) ATT_WAIT_BAR(3); else ATT_WAIT_BAR(0);
    PROF_END(8, pacc);
    if (all_done(DONE, i)) break;
    if (i + 2 < NT) FOX_LOAD(j - 2, nx2, vn2);
    if (j <= jl && !stopped) {
      const float bj = ((const ATT_LAS float*)(BW + cur * 256))[63] + (CARRY[j >> 1] - cq);
      const float tA = bndA + (bj - refA) - __builtin_amdgcn_logf(lA), tB = bndB + (bj - refB) - __builtin_amdgcn_logf(lB);
      if (!__any(fmaxf(tA, tB) >= -SKIP_T)) { stopped = true; if (lane == 0) DONE[wid] = i; }
    }
    if (j <= jl && !stopped) {
      PROF_BEGIN(9);
      f32x16 pA0, pA1, pB0, pB1; bf16x8 paA0, paA1, paA2, paA3, paB0, paB1, paB2, paB3;
      const float c2 = CARRY[j >> 1] - cq;
      { const ATT_LAS float* BT = (const ATT_LAS float*)(BW + cur * 256); const ATT_LAS unsigned char* Ks = lds + cur * 8192;
#pragma unroll
        for (int g = 0; g < 4; ++g) { const f32x4 b0 = *(const ATT_LAS f32x4*)(BT + 8 * g + 4 * hi), b1 = *(const ATT_LAS f32x4*)(BT + 32 + 8 * g + 4 * hi);
#pragma unroll
          for (int e = 0; e < 4; ++e) { pA0[4 * g + e] = b0[e]; pA1[4 * g + e] = b1[e]; pB0[4 * g + e] = b0[e]; pB1[4 * g + e] = b1[e]; } }
#pragma unroll
        for (int d0 = 0; d0 < 4; ++d0) {
          const bf16x8 k0 = *(const ATT_LAS bf16x8*)(Ks + ksw(r32, 2 * d0 + hi));
          const bf16x8 k1 = *(const ATT_LAS bf16x8*)(Ks + ksw(32 + r32, 2 * d0 + hi));
          pA0 = __builtin_amdgcn_mfma_f32_32x32x16_bf16(k0, qA[d0], pA0, 0, 0, 0); pB0 = __builtin_amdgcn_mfma_f32_32x32x16_bf16(k0, qB[d0], pB0, 0, 0, 0);
          pA1 = __builtin_amdgcn_mfma_f32_32x32x16_bf16(k1, qA[d0], pA1, 0, 0, 0); pB1 = __builtin_amdgcn_mfma_f32_32x32x16_bf16(k1, qB[d0], pB1, 0, 0, 0);
          if (d0 == 1) ATT_SBAR(); }
        const bf16x8 gA = aug_b(c2 - refA, hi), gB = aug_b(c2 - refB, hi);
        pA0 = __builtin_amdgcn_mfma_f32_32x32x16_bf16(augA, gA, pA0, 0, 0, 0); pA1 = __builtin_amdgcn_mfma_f32_32x32x16_bf16(augA, gA, pA1, 0, 0, 0);
        pB0 = __builtin_amdgcn_mfma_f32_32x32x16_bf16(augA, gB, pB0, 0, 0, 0); pB1 = __builtin_amdgcn_mfma_f32_32x32x16_bf16(augA, gB, pB1, 0, 0, 0); }
      if (j == jl) { const int qrel = opaque(r32), hio = opaque(hi);
#pragma unroll
        for (int r = 0; r < 16; ++r) { const int kr = crow(r, hio); if (kr > qrel) { pA0[r] = -1e30f; pB1[r] = -1e30f; } pA1[r] = -1e30f; } }
      sm_direct(pA0, pA1, lA, paA0, paA1, paA2, paA3);
      sm_direct(pB0, pB1, lB, paB0, paB1, paB2, paB3);
      PROF_END(9, pacc);
      PROF_BEGIN(10);
      { const int vb = vb0 + vc * 8192;
#define FOX2_TR8(S, D0_) do { \
        S[0] = tr_read<v_rd_off<2>(D0_, 0, 0)>(vb); S[1] = tr_read<v_rd_off<2>(D0_, 0, 1)>(vb); S[2] = tr_read<v_rd_off<2>(D0_, 1, 0)>(vb); S[3] = tr_read<v_rd_off<2>(D0_, 1, 1)>(vb); \
        S[4] = tr_read<v_rd_off<2>(D0_, 2, 0)>(vb); S[5] = tr_read<v_rd_off<2>(D0_, 2, 1)>(vb); S[6] = tr_read<v_rd_off<2>(D0_, 3, 0)>(vb); S[7] = tr_read<v_rd_off<2>(D0_, 3, 1)>(vb); } while (0)
#define FOX2_PK(L, H) (bf16x8){L[0], L[1], L[2], L[3], H[0], H[1], H[2], H[3]}
#define FOX2_MM(OD, P0_, P1_, P2_, P3_, S) do { \
        OD = __builtin_amdgcn_mfma_f32_32x32x16_bf16(P0_, FOX2_PK(S[0], S[1]), OD, 0, 0, 0); OD = __builtin_amdgcn_mfma_f32_32x32x16_bf16(P1_, FOX2_PK(S[2], S[3]), OD, 0, 0, 0); \
        OD = __builtin_amdgcn_mfma_f32_32x32x16_bf16(P2_, FOX2_PK(S[4], S[5]), OD, 0, 0, 0); OD = __builtin_amdgcn_mfma_f32_32x32x16_bf16(P3_, FOX2_PK(S[6], S[7]), OD, 0, 0, 0); } while (0)
        s16x4 S0[8], S1[8];
        FOX2_TR8(S0, 0); FOX2_TR8(S1, 1);
        asm volatile("s_waitcnt lgkmcnt(8)" ::: "memory"); ATT_SBAR();
        FOX2_MM(oA[0], paA0, paA1, paA2, paA3, S0); FOX2_MM(oB[0], paB0, paB1, paB2, paB3, S0);
        asm volatile("s_waitcnt lgkmcnt(0)" ::: "memory"); ATT_SBAR();
        FOX2_MM(oA[1], paA0, paA1, paA2, paA3, S1); FOX2_MM(oB[1], paB0, paB1, paB2, paB3, S1);
#undef FOX2_TR8
#undef FOX2_PK
#undef FOX2_MM
      }
      PROF_END(10, pacc);
    }
    cur = cur == 2 ? 0 : cur + 1; nx2 = nx2 == 2 ? 0 : nx2 + 1; vc = (vc + 1) & 3; vn2 = (vn2 + 1) & 3;
  }
#undef FOX_LOAD
  PROF_BEGIN(12);
  asm volatile("s_waitcnt vmcnt(0)" ::: "memory");
  lA = lx_sum32(lA); lB = lx_sum32(lB);
  { const int le = opaque(lane), r32e = le & 31, hie = le >> 5;
    if (hie == 0) wsf[32 + r32e] = lA; asm volatile("s_waitcnt lgkmcnt(0)" ::: "memory");
    bf16_t* Ow = attn + (rowb + q0 + wid * 64) * LDATT + h * 64 + r32e;
#pragma unroll
    for (int r = 0; r < 16; ++r) { const int orow = crow(r, hie); const float rl = __builtin_amdgcn_rcpf(wsf[32 + orow]);
#pragma unroll
      for (int d0 = 0; d0 < 2; ++d0) { const unsigned w = cvtpk(oA[d0][r] * rl, 0.f); Ow[(size_t)orow * LDATT + d0 * 32] = (bf16_t)(w & 0xffffu); } }
    asm volatile("s_waitcnt lgkmcnt(0)" ::: "memory");
    if (hie == 0) wsf[32 + r32e] = lB; asm volatile("s_waitcnt lgkmcnt(0)" ::: "memory");
#pragma unroll
    for (int r = 0; r < 16; ++r) { const int orow = crow(r, hie); const float rl = __builtin_amdgcn_rcpf(wsf[32 + orow]);
#pragma unroll
      for (int d0 = 0; d0 < 2; ++d0) { const unsigned w = cvtpk(oB[d0][r] * rl, 0.f); Ow[(size_t)(32 + orow) * LDATT + d0 * 32] = (bf16_t)(w & 0xffffu); } } }
  asm volatile("s_waitcnt lgkmcnt(0)" ::: "memory");
  __syncthreads();
  PROF_END(12, pacc);
}

__device__ __forceinline__ void diff_unit(ATT_LAS unsigned char* lds, const bf16_t* __restrict__ qkv, bf16_t* __restrict__ attn, const float* __restrict__ subln_g, float lam, const unsigned* km,
                                          int b, int h, int qb, int wave, unsigned long long& pacc) {
  PROF_BEGIN(6);
  const int wid = wave, lane = fresh_lane(), tid = wid * 64 + lane, r32 = lane & 31, hi = lane >> 5;
  ATT_LAS float* wsf = (ATT_LAS float*)(lds + 114688) + wid * 64; ATT_LAS float* BT = (ATT_LAS float*)(lds + 116736) + wid * 64;
  ATT_LAS int* DONE = (ATT_LAS int*)(lds + 118784);
  if (lane == 0) DONE[wid] = 0x7fffffff;
  const int map = wid >> 2, w4 = wid & 3;
  const int q0 = qb * 128, NT = 2 * (qb + 1), jl = 2 * qb + (w4 >> 1);
  const size_t rowb = (size_t)b * SEQ;
  const float sl2 = LOG2E * (h == 0 ? 0.25f : h == 1 ? 0.0625f : h == 2 ? 0.015625f : 0.00390625f);
  const int pk = 64 * wid + lane;
  unsigned koff, voff0, voff1;
  { const int row = pk >> 3, c = (pk & 7) ^ ((row >> 1) & 7); koff = (unsigned)((row * LDQKV + 2048 + h * 128 + c * 8) * 2);
    const int sub0 = pk >> 5, kk0 = 8 * (sub0 >> 2) + ((pk & 31) >> 2), k0 = swap23(kk0), c0 = (sub0 & 3) * 32 + (pk & 3) * 8; voff0 = (unsigned)((k0 * LDQKV + 2560 + h * 128 + c0) * 2);
    const int p1 = pk + 512, sub1 = p1 >> 5, kk1 = 8 * (sub1 >> 2) + ((p1 & 31) >> 2), k1 = swap23(kk1), c1 = (sub1 & 3) * 32 + (p1 & 3) * 8; voff1 = (unsigned)((k1 * LDQKV + 2560 + h * 128 + c1) * 2); }
  const char* tb = (const char*)(qkv + rowb * LDQKV);
  const int vb0 = (int)(uintptr_t)(lds + 49152) + v_rd_base(lane);
#define DIFF_LOAD(j, kbo, vbo) do { const char* tj = tb + (size_t)(j) * (64 * LDQKV * 2); dma16(tj + koff, lds + (kbo) * 8192 + wid * 1024); dma16(tj + koff + 128, lds + 24576 + (kbo) * 8192 + wid * 1024); \
    dma16(tj + voff0, lds + 49152 + (vbo) * 16384 + wid * 1024); dma16(tj + voff1, lds + 49152 + (vbo) * 16384 + 8192 + wid * 1024); } while (0)
#define DIFF_PV(vbo) pv_all<4>(o, vb0 + (vbo) * 16384, pa0, pa1, pa2, pa3)
  ATT_LAS unsigned char* QS = lds + 118912;
  { const int pq = pk + 512, r0_ = pk >> 3, c0q = (pk & 7) ^ ((r0_ >> 1) & 7), r1_ = pq >> 3, c1q = (pq & 7) ^ ((r1_ >> 1) & 7);
    const char* qb_ = (const char*)(qkv + (rowb + q0) * LDQKV + 1536 + h * 128);
#pragma unroll
    for (int m2 = 0; m2 < 2; ++m2) { dma16(qb_ + ((size_t)r0_ * LDQKV + m2 * 64 + c0q * 8) * 2, QS + m2 * 16384 + wid * 1024); dma16(qb_ + ((size_t)r1_ * LDQKV + m2 * 64 + c1q * 8) * 2, QS + m2 * 16384 + 8192 + wid * 1024); } }
  DIFF_LOAD(NT - 1, 0, 0); DIFF_LOAD(NT - 2, 1, 1);
  __builtin_amdgcn_s_waitcnt(0x0F70);
  asm volatile("s_waitcnt lgkmcnt(0)\n\ts_barrier" ::: "memory");
  const ATT_LAS unsigned char* Qs = QS + map * 16384; const int qrow = 32 * w4 + r32;
  float l_reg = 0.f; f32x16 o[4]; o[0] = f32x16{}; o[1] = f32x16{}; o[2] = f32x16{}; o[3] = f32x16{};
  float bnd;
  { bf16x8 qr[4];
#pragma unroll
    for (int d0 = 0; d0 < 4; ++d0) qr[d0] = *(const ATT_LAS bf16x8*)(Qs + ksw(qrow, 2 * d0 + hi));
    bnd = q_norm(qr) * k_max(km + b * 96, 64 + 4 * h + 2 * map); }
  const float refq = sl2 * (float)(32 * w4 + r32) + fmaxf(0.f, bnd - 60.f);
  const bf16x8 augA0 = aug_a_alibi(r32, hi), augA1 = aug_a_alibi(r32 + 32, hi);
  unsigned s_hi, s_lo; { s_hi = cvtpk(sl2, 0.f) & 0xffffu; s_lo = cvtpk(sl2 - __uint_as_float(s_hi << 16), 0.f) & 0xffffu; }
  __builtin_amdgcn_s_waitcnt(0x0F70);
  bool stopped = false, pend = false; const bool late = wid >= 4;
  bf16x8 pa0, pa1, pa2, pa3;
  int cur = 0, nx2 = 2, vc = 0, vn2 = 2, vprev = 3;
  PROF_END(6, pacc);
  for (int i = 0; i < NT; ++i) {
    const int j = NT - 1 - i;
    if (PROF_ID == 14) pacc += 100;
    PROF_BEGIN(3);
    if (i + 1 < NT) ATT_WAIT_BAR(4); else ATT_WAIT_BAR(0);
    PROF_END(3, pacc);
    if (all_done(DONE, i)) break;
    if (i + 2 < NT) DIFF_LOAD(j - 2, nx2, vn2);
    if (pend) { PROF_BEGIN(5); DIFF_PV(vprev); pend = false; PROF_END(5, pacc); }
    if (j < jl && !stopped) {
      const float bj = sl2 * (float)(64 * j + 63 - q0);
      if (!__any(bnd + (bj - refq) - __builtin_amdgcn_logf(l_reg) >= -SKIP_T)) { stopped = true; if (lane == 0) DONE[wid] = i; }
    }
    if (j <= jl && !stopped) {
      f32x16 p0, p1;
      PROF_BEGIN(4); PROF_BEGIN(15);
      qkt_aug_q(p0, p1, lds + map * 24576 + cur * 8192, Qs, qrow, r32, hi, augA0, augA1, aug_b_alibi(sl2 * (float)(64 * j - q0) - refq, s_hi, s_lo, hi));
      PROF_END(15, pacc);
      if (j == jl) { const int tq = opaque(32 * (w4 & 1) + r32), hio = opaque(hi);
#pragma unroll
        for (int r = 0; r < 16; ++r) { const int k0 = crow(r, hio), k1 = k0 + 32; if (k0 > tq) p0[r] += sl2 * (float)(2 * (tq - k0)); if (k1 > tq) p1[r] += sl2 * (float)(2 * (tq - k1)); } }
      PROF_BEGIN(16);
      sm_direct(p0, p1, l_reg, pa0, pa1, pa2, pa3);
      PROF_END(16, pacc);
      PROF_END(4, pacc);
      if (late) pend = true; else { PROF_BEGIN(5); DIFF_PV(vc); PROF_END(5, pacc); }
    }
    cur = cur == 2 ? 0 : cur + 1; nx2 = nx2 == 2 ? 0 : nx2 + 1; vprev = vc; vc = (vc + 1) & 3; vn2 = (vn2 + 1) & 3;
  }
  if (pend) DIFF_PV(vprev);
#undef DIFF_PV
  PROF_BEGIN(7);
#undef DIFF_LOAD
  asm volatile("s_waitcnt vmcnt(0)" ::: "memory");
  l_reg = lx_sum32(l_reg);
  if (hi == 0) wsf[32 + r32] = l_reg; asm volatile("s_waitcnt lgkmcnt(0)" ::: "memory");
  const int te = opaque(tid), r32e = te & 31, hie = (te >> 5) & 1;
  float rl[16];
#pragma unroll
  for (int r = 0; r < 16; ++r) rl[r] = __builtin_amdgcn_rcpf(wsf[32 + crow(r, hie)]);
  asm volatile("s_waitcnt lgkmcnt(0)" ::: "memory");
  __syncthreads();
  { ATT_LAS float* Xm = (ATT_LAS float*)lds + map * (128 * 132);
#pragma unroll
    for (int r = 0; r < 16; ++r) { const int orow = crow(r, hie);
#pragma unroll
      for (int d0 = 0; d0 < 4; ++d0) Xm[(32 * w4 + orow) * 132 + d0 * 32 + r32e] = o[d0][r] * rl[r]; } }
  __syncthreads();
  { const int row = te >> 2, qt = te & 3; const ATT_LAS float* X0 = (const ATT_LAS float*)lds + row * 132 + qt * 32; const ATT_LAS float* X1 = X0 + 128 * 132;
    float v[32]; float ss = 0.f;
#pragma unroll
    for (int i = 0; i < 8; ++i) { const f32x4 t0 = *(const ATT_LAS f32x4*)(X0 + 4 * i), t1 = *(const ATT_LAS f32x4*)(X1 + 4 * i); const f32x4 t = t0 - lam * t1;
      v[4 * i] = t[0]; v[4 * i + 1] = t[1]; v[4 * i + 2] = t[2]; v[4 * i + 3] = t[3];
      ss += t[0] * t[0] + t[1] * t[1] + t[2] * t[2] + t[3] * t[3]; }
    ss += lx_get<1>(ss); ss += lx_get<2>(ss);
    const float rstd = 0.8f / sqrtf(ss * (1.0f / 128.0f) + 1e-5f);
    bf16_t* op = attn + (rowb + q0 + row) * LDATT + 512 + h * 128 + qt * 32; const f32x4* gp = (const f32x4*)(subln_g + qt * 32);
#pragma unroll
    for (int i = 0; i < 4; ++i) { const f32x4 g0 = gp[2 * i], g1 = gp[2 * i + 1]; u32x4 w;
      w.x = cvtpk(v[8 * i + 0] * rstd * g0[0], v[8 * i + 1] * rstd * g0[1]); w.y = cvtpk(v[8 * i + 2] * rstd * g0[2], v[8 * i + 3] * rstd * g0[3]);
      w.z = cvtpk(v[8 * i + 4] * rstd * g1[0], v[8 * i + 5] * rstd * g1[1]); w.w = cvtpk(v[8 * i + 6] * rstd * g1[2], v[8 * i + 7] * rstd * g1[3]);
      *(u32x4*)(op + 8 * i) = w; } }
  __syncthreads();
  PROF_END(7, pacc);
}
#undef ATT_WAIT_BAR
#undef ATT_SBAR
}

constexpr int NWAVES = 8;
constexpr int BATCH = 8, SEQ = 4096, D = 1024, T = BATCH * SEQ;
constexpr int IN_COLS = 3080, NQKV = 3072;
constexpr int NEXP = 32, DEXP = 512, NSLOT_MAX = 73728;
constexpr int NPH = 9;
constexpr float C2 = 0.125f * 1.4426950408889634f;
constexpr float LAM_INIT = 0.2f;

constexpr size_t MiB = 1u << 20;
constexpr size_t WS_CTL = 0, CTL_ZERO_BYTES = 256 * 1024;
constexpr size_t WS_WIN = 1 * MiB;
constexpr size_t WS_WO = 7 * MiB;
constexpr size_t WS_WGU = 9 * MiB;
constexpr size_t WS_WD = 73 * MiB;
constexpr size_t WS_WR = 105 * MiB;
constexpr size_t WS_MOD = 106 * MiB;
constexpr size_t WS_CUM = 107 * MiB;
constexpr size_t WS_BLK = 108 * MiB;
constexpr size_t WS_RT = 109 * MiB;
constexpr size_t WS_STOK = 110 * MiB;
constexpr size_t WS_R = 118 * MiB;
constexpr size_t WS_H = WS_R;
constexpr size_t WS_QKV = WS_R + 64 * MiB;
constexpr size_t WS_Y = WS_R;
constexpr size_t WS_HID = WS_R + 144 * MiB;
constexpr size_t WS_H2F8 = WS_R + 184 * MiB;
constexpr size_t WS_X1 = WS_R + 256 * MiB;
constexpr size_t WS_END = WS_X1 + 64 * MiB;
constexpr int CW_BAR = 4096;
constexpr int CW_KM = 32768;
constexpr int CW_QH = 36864;
constexpr int CW_CNT = 16384;

constexpr int LDS_BYTES = 155648;
constexpr int MISC_OFF = LDS_BYTES - 256;

#define GAS __attribute__((address_space(1)))
#define LAS __attribute__((address_space(3)))
typedef unsigned short bf16;
typedef unsigned v4u __attribute__((ext_vector_type(4)));
typedef unsigned v2u __attribute__((ext_vector_type(2)));
typedef float f32x4 __attribute__((ext_vector_type(4)));
typedef GAS unsigned gu32;
#define RLX_AGENT __ATOMIC_RELAXED, __HIP_MEMORY_SCOPE_AGENT
#define LDS_WAIT() asm volatile("s_waitcnt lgkmcnt(0)" ::: "memory")
#define VM_WAIT() asm volatile("s_waitcnt vmcnt(0)" ::: "memory")
__device__ __forceinline__ unsigned f2bf(float f) { unsigned u = __builtin_bit_cast(unsigned, f); return (u + 0x7fffu + ((u >> 16) & 1u)) >> 16; }
__device__ __forceinline__ unsigned pk2(float lo, float hi) { return f2bf(lo) | (f2bf(hi) << 16); }
__device__ __forceinline__ float bflo(unsigned w) { return __builtin_bit_cast(float, w << 16); }
__device__ __forceinline__ float bfhi(unsigned w) { return __builtin_bit_cast(float, w & 0xffff0000u); }
__device__ __forceinline__ float wave_sum(float v) {
#ifdef OLD_WSUM
#pragma unroll
    for (int o = 1; o < 64; o <<= 1) v += __shfl_xor(v, o);
    return v;
#else
    v += lx_get<1>(v); v += lx_get<2>(v); v += lx_get<4>(v); v += lx_get<8>(v); v += lx_get<16>(v);
    return lx_sum32(v);
#endif
}
#define XB_TMO      128
#define XB_XCNT(j)  (256  + 64 * (j))
#define XB_XSUB(j)  (1280 + 64 * (j))
#define XB_XGEN(j)  (2304 + 64 * (j))
#define XB_TOP      3328
#define XB_TOPGEN   3392
#define XCD_BAR_WORDS 3456
#define XB_SPIN_CAP (1u << 18)

__device__ __forceinline__ unsigned xb_ld(unsigned* p)              { return __hip_atomic_load(p, __ATOMIC_RELAXED, __HIP_MEMORY_SCOPE_AGENT); }
__device__ __forceinline__ unsigned xb_add(unsigned* p, unsigned v) { return __hip_atomic_fetch_add(p, v, __ATOMIC_RELAXED, __HIP_MEMORY_SCOPE_AGENT); }
__device__ __forceinline__ unsigned xb_xcc_id() { return (unsigned)__builtin_amdgcn_s_getreg((3 << 11) | 20) & 0xFu; }
#define XB_SPIN(cond, bar) do { unsigned _sp = 0; while (cond) { __builtin_amdgcn_s_sleep(1); \
    if ((++_sp & 255u) == 0u) { if (xb_ld(&(bar)[XB_TMO])) break; if (_sp > XB_SPIN_CAP) { atomicAdd(&(bar)[XB_TMO], 1u); break; } } } } while (0)

struct XcdBarrier {
    int wave;
    unsigned* bar; unsigned x;
    volatile LAS unsigned* st;
};

__device__ __forceinline__ XcdBarrier xcd_barrier_post(unsigned* bar, volatile LAS unsigned* st) {
    XcdBarrier b; b.bar = bar; b.x = xb_xcc_id(); b.st = st;
    if (threadIdx.x == 0) (void)xb_add(&bar[XB_XCNT(b.x)], 1u);
    return b;
}
__device__ __forceinline__ void xcd_barrier_complete(unsigned* bar, unsigned x, unsigned& nloc, unsigned& nx) {
    const unsigned G = gridDim.x * gridDim.y * gridDim.z;
    unsigned sum, cnt, mine, sp = 0u;
    for (;;) {
        sum = 0u; cnt = 0u; mine = 0u;
#pragma unroll
        for (unsigned j = 0; j < 16; ++j) { const unsigned c = xb_ld(&bar[XB_XCNT(j)]); sum += c; cnt += (c > 0u) ? 1u : 0u; mine = (j == x) ? c : mine; }
        if (sum == G) break;
        __builtin_amdgcn_s_sleep(1);
        if ((++sp & 255u) == 0u) { if (xb_ld(&bar[XB_TMO])) break; if (sp > XB_SPIN_CAP) { atomicAdd(&bar[XB_TMO], 1u); break; } }
    }
    nloc = mine > 0u ? mine : 1u; nx = cnt > 0u ? cnt : 1u;
}

__device__ __forceinline__ void xcd_barrier(const XcdBarrier& b) {
    asm volatile("s_waitcnt vmcnt(0)" ::: "memory");
    __syncthreads();
    if (b.wave == 0 && fresh_lane() == 0) {
        unsigned* bar = b.bar;
        __builtin_amdgcn_s_waitcnt(0);
        unsigned nloc = b.st[0], nx = b.st[1];
        if (nloc == 0u) { xcd_barrier_complete(bar, b.x, nloc, nx); b.st[0] = nloc; b.st[1] = nx; }
        const unsigned old = xb_add(&bar[XB_XSUB(b.x)], 1u);
        const unsigned gen = old / nloc;
        if (old + 1u == (gen + 1u) * nloc) {
            __builtin_amdgcn_fence(__ATOMIC_RELEASE, "agent");
            asm volatile("s_waitcnt vmcnt(0)" ::: "memory");
            const unsigned og = xb_add(&bar[XB_TOP], 1u);
            const unsigned tg = og / nx;
            if (og + 1u == (tg + 1u) * nx) xb_add(&bar[XB_TOPGEN], 1u);
            else XB_SPIN(xb_ld(&bar[XB_TOPGEN]) == tg, bar);
            __builtin_amdgcn_fence(__ATOMIC_ACQUIRE, "agent");
            xb_add(&bar[XB_XGEN(b.x)], 1u);
            asm volatile("s_waitcnt vmcnt(0)" ::: "memory");
        } else {
            XB_SPIN(xb_ld(&bar[XB_XGEN(b.x)]) == gen, bar);
            __builtin_amdgcn_fence(__ATOMIC_ACQUIRE, "agent");
            asm volatile("s_waitcnt vmcnt(0)" ::: "memory");
        }
    }
    __syncthreads();
}

template <bool F8OUT = false>
__device__ __forceinline__ void tr_item(const float* __restrict__ src, int ldS, bf16* __restrict__ dst, int ldD, float scale, LAS float* scr, int lane) {
    f32x4 v[8];
#pragma unroll
    for (int t = 0; t < 8; ++t) { const int idx = lane + 64 * t; v[t] = *(const f32x4*)(src + (size_t)(idx >> 3) * ldS + 4 * (idx & 7)); }
#pragma unroll
    for (int t = 0; t < 8; ++t) { const int idx = lane + 64 * t; LAS float* p = scr + (idx >> 3) * 33 + 4 * (idx & 7); p[0] = v[t].x; p[1] = v[t].y; p[2] = v[t].z; p[3] = v[t].w; }
    LDS_WAIT(); asm volatile("" ::: "memory");
    const int c = lane & 7;
#pragma unroll
    for (int j = 0; j < 4; ++j) { const int n = (lane >> 3) + 8 * j; const LAS float* s = scr + (8 * c) * 33 + n;
        if constexpr (F8OUT) {
            int t0 = 0, t1 = 0;
            t0 = __builtin_amdgcn_cvt_pk_fp8_f32(s[0 * 33] * scale, s[1 * 33] * scale, t0, false); t0 = __builtin_amdgcn_cvt_pk_fp8_f32(s[2 * 33] * scale, s[3 * 33] * scale, t0, true);
            t1 = __builtin_amdgcn_cvt_pk_fp8_f32(s[4 * 33] * scale, s[5 * 33] * scale, t1, false); t1 = __builtin_amdgcn_cvt_pk_fp8_f32(s[6 * 33] * scale, s[7 * 33] * scale, t1, true);
            v2u o; o.x = (unsigned)t0; o.y = (unsigned)t1; *(v2u*)((unsigned char*)dst + (size_t)n * ldD + 8 * c) = o;
        } else {
        v4u o; o.x = pk2(s[0 * 33] * scale, s[1 * 33] * scale); o.y = pk2(s[2 * 33] * scale, s[3 * 33] * scale); o.z = pk2(s[4 * 33] * scale, s[5 * 33] * scale); o.w = pk2(s[6 * 33] * scale, s[7 * 33] * scale);
        *(v4u*)(dst + (size_t)n * ldD + 8 * c) = o; } }
    LDS_WAIT(); asm volatile("" ::: "memory");
}
constexpr int XI_GU = 32 * 16 * 32, XI_D = 32 * 8 * 32, XI_PER_UNIT = 48, X_UNITS = (XI_GU + XI_D) / XI_PER_UNIT;
__device__ __forceinline__ void expert_item(const float* __restrict__ w_gate, const float* __restrict__ w_up, const float* __restrict__ w_down, bf16* __restrict__ Wt_gu, bf16* __restrict__ Wt_d, int r, LAS float* scr, int lane) {
    if (r < XI_GU) { const int e = r / 512, q = r % 512, kb = q / 32, nb = q % 32, n0 = 32 * nb, pn = n0 >> 8, bj = (n0 >> 7) & 1, j0 = n0 & 127;
        const float* src = (bj ? w_up : w_gate) + (size_t)e * 1024 * 512 + (size_t)(64 * kb) * 512 + 128 * pn + j0;
        tr_item<true>(src, 512, (bf16*)((unsigned char*)Wt_gu + ((size_t)e * 1024 + n0) * 1024 + 64 * kb), 1024, 32.0f, scr, lane); }
    else { r -= XI_GU; const int e = r / 256, q = r % 256, kb = q / 32, nb = q % 32;
        tr_item<true>(w_down + (size_t)e * 512 * 1024 + (size_t)(64 * kb) * 1024 + 32 * nb, 1024, (bf16*)((unsigned char*)Wt_d + ((size_t)e * 1024 + 32 * nb) * 512 + 64 * kb), 512, 32.0f, scr, lane); }
}
struct P0Args { const float *c, *ada_w, *ada_b, *w_in, *w_o, *w_rg, *w_re, *w_gate, *w_up, *w_down; bf16 *Wt_in, *Wt_o, *Wt_gu, *Wt_d; float *Wr, *mod; };
__device__ __forceinline__ void p0_prologue(const P0Args& a, LAS unsigned char* lds, int vcu, int G, int tid, int wave, int lane) {
    LAS float* scr = (LAS float*)(lds + wave * 8448);
    const int gw = vcu * NWAVES + wave, NGW = G * NWAVES;
    constexpr int I_IN = 16 * 96, I_O = 16 * 32, I_GU = 32 * 16 * 32, I_D = 32 * 8 * 32;
    constexpr int NITEMS = I_IN + I_O;
    for (int it = gw; it < NITEMS; it += NGW) {
        int r = it;
        if (r < I_IN) { const int kb = r / 96, nb = r % 96, n0 = 32 * nb, sc = n0 < 1536 ? n0 : n0 + 8;
            const float scale = (n0 < 512 || (n0 >= 1536 && n0 < 2048)) ? C2 : 1.0f;
            tr_item(a.w_in + (size_t)(64 * kb) * IN_COLS + sc, IN_COLS, a.Wt_in + (size_t)n0 * 1024 + 64 * kb, 1024, scale, scr, lane); continue; }
        r -= I_IN;
        { const int kb = r / 32, nb = r % 32;
            tr_item(a.w_o + (size_t)(64 * kb) * 1024 + 32 * nb, 1024, a.Wt_o + (size_t)(32 * nb) * 1024 + 64 * kb, 1024, 1.0f, scr, lane); }
    }
    for (int t = (vcu * NWAVES * 64 + tid); t < 32 * 3 * 2 * 64; t += G * NWAVES * 64) { const int l = t & 63, part = (t >> 6) & 1, ic = t >> 7, c = ic % 3, i = ic / 3, n = 16 * c + (l & 15), k0 = 32 * i + 8 * (l >> 4);
        unsigned short o[8];
#pragma unroll
        for (int j = 0; j < 8; ++j) { const int k = k0 + j; const float w = n < 32 ? a.w_re[k * 32 + n] : (n < 36 ? a.w_rg[k * 4 + (n - 32)] : 0.f);
            const unsigned hi = f2bf(w); const float lo = w - __builtin_bit_cast(float, hi << 16); o[j] = (unsigned short)(part ? f2bf(lo) : hi); }
        v4u pk; pk.x = o[0] | ((unsigned)o[1] << 16); pk.y = o[2] | ((unsigned)o[3] << 16); pk.z = o[4] | ((unsigned)o[5] << 16); pk.w = o[6] | ((unsigned)o[7] << 16);
        *(v4u*)((bf16*)a.Wr + (size_t)t * 8) = pk; }
    for (int t = (vcu * NWAVES * 64 + tid); t < 32 * 2 * 64; t += G * NWAVES * 64) { const int l = t & 63, part = (t >> 6) & 1, i = t >> 7, n = l & 15, k0 = 32 * i + 8 * (l >> 4);
        unsigned short o[8];
#pragma unroll
        for (int j = 0; j < 8; ++j) { const float w = n < 8 ? a.w_in[(size_t)(k0 + j) * IN_COLS + 1536 + n] : 0.f;
            const unsigned hi = f2bf(w); const float lo = w - __builtin_bit_cast(float, hi << 16); o[j] = (unsigned short)(part ? f2bf(lo) : hi); }
        v4u pk; pk.x = o[0] | ((unsigned)o[1] << 16); pk.y = o[2] | ((unsigned)o[3] << 16); pk.z = o[4] | ((unsigned)o[5] << 16); pk.w = o[6] | ((unsigned)o[7] << 16);
        *(v4u*)((bf16*)a.Wr + 131072 + (size_t)t * 8) = pk; }
    __syncthreads();
    LAS float* cs = (LAS float*)(lds + 69632);
    LAS float* red = (LAS float*)(lds + 69632 + 32768);
    for (int i = tid; i < 8192; i += NWAVES * 64) cs[i] = a.c[i];
    __syncthreads();
    for (int ch = vcu; ch < 256; ch += G) {
        const int col = lane % 24, half = lane / 24;
        float acc[8];
#pragma unroll
        for (int b = 0; b < 8; ++b) acc[b] = 0.f;
        if (lane < 48) {
            const int kb = wave * 128 + half * 64;
            const float* wp = a.ada_w + (size_t)kb * 6144 + ch * 24 + col;
#pragma unroll 16
            for (int k = 0; k < 64; ++k) { const float wv = wp[(size_t)k * 6144];
#pragma unroll
                for (int b = 0; b < 8; ++b) acc[b] = fmaf(cs[b * 1024 + kb + k], wv, acc[b]); }
#pragma unroll
            for (int b = 0; b < 8; ++b) red[((wave * 2 + half) * 8 + b) * 24 + col] = acc[b];
        }
        __syncthreads();
        if (tid < 192) { const int b = tid / 24, cl = tid % 24; float s = a.ada_b[ch * 24 + cl];
#pragma unroll
          for (int w = 0; w < 16; ++w) s += red[(w * 8 + b) * 24 + cl];
          a.mod[b * 6144 + ch * 24 + cl] = s; }
        __syncthreads();
    }
}

typedef short p5_bf16x8 __attribute__((ext_vector_type(8)));
__device__ __forceinline__ void p1_norm(const float* __restrict__ x, const float* __restrict__ g1, const float* __restrict__ mod, const bf16* __restrict__ WfzF, const float* __restrict__ b_f,
                                        bf16* __restrict__ H, float* __restrict__ cumloc, float* __restrict__ blktot, LAS unsigned char* lds, int vcu, int G, int tid, int wave, int lane) {
    LAS float* lf = (LAS float*)(lds + 65536); LAS float* segtot = (LAS float*)(lds + 69632);
    for (int i = tid; i < 4096; i += NWAVES * 64) ((LAS v4u*)lds)[i] = ((const v4u*)WfzF)[i];
    __syncthreads();
    for (int rb = vcu; rb < T / 128; rb += G) {
        const int b = rb >> 5;
        { f32x4 A[4], Bc[4];
#pragma unroll
          for (int j = 0; j < 4; ++j) { const int col = 256 * j + 4 * lane; const f32x4 g = *(const f32x4*)(g1 + col), sc = *(const f32x4*)(mod + b * 6144 + 1024 + col);
            A[j] = g * (1.0f + sc); Bc[j] = *(const f32x4*)(mod + b * 6144 + col); }
          f32x4 XB[3][4];
          const int row0 = rb * 128 + wave * 16;
#define P1_ISS(i) { const f32x4* xr = (const f32x4*)(x + (size_t)(row0 + (i)) * D) + lane; _Pragma("unroll") for (int j = 0; j < 4; ++j) XB[(i) % 3][j] = xr[64 * j]; }
#pragma unroll
          for (int rr = 0; rr < 16; ++rr) {
            if (rr == 0) { P1_ISS(0) P1_ISS(1) P1_ISS(2) __builtin_amdgcn_sched_barrier(0); }
            float s = 0.f;
#pragma unroll
            for (int j = 0; j < 4; ++j) { const f32x4 v = XB[rr % 3][j]; s += (v.x * v.x + v.y * v.y) + (v.z * v.z + v.w * v.w); }
            const float rstd = 1.0f / sqrtf(wave_sum(s) * (1.0f / D) + 1e-6f);
            v2u* o8 = (v2u*)(H + (size_t)(row0 + rr) * D) + lane;
#pragma unroll
            for (int j = 0; j < 4; ++j) { const f32x4 h = XB[rr % 3][j] * rstd * A[j] + Bc[j]; v2u w; w.x = pk2(h.x, h.y); w.y = pk2(h.z, h.w); o8[64 * j] = w; }
            __builtin_amdgcn_sched_barrier(0);
            if (rr + 3 < 16) { P1_ISS(rr + 3) __builtin_amdgcn_sched_barrier(0); }
          } }
#undef P1_ISS
        VM_WAIT();
        f32x4 acc = (f32x4){0.f, 0.f, 0.f, 0.f};
        { const bf16* ap = H + (size_t)(rb * 128 + wave * 16 + (lane & 15)) * D + 8 * (lane >> 4);
          const LAS p5_bf16x8* bp = (const LAS p5_bf16x8*)lds + lane;
#pragma unroll 8
          for (int i = 0; i < 32; ++i) {
            const p5_bf16x8 af = *(const p5_bf16x8*)(ap + 32 * i);
            acc = __builtin_amdgcn_mfma_f32_16x16x32_bf16(af, bp[(i * 2 + 0) * 64], acc, 0, 0, 0);
            acc = __builtin_amdgcn_mfma_f32_16x16x32_bf16(af, bp[(i * 2 + 1) * 64], acc, 0, 0, 0); } }
        if ((lane & 15) < 8) { const float bfv = b_f[lane & 15];
#pragma unroll
            for (int r = 0; r < 4; ++r) { const float z = acc[r] + bfv; lf[(wave * 16 + 4 * (lane >> 4) + r) * 8 + (lane & 15)] = fminf(z, 0.f) - log1pf(expf(-fabsf(z))); } }
        __syncthreads();
        float run[16]; const int hh = tid & 7, seg = (tid >> 3) & 7;
        if (tid < 64) { float s = 0.f;
#pragma unroll
            for (int i = 0; i < 16; ++i) { s += lf[(seg * 16 + i) * 8 + hh]; run[i] = s; }
            segtot[seg * 8 + hh] = s; }
        __syncthreads();
        if (tid < 64) { float off = 0.f;
            for (int s2 = 0; s2 < seg; ++s2) off += segtot[s2 * 8 + hh];
            float* cp = cumloc + (size_t)(b * 8 + hh) * SEQ + (rb & 31) * 128 + seg * 16;
            const float NL2E = -1.4426950408889634f;
#pragma unroll
            for (int i = 0; i < 4; ++i) { f32x4 t; t.x = (run[4 * i] + off) * NL2E; t.y = (run[4 * i + 1] + off) * NL2E; t.z = (run[4 * i + 2] + off) * NL2E; t.w = (run[4 * i + 3] + off) * NL2E; *(f32x4*)(cp + 4 * i) = t; }
            if (seg == 7) blktot[rb * 8 + hh] = (run[15] + off) * NL2E; }
        __syncthreads();
    }
}

__device__ __forceinline__ void p5_route(const bf16* __restrict__ x1, const float* __restrict__ g2, const float* __restrict__ mod, const bf16* __restrict__ WrF, const float* __restrict__ b_rg, const float* __restrict__ b_re,
                                         bf16* __restrict__ H2, unsigned char* __restrict__ H2F8, gu32* cnt, int* __restrict__ stok, int* __restrict__ rt_e, int* __restrict__ rt_pos, float* __restrict__ rt_w,
                                         LAS unsigned char* lds, int vcu, int G, int tid, int wave, int lane) {
    LAS unsigned* CNT = (LAS unsigned*)lds; LAS unsigned* BASE = (LAS unsigned*)(lds + 128); LAS unsigned* REC = (LAS unsigned*)(lds + 256); LAS unsigned char* RB = lds + 4352 + wave * 16640;
    LAS float* LG = (LAS float*)RB;
    if (tid < 32) CNT[tid] = 0u;
    __syncthreads();
    for (int rb = vcu; rb < T / 128; rb += G) {
        const int b = rb >> 5;
        v2u KEEP[16][2];
        { f32x4 A[4], Bc[4];
#pragma unroll
          for (int j = 0; j < 4; ++j) { const int col = 256 * j + 4 * lane; const f32x4 g = *(const f32x4*)(g2 + col), sc = *(const f32x4*)(mod + b * 6144 + 4096 + col);
            A[j] = g * (1.0f + sc); Bc[j] = *(const f32x4*)(mod + b * 6144 + 3072 + col); }
          v2u XB[4][4];
          const int row0 = rb * 128 + wave * 16;
#define P5_ISS(i) { const GAS v2u* xr = (const GAS v2u*)(x1 + (size_t)(row0 + (i)) * D) + lane; _Pragma("unroll") for (int j = 0; j < 4; ++j) XB[(i) % 4][j] = xr[64 * j]; }
#pragma unroll
          for (int rr = 0; rr < 16; ++rr) {
            if (rr == 0) { P5_ISS(0) P5_ISS(1) P5_ISS(2) P5_ISS(3) __builtin_amdgcn_sched_barrier(0); }
            f32x4 v[4]; float s = 0.f;
#pragma unroll
            for (int j = 0; j < 4; ++j) { const v2u xw = XB[rr % 4][j]; v[j].x = bflo(xw.x); v[j].y = bfhi(xw.x); v[j].z = bflo(xw.y); v[j].w = bfhi(xw.y); s += (v[j].x * v[j].x + v[j].y * v[j].y) + (v[j].z * v[j].z + v[j].w * v[j].w); }
            const float rstd = 1.0f / sqrtf(wave_sum(s) * (1.0f / D) + 1e-6f);
            GAS unsigned* o4 = (GAS unsigned*)(H2F8 + (size_t)(row0 + rr) * D) + lane;
#pragma unroll
            for (int j = 0; j < 4; ++j) { const f32x4 h = v[j] * rstd * A[j] + Bc[j]; v2u w; w.x = pk2(h.x, h.y); w.y = pk2(h.z, h.w);
                if (j < 2) *(LAS v2u*)(RB + rr * 1040 + (256 * j + 4 * lane) * 2) = w; else KEEP[rr][j - 2] = w;
                int t = 0; t = __builtin_amdgcn_cvt_pk_fp8_f32(h.x, h.y, t, false); t = __builtin_amdgcn_cvt_pk_fp8_f32(h.z, h.w, t, true); o4[64 * j] = (unsigned)t; }
            __builtin_amdgcn_sched_barrier(0);
            if (rr + 4 < 16) { P5_ISS(rr + 4) __builtin_amdgcn_sched_barrier(0); }
          } }
#undef P5_ISS
        f32x4 acc[3];
#pragma unroll
        for (int c = 0; c < 3; ++c) acc[c] = (f32x4){0.f, 0.f, 0.f, 0.f};
        { const LAS unsigned char* ar = RB + (lane & 15) * 1040 + (lane >> 4) * 16;
          const GAS p5_bf16x8* bp = (const GAS p5_bf16x8*)WrF + lane;
#pragma unroll
          for (int hf = 0; hf < 2; ++hf) {
            if (hf == 1) {
#pragma unroll
                for (int rr = 0; rr < 16; ++rr)
#pragma unroll
                    for (int j = 0; j < 2; ++j) *(LAS v2u*)(RB + rr * 1040 + (256 * j + 4 * lane) * 2) = KEEP[rr][j];
            }
            LDS_WAIT();
#pragma unroll 4
            for (int i = 0; i < 16; ++i) {
                const p5_bf16x8 af = *(const LAS p5_bf16x8*)(ar + i * 64);
#pragma unroll
                for (int c = 0; c < 3; ++c) {
                    const p5_bf16x8 bh = bp[(((hf * 16 + i) * 3 + c) * 2 + 0) * 64], bl = bp[(((hf * 16 + i) * 3 + c) * 2 + 1) * 64];
                    acc[c] = __builtin_amdgcn_mfma_f32_16x16x32_bf16(af, bh, acc[c], 0, 0, 0);
                    acc[c] = __builtin_amdgcn_mfma_f32_16x16x32_bf16(af, bl, acc[c], 0, 0, 0); }
            }
          } }
#pragma unroll
        for (int c = 0; c < 3; ++c)
#pragma unroll
            for (int r = 0; r < 4; ++r) LG[(4 * (lane >> 4) + r) * 48 + 16 * c + (lane & 15)] = acc[c][r];
        LDS_WAIT();
        if (lane < 16) {
            const LAS float* L = LG + lane * 48;
            float gl[4];
#pragma unroll
            for (int i = 0; i < 4; ++i) gl[i] = L[32 + i] + b_rg[i];
            int g = 0; float gm = gl[0];
#pragma unroll
            for (int i = 1; i < 4; ++i) if (gl[i] > gm) { gm = gl[i]; g = i; }
            float gs = 0.f;
#pragma unroll
            for (int i = 0; i < 4; ++i) gs += expf(gl[i] - gm);
            const float pg = 1.0f / gs;
            float el[8];
#pragma unroll
            for (int i = 0; i < 8; ++i) el[i] = L[g * 8 + i] + b_re[g * 8 + i];
            int i1 = 0; float m1 = el[0];
#pragma unroll
            for (int i = 1; i < 8; ++i) if (el[i] > m1) { m1 = el[i]; i1 = i; }
            int i2 = -1; float m2 = -3.0e38f;
#pragma unroll
            for (int i = 0; i < 8; ++i) if (i != i1 && el[i] > m2) { m2 = el[i]; i2 = i; }
            const float ex = expf(m2 - m1); const float w1 = pg / (1.0f + ex), w2 = pg * ex / (1.0f + ex);
            const int e1 = g * 8 + i1, e2 = g * 8 + i2, rl = wave * 16 + lane;
            const unsigned p1 = __hip_atomic_fetch_add(&CNT[e1], 1u, __ATOMIC_RELAXED, __HIP_MEMORY_SCOPE_WORKGROUP), p2 = __hip_atomic_fetch_add(&CNT[e2], 1u, __ATOMIC_RELAXED, __HIP_MEMORY_SCOPE_WORKGROUP);
            REC[(rl * 2 + 0) * 4 + 0] = (unsigned)e1; REC[(rl * 2 + 0) * 4 + 1] = p1; REC[(rl * 2 + 0) * 4 + 2] = __float_as_uint(w1);
            REC[(rl * 2 + 1) * 4 + 0] = (unsigned)e2; REC[(rl * 2 + 1) * 4 + 1] = p2; REC[(rl * 2 + 1) * 4 + 2] = __float_as_uint(w2);
        }
        __syncthreads();
        if (tid < 32) BASE[tid] = __hip_atomic_fetch_add(cnt + 64 * tid, CNT[tid], RLX_AGENT);
        __syncthreads();
        if (tid < 256) { const unsigned e = REC[tid * 4 + 0], pl = REC[tid * 4 + 1], wb = REC[tid * 4 + 2]; const unsigned pos = BASE[e] + pl; const int tok = rb * 128 + (tid >> 1);
            stok[(size_t)e * 65536 + pos] = tok; rt_e[tok * 2 + (tid & 1)] = (int)e; rt_pos[tok * 2 + (tid & 1)] = (int)pos; rt_w[tok * 2 + (tid & 1)] = __uint_as_float(wb); }
        __syncthreads();
        if (tid < 32) CNT[tid] = 0u;
        __syncthreads();
    }
}

__device__ __forceinline__ void moe_tables(gu32* cnt, LAS int* TB, LAS int* CN, int tid) {
    if (tid < 64) {
        const int e = tid & 31; const int c = (int)__hip_atomic_load(cnt + 64 * e, RLX_AGENT); const int nt = (c + 255) >> 8; int v = nt;
#pragma unroll
        for (int off = 1; off < 32; off <<= 1) { const int t = __builtin_amdgcn_ds_bpermute(((tid - off) & 63) << 2, v); v += (e >= off) ? t : 0; }
        if (tid < 32) { CN[e] = c; TB[e] = v - nt; if (e == 31) TB[32] = v; } }
    __syncthreads();
}
struct MoeOrder {
    const LAS int* TB; const LAS int* CN; const int* stok; int G, c; bool gather;
    __device__ __forceinline__ bool next(int i, pg8::Unit& u) const {
        const int L = i * G + c; if (L >= 4 * TB[32]) return false;
        const int gt = L >> 2, ct = L & 3; int e = 0;
        for (int k = 1; k < 32; ++k) e += (gt >= TB[k]) ? 1 : 0;
        u.pm = gt; u.pn = e * 4 + ct; u.e = e; return true;
    }
    __device__ __forceinline__ void a_off(const pg8::Unit& u, const int (&RA)[2], const int (&CA)[2], int KB  , unsigned (&off)[2][2]) const {
        if (gather) {
            const int p0 = (u.pm - TB[u.e]) * 256, n = CN[u.e];
#pragma unroll
            for (int h = 0; h < 2; ++h)
#pragma unroll
                for (int i = 0; i < 2; ++i) { const int pos = p0 + h * 128 + RA[i]; const int tok = pos < n ? stok[(size_t)u.e * 65536 + pos] : 0;
                    off[h][i] = (unsigned)((size_t)tok * KB + CA[i] * 2); }
            __builtin_amdgcn_s_waitcnt(0x0F70);
        } else {
#pragma unroll
            for (int h = 0; h < 2; ++h)
#pragma unroll
                for (int i = 0; i < 2; ++i) off[h][i] = (unsigned)((size_t)(u.pm * 256 + h * 128 + RA[i]) * KB + CA[i] * 2);
        }
    }
};

__device__ __forceinline__ void p8_final(const bf16* __restrict__ x1, float* __restrict__ xo, const bf16* __restrict__ Y, const float* __restrict__ mod, const float* __restrict__ gf,
                                         const int* __restrict__ rt_e, const int* __restrict__ rt_pos, const float* __restrict__ rt_w, const LAS int* TB,
                                         int vcu, int G, int wave, int lane) {
    const int gw = vcu * NWAVES + wave, NGW = G * NWAVES;
    f32x4 gfv[4];
#pragma unroll
    for (int j = 0; j < 4; ++j) gfv[j] = *(const f32x4*)(gf + 256 * j + 4 * lane);
    if (NGW == 2048) {
        int s0v, s1v; float w0v, w1v;
        { const int r = gw + (lane & 15) * 2048; const int e0 = rt_e[r * 2], e1 = rt_e[r * 2 + 1];
          s0v = TB[e0] * 256 + rt_pos[r * 2]; s1v = TB[e1] * 256 + rt_pos[r * 2 + 1]; w0v = 0.125f * rt_w[r * 2]; w1v = 0.125f * rt_w[r * 2 + 1]; }
        v2u XB[3][4]; unsigned YA[3][4], YC[3][4]; f32x4 g2v[4];
#define P8_ISS(i) { const int s0 = __builtin_amdgcn_readlane(s0v, (i)), s1 = __builtin_amdgcn_readlane(s1v, (i)); const v2u* x1r = (const v2u*)(x1 + (size_t)(gw + (i) * 2048) * D) + lane; \
            const unsigned* y0 = (const unsigned*)((const unsigned char*)Y + (size_t)s0 * D) + lane; const unsigned* y1 = (const unsigned*)((const unsigned char*)Y + (size_t)s1 * D) + lane; \
            _Pragma("unroll") for (int j = 0; j < 4; ++j) { XB[(i) % 3][j] = x1r[64 * j]; YA[(i) % 3][j] = y0[64 * j]; YC[(i) % 3][j] = y1[64 * j]; } }
#pragma unroll
        for (int i = 0; i < 16; ++i) {
            if (i == 0) { P8_ISS(0) P8_ISS(1) P8_ISS(2) __builtin_amdgcn_sched_barrier(0); }
            if ((i & 1) == 0) {
#pragma unroll
                for (int j = 0; j < 4; ++j) g2v[j] = *(const f32x4*)(mod + (i >> 1) * 6144 + 5120 + 256 * j + 4 * lane); }
            const float w0 = __uint_as_float((unsigned)__builtin_amdgcn_readlane((int)__float_as_uint(w0v), i)), w1 = __uint_as_float((unsigned)__builtin_amdgcn_readlane((int)__float_as_uint(w1v), i));
            f32x4* xr = (f32x4*)(xo + (size_t)(gw + i * 2048) * D) + lane;
            f32x4 v[4]; float s = 0.f;
#pragma unroll
            for (int j = 0; j < 4; ++j) { const v2u xw = XB[i % 3][j]; f32x4 xv; xv.x = bflo(xw.x); xv.y = bfhi(xw.x); xv.z = bflo(xw.y); xv.w = bfhi(xw.y); const unsigned a = YA[i % 3][j], c = YC[i % 3][j];
                const auto a01 = __builtin_amdgcn_cvt_pk_f32_fp8(a, false), a23 = __builtin_amdgcn_cvt_pk_f32_fp8(a, true), c01 = __builtin_amdgcn_cvt_pk_f32_fp8(c, false), c23 = __builtin_amdgcn_cvt_pk_f32_fp8(c, true);
                f32x4 y; y.x = w0 * a01[0] + w1 * c01[0]; y.y = w0 * a01[1] + w1 * c01[1]; y.z = w0 * a23[0] + w1 * c23[0]; y.w = w0 * a23[1] + w1 * c23[1];
                v[j] = xv + g2v[j] * y; s += (v[j].x * v[j].x + v[j].y * v[j].y) + (v[j].z * v[j].z + v[j].w * v[j].w); }
            const float rstd = 1.0f / sqrtf(wave_sum(s) * (1.0f / D) + 1e-6f);
#pragma unroll
            for (int j = 0; j < 4; ++j) xr[64 * j] = v[j] * rstd * gfv[j];
            __builtin_amdgcn_sched_barrier(0);
            if (i + 3 < 16) { P8_ISS(i + 3) __builtin_amdgcn_sched_barrier(0); }
        }
#undef P8_ISS
        return;
    }
#pragma unroll 2
    for (int row = gw; row < T; row += NGW) {
        const int b = row >> 12;
        const int e0 = rt_e[row * 2], e1 = rt_e[row * 2 + 1]; const int s0 = TB[e0] * 256 + rt_pos[row * 2], s1 = TB[e1] * 256 + rt_pos[row * 2 + 1];
        const float w0 = 0.125f * rt_w[row * 2], w1 = 0.125f * rt_w[row * 2 + 1];
        f32x4* xr = (f32x4*)(xo + (size_t)row * D) + lane; const v2u* x1r = (const v2u*)(x1 + (size_t)row * D) + lane;
        const unsigned* y0 = (const unsigned*)((const unsigned char*)Y + (size_t)s0 * D) + lane; const unsigned* y1 = (const unsigned*)((const unsigned char*)Y + (size_t)s1 * D) + lane;
        f32x4 v[4]; float s = 0.f;
#pragma unroll
        for (int j = 0; j < 4; ++j) { const v2u xw = x1r[64 * j]; f32x4 xv; xv.x = bflo(xw.x); xv.y = bfhi(xw.x); xv.z = bflo(xw.y); xv.w = bfhi(xw.y); const unsigned a = y0[64 * j], c = y1[64 * j]; const f32x4 g2 = *(const f32x4*)(mod + b * 6144 + 5120 + 256 * j + 4 * lane);
            const auto a01 = __builtin_amdgcn_cvt_pk_f32_fp8(a, false), a23 = __builtin_amdgcn_cvt_pk_f32_fp8(a, true), c01 = __builtin_amdgcn_cvt_pk_f32_fp8(c, false), c23 = __builtin_amdgcn_cvt_pk_f32_fp8(c, true);
            f32x4 y; y.x = w0 * a01[0] + w1 * c01[0]; y.y = w0 * a01[1] + w1 * c01[1]; y.z = w0 * a23[0] + w1 * c23[0]; y.w = w0 * a23[1] + w1 * c23[1];
            v[j] = xv + g2 * y; s += (v[j].x * v[j].x + v[j].y * v[j].y) + (v[j].z * v[j].z + v[j].w * v[j].w); }
        const float rstd = 1.0f / sqrtf(wave_sum(s) * (1.0f / D) + 1e-6f);
#pragma unroll
        for (int j = 0; j < 4; ++j) xr[64 * j] = v[j] * rstd * gfv[j];
    }
}

constexpr int ATT_NU = 256;
__device__ const unsigned short ATT_ORDER[256] = {127, 126, 125, 512, 124, 123, 122, 513, 121, 120, 119, 514, 118, 85, 86, 515, 87, 88, 89, 516, 90, 91, 92, 517, 93, 94, 95, 518, 117, 84, 116, 519, 83, 115, 259, 520, 260, 261, 262, 521, 263, 291, 292, 522, 293, 294, 295, 523, 323, 324, 325, 524, 326, 327, 355, 525, 356, 357, 358, 526, 359, 387, 388, 527, 389, 390, 391, 528, 419, 420, 421, 529, 422, 423, 451, 530, 452, 453, 454, 531, 455, 483, 484, 532, 485, 486, 487, 533, 82, 114, 81, 534, 113, 80, 112, 535, 79, 111, 258, 536, 290, 322, 354, 537, 386, 418, 450, 538, 482, 78, 110, 539, 77, 109, 76, 540, 108, 75, 107, 541, 74, 106, 73, 542, 105, 257, 289, 543, 321, 353, 385, 544, 417, 449, 481, 545, 72, 104, 71, 546, 103, 38, 39, 547, 40, 41, 42, 548, 43, 44, 45, 549, 46, 47, 48, 550, 49, 50, 51, 551, 52, 53, 54, 552, 55, 56, 57, 553, 58, 59, 60, 554, 61, 62, 63, 555, 70, 102, 37, 556, 69, 101, 36, 557, 68, 100, 256, 558, 288, 320, 352, 559, 384, 416, 448, 560, 480, 35, 67, 561, 99, 34, 66, 562, 98, 2, 3, 563, 4, 5, 6, 564, 7, 8, 9, 565, 10, 11, 12, 566, 13, 14, 15, 567, 16, 17, 18, 568, 19, 20, 21, 569, 22, 23, 24, 570, 25, 26, 27, 571, 28, 29, 30, 572, 31, 1, 33, 573, 65, 97, 0, 574, 32, 64, 96, 575};
struct Args { const float* in[22]; float* out; unsigned char* ws; int ph_lo, ph_hi; };
typedef __attribute__((address_space(4))) const unsigned long long cu64;
__device__ __forceinline__ cu64* karg() { cu64* p = (cu64*)__builtin_amdgcn_kernarg_segment_ptr(); asm volatile("" : "+s"(p)); return p; }
#define KA_IN(ka, i) ((const float*)(ka)[i])
#define KA_OUT(ka) ((float*)(ka)[22])
#define KA_WS(ka) ((unsigned char*)(ka)[23])
__global__ void __launch_bounds__(NWAVES * 64, 2) fwd_kernel(Args args) {
    extern __shared__ __attribute__((aligned(16))) unsigned char lds_raw[];
    LAS unsigned char* lds = (LAS unsigned char*)lds_raw;
    volatile LAS unsigned* MISC = (volatile LAS unsigned*)(lds + MISC_OFF);
    const int wave = __builtin_amdgcn_readfirstlane((int)threadIdx.x >> 6);
    const int G = gridDim.x; const int bx = blockIdx.x; const int vcu = (G % 8 == 0) ? (bx % 8) * (G / 8) + bx / 8 : bx;
    if (wave == 0) MISC[fresh_lane()] = 0u;
    __syncthreads();
    XcdBarrier bar = xcd_barrier_post((unsigned*)((gu32*)(args.ws + WS_CTL) + CW_BAR), MISC + 8); bar.wave = wave;
    const int lo = args.ph_lo, hi = args.ph_hi;
    unsigned long long prof_acc = 0;
#ifndef PHASE_MASK
#define PHASE_MASK 0x1ff
#endif
#define IN(k) ((((PHASE_MASK) >> (k)) & 1) && lo <= (k) && (k) < hi)
#define SEAM(k) do { if (IN(k) && IN((k) + 1)) { unsigned long long t0_ = 0; if (PROF_ID == 30 + (k)) t0_ = __builtin_amdgcn_s_memrealtime(); xcd_barrier(bar); if (PROF_ID == 30 + (k)) prof_acc += __builtin_amdgcn_s_memrealtime() - t0_; } } while (0)
#define PH_T0(k) unsigned long long pht0_##k = 0; if (PROF_ID == 20 + (k)) pht0_##k = __builtin_amdgcn_s_memrealtime()
#define PH_T1(k) do { if (PROF_ID == 20 + (k)) prof_acc += __builtin_amdgcn_s_memrealtime() - pht0_##k; } while (0)
#ifndef PROBE_PHASE
#define PROBE_PHASE -1
#endif
#define REP(k) _Pragma("unroll 1") for (int rep_ = 0; rep_ < ((PROBE_PHASE) == (k) ? 2 : 1); ++rep_)

    PH_T0(0);
    if (IN(0)) REP(0) {
        cu64* ka = karg(); unsigned char* ws = KA_WS(ka);
        P0Args a{KA_IN(ka, 1), KA_IN(ka, 2), KA_IN(ka, 3), KA_IN(ka, 5), KA_IN(ka, 12), KA_IN(ka, 14), KA_IN(ka, 16), KA_IN(ka, 18), KA_IN(ka, 19), KA_IN(ka, 20),
                 (bf16*)(ws + WS_WIN), (bf16*)(ws + WS_WO), (bf16*)(ws + WS_WGU), (bf16*)(ws + WS_WD), (float*)(ws + WS_WR), (float*)(ws + WS_MOD)};
        const int lane = fresh_lane(), tid = wave * 64 + lane; p0_prologue(a, lds, vcu, G, tid, wave, lane);
    }
    PH_T1(0);
    SEAM(0);
    PH_T0(1);
    if (IN(1)) REP(1) { cu64* ka = karg(); unsigned char* ws = KA_WS(ka); const int lane = fresh_lane(), tid = wave * 64 + lane;
        p1_norm(KA_IN(ka, 0), KA_IN(ka, 4), (const float*)(ws + WS_MOD), (const bf16*)(ws + WS_WR) + 131072, KA_IN(ka, 6), (bf16*)(ws + WS_H), (float*)(ws + WS_CUM), (float*)(ws + WS_BLK), lds, vcu, G, tid, wave, lane); }
    PH_T1(1);
    SEAM(1);
#define P2BODY { cu64* ka = karg(); unsigned char* ws = KA_WS(ka); pg8::Gemm g{(const bf16*)(ws + WS_H), (const bf16*)(ws + WS_WIN), T, NQKV, D}; pg8::StaticOrder S; S.init(T, NQKV, G, bx); \
        pg8::EpiStore E{(bf16*)(ws + WS_QKV), NQKV, 0xffff, (unsigned*)(ws + WS_CTL) + CW_KM}; \
        pg8::gemm_phase<pg8::EpiStore, pg8::StaticOrder, true, true>(lds, g, S, E, wave); }
    PH_T0(2);
    if (IN(2)) { P2BODY if (PROBE_PHASE == 2) P2BODY }
    PH_T1(2);
    SEAM(2);
    PH_T0(3);
    if (IN(3)) REP(3) {
        float lam;
        { cu64* ka = karg(); const float* lq1 = KA_IN(ka, 7); const float* lk1 = KA_IN(ka, 8); const float* lq2 = KA_IN(ka, 9); const float* lk2 = KA_IN(ka, 10);
          const int lane = fresh_lane(); const float a = wave_sum(lq1[lane] * lk1[lane]), b2 = wave_sum(lq2[lane] * lk2[lane]); lam = expf(a) - expf(b2) + LAM_INIT; }
        volatile LAS int* QSLOT = (volatile LAS int*)(lds + MISC_OFF + 64);
        const int xq0 = (G >= 8) ? (vcu * 8) / G : 0;
#pragma unroll 1
        for (int qi = 0; qi < 8; ++qi) {
            const int xq = (xq0 + qi) & 7;
#pragma unroll 1
            for (;;) {
                cu64* ka = karg(); unsigned char* ws = KA_WS(ka);
                if (wave == 0 && fresh_lane() == 0) QSLOT[0] = (int)__hip_atomic_fetch_add((gu32*)(ws + WS_CTL) + CW_QH + 64 * xq, 1u, RLX_AGENT);
                __syncthreads();
                const int idx = __builtin_amdgcn_readfirstlane(QSLOT[0]);
                __syncthreads();
                if (idx >= ATT_NU) break;
                const int u = ATT_ORDER[idx], h = (u >> 5) & 7, qb = u & 31;
                if ((u >> 8) == 2) {
                    LAS float* scr = (LAS float*)(lds + wave * 8448); const int lane_ = fresh_lane(); const int it0 = (xq * 64 + (u & 255)) * XI_PER_UNIT + wave * 6;
#pragma unroll 1
                    for (int k = 0; k < 6; ++k) expert_item(KA_IN(ka, 18), KA_IN(ka, 19), KA_IN(ka, 20), (bf16*)(ws + WS_WGU), (bf16*)(ws + WS_WD), it0 + k, scr, lane_);
                    __syncthreads();
                } else
                if ((u >> 8) == 0) { PROF_BEGIN(1); att::diff_unit(lds, (const bf16*)(ws + WS_QKV), (bf16*)(ws + WS_H), KA_IN(ka, 11), lam, (const unsigned*)(ws + WS_CTL) + CW_KM, xq, h, qb, wave, prof_acc); PROF_END(1, prof_acc); }
                else { PROF_BEGIN(2); att::fox2_unit(lds, (const bf16*)(ws + WS_QKV), (bf16*)(ws + WS_H), (const float*)(ws + WS_CUM), (const float*)(ws + WS_BLK), (const unsigned*)(ws + WS_CTL) + CW_KM, xq, h, qb, wave, prof_acc); PROF_END(2, prof_acc); }
            }
        }
    }
    PH_T1(3);
    SEAM(3);
#define P4BODY { cu64* ka = karg(); unsigned char* ws = KA_WS(ka); pg8::Gemm g{(const bf16*)(ws + WS_H), (const bf16*)(ws + WS_WO), T, D, D}; pg8::StaticOrder S; S.init(T, D, G, bx); \
        pg8::EpiResid E{KA_IN(ka, 0), (bf16*)(ws + WS_X1), (const float*)(ws + WS_MOD) + 2048}; \
        pg8::gemm_phase<pg8::EpiResid, pg8::StaticOrder, true, true>(lds, g, S, E, wave); }
    PH_T0(4);
    if (IN(4)) { P4BODY if (PROBE_PHASE == 4) P4BODY }
    PH_T1(4);
    SEAM(4);
    PH_T0(5);
    if (IN(5)) { cu64* ka = karg(); unsigned char* ws = KA_WS(ka); int* rt_e = (int*)(ws + WS_RT); const int lane = fresh_lane(), tid = wave * 64 + lane;
        p5_route((const bf16*)(ws + WS_X1), KA_IN(ka, 13), (const float*)(ws + WS_MOD), (const bf16*)(ws + WS_WR), KA_IN(ka, 15), KA_IN(ka, 17), (bf16*)(ws + WS_H), ws + WS_H2F8, (gu32*)(ws + WS_CTL) + CW_CNT, (int*)(ws + WS_STOK),
                 rt_e, rt_e + 2 * T, (float*)(rt_e + 4 * T), lds, vcu, G, tid, wave, lane); }
    PH_T1(5);
    SEAM(5);
    LAS int* TB = (LAS int*)(lds + 131072); LAS int* CN = (LAS int*)(lds + 131072 + 256);
#define P6BODY { cu64* ka = karg(); unsigned char* ws = KA_WS(ka); moe_tables((gu32*)(ws + WS_CTL) + CW_CNT, TB, CN, wave * 64 + fresh_lane()); pg8::Gemm g{(const bf16*)(ws + WS_H2F8), (const bf16*)(ws + WS_WGU), T, 1024, D}; \
        MoeOrder S{TB, CN, (const int*)(ws + WS_STOK), G, bx, true}; pg8::EpiSwigluF8 E{ws + WS_HID}; \
        pg8::gemm_phase<pg8::EpiSwigluF8, MoeOrder, true, true, true>(lds, g, S, E, wave); }
    PH_T0(6);
    if (IN(6)) { P6BODY if (PROBE_PHASE == 6) P6BODY }
    PH_T1(6);
    SEAM(6);
#define P7BODY { cu64* ka = karg(); unsigned char* ws = KA_WS(ka); moe_tables((gu32*)(ws + WS_CTL) + CW_CNT, TB, CN, wave * 64 + fresh_lane()); pg8::Gemm g{(const bf16*)(ws + WS_HID), (const bf16*)(ws + WS_WD), NSLOT_MAX, 1024, DEXP}; \
        MoeOrder S{TB, CN, (const int*)(ws + WS_STOK), G, bx, false}; pg8::EpiStoreF8 E{ws + WS_Y}; \
        pg8::gemm_phase<pg8::EpiStoreF8, MoeOrder, true, true, true>(lds, g, S, E, wave); }
    PH_T0(7);
    if (IN(7)) { P7BODY if (PROBE_PHASE == 7) P7BODY }
    PH_T1(7);
    SEAM(7);
    PH_T0(8);
    if (IN(8)) { cu64* ka = karg(); unsigned char* ws = KA_WS(ka); int* rt_e = (int*)(ws + WS_RT);
        moe_tables((gu32*)(ws + WS_CTL) + CW_CNT, TB, CN, wave * 64 + fresh_lane());
        p8_final((const bf16*)(ws + WS_X1), KA_OUT(ka), (const bf16*)(ws + WS_Y), (const float*)(ws + WS_MOD), KA_IN(ka, 21), rt_e, rt_e + 2 * T, (const float*)(rt_e + 4 * T), TB, vcu, G, wave, fresh_lane());
    }
    PH_T1(8);
    if (PROF_ID != 0) { const unsigned long long t0_ = __builtin_amdgcn_s_memrealtime(); while (__builtin_amdgcn_s_memrealtime() - t0_ < prof_acc) __builtin_amdgcn_s_sleep(8); }
#undef IN
#undef SEAM
}

#ifndef MK_N_LAUNCHES
#define MK_N_LAUNCHES 1
#endif
extern "C" void kernel_launch(void* const* d_in, const int* in_sizes, int n_in, void* d_out, int out_size, void* d_ws, size_t ws_size, hipStream_t stream) {
    static int grid = 0;
    if (grid == 0) {
        if (n_in != 22 || in_sizes[0] != T * D || out_size != T * D || ws_size < WS_END) { fprintf(stderr, "kernel_launch: shape/workspace mismatch (n_in %d, in0 %d, out %d, ws %zu, need %zu)\n", n_in, n_in > 0 ? in_sizes[0] : -1, out_size, ws_size, (size_t)WS_END); grid = -1; return; }
        int dev = 0, cus = 0, per_cu = 0;
        if (hipGetDevice(&dev) != hipSuccess || hipDeviceGetAttribute(&cus, hipDeviceAttributeMultiprocessorCount, dev) != hipSuccess) { grid = -1; return; }
        if (hipFuncSetAttribute((const void*)fwd_kernel, hipFuncAttributeMaxDynamicSharedMemorySize, LDS_BYTES) != hipSuccess) { fprintf(stderr, "kernel_launch: hipFuncSetAttribute failed\n"); grid = -1; return; }
        if (hipOccupancyMaxActiveBlocksPerMultiprocessor(&per_cu, (const void*)fwd_kernel, NWAVES * 64, LDS_BYTES) != hipSuccess || per_cu < 1) fprintf(stderr, "kernel_launch: occupancy query reports %d\n", per_cu);
        (void)hipGetLastError();
        grid = cus > 0 ? cus : 256;
    }
    if (grid < 0) return;
    (void)hipMemsetAsync((char*)d_ws + WS_CTL, 0, CTL_ZERO_BYTES, stream);
    Args a{};
    for (int i = 0; i < 22; ++i) a.in[i] = (const float*)d_in[i];
    a.out = (float*)d_out; a.ws = (unsigned char*)d_ws;
    if (MK_N_LAUNCHES == 1) { a.ph_lo = 0; a.ph_hi = NPH; hipLaunchKernelGGL(fwd_kernel, dim3(grid), dim3(NWAVES * 64), LDS_BYTES, stream, a); }
    else for (int p = 0; p < NPH; ++p) { a.ph_lo = p; a.ph_hi = p + 1; hipLaunchKernelGGL(fwd_kernel, dim3(grid), dim3(NWAVES * 64), LDS_BYTES, stream, a); }
    const hipError_t le = hipPeekAtLastError();
    if (le != hipSuccess) fprintf(stderr, "kernel_launch: launch failed: %s\n", hipGetErrorName(le));
}
```

```cpp
#include <hip/hip_runtime.h>
#include <hip/hip_bf16.h>
#include <cstdio>
#include <cstdint>

__device__ __forceinline__ int fresh_lane() { int l; asm volatile("v_mbcnt_lo_u32_b32 %0, -1, 0\n\tv_mbcnt_hi_u32_b32 %0, -1, %0" : "=v"(l)); return l; }
template <int M> __device__ __forceinline__ float lx_get(float v) {
    static_assert(M == 1 || M == 2 || M == 4 || M == 8 || M == 16, "lx_get: M");
    return __builtin_bit_cast(float, __builtin_amdgcn_ds_swizzle(__builtin_bit_cast(int, v), (M << 10) | 0x1f));
}
__device__ __forceinline__ void swap32(float v, float& lo, float& hi) { const unsigned a = __float_as_uint(v);
    auto rr = __builtin_amdgcn_permlane32_swap(a, a, false, false); const unsigned r0 = rr[0], r1 = rr[1]; lo = __uint_as_float(r0); hi = __uint_as_float(r1); }
__device__ __forceinline__ float lx_sum32(float v) { float lo, hi; swap32(v, lo, hi); return lo + hi; }
__device__ __forceinline__ float lx_max32(float v) { float lo, hi; swap32(v, lo, hi); return fmaxf(lo, hi); }
#ifndef PROF_ID
#define PROF_ID 0
#endif
#define PROF_BEGIN(id) unsigned long long prof_t0_##id = 0; if (PROF_ID == (id)) prof_t0_##id = __builtin_amdgcn_s_memrealtime()
#define PROF_END(id, acc) do { if (PROF_ID == (id)) (acc) += __builtin_amdgcn_s_memrealtime() - prof_t0_##id; } while (0)
namespace pg8 {
#define PG8_LAS __attribute__((address_space(3)))
typedef unsigned short bf16_t;
typedef short bf16x8 __attribute__((ext_vector_type(8)));
typedef float f32x4 __attribute__((ext_vector_type(4)));
typedef unsigned u32x4 __attribute__((ext_vector_type(4)));
typedef unsigned u32x2 __attribute__((ext_vector_type(2)));
typedef int i32x8 __attribute__((ext_vector_type(8)));
constexpr int BM = 256, BK = 64, HALF = 128, HTB = HALF * BK * 2  , STAGE_BYTES = 8 * HTB, NXCD = 8, WGM = 8;

__host__ __device__ __forceinline__ int lds_byte(int r, int c) { const int st = (r >> 4) * 2 + (c >> 5), rr = r & 15, cc = c & 31, ob = rr * 64 + cc * 2; return st * 1024 + (ob ^ (((ob >> 9) & 1) << 5)); }
__host__ __device__ __forceinline__ void stage_rc(int b, int& R, int& C) { const int st = b / 1024, sb = b % 1024, swz = sb ^ (((sb >> 9) & 1) << 5); R = (st >> 1) * 16 + swz / 64; C = (st & 1) * 32 + (swz % 64) / 2; }
__host__ __device__ __forceinline__ int perm32(int rho) { const int n = rho >> 4, i = rho & 15; return 8 * (i >> 2) + 4 * n + (i & 3); }

struct Unit { int pm, pn, e; };
struct Gemm { const bf16_t* A; const bf16_t* Bt; int M, N, K; };

struct StaticOrder {
    int nM, nN, nwg, G, c;
    __host__ __device__ void init(int M, int N, int G_, int c_) { nM = M / BM; nN = N / BM; nwg = nM * nN; G = G_; c = c_; }
    __host__ __device__ bool next(int i, Unit& u) const {
        const long L = (long)i * G + c; if (L >= nwg) return false;
        int wgid = (int)L; { const int q = nwg / NXCD, r = nwg % NXCD, xcd = wgid % NXCD, off = wgid / NXCD; wgid = (xcd < r ? xcd * (q + 1) : r * (q + 1) + (xcd - r) * q) + off; }
        const int nig = WGM * nN, gid = wgid / nig, fm = gid * WGM, gsz = (nM - fm) < WGM ? (nM - fm) : WGM;
        u.pm = fm + ((wgid % nig) % gsz); u.pn = (wgid % nig) / gsz; u.e = 0; return true;
    }
    __device__ __forceinline__ void a_off(const Unit& u, const int (&RA)[2], const int (&CA)[2], int KB  , unsigned (&off)[2][2]) const {
#pragma unroll
        for (int h = 0; h < 2; ++h)
#pragma unroll
            for (int i = 0; i < 2; ++i) off[h][i] = (unsigned)((size_t)(u.pm * BM + h * HALF + RA[i]) * KB + CA[i] * 2);
    }
};


__device__ __forceinline__ unsigned cvt_pk_bf16(float lo, float hi) { unsigned r; asm volatile("v_cvt_pk_bf16_f32 %0, %1, %2" : "=v"(r) : "v"(lo), "v"(hi)); return r; }

struct EpiStore {
    static constexpr bool PERM = true, AFTER_DRAIN = false;
    bf16_t* O; int ldc; int pn_mask; unsigned* km;
    __device__ __forceinline__ void operator()(const f32x4 (&acc)[2][2][4][2], const Unit& u, int wr, int wc, int fr, int fq) const {
        const int row0 = u.pm * BM + wr * 64 + fr; const int col0 = (u.pn & pn_mask) * BM + wc * 32 + 8 * fq;
        if (km && (u.pn == 2 || u.pn == 3 || u.pn == 8 || u.pn == 9)) {
#pragma unroll
            for (int bj = 0; bj < 2; ++bj) { float mx = 0.f;
#pragma unroll
                for (int ai = 0; ai < 2; ++ai)
#pragma unroll
                    for (int m = 0; m < 4; ++m) { const f32x4 v0 = acc[ai][bj][m][0], v1 = acc[ai][bj][m][1];
                        float ss = (v0[0] * v0[0] + v0[1] * v0[1]) + (v0[2] * v0[2] + v0[3] * v0[3]) + (v1[0] * v1[0] + v1[1] * v1[1]) + (v1[2] * v1[2] + v1[3] * v1[3]);
                        ss += lx_get<16>(ss); ss = lx_sum32(ss); mx = fmaxf(mx, ss); }
                mx = fmaxf(mx, lx_get<1>(mx)); mx = fmaxf(mx, lx_get<2>(mx)); mx = fmaxf(mx, lx_get<4>(mx)); mx = fmaxf(mx, lx_get<8>(mx));
                if ((fr | fq) == 0) __hip_atomic_fetch_max(km + (u.pm >> 4) * 96 + (u.pn * BM + bj * HALF + wc * 32) / 32, __float_as_uint(mx), __ATOMIC_RELAXED, __HIP_MEMORY_SCOPE_AGENT); }
        }
#pragma unroll
        for (int ai = 0; ai < 2; ++ai)
#pragma unroll
            for (int m = 0; m < 4; ++m) { bf16_t* rowp = O + (size_t)(row0 + ai * HALF + m * 16) * ldc + col0;
#pragma unroll
                for (int bj = 0; bj < 2; ++bj) { const f32x4 v0 = acc[ai][bj][m][0], v1 = acc[ai][bj][m][1];
                    u32x4 w; w.x = cvt_pk_bf16(v0[0], v0[1]); w.y = cvt_pk_bf16(v0[2], v0[3]); w.z = cvt_pk_bf16(v1[0], v1[1]); w.w = cvt_pk_bf16(v1[2], v1[3]);
                    *(u32x4*)(rowp + bj * HALF) = w; } }
    }
};
struct EpiSwiglu {
    static constexpr bool PERM = true, AFTER_DRAIN = false;
    bf16_t* H;
    __device__ __forceinline__ void operator()(const f32x4 (&acc)[2][2][4][2], const Unit& u, int wr, int wc, int fr, int fq) const {
        const int row0 = u.pm * BM + wr * 64 + fr; const int col0 = (u.pn & 3) * 128 + wc * 32 + 8 * fq;
#pragma unroll
        for (int ai = 0; ai < 2; ++ai)
#pragma unroll
            for (int m = 0; m < 4; ++m) { bf16_t* rowp = H + (size_t)(row0 + ai * HALF + m * 16) * 512 + col0;
                float hv[8];
#pragma unroll
                for (int n = 0; n < 2; ++n)
#pragma unroll
                    for (int i = 0; i < 4; ++i) { const float g = acc[ai][0][m][n][i], up = acc[ai][1][m][n][i];
                        const float e = __builtin_amdgcn_exp2f(-g * 1.4426950408889634f);
                        hv[n * 4 + i] = g * __builtin_amdgcn_rcpf(1.0f + e) * up; }
                u32x4 w; w.x = cvt_pk_bf16(hv[0], hv[1]); w.y = cvt_pk_bf16(hv[2], hv[3]); w.z = cvt_pk_bf16(hv[4], hv[5]); w.w = cvt_pk_bf16(hv[6], hv[7]);
                *(u32x4*)rowp = w; }
    }
};
struct EpiStoreF8 {
    static constexpr bool PERM = true, AFTER_DRAIN = false;
    unsigned char* Y8;
    __device__ __forceinline__ void operator()(const f32x4 (&acc)[2][2][4][2], const Unit& u, int wr, int wc, int fr, int fq) const {
        const int row0 = u.pm * BM + wr * 64 + fr; const int col0 = (u.pn & 3) * BM + wc * 32 + 8 * fq;
#pragma unroll
        for (int ai = 0; ai < 2; ++ai)
#pragma unroll
            for (int m = 0; m < 4; ++m) { unsigned char* rowp = Y8 + (size_t)(row0 + ai * HALF + m * 16) * 1024 + col0;
#pragma unroll
                for (int bj = 0; bj < 2; ++bj) { const f32x4 v0 = acc[ai][bj][m][0] * 8.0f, v1 = acc[ai][bj][m][1] * 8.0f;
                    int t0 = 0, t1 = 0;
                    t0 = __builtin_amdgcn_cvt_pk_fp8_f32(v0[0], v0[1], t0, false); t0 = __builtin_amdgcn_cvt_pk_fp8_f32(v0[2], v0[3], t0, true);
                    t1 = __builtin_amdgcn_cvt_pk_fp8_f32(v1[0], v1[1], t1, false); t1 = __builtin_amdgcn_cvt_pk_fp8_f32(v1[2], v1[3], t1, true);
                    u32x2 w; w.x = (unsigned)t0; w.y = (unsigned)t1; *(u32x2*)(rowp + bj * HALF) = w; } }
    }
};
struct EpiSwigluF8 {
    static constexpr bool PERM = true, AFTER_DRAIN = false;
    unsigned char* H8;
    __device__ __forceinline__ void operator()(const f32x4 (&acc)[2][2][4][2], const Unit& u, int wr, int wc, int fr, int fq) const {
        const int row0 = u.pm * BM + wr * 64 + fr; const int col0 = (u.pn & 3) * 128 + wc * 32 + 8 * fq;
#pragma unroll
        for (int ai = 0; ai < 2; ++ai)
#pragma unroll
            for (int m = 0; m < 4; ++m) { unsigned char* rowp = H8 + (size_t)(row0 + ai * HALF + m * 16) * 512 + col0;
                float hv[8];
#pragma unroll
                for (int n = 0; n < 2; ++n)
#pragma unroll
                    for (int i = 0; i < 4; ++i) { const float g = acc[ai][0][m][n][i], up = acc[ai][1][m][n][i];
                        const float e = __builtin_amdgcn_exp2f(-g * 1.4426950408889634f);
                        hv[n * 4 + i] = g * __builtin_amdgcn_rcpf(1.0f + e) * up; }
                u32x2 w; int t0 = 0, t1 = 0;
                t0 = __builtin_amdgcn_cvt_pk_fp8_f32(hv[0], hv[1], t0, false); t0 = __builtin_amdgcn_cvt_pk_fp8_f32(hv[2], hv[3], t0, true);
                t1 = __builtin_amdgcn_cvt_pk_fp8_f32(hv[4], hv[5], t1, false); t1 = __builtin_amdgcn_cvt_pk_fp8_f32(hv[6], hv[7], t1, true);
                w.x = (unsigned)t0; w.y = (unsigned)t1; *(u32x2*)rowp = w; }
    }
};
struct EpiResid {
    static constexpr bool PERM = true, AFTER_DRAIN = false;
    const float* base; bf16_t* out; const float* gate;
    __device__ __forceinline__ void operator()(const f32x4 (&acc)[2][2][4][2], const Unit& u, int wr, int wc, int fr, int fq) const {
        const int col0 = u.pn * BM + wc * 32 + 8 * fq; const float* gp = gate + (size_t)(u.pm >> 4) * 6144 + col0;
        f32x4 gv[2][2];
#pragma unroll
        for (int bj = 0; bj < 2; ++bj)
#pragma unroll
            for (int n = 0; n < 2; ++n) gv[bj][n] = *(const f32x4*)(gp + bj * HALF + n * 4);
#pragma unroll
        for (int ai = 0; ai < 2; ++ai)
#pragma unroll
            for (int m = 0; m < 4; ++m) { const size_t off = (size_t)(u.pm * BM + ai * HALF + wr * 64 + m * 16 + fr) * 1024 + col0;
#pragma unroll
                for (int bj = 0; bj < 2; ++bj) { const f32x4 b0 = *(const f32x4*)(base + off + bj * HALF), b1 = *(const f32x4*)(base + off + bj * HALF + 4);
                    const f32x4 v0 = b0 + gv[bj][0] * acc[ai][bj][m][0], v1 = b1 + gv[bj][1] * acc[ai][bj][m][1];
                    u32x4 w; w.x = cvt_pk_bf16(v0[0], v0[1]); w.y = cvt_pk_bf16(v0[2], v0[3]); w.z = cvt_pk_bf16(v1[0], v1[1]); w.w = cvt_pk_bf16(v1[2], v1[3]);
                    *(u32x4*)(out + off + bj * HALF) = w; } }
    }
};

template <class Epi, class Sched, bool ALIGN_EPI = false, bool SP2 = false, bool F8 = false>
__device__ __forceinline__ void gemm_phase(PG8_LAS unsigned char* lds, const Gemm g, const Sched& S, const Epi& E, int wave) {
    const int wid = wave, lane = fresh_lane(), tid = wid * 64 + lane, wr = wid >> 2, wc = wid & 3, fr = lane & 15, fq = lane >> 4;
    const int K = g.K, KB = F8 ? K : 2 * K  ; int nt = KB / (BK * 2); asm volatile("" : "+s"(nt));
    int RA[2], CA[2]; unsigned voffB[2];
#pragma unroll
    for (int i = 0; i < 2; ++i) { int R, C; stage_rc(tid * 16 + i * 8192, R, C); const int Rb = Epi::PERM ? ((R & ~31) + perm32(R & 31)) : R;
        RA[i] = R; CA[i] = C; voffB[i] = (unsigned)(Rb * KB + C * 2); }
    const size_t kstep = (size_t)(BK * 2);
    const size_t hstep = (size_t)HALF * KB;
    const size_t tstep = 2 * hstep;
    const unsigned ldsw = (unsigned)wid * 1024u;
    const int aoff = lds_byte(wr * 64 + fr, fq * 8), boff = lds_byte(wc * 32 + fr, fq * 8);
#define PG8_SA(b, h) (((b) * 2 + (h)) * HTB)
#define PG8_SB(b, h) ((4 + (b) * 2 + (h)) * HTB)
#define PG8_STAGE(bufoff, gbase, voff) do { _Pragma("unroll") for (int _i = 0; _i < 2; ++_i) \
        __builtin_amdgcn_global_load_lds((const unsigned*)((const char*)(gbase) + (voff)[_i]), (PG8_LAS unsigned*)(lds + (bufoff) + ldsw + _i * 8192), 16, 0, 0); } while (0)
#define PG8_LDA(dst, b, h) do { if constexpr (F8) { _Pragma("unroll") for (int m = 0; m < 4; ++m) { const u32x4 lo_ = *(const PG8_LAS u32x4*)(lds + PG8_SA(b, h) + aoff + m * 2048), hi_ = *(const PG8_LAS u32x4*)(lds + PG8_SA(b, h) + aoff + 1024 + m * 2048); \
            dst##8[m] = (i32x8){(int)lo_.x, (int)lo_.y, (int)lo_.z, (int)lo_.w, (int)hi_.x, (int)hi_.y, (int)hi_.z, (int)hi_.w}; } } \
        else { _Pragma("unroll") for (int m = 0; m < 4; ++m) _Pragma("unroll") for (int k = 0; k < 2; ++k) dst[m][k] = *(const PG8_LAS bf16x8*)(lds + PG8_SA(b, h) + aoff + m * 2048 + k * 1024); } } while (0)
#define PG8_LDB(dst, b, h) do { if constexpr (F8) { _Pragma("unroll") for (int n = 0; n < 2; ++n) { const u32x4 lo_ = *(const PG8_LAS u32x4*)(lds + PG8_SB(b, h) + boff + n * 2048), hi_ = *(const PG8_LAS u32x4*)(lds + PG8_SB(b, h) + boff + 1024 + n * 2048); \
            dst##8[n] = (i32x8){(int)lo_.x, (int)lo_.y, (int)lo_.z, (int)lo_.w, (int)hi_.x, (int)hi_.y, (int)hi_.z, (int)hi_.w}; } } \
        else { _Pragma("unroll") for (int n = 0; n < 2; ++n) _Pragma("unroll") for (int k = 0; k < 2; ++k) dst[n][k] = *(const PG8_LAS bf16x8*)(lds + PG8_SB(b, h) + boff + n * 2048 + k * 1024); } } while (0)
#define PG8_MMA(ai, bj, At, Bt) do { __builtin_amdgcn_s_setprio(1); if constexpr (F8) { _Pragma("unroll") for (int m = 0; m < 4; ++m) _Pragma("unroll") for (int n = 0; n < 2; ++n) \
            acc[ai][bj][m][n] = __builtin_amdgcn_mfma_scale_f32_16x16x128_f8f6f4(Bt##8[n], At##8[m], acc[ai][bj][m][n], 0, 0, 0, 0x7A7A7A7A  , 0, 0x7F7F7F7F  ); } \
        else { _Pragma("unroll") for (int m = 0; m < 4; ++m) _Pragma("unroll") for (int n = 0; n < 2; ++n) _Pragma("unroll") for (int k = 0; k < 2; ++k) \
            acc[ai][bj][m][n] = __builtin_amdgcn_mfma_f32_16x16x32_bf16(Bt[n][k], At[m][k], acc[ai][bj][m][n], 0, 0, 0); } __builtin_amdgcn_s_setprio(0); } while (0)
#define PG8_WAIT_V(n) asm volatile("s_waitcnt vmcnt(" #n ")" ::: "memory")
#define PG8_WAIT_L(n) asm volatile("s_waitcnt lgkmcnt(" #n ")" ::: "memory")
#define PG8_BAR __builtin_amdgcn_s_barrier()
#define PG8_SCHED __builtin_amdgcn_sched_barrier(0)
    Unit cur, nxt; int ui = 0;
    if (!S.next(0, cur)) return;
    f32x4 acc[2][2][4][2];
#pragma unroll
    for (int a = 0; a < 2; ++a)
#pragma unroll
        for (int b = 0; b < 2; ++b)
#pragma unroll
            for (int m = 0; m < 4; ++m)
#pragma unroll
                for (int n = 0; n < 2; ++n) acc[a][b][m][n] = (f32x4){0.f, 0.f, 0.f, 0.f};
    bf16x8 At[4][2], B0[2][2], B1[2][2]; i32x8 At8[4], B08[2], B18[2];
    unsigned oc[2][2], on[2][2];
    S.a_off(cur, RA, CA, KB, oc);
    const char* A0 = (const char*)g.A;
    const char* cB = (const char*)g.Bt + (size_t)cur.pn * tstep;
    if constexpr (SP2) {
        PG8_STAGE(PG8_SB(0, 0), cB, voffB); PG8_STAGE(PG8_SB(0, 1), cB + hstep, voffB); PG8_STAGE(PG8_SA(0, 0), A0, oc[0]); PG8_STAGE(PG8_SA(0, 1), A0, oc[1]);
        if (wr == 1) PG8_BAR;
        PG8_WAIT_V(2); PG8_BAR;
        PG8_STAGE(PG8_SB(1, 0), cB + kstep, voffB); PG8_STAGE(PG8_SA(1, 0), A0 + kstep, oc[0]); PG8_STAGE(PG8_SB(1, 1), cB + hstep + kstep, voffB);
        PG8_WAIT_V(6); PG8_BAR;
    } else {
        PG8_STAGE(PG8_SB(0, 0), cB, voffB); PG8_STAGE(PG8_SA(0, 0), A0, oc[0]); PG8_STAGE(PG8_SB(0, 1), cB + hstep, voffB); PG8_STAGE(PG8_SA(0, 1), A0, oc[1]);
        if (wr == 1) PG8_BAR;
        PG8_WAIT_V(4); PG8_BAR;
        PG8_STAGE(PG8_SB(1, 0), cB + kstep, voffB); PG8_STAGE(PG8_SA(1, 0), A0 + kstep, oc[0]); PG8_STAGE(PG8_SB(1, 1), cB + hstep + kstep, voffB);
        PG8_WAIT_V(6); PG8_BAR;
    }
    for (;;) {
        const bool has_next = S.next(ui + 1, nxt);
        if (has_next) S.a_off(nxt, RA, CA, KB, on);
        else {
#pragma unroll
            for (int h = 0; h < 2; ++h)
#pragma unroll
                for (int i = 0; i < 2; ++i) on[h][i] = oc[h][i]; }
        const char* nB = has_next ? (const char*)g.Bt + (size_t)nxt.pn * tstep : cB;
        for (int t = 0; t < nt; t += 2) {
            const bool last = (t == nt - 2);
            const char* a1 = A0 + (size_t)(t + 1) * kstep;
            const char* a2 = last ? A0 : A0 + (size_t)(t + 2) * kstep; const char* b2 = last ? nB : cB + (size_t)(t + 2) * kstep;
            const char* a3 = a2 + kstep; const char* b3 = b2 + kstep;
            if constexpr (SP2) {
            PG8_LDB(B0, 0, 0); PG8_LDB(B1, 0, 1); PG8_SCHED; PG8_LDA(At, 0, 0); PG8_STAGE(PG8_SA(1, 1), a1, oc[1]); if (last) { _Pragma("unroll") for (int h_ = 0; h_ < 2; ++h_) _Pragma("unroll") for (int i_ = 0; i_ < 2; ++i_) oc[h_][i_] = on[h_][i_]; }
            PG8_WAIT_V(8); PG8_WAIT_L(0); PG8_BAR; PG8_MMA(0, 0, At, B0); PG8_MMA(0, 1, At, B1); PG8_BAR; PG8_SCHED;
            PG8_LDA(At, 0, 1); PG8_STAGE(PG8_SB(0, 0), b2, voffB); PG8_STAGE(PG8_SB(0, 1), b2 + hstep, voffB); PG8_STAGE(PG8_SA(0, 0), a2, oc[0]);
            PG8_WAIT_V(8); PG8_WAIT_L(0); PG8_BAR; PG8_MMA(1, 0, At, B0); PG8_MMA(1, 1, At, B1); PG8_BAR; PG8_SCHED;
            PG8_LDB(B0, 1, 0); PG8_LDB(B1, 1, 1); PG8_SCHED; PG8_LDA(At, 1, 0); PG8_STAGE(PG8_SA(0, 1), a2, oc[1]);
            PG8_WAIT_V(8); PG8_WAIT_L(0); PG8_BAR; PG8_MMA(0, 0, At, B0); PG8_MMA(0, 1, At, B1); PG8_BAR; PG8_SCHED;
            PG8_LDA(At, 1, 1); PG8_STAGE(PG8_SB(1, 0), b3, voffB); PG8_STAGE(PG8_SB(1, 1), b3 + hstep, voffB); PG8_STAGE(PG8_SA(1, 0), a3, oc[0]);
            PG8_WAIT_V(8); PG8_WAIT_L(0); PG8_BAR; PG8_MMA(1, 0, At, B0); PG8_MMA(1, 1, At, B1); PG8_BAR; PG8_SCHED;
            } else {
            PG8_LDB(B0, 0, 0); PG8_SCHED; PG8_LDA(At, 0, 0); PG8_STAGE(PG8_SA(1, 1), a1, oc[1]); if (last) { _Pragma("unroll") for (int h_ = 0; h_ < 2; ++h_) _Pragma("unroll") for (int i_ = 0; i_ < 2; ++i_) oc[h_][i_] = on[h_][i_]; }
            PG8_WAIT_L(8); PG8_BAR; PG8_WAIT_L(0); PG8_MMA(0, 0, At, B0); PG8_BAR; PG8_SCHED;
            PG8_LDB(B1, 0, 1); PG8_STAGE(PG8_SB(0, 0), b2, voffB);
            PG8_BAR; PG8_WAIT_L(0); PG8_MMA(0, 1, At, B1); PG8_BAR;
            PG8_LDA(At, 0, 1); PG8_STAGE(PG8_SA(0, 0), a2, oc[0]);
            PG8_BAR; PG8_WAIT_L(0); PG8_MMA(1, 0, At, B0); PG8_BAR; PG8_SCHED;
            PG8_STAGE(PG8_SB(0, 1), b2 + hstep, voffB);
            PG8_WAIT_V(6); PG8_BAR; PG8_MMA(1, 1, At, B1); PG8_BAR;
            PG8_LDB(B0, 1, 0); PG8_SCHED; PG8_LDA(At, 1, 0); PG8_STAGE(PG8_SA(0, 1), a2, oc[1]);
            PG8_WAIT_L(8); PG8_BAR; PG8_WAIT_L(0); PG8_MMA(0, 0, At, B0); PG8_BAR; PG8_SCHED;
            PG8_LDB(B1, 1, 1); PG8_STAGE(PG8_SB(1, 0), b3, voffB);
            PG8_BAR; PG8_WAIT_L(0); PG8_MMA(0, 1, At, B1); PG8_BAR;
            PG8_LDA(At, 1, 1); PG8_STAGE(PG8_SA(1, 0), a3, oc[0]);
            PG8_BAR; PG8_WAIT_L(0); PG8_MMA(1, 0, At, B0); PG8_BAR; PG8_SCHED;
            PG8_STAGE(PG8_SB(1, 1), b3 + hstep, voffB);
            PG8_WAIT_V(6); PG8_BAR; PG8_MMA(1, 1, At, B1); PG8_BAR;
            }
        }
        if constexpr (ALIGN_EPI) { if (wr == 0) PG8_BAR; }
        if constexpr (!Epi::AFTER_DRAIN) { E(acc, cur, wr, wc, fr, fq); }
        if (!has_next) break;
#pragma unroll
        for (int a = 0; a < 2; ++a)
#pragma unroll
            for (int b = 0; b < 2; ++b)
#pragma unroll
                for (int m = 0; m < 4; ++m)
#pragma unroll
                    for (int n = 0; n < 2; ++n) acc[a][b][m][n] = (f32x4){0.f, 0.f, 0.f, 0.f};
        cur = nxt; cB = nB; ++ui;
        if constexpr (ALIGN_EPI) { if (wr == 1) PG8_BAR; }
    }
    PG8_WAIT_V(0);
    if constexpr (!ALIGN_EPI) { if (wr == 0) PG8_BAR; }
    PG8_BAR;
#undef PG8_SA
#undef PG8_SB
#undef PG8_STAGE
#undef PG8_LDA
#undef PG8_LDB
#undef PG8_MMA
#undef PG8_WAIT_V
#undef PG8_WAIT_L
#undef PG8_BAR
#undef PG8_SCHED
}
}

namespace att {
#define ATT_LAS __attribute__((address_space(3)))
typedef unsigned short bf16_t;
using bf16x8 = __attribute__((ext_vector_type(8))) short;
using s16x4  = __attribute__((ext_vector_type(4))) short;
using f32x16 = __attribute__((ext_vector_type(16))) float;
using f32x4  = __attribute__((ext_vector_type(4))) float;
using u32x4  = __attribute__((ext_vector_type(4))) unsigned;
using u32x2  = __attribute__((ext_vector_type(2))) unsigned;
constexpr int SEQ = 4096, LDQKV = 3072, LDATT = 1024;
constexpr float LOG2E = 1.4426950408889634f;
#define ATT_SBAR() __builtin_amdgcn_sched_barrier(0)
__device__ __forceinline__ int opaque(int v) { asm volatile("" : "+v"(v)); return v; }
__device__ __forceinline__ void dma16(const void* g, ATT_LAS unsigned char* l) { __builtin_amdgcn_global_load_lds((const unsigned*)g, (ATT_LAS unsigned*)l, 16, 0, 0); }
__device__ __forceinline__ int swap23(int k) { return (k & ~0xC) | ((k & 4) << 1) | ((k & 8) >> 1); }
__device__ __forceinline__ int crow(int r, int hi) { return (r & 3) + 8 * (r >> 2) + 4 * hi; }
__device__ __forceinline__ unsigned cvtpk(float lo, float hi) { unsigned r; asm volatile("v_cvt_pk_bf16_f32 %0, %1, %2" : "=v"(r) : "v"(lo), "v"(hi)); return r; }
__device__ __forceinline__ int ksw(int row, int c) { return row * 128 + ((c ^ ((row >> 1) & 7)) << 4); }
template <int NC> __device__ __forceinline__ int v_st(int k, int c) { const int kk = (k & ~0xC) | ((k & 4) << 1) | ((k & 8) >> 1); return ((kk >> 3) * NC + (c >> 5)) * 512 + ((kk & 7) * 32 + (c & 31)) * 2; }
__device__ __forceinline__ int v_rd_base(int lane) { return ((lane & 3) << 3) | (((lane >> 2) & 3) << 6) | (((lane >> 4) & 1) << 5) | (((lane >> 5) & 1) << 8); }
template <int NC> constexpr int v_rd_off(int d0, int ks, int half) { return d0 * 512 + ks * (2 * NC * 512) + half * (NC * 512); }
template <int OFF> __device__ __forceinline__ s16x4 tr_read(int vb) {
  s16x4 r; asm volatile("ds_read_b64_tr_b16 %0, %1 offset:%2" : "=&v"(r) : "v"(vb), "i"(OFF) : "memory"); return r;
}
#define ATT_TR8(S, D0_) do { \
    S[0] = tr_read<v_rd_off<NC>(D0_, 0, 0)>(vb); S[1] = tr_read<v_rd_off<NC>(D0_, 0, 1)>(vb); S[2] = tr_read<v_rd_off<NC>(D0_, 1, 0)>(vb); S[3] = tr_read<v_rd_off<NC>(D0_, 1, 1)>(vb); \
    S[4] = tr_read<v_rd_off<NC>(D0_, 2, 0)>(vb); S[5] = tr_read<v_rd_off<NC>(D0_, 2, 1)>(vb); S[6] = tr_read<v_rd_off<NC>(D0_, 3, 0)>(vb); S[7] = tr_read<v_rd_off<NC>(D0_, 3, 1)>(vb); } while (0)
#define ATT_PK(L, H) (bf16x8){L[0], L[1], L[2], L[3], H[0], H[1], H[2], H[3]}
#define ATT_MM4(OD, S) do { \
    OD = __builtin_amdgcn_mfma_f32_32x32x16_bf16(pa0, ATT_PK(S[0], S[1]), OD, 0, 0, 0); OD = __builtin_amdgcn_mfma_f32_32x32x16_bf16(pa1, ATT_PK(S[2], S[3]), OD, 0, 0, 0); \
    OD = __builtin_amdgcn_mfma_f32_32x32x16_bf16(pa2, ATT_PK(S[4], S[5]), OD, 0, 0, 0); OD = __builtin_amdgcn_mfma_f32_32x32x16_bf16(pa3, ATT_PK(S[6], S[7]), OD, 0, 0, 0); } while (0)
template <int NC> __device__ __forceinline__ void pv_all(f32x16 (&o)[NC], int vb, bf16x8 pa0, bf16x8 pa1, bf16x8 pa2, bf16x8 pa3) {
  s16x4 A[8], B[8];
  ATT_TR8(A, 0);
  if constexpr (NC == 2) {
    ATT_TR8(B, 1); asm volatile("s_waitcnt lgkmcnt(8)" ::: "memory"); ATT_SBAR(); ATT_MM4(o[0], A);
    asm volatile("s_waitcnt lgkmcnt(0)" ::: "memory"); ATT_SBAR(); ATT_MM4(o[1], B);
  } else {
    ATT_TR8(B, 1); asm volatile("s_waitcnt lgkmcnt(8)" ::: "memory"); ATT_SBAR(); ATT_MM4(o[0], A);
    ATT_SBAR(); ATT_TR8(A, 2); asm volatile("s_waitcnt lgkmcnt(8)" ::: "memory"); ATT_SBAR(); ATT_MM4(o[1], B);
    ATT_SBAR(); ATT_TR8(B, 3); asm volatile("s_waitcnt lgkmcnt(8)" ::: "memory"); ATT_SBAR(); ATT_MM4(o[2], A);
    asm volatile("s_waitcnt lgkmcnt(0)" ::: "memory"); ATT_SBAR(); ATT_MM4(o[3], B);
  }
}
#undef ATT_TR8
#undef ATT_PK
#undef ATT_MM4
__device__ __forceinline__ void qkt_bias(f32x16& p0, f32x16& p1, const ATT_LAS float* BT, const ATT_LAS unsigned char* Ks, const bf16x8 (&qr)[4], int r32, int hi, bf16x8 augA, bf16x8 augB) {
#pragma unroll
  for (int g = 0; g < 4; ++g) { const f32x4 b0 = *(const ATT_LAS f32x4*)(BT + 8 * g + 4 * hi), b1 = *(const ATT_LAS f32x4*)(BT + 32 + 8 * g + 4 * hi);
#pragma unroll
    for (int i = 0; i < 4; ++i) { p0[4 * g + i] = b0[i]; p1[4 * g + i] = b1[i]; } }
#pragma unroll
  for (int d0 = 0; d0 < 4; ++d0) {
    const bf16x8 b0 = *(const ATT_LAS bf16x8*)(Ks + ksw(r32, 2 * d0 + hi));
    const bf16x8 b1 = *(const ATT_LAS bf16x8*)(Ks + ksw(32 + r32, 2 * d0 + hi));
    p0 = __builtin_amdgcn_mfma_f32_32x32x16_bf16(b0, qr[d0], p0, 0, 0, 0);
    p1 = __builtin_amdgcn_mfma_f32_32x32x16_bf16(b1, qr[d0], p1, 0, 0, 0);
    if (d0 == 1) ATT_SBAR(); }
  p0 = __builtin_amdgcn_mfma_f32_32x32x16_bf16(augA, augB, p0, 0, 0, 0);
  p1 = __builtin_amdgcn_mfma_f32_32x32x16_bf16(augA, augB, p1, 0, 0, 0);
}

constexpr float SKIP_T = 40.0f;
__device__ __forceinline__ float q_norm(const bf16x8 (&qr)[4]) {
  float s = 0.f;
#pragma unroll
  for (int d0 = 0; d0 < 4; ++d0)
#pragma unroll
    for (int e = 0; e < 8; ++e) { const float v = __uint_as_float(((unsigned)(unsigned short)qr[d0][e]) << 16); s = fmaf(v, v, s); }
  return sqrtf(lx_sum32(s));
}
__device__ __forceinline__ float k_max(const unsigned* km, int g) {
  const float a = __uint_as_float(__hip_atomic_load(km + g, __ATOMIC_RELAXED, __HIP_MEMORY_SCOPE_AGENT)), b = __uint_as_float(__hip_atomic_load(km + g + 1, __ATOMIC_RELAXED, __HIP_MEMORY_SCOPE_AGENT));
  return sqrtf(a + b) * 1.005f;
}
__device__ __forceinline__ bool all_done(const ATT_LAS int* DONE, int i) {
  const ATT_LAS u32x4* d = (const ATT_LAS u32x4*)DONE; const u32x4 a = d[0], b = d[1];
  const unsigned m = max(max(max(a.x, a.y), max(a.z, a.w)), max(max(b.x, b.y), max(b.z, b.w)));
  return __builtin_amdgcn_readfirstlane((int)(m < (unsigned)i)) != 0;
}
__device__ __forceinline__ void qkt_bias_q(f32x16& p0, f32x16& p1, const ATT_LAS float* BT, const ATT_LAS unsigned char* Ks, const ATT_LAS unsigned char* Qs, int qrow, int r32, int hi, bf16x8 augA, bf16x8 augB) {
#pragma unroll
  for (int g = 0; g < 4; ++g) { const f32x4 b0 = *(const ATT_LAS f32x4*)(BT + 8 * g + 4 * hi), b1 = *(const ATT_LAS f32x4*)(BT + 32 + 8 * g + 4 * hi);
#pragma unroll
    for (int i = 0; i < 4; ++i) { p0[4 * g + i] = b0[i]; p1[4 * g + i] = b1[i]; } }
#pragma unroll
  for (int d0 = 0; d0 < 4; ++d0) {
    const bf16x8 b0 = *(const ATT_LAS bf16x8*)(Ks + ksw(r32, 2 * d0 + hi));
    const bf16x8 b1 = *(const ATT_LAS bf16x8*)(Ks + ksw(32 + r32, 2 * d0 + hi));
    const bf16x8 q = *(const ATT_LAS bf16x8*)(Qs + ksw(qrow, 2 * d0 + hi));
    p0 = __builtin_amdgcn_mfma_f32_32x32x16_bf16(b0, q, p0, 0, 0, 0);
    p1 = __builtin_amdgcn_mfma_f32_32x32x16_bf16(b1, q, p1, 0, 0, 0);
    if (d0 == 1) ATT_SBAR(); }
  p0 = __builtin_amdgcn_mfma_f32_32x32x16_bf16(augA, augB, p0, 0, 0, 0);
  p1 = __builtin_amdgcn_mfma_f32_32x32x16_bf16(augA, augB, p1, 0, 0, 0);
}

__device__ __forceinline__ bf16x8 aug_a(int hi) { const u32x4 v = {hi ? 0u : 0x3F803F80u, hi ? 0u : 0x00003F80u, 0u, 0u}; return __builtin_bit_cast(bf16x8, v); }
__device__ __forceinline__ bf16x8 aug_b(float w, int hi) {
  const unsigned h = cvtpk(w, 0.f) & 0xffffu; const float d1 = w - __uint_as_float(h << 16);
  const unsigned m = cvtpk(d1, 0.f) & 0xffffu; const float d2 = d1 - __uint_as_float(m << 16);
  const unsigned l = cvtpk(d2, 0.f) & 0xffffu;
  const u32x4 v = {hi ? 0u : (h | (m << 16)), hi ? 0u : l, 0u, 0u}; return __builtin_bit_cast(bf16x8, v);
}
__device__ __forceinline__ void sm_direct(f32x16& p0, f32x16& p1, float& l_part, bf16x8& pa0, bf16x8& pa1, bf16x8& pa2, bf16x8& pa3) {
#pragma unroll
  for (int r = 0; r < 16; ++r) { p0[r] = __builtin_amdgcn_exp2f(p0[r]); p1[r] = __builtin_amdgcn_exp2f(p1[r]); }
  float ps = 0.f;
#pragma unroll
  for (int r = 0; r < 16; ++r) ps += p0[r];
#pragma unroll
  for (int r = 0; r < 16; ++r) ps += p1[r];
  l_part += ps;
#define ATT_PK4(P, BASE, OUT) do { unsigned a0 = cvtpk(P[BASE + 0], P[BASE + 1]), a1 = cvtpk(P[BASE + 2], P[BASE + 3]);   \
    unsigned b0 = cvtpk(P[BASE + 4], P[BASE + 5]), b1 = cvtpk(P[BASE + 6], P[BASE + 7]);                              \
    auto r0 = __builtin_amdgcn_permlane32_swap(a0, b0, false, false); auto r1 = __builtin_amdgcn_permlane32_swap(a1, b1, false, false); \
    u32x4 w = {r0[0], r1[0], r0[1], r1[1]}; OUT = __builtin_bit_cast(bf16x8, w); } while (0)
  ATT_PK4(p0, 0, pa0); ATT_PK4(p0, 8, pa1); ATT_PK4(p1, 0, pa2); ATT_PK4(p1, 8, pa3);
#undef ATT_PK4
}
__device__ __forceinline__ bf16x8 aug_a_alibi(int koff, int hi) { const unsigned kb = __float_as_uint((float)koff) >> 16;
  const u32x4 v = {hi ? 0u : 0x3F803F80u, hi ? 0u : (0x3F80u | (kb << 16)), hi ? 0u : kb, 0u}; return __builtin_bit_cast(bf16x8, v); }
__device__ __forceinline__ bf16x8 aug_b_alibi(float w, unsigned s_hi, unsigned s_lo, int hi) {
  const unsigned h = cvtpk(w, 0.f) & 0xffffu; const float d1 = w - __uint_as_float(h << 16);
  const unsigned m = cvtpk(d1, 0.f) & 0xffffu; const float d2 = d1 - __uint_as_float(m << 16);
  const unsigned l = cvtpk(d2, 0.f) & 0xffffu;
  const u32x4 v = {hi ? 0u : (h | (m << 16)), hi ? 0u : (l | (s_hi << 16)), hi ? 0u : s_lo, 0u}; return __builtin_bit_cast(bf16x8, v);
}
__device__ __forceinline__ void qkt_aug_q(f32x16& p0, f32x16& p1, const ATT_LAS unsigned char* Ks, const ATT_LAS unsigned char* Qs, int qrow, int r32, int hi, bf16x8 augA0, bf16x8 augA1, bf16x8 augB) {
  p0 = f32x16{}; p1 = f32x16{};
#pragma unroll
  for (int d0 = 0; d0 < 4; ++d0) {
    const bf16x8 b0 = *(const ATT_LAS bf16x8*)(Ks + ksw(r32, 2 * d0 + hi));
    const bf16x8 b1 = *(const ATT_LAS bf16x8*)(Ks + ksw(32 + r32, 2 * d0 + hi));
    const bf16x8 q = *(const ATT_LAS bf16x8*)(Qs + ksw(qrow, 2 * d0 + hi));
    p0 = __builtin_amdgcn_mfma_f32_32x32x16_bf16(b0, q, p0, 0, 0, 0);
    p1 = __builtin_amdgcn_mfma_f32_32x32x16_bf16(b1, q, p1, 0, 0, 0);
    if (d0 == 1) ATT_SBAR(); }
  p0 = __builtin_amdgcn_mfma_f32_32x32x16_bf16(augA0, augB, p0, 0, 0, 0);
  p1 = __builtin_amdgcn_mfma_f32_32x32x16_bf16(augA1, augB, p1, 0, 0, 0);
}
#define ATT_WAIT_BAR(N) asm volatile("s_waitcnt vmcnt(" #N ") lgkmcnt(0)\n\ts_barrier" ::: "memory")

__device__ __forceinline__ void fox_unit(ATT_LAS unsigned char* lds, const bf16_t* __restrict__ qkv, bf16_t* __restrict__ attn, const float* __restrict__ cl2, const float* __restrict__ blk2, const unsigned* km,
                                         int b, int h, int qb, int wave, unsigned long long& pacc) {
  PROF_BEGIN(11);
  const int wid = wave, lane = fresh_lane(), tid = wid * 64 + lane, r32 = lane & 31, hi = lane >> 5;
  ATT_LAS float* CARRY = (ATT_LAS float*)(lds + 63488); ATT_LAS float* wsf = (ATT_LAS float*)(lds + 63744) + wid * 64;
  ATT_LAS unsigned char* BW = lds + 57344 + wid * 768; ATT_LAS int* DONE = (ATT_LAS int*)(lds + 65792);
  if (lane == 0) DONE[wid] = 0x7fffffff;
  const int q0 = qb * 256, NT = 4 * (qb + 1), jl = 4 * qb + (wid >> 1);
  const size_t rowb = (size_t)b * SEQ; const int bh = b * 8 + h;
  if (wid == 0) { float v = lane < 32 ? blk2[(b * 32 + lane) * 8 + h] : 0.f; float s = v;
#pragma unroll
    for (int o = 1; o < 32; o <<= 1) { const float t = __builtin_bit_cast(float, __builtin_amdgcn_ds_bpermute(((lane - o) & 63) << 2, __builtin_bit_cast(int, s))); if (lane >= o) s += t; }
    if (lane < 32) CARRY[lane] = s - v; }
  __syncthreads();
  const float cq = CARRY[q0 >> 7] + cl2[(size_t)bh * SEQ + q0];
  bf16x8 qr[4];
  { const bf16_t* Qw = qkv + (rowb + q0 + wid * 32 + r32) * LDQKV + h * 64 + hi * 8;
#pragma unroll
    for (int d0 = 0; d0 < 4; ++d0) qr[d0] = *(const bf16x8*)(Qw + d0 * 16); }
  const int pk = 64 * wid + lane;
  unsigned koff, voff;
  { const int row = pk >> 3, c = (pk & 7) ^ ((row >> 1) & 7); koff = (unsigned)((row * LDQKV + 512 + h * 64 + c * 8) * 2);
    const int sub = pk >> 5, kk = 8 * (sub >> 1) + ((pk & 31) >> 2), k = swap23(kk), cv = (sub & 1) * 32 + (pk & 3) * 8; voff = (unsigned)((k * LDQKV + 1024 + h * 64 + cv) * 2); }
  const char* tb = (const char*)(qkv + rowb * LDQKV);
  const char* cg = (const char*)(cl2 + (size_t)bh * SEQ) + (lane & 15) * 16;
  const int vb0 = (int)(uintptr_t)(lds + 24576) + v_rd_base(lane);
#define FOX_LOAD(j, bo, vbo) do { const char* tj = tb + (size_t)(j) * (64 * LDQKV * 2); dma16(tj + koff, lds + (bo) * 8192 + wid * 1024); dma16(tj + voff, lds + 24576 + (vbo) * 8192 + wid * 1024); \
    if (lane < 16) dma16(cg + (j) * 256, BW + (bo) * 256); } while (0)
#define FOX_PV(vbo) pv_all<2>(o, vb0 + (vbo) * 8192, pa0, pa1, pa2, pa3)
  FOX_LOAD(NT - 1, 0, 0); FOX_LOAD(NT - 2, 1, 1);
  float l_reg = 0.f; f32x16 o[2]; o[0] = f32x16{}; o[1] = f32x16{};
  const float bnd = q_norm(qr) * k_max(km + b * 96, 16 + 2 * h);
  const int qpos = q0 + wid * 32 + r32;
  const float refq = (cl2[(size_t)bh * SEQ + qpos] + CARRY[qpos >> 7] - cq) + fmaxf(0.f, bnd - 60.f);
  const bf16x8 augA = aug_a(hi);
  __builtin_amdgcn_s_waitcnt(0x0F70);
  bool stopped = false, pend = false; const bool late = wid >= 4;
  bf16x8 pa0, pa1, pa2, pa3;
  int cur = 0, nx2 = 2, vc = 0, vn2 = 2, vprev = 3;
  PROF_END(11, pacc);
  for (int i = 0; i < NT; ++i) {
    const int j = NT - 1 - i;
    if (PROF_ID == 13) pacc += 100;
    PROF_BEGIN(8);
    if (i + 1 < NT) ATT_WAIT_BAR(3); else ATT_WAIT_BAR(0);
    PROF_END(8, pacc);
    if (all_done(DONE, i)) break;
    if (i + 2 < NT) FOX_LOAD(j - 2, nx2, vn2);
    if (pend) { PROF_BEGIN(10); FOX_PV(vprev); pend = false; PROF_END(10, pacc); }
    if (j <= jl && !stopped) {
      const float bj = ((const ATT_LAS float*)(BW + cur * 256))[63] + (CARRY[j >> 1] - cq);
      if (!__any(bnd + (bj - refq) - __builtin_amdgcn_logf(l_reg) >= -SKIP_T)) { stopped = true; if (lane == 0) DONE[wid] = i; }
    }
    if (j <= jl && !stopped) {
      f32x16 p0, p1;
      PROF_BEGIN(9);
      const float c2 = CARRY[j >> 1] - cq;
      qkt_bias(p0, p1, (const ATT_LAS float*)(BW + cur * 256), lds + cur * 8192, qr, r32, hi, augA, aug_b(c2 - refq, hi));
      if (j == jl) { const int qrel = opaque(32 * (wid & 1) + r32), hio = opaque(hi);
#pragma unroll
        for (int r = 0; r < 16; ++r) { const int kr = crow(r, hio); if (kr > qrel) p0[r] = -1e30f; if (kr + 32 > qrel) p1[r] = -1e30f; } }
      sm_direct(p0, p1, l_reg, pa0, pa1, pa2, pa3);
      PROF_END(9, pacc);
      if (late) pend = true; else { PROF_BEGIN(10); FOX_PV(vc); PROF_END(10, pacc); }
    }
    cur = cur == 2 ? 0 : cur + 1; nx2 = nx2 == 2 ? 0 : nx2 + 1; vprev = vc; vc = (vc + 1) & 3; vn2 = (vn2 + 1) & 3;
  }
  if (pend) FOX_PV(vprev);
#undef FOX_PV
#undef FOX_LOAD
  PROF_BEGIN(12);
  asm volatile("s_waitcnt vmcnt(0)" ::: "memory");
  l_reg = lx_sum32(l_reg);
  if (hi == 0) wsf[32 + r32] = l_reg; asm volatile("s_waitcnt lgkmcnt(0)" ::: "memory");
  { const int le = opaque(lane), r32e = le & 31, hie = le >> 5;
  bf16_t* Ow = attn + (rowb + q0 + wid * 32) * LDATT + h * 64 + r32e;
#pragma unroll
  for (int r = 0; r < 16; ++r) { const int orow = crow(r, hie); const float rl = __builtin_amdgcn_rcpf(wsf[32 + orow]);
#pragma unroll
    for (int d0 = 0; d0 < 2; ++d0) { const unsigned w = cvtpk(o[d0][r] * rl, 0.f); Ow[(size_t)orow * LDATT + d0 * 32] = (bf16_t)(w & 0xffffu); } } }
  asm volatile("s_waitcnt lgkmcnt(0)" ::: "memory");
  __syncthreads();
  PROF_END(12, pacc);
}

__device__ __forceinline__ void fox2_unit(ATT_LAS unsigned char* lds, const bf16_t* __restrict__ qkv, bf16_t* __restrict__ attn, const float* __restrict__ cl2, const float* __restrict__ blk2, const unsigned* km,
                                          int b, int h, int qb, int wave, unsigned long long& pacc) {
  PROF_BEGIN(11);
  const int wid = wave, lane = fresh_lane(), r32 = lane & 31, hi = lane >> 5;
  ATT_LAS float* CARRY = (ATT_LAS float*)(lds + 63488); ATT_LAS float* wsf = (ATT_LAS float*)(lds + 63744) + wid * 64;
  ATT_LAS unsigned char* BW = lds + 57344 + wid * 768; ATT_LAS int* DONE = (ATT_LAS int*)(lds + 65792);
  if (lane == 0) DONE[wid] = 0x7fffffff;
  const int q0 = qb * 512, NT = 8 * (qb + 1), jl = 8 * qb + wid;
  const size_t rowb = (size_t)b * SEQ; const int bh = b * 8 + h;
  if (wid == 0) { float v = lane < 32 ? blk2[(b * 32 + lane) * 8 + h] : 0.f; float s = v;
#pragma unroll
    for (int o = 1; o < 32; o <<= 1) { const float t = __builtin_bit_cast(float, __builtin_amdgcn_ds_bpermute(((lane - o) & 63) << 2, __builtin_bit_cast(int, s))); if (lane >= o) s += t; }
    if (lane < 32) CARRY[lane] = s - v; }
  __syncthreads();
  const float cq = CARRY[q0 >> 7] + cl2[(size_t)bh * SEQ + q0];
  bf16x8 qA[4], qB[4];
  { const bf16_t* Qw = qkv + (rowb + q0 + wid * 64 + r32) * LDQKV + h * 64 + hi * 8;
#pragma unroll
    for (int d0 = 0; d0 < 4; ++d0) { qA[d0] = *(const bf16x8*)(Qw + d0 * 16); qB[d0] = *(const bf16x8*)(Qw + (size_t)32 * LDQKV + d0 * 16); } }
  const int pk = 64 * wid + lane;
  unsigned koff, voff;
  { const int row = pk >> 3, c = (pk & 7) ^ ((row >> 1) & 7); koff = (unsigned)((row * LDQKV + 512 + h * 64 + c * 8) * 2);
    const int sub = pk >> 5, kk = 8 * (sub >> 1) + ((pk & 31) >> 2), k = swap23(kk), cv = (sub & 1) * 32 + (pk & 3) * 8; voff = (unsigned)((k * LDQKV + 1024 + h * 64 + cv) * 2); }
  const char* tb = (const char*)(qkv + rowb * LDQKV);
  const char* cg = (const char*)(cl2 + (size_t)bh * SEQ) + (lane & 15) * 16;
  const int vb0 = (int)(uintptr_t)(lds + 24576) + v_rd_base(lane);
#define FOX_LOAD(j, bo, vbo) do { const char* tj = tb + (size_t)(j) * (64 * LDQKV * 2); dma16(tj + koff, lds + (bo) * 8192 + wid * 1024); dma16(tj + voff, lds + 24576 + (vbo) * 8192 + wid * 1024); \
    if (lane < 16) dma16(cg + (j) * 256, BW + (bo) * 256); } while (0)
  FOX_LOAD(NT - 1, 0, 0); FOX_LOAD(NT - 2, 1, 1);
  float lA = 0.f, lB = 0.f; f32x16 oA[2], oB[2]; oA[0] = f32x16{}; oA[1] = f32x16{}; oB[0] = f32x16{}; oB[1] = f32x16{};
  const float kmx = k_max(km + b * 96, 16 + 2 * h);
  const float bndA = q_norm(qA) * kmx, bndB = q_norm(qB) * kmx;
  const int qposA = q0 + wid * 64 + r32;
  const float refA = (cl2[(size_t)bh * SEQ + qposA] + CARRY[qposA >> 7] - cq) + fmaxf(0.f, bndA - 60.f);
  const float refB = (cl2[(size_t)bh * SEQ + qposA + 32] + CARRY[(qposA + 32) >> 7] - cq) + fmaxf(0.f, bndB - 60.f);
  const bf16x8 augA = aug_a(hi);
  __builtin_amdgcn_s_waitcnt(0x0F70);
  bool stopped = false;
  int cur = 0, nx2 = 2, vc = 0, vn2 = 2;
  PROF_END(11, pacc);
  for (int i = 0; i < NT; ++i) {
    const int j = NT - 1 - i;
    if (PROF_ID == 13) pacc += 100;
    PROF_BEGIN(8);
    if (i + 1 < NT) ATT_WAIT_BAR(3); else ATT_WAIT_BAR(0);
    PROF_END(8, pacc);
    if (all_done(DONE, i)) break;
    if (i + 2 < NT) FOX_LOAD(j - 2, nx2, vn2);
    if (j <= jl && !stopped) {
      const float bj = ((const ATT_LAS float*)(BW + cur * 256))[63] + (CARRY[j >> 1] - cq);
      const float tA = bndA + (bj - refA) - __builtin_amdgcn_logf(lA), tB = bndB + (bj - refB) - __builtin_amdgcn_logf(lB);
      if (!__any(fmaxf(tA, tB) >= -SKIP_T)) { stopped = true; if (lane == 0) DONE[wid] = i; }
    }
    if (j <= jl && !stopped) {
      PROF_BEGIN(9);
      f32x16 pA0, pA1, pB0, pB1; bf16x8 paA0, paA1, paA2, paA3, paB0, paB1, paB2, paB3;
      const float c2 = CARRY[j >> 1] - cq;
      { const ATT_LAS float* BT = (const ATT_LAS float*)(BW + cur * 256); const ATT_LAS unsigned char* Ks = lds + cur * 8192;
#pragma unroll
        for (int g = 0; g < 4; ++g) { const f32x4 b0 = *(const ATT_LAS f32x4*)(BT + 8 * g + 4 * hi), b1 = *(const ATT_LAS f32x4*)(BT + 32 + 8 * g + 4 * hi);
#pragma unroll
          for (int e = 0; e < 4; ++e) { pA0[4 * g + e] = b0[e]; pA1[4 * g + e] = b1[e]; pB0[4 * g + e] = b0[e]; pB1[4 * g + e] = b1[e]; } }
#pragma unroll
        for (int d0 = 0; d0 < 4; ++d0) {
          const bf16x8 k0 = *(const ATT_LAS bf16x8*)(Ks + ksw(r32, 2 * d0 + hi));
          const bf16x8 k1 = *(const ATT_LAS bf16x8*)(Ks + ksw(32 + r32, 2 * d0 + hi));
          pA0 = __builtin_amdgcn_mfma_f32_32x32x16_bf16(k0, qA[d0], pA0, 0, 0, 0); pB0 = __builtin_amdgcn_mfma_f32_32x32x16_bf16(k0, qB[d0], pB0, 0, 0, 0);
          pA1 = __builtin_amdgcn_mfma_f32_32x32x16_bf16(k1, qA[d0], pA1, 0, 0, 0); pB1 = __builtin_amdgcn_mfma_f32_32x32x16_bf16(k1, qB[d0], pB1, 0, 0, 0);
          if (d0 == 1) ATT_SBAR(); }
        const bf16x8 gA = aug_b(c2 - refA, hi), gB = aug_b(c2 - refB, hi);
        pA0 = __builtin_amdgcn_mfma_f32_32x32x16_bf16(augA, gA, pA0, 0, 0, 0); pA1 = __builtin_amdgcn_mfma_f32_32x32x16_bf16(augA, gA, pA1, 0, 0, 0);
        pB0 = __builtin_amdgcn_mfma_f32_32x32x16_bf16(augA, gB, pB0, 0, 0, 0); pB1 = __builtin_amdgcn_mfma_f32_32x32x16_bf16(augA, gB, pB1, 0, 0, 0); }
      if (j == jl) { const int qrel = opaque(r32), hio = opaque(hi);
#pragma unroll
        for (int r = 0; r < 16; ++r) { const int kr = crow(r, hio); if (kr > qrel) { pA0[r] = -1e30f; pB1[r] = -1e30f; } pA1[r] = -1e30f; } }
      sm_direct(pA0, pA1, lA, paA0, paA1, paA2, paA3);
      sm_direct(pB0, pB1, lB, paB0, paB1, paB2, paB3);
      PROF_END(9, pacc);
      PROF_BEGIN(10);
      { const int vb = vb0 + vc * 8192;
#define FOX2_TR8(S, D0_) do { \
        S[0] = tr_read<v_rd_off<2>(D0_, 0, 0)>(vb); S[1] = tr_read<v_rd_off<2>(D0_, 0, 1)>(vb); S[2] = tr_read<v_rd_off<2>(D0_, 1, 0)>(vb); S[3] = tr_read<v_rd_off<2>(D0_, 1, 1)>(vb); \
        S[4] = tr_read<v_rd_off<2>(D0_, 2, 0)>(vb); S[5] = tr_read<v_rd_off<2>(D0_, 2, 1)>(vb); S[6] = tr_read<v_rd_off<2>(D0_, 3, 0)>(vb); S[7] = tr_read<v_rd_off<2>(D0_, 3, 1)>(vb); } while (0)
#define FOX2_PK(L, H) (bf16x8){L[0], L[1], L[2], L[3], H[0], H[1], H[2], H[3]}
#define FOX2_MM(OD, P0_, P1_, P2_, P3_, S) do { \
        OD = __builtin_amdgcn_mfma_f32_32x32x16_bf16(P0_, FOX2_PK(S[0], S[1]), OD, 0, 0, 0); OD = __builtin_amdgcn_mfma_f32_32x32x16_bf16(P1_, FOX2_PK(S[2], S[3]), OD, 0, 0, 0); \
        OD = __builtin_amdgcn_mfma_f32_32x32x16_bf16(P2_, FOX2_PK(S[4], S[5]), OD, 0, 0, 0); OD = __builtin_amdgcn_mfma_f32_32x32x16_bf16(P3_, FOX2_PK(S[6], S[7]), OD, 0, 0, 0); } while (0)
        s16x4 S0[8], S1[8];
        FOX2_TR8(S0, 0); FOX2_TR8(S1, 1);
        asm volatile("s_waitcnt lgkmcnt(8)" ::: "memory"); ATT_SBAR();
        FOX2_MM(oA[0], paA0, paA1, paA2, paA3, S0); FOX2_MM(oB[0], paB0, paB1, paB2, paB3, S0);
        asm volatile("s_waitcnt lgkmcnt(0)" ::: "memory"); ATT_SBAR();
        FOX2_MM(oA[1], paA0, paA1, paA2, paA3, S1); FOX2_MM(oB[1], paB0, paB1, paB2, paB3, S1);
#undef FOX2_TR8
#undef FOX2_PK
#undef FOX2_MM
      }
      PROF_END(10, pacc);
    }
    cur = cur == 2 ? 0 : cur + 1; nx2 = nx2 == 2 ? 0 : nx2 + 1; vc = (vc + 1) & 3; vn2 = (vn2 + 1) & 3;
  }
#undef FOX_LOAD
  PROF_BEGIN(12);
  asm volatile("s_waitcnt vmcnt(0)" ::: "memory");
  lA = lx_sum32(lA); lB = lx_sum32(lB);
  { const int le = opaque(lane), r32e = le & 31, hie = le >> 5;
    if (hie == 0) wsf[32 + r32e] = lA; asm volatile("s_waitcnt lgkmcnt(0)" ::: "memory");
    bf16_t* Ow = attn + (rowb + q0 + wid * 64) * LDATT + h * 64 + r32e;
#pragma unroll
    for (int r = 0; r < 16; ++r) { const int orow = crow(r, hie); const float rl = __builtin_amdgcn_rcpf(wsf[32 + orow]);
#pragma unroll
      for (int d0 = 0; d0 < 2; ++d0) { const unsigned w = cvtpk(oA[d0][r] * rl, 0.f); Ow[(size_t)orow * LDATT + d0 * 32] = (bf16_t)(w & 0xffffu); } }
    asm volatile("s_waitcnt lgkmcnt(0)" ::: "memory");
    if (hie == 0) wsf[32 + r32e] = lB; asm volatile("s_waitcnt lgkmcnt(0)" ::: "memory");
#pragma unroll
    for (int r = 0; r < 16; ++r) { const int orow = crow(r, hie); const float rl = __builtin_amdgcn_rcpf(wsf[32 + orow]);
#pragma unroll
      for (int d0 = 0; d0 < 2; ++d0) { const unsigned w = cvtpk(oB[d0][r] * rl, 0.f); Ow[(size_t)(32 + orow) * LDATT + d0 * 32] = (bf16_t)(w & 0xffffu); } } }
  asm volatile("s_waitcnt lgkmcnt(0)" ::: "memory");
  __syncthreads();
  PROF_END(12, pacc);
}

__device__ __forceinline__ void diff_unit(ATT_LAS unsigned char* lds, const bf16_t* __restrict__ qkv, bf16_t* __restrict__ attn, const float* __restrict__ subln_g, float lam, const unsigned* km,
                                          int b, int h, int qb, int wave, unsigned long long& pacc) {
  PROF_BEGIN(6);
  const int wid = wave, lane = fresh_lane(), tid = wid * 64 + lane, r32 = lane & 31, hi = lane >> 5;
  ATT_LAS float* wsf = (ATT_LAS float*)(lds + 114688) + wid * 64; ATT_LAS float* BT = (ATT_LAS float*)(lds + 116736) + wid * 64;
  ATT_LAS int* DONE = (ATT_LAS int*)(lds + 118784);
  if (lane == 0) DONE[wid] = 0x7fffffff;
  const int map = wid >> 2, w4 = wid & 3;
  const int q0 = qb * 128, NT = 2 * (qb + 1), jl = 2 * qb + (w4 >> 1);
  const size_t rowb = (size_t)b * SEQ;
  const float sl2 = LOG2E * (h == 0 ? 0.25f : h == 1 ? 0.0625f : h == 2 ? 0.015625f : 0.00390625f);
  const int pk = 64 * wid + lane;
  unsigned koff, voff0, voff1;
  { const int row = pk >> 3, c = (pk & 7) ^ ((row >> 1) & 7); koff = (unsigned)((row * LDQKV + 2048 + h * 128 + c * 8) * 2);
    const int sub0 = pk >> 5, kk0 = 8 * (sub0 >> 2) + ((pk & 31) >> 2), k0 = swap23(kk0), c0 = (sub0 & 3) * 32 + (pk & 3) * 8; voff0 = (unsigned)((k0 * LDQKV + 2560 + h * 128 + c0) * 2);
    const int p1 = pk + 512, sub1 = p1 >> 5, kk1 = 8 * (sub1 >> 2) + ((p1 & 31) >> 2), k1 = swap23(kk1), c1 = (sub1 & 3) * 32 + (p1 & 3) * 8; voff1 = (unsigned)((k1 * LDQKV + 2560 + h * 128 + c1) * 2); }
  const char* tb = (const char*)(qkv + rowb * LDQKV);
  const int vb0 = (int)(uintptr_t)(lds + 49152) + v_rd_base(lane);
#define DIFF_LOAD(j, kbo, vbo) do { const char* tj = tb + (size_t)(j) * (64 * LDQKV * 2); dma16(tj + koff, lds + (kbo) * 8192 + wid * 1024); dma16(tj + koff + 128, lds + 24576 + (kbo) * 8192 + wid * 1024); \
    dma16(tj + voff0, lds + 49152 + (vbo) * 16384 + wid * 1024); dma16(tj + voff1, lds + 49152 + (vbo) * 16384 + 8192 + wid * 1024); } while (0)
#define DIFF_PV(vbo) pv_all<4>(o, vb0 + (vbo) * 16384, pa0, pa1, pa2, pa3)
  ATT_LAS unsigned char* QS = lds + 118912;
  { const int pq = pk + 512, r0_ = pk >> 3, c0q = (pk & 7) ^ ((r0_ >> 1) & 7), r1_ = pq >> 3, c1q = (pq & 7) ^ ((r1_ >> 1) & 7);
    const char* qb_ = (const char*)(qkv + (rowb + q0) * LDQKV + 1536 + h * 128);
#pragma unroll
    for (int m2 = 0; m2 < 2; ++m2) { dma16(qb_ + ((size_t)r0_ * LDQKV + m2 * 64 + c0q * 8) * 2, QS + m2 * 16384 + wid * 1024); dma16(qb_ + ((size_t)r1_ * LDQKV + m2 * 64 + c1q * 8) * 2, QS + m2 * 16384 + 8192 + wid * 1024); } }
  DIFF_LOAD(NT - 1, 0, 0); DIFF_LOAD(NT - 2, 1, 1);
  __builtin_amdgcn_s_waitcnt(0x0F70);
  asm volatile("s_waitcnt lgkmcnt(0)\n\ts_barrier" ::: "memory");
  const ATT_LAS unsigned char* Qs = QS + map * 16384; const int qrow = 32 * w4 + r32;
  float l_reg = 0.f; f32x16 o[4]; o[0] = f32x16{}; o[1] = f32x16{}; o[2] = f32x16{}; o[3] = f32x16{};
  float bnd;
  { bf16x8 qr[4];
#pragma unroll
    for (int d0 = 0; d0 < 4; ++d0) qr[d0] = *(const ATT_LAS bf16x8*)(Qs + ksw(qrow, 2 * d0 + hi));
    bnd = q_norm(qr) * k_max(km + b * 96, 64 + 4 * h + 2 * map); }
  const float refq = sl2 * (float)(32 * w4 + r32) + fmaxf(0.f, bnd - 60.f);
  const bf16x8 augA0 = aug_a_alibi(r32, hi), augA1 = aug_a_alibi(r32 + 32, hi);
  unsigned s_hi, s_lo; { s_hi = cvtpk(sl2, 0.f) & 0xffffu; s_lo = cvtpk(sl2 - __uint_as_float(s_hi << 16), 0.f) & 0xffffu; }
  __builtin_amdgcn_s_waitcnt(0x0F70);
  bool stopped = false, pend = false; const bool late = wid >= 4;
  bf16x8 pa0, pa1, pa2, pa3;
  int cur = 0, nx2 = 2, vc = 0, vn2 = 2, vprev = 3;
  PROF_END(6, pacc);
  for (int i = 0; i < NT; ++i) {
    const int j = NT - 1 - i;
    if (PROF_ID == 14) pacc += 100;
    PROF_BEGIN(3);
    if (i + 1 < NT) ATT_WAIT_BAR(4); else ATT_WAIT_BAR(0);
    PROF_END(3, pacc);
    if (all_done(DONE, i)) break;
    if (i + 2 < NT) DIFF_LOAD(j - 2, nx2, vn2);
    if (pend) { PROF_BEGIN(5); DIFF_PV(vprev); pend = false; PROF_END(5, pacc); }
    if (j < jl && !stopped) {
      const float bj = sl2 * (float)(64 * j + 63 - q0);
      if (!__any(bnd + (bj - refq) - __builtin_amdgcn_logf(l_reg) >= -SKIP_T)) { stopped = true; if (lane == 0) DONE[wid] = i; }
    }
    if (j <= jl && !stopped) {
      f32x16 p0, p1;
      PROF_BEGIN(4); PROF_BEGIN(15);
      qkt_aug_q(p0, p1, lds + map * 24576 + cur * 8192, Qs, qrow, r32, hi, augA0, augA1, aug_b_alibi(sl2 * (float)(64 * j - q0) - refq, s_hi, s_lo, hi));
      PROF_END(15, pacc);
      if (j == jl) { const int tq = opaque(32 * (w4 & 1) + r32), hio = opaque(hi);
#pragma unroll
        for (int r = 0; r < 16; ++r) { const int k0 = crow(r, hio), k1 = k0 + 32; if (k0 > tq) p0[r] += sl2 * (float)(2 * (tq - k0)); if (k1 > tq) p1[r] += sl2 * (float)(2 * (tq - k1)); } }
      PROF_BEGIN(16);
      sm_direct(p0, p1, l_reg, pa0, pa1, pa2, pa3);
      PROF_END(16, pacc);
      PROF_END(4, pacc);
      if (late) pend = true; else { PROF_BEGIN(5); DIFF_PV(vc); PROF_END(5, pacc); }
    }
    cur = cur == 2 ? 0 : cur + 1; nx2 = nx2 == 2 ? 0 : nx2 + 1; vprev = vc; vc = (vc + 1) & 3; vn2 = (vn2 + 1) & 3;
  }
  if (pend) DIFF_PV(vprev);
#undef DIFF_PV
  PROF_BEGIN(7);
#undef DIFF_LOAD
  asm volatile("s_waitcnt vmcnt(0)" ::: "memory");
  l_reg = lx_sum32(l_reg);
  if (hi == 0) wsf[32 + r32] = l_reg; asm volatile("s_waitcnt lgkmcnt(0)" ::: "memory");
  const int te = opaque(tid), r32e = te & 31, hie = (te >> 5) & 1;
  float rl[16];
#pragma unroll
  for (int r = 0; r < 16; ++r) rl[r] = __builtin_amdgcn_rcpf(wsf[32 + crow(r, hie)]);
  asm volatile("s_waitcnt lgkmcnt(0)" ::: "memory");
  __syncthreads();
  { ATT_LAS float* Xm = (ATT_LAS float*)lds + map * (128 * 132);
#pragma unroll
    for (int r = 0; r < 16; ++r) { const int orow = crow(r, hie);
#pragma unroll
      for (int d0 = 0; d0 < 4; ++d0) Xm[(32 * w4 + orow) * 132 + d0 * 32 + r32e] = o[d0][r] * rl[r]; } }
  __syncthreads();
  { const int row = te >> 2, qt = te & 3; const ATT_LAS float* X0 = (const ATT_LAS float*)lds + row * 132 + qt * 32; const ATT_LAS float* X1 = X0 + 128 * 132;
    float v[32]; float ss = 0.f;
#pragma unroll
    for (int i = 0; i < 8; ++i) { const f32x4 t0 = *(const ATT_LAS f32x4*)(X0 + 4 * i), t1 = *(const ATT_LAS f32x4*)(X1 + 4 * i); const f32x4 t = t0 - lam * t1;
      v[4 * i] = t[0]; v[4 * i + 1] = t[1]; v[4 * i + 2] = t[2]; v[4 * i + 3] = t[3];
      ss += t[0] * t[0] + t[1] * t[1] + t[2] * t[2] + t[3] * t[3]; }
    ss += lx_get<1>(ss); ss += lx_get<2>(ss);
    const float rstd = 0.8f / sqrtf(ss * (1.0f / 128.0f) + 1e-5f);
    bf16_t* op = attn + (rowb + q0 + row) * LDATT + 512 + h * 128 + qt * 32; const f32x4* gp = (const f32x4*)(subln_g + qt * 32);
#pragma unroll
    for (int i = 0; i < 4; ++i) { const f32x4 g0 = gp[2 * i], g1 = gp[2 * i + 1]; u32x4 w;
      w.x = cvtpk(v[8 * i + 0] * rstd * g0[0], v[8 * i + 1] * rstd * g0[1]); w.y = cvtpk(v[8 * i + 2] * rstd * g0[2], v[8 * i + 3] * rstd * g0[3]);
      w.z = cvtpk(v[8 * i + 4] * rstd * g1[0], v[8 * i + 5] * rstd * g1[1]); w.w = cvtpk(v[8 * i + 6] * rstd * g1[2], v[8 * i + 7] * rstd * g1[3]);
      *(u32x4*)(op + 8 * i) = w; } }
  __syncthreads();
  PROF_END(7, pacc);
}
#undef ATT_WAIT_BAR
#undef ATT_SBAR
}

constexpr int NWAVES = 8;
constexpr int BATCH = 8, SEQ = 4096, D = 1024, T = BATCH * SEQ;
constexpr int IN_COLS = 3080, NQKV = 3072;
constexpr int NEXP = 32, DEXP = 512, NSLOT_MAX = 73728;
constexpr int NPH = 9;
constexpr float C2 = 0.125f * 1.4426950408889634f;
constexpr float LAM_INIT = 0.2f;

constexpr size_t MiB = 1u << 20;
constexpr size_t WS_CTL = 0, CTL_ZERO_BYTES = 256 * 1024;
constexpr size_t WS_WIN = 1 * MiB;
constexpr size_t WS_WO = 7 * MiB;
constexpr size_t WS_WGU = 9 * MiB;
constexpr size_t WS_WD = 73 * MiB;
constexpr size_t WS_WR = 105 * MiB;
constexpr size_t WS_MOD = 106 * MiB;
constexpr size_t WS_CUM = 107 * MiB;
constexpr size_t WS_BLK = 108 * MiB;
constexpr size_t WS_RT = 109 * MiB;
constexpr size_t WS_STOK = 110 * MiB;
constexpr size_t WS_R = 118 * MiB;
constexpr size_t WS_H = WS_R;
constexpr size_t WS_QKV = WS_R + 64 * MiB;
constexpr size_t WS_Y = WS_R;
constexpr size_t WS_HID = WS_R + 144 * MiB;
constexpr size_t WS_H2F8 = WS_R + 184 * MiB;
constexpr size_t WS_X1 = WS_R + 256 * MiB;
constexpr size_t WS_END = WS_X1 + 64 * MiB;
constexpr int CW_BAR = 4096;
constexpr int CW_KM = 32768;
constexpr int CW_QH = 36864;
constexpr int CW_CNT = 16384;

constexpr int LDS_BYTES = 155648;
constexpr int MISC_OFF = LDS_BYTES - 256;

#define GAS __attribute__((address_space(1)))
#define LAS __attribute__((address_space(3)))
typedef unsigned short bf16;
typedef unsigned v4u __attribute__((ext_vector_type(4)));
typedef unsigned v2u __attribute__((ext_vector_type(2)));
typedef float f32x4 __attribute__((ext_vector_type(4)));
typedef GAS unsigned gu32;
#define RLX_AGENT __ATOMIC_RELAXED, __HIP_MEMORY_SCOPE_AGENT
#define LDS_WAIT() asm volatile("s_waitcnt lgkmcnt(0)" ::: "memory")
#define VM_WAIT() asm volatile("s_waitcnt vmcnt(0)" ::: "memory")
__device__ __forceinline__ unsigned f2bf(float f) { unsigned u = __builtin_bit_cast(unsigned, f); return (u + 0x7fffu + ((u >> 16) & 1u)) >> 16; }
__device__ __forceinline__ unsigned pk2(float lo, float hi) { return f2bf(lo) | (f2bf(hi) << 16); }
__device__ __forceinline__ float bflo(unsigned w) { return __builtin_bit_cast(float, w << 16); }
__device__ __forceinline__ float bfhi(unsigned w) { return __builtin_bit_cast(float, w & 0xffff0000u); }
__device__ __forceinline__ float wave_sum(float v) {
#ifdef OLD_WSUM
#pragma unroll
    for (int o = 1; o < 64; o <<= 1) v += __shfl_xor(v, o);
    return v;
#else
    v += lx_get<1>(v); v += lx_get<2>(v); v += lx_get<4>(v); v += lx_get<8>(v); v += lx_get<16>(v);
    return lx_sum32(v);
#endif
}
#define XB_TMO      128
#define XB_XCNT(j)  (256  + 64 * (j))
#define XB_XSUB(j)  (1280 + 64 * (j))
#define XB_XGEN(j)  (2304 + 64 * (j))
#define XB_TOP      3328
#define XB_TOPGEN   3392
#define XCD_BAR_WORDS 3456
#define XB_SPIN_CAP (1u << 18)

__device__ __forceinline__ unsigned xb_ld(unsigned* p)              { return __hip_atomic_load(p, __ATOMIC_RELAXED, __HIP_MEMORY_SCOPE_AGENT); }
__device__ __forceinline__ unsigned xb_add(unsigned* p, unsigned v) { return __hip_atomic_fetch_add(p, v, __ATOMIC_RELAXED, __HIP_MEMORY_SCOPE_AGENT); }
__device__ __forceinline__ unsigned xb_xcc_id() { return (unsigned)__builtin_amdgcn_s_getreg((3 << 11) | 20) & 0xFu; }
#define XB_SPIN(cond, bar) do { unsigned _sp = 0; while (cond) { __builtin_amdgcn_s_sleep(1); \
    if ((++_sp & 255u) == 0u) { if (xb_ld(&(bar)[XB_TMO])) break; if (_sp > XB_SPIN_CAP) { atomicAdd(&(bar)[XB_TMO], 1u); break; } } } } while (0)

struct XcdBarrier {
    int wave;
    unsigned* bar; unsigned x;
    volatile LAS unsigned* st;
};

__device__ __forceinline__ XcdBarrier xcd_barrier_post(unsigned* bar, volatile LAS unsigned* st) {
    XcdBarrier b; b.bar = bar; b.x = xb_xcc_id(); b.st = st;
    if (threadIdx.x == 0) (void)xb_add(&bar[XB_XCNT(b.x)], 1u);
    return b;
}
__device__ __forceinline__ void xcd_barrier_complete(unsigned* bar, unsigned x, unsigned& nloc, unsigned& nx) {
    const unsigned G = gridDim.x * gridDim.y * gridDim.z;
    unsigned sum, cnt, mine, sp = 0u;
    for (;;) {
        sum = 0u; cnt = 0u; mine = 0u;
#pragma unroll
        for (unsigned j = 0; j < 16; ++j) { const unsigned c = xb_ld(&bar[XB_XCNT(j)]); sum += c; cnt += (c > 0u) ? 1u : 0u; mine = (j == x) ? c : mine; }
        if (sum == G) break;
        __builtin_amdgcn_s_sleep(1);
        if ((++sp & 255u) == 0u) { if (xb_ld(&bar[XB_TMO])) break; if (sp > XB_SPIN_CAP) { atomicAdd(&bar[XB_TMO], 1u); break; } }
    }
    nloc = mine > 0u ? mine : 1u; nx = cnt > 0u ? cnt : 1u;
}

__device__ __forceinline__ void xcd_barrier(const XcdBarrier& b) {
    asm volatile("s_waitcnt vmcnt(0)" ::: "memory");
    __syncthreads();
    if (b.wave == 0 && fresh_lane() == 0) {
        unsigned* bar = b.bar;
        __builtin_amdgcn_s_waitcnt(0);
        unsigned nloc = b.st[0], nx = b.st[1];
        if (nloc == 0u) { xcd_barrier_complete(bar, b.x, nloc, nx); b.st[0] = nloc; b.st[1] = nx; }
        const unsigned old = xb_add(&bar[XB_XSUB(b.x)], 1u);
        const unsigned gen = old / nloc;
        if (old + 1u == (gen + 1u) * nloc) {
            __builtin_amdgcn_fence(__ATOMIC_RELEASE, "agent");
            asm volatile("s_waitcnt vmcnt(0)" ::: "memory");
            const unsigned og = xb_add(&bar[XB_TOP], 1u);
            const unsigned tg = og / nx;
            if (og + 1u == (tg + 1u) * nx) xb_add(&bar[XB_TOPGEN], 1u);
            else XB_SPIN(xb_ld(&bar[XB_TOPGEN]) == tg, bar);
            __builtin_amdgcn_fence(__ATOMIC_ACQUIRE, "agent");
            asm volatile("s_waitcnt vmcnt(0)" ::: "memory");
        } else {
            XB_SPIN(xb_ld(&bar[XB_TOPGEN]) == gen, bar);
            __builtin_amdgcn_fence(__ATOMIC_ACQUIRE, "agent");
            asm volatile("s_waitcnt vmcnt(0)" ::: "memory");
        }
    }
    __syncthreads();
}

template <bool F8OUT = false>
__device__ __forceinline__ void tr_item(const float* __restrict__ src, int ldS, bf16* __restrict__ dst, int ldD, float scale, LAS float* scr, int lane) {
    f32x4 v[8];
#pragma unroll
    for (int t = 0; t < 8; ++t) { const int idx = lane + 64 * t; v[t] = *(const f32x4*)(src + (size_t)(idx >> 3) * ldS + 4 * (idx & 7)); }
#pragma unroll
    for (int t = 0; t < 8; ++t) { const int idx = lane + 64 * t; LAS float* p = scr + (idx >> 3) * 33 + 4 * (idx & 7); p[0] = v[t].x; p[1] = v[t].y; p[2] = v[t].z; p[3] = v[t].w; }
    LDS_WAIT(); asm volatile("" ::: "memory");
    const int c = lane & 7;
#pragma unroll
    for (int j = 0; j < 4; ++j) { const int n = (lane >> 3) + 8 * j; const LAS float* s = scr + (8 * c) * 33 + n;
        if constexpr (F8OUT) {
            int t0 = 0, t1 = 0;
            t0 = __builtin_amdgcn_cvt_pk_fp8_f32(s[0 * 33] * scale, s[1 * 33] * scale, t0, false); t0 = __builtin_amdgcn_cvt_pk_fp8_f32(s[2 * 33] * scale, s[3 * 33] * scale, t0, true);
            t1 = __builtin_amdgcn_cvt_pk_fp8_f32(s[4 * 33] * scale, s[5 * 33] * scale, t1, false); t1 = __builtin_amdgcn_cvt_pk_fp8_f32(s[6 * 33] * scale, s[7 * 33] * scale, t1, true);
            v2u o; o.x = (unsigned)t0; o.y = (unsigned)t1; *(v2u*)((unsigned char*)dst + (size_t)n * ldD + 8 * c) = o;
        } else {
        v4u o; o.x = pk2(s[0 * 33] * scale, s[1 * 33] * scale); o.y = pk2(s[2 * 33] * scale, s[3 * 33] * scale); o.z = pk2(s[4 * 33] * scale, s[5 * 33] * scale); o.w = pk2(s[6 * 33] * scale, s[7 * 33] * scale);
        *(v4u*)(dst + (size_t)n * ldD + 8 * c) = o; } }
    LDS_WAIT(); asm volatile("" ::: "memory");
}
constexpr int XI_GU = 32 * 16 * 32, XI_D = 32 * 8 * 32, XI_PER_UNIT = 48, X_UNITS = (XI_GU + XI_D) / XI_PER_UNIT;
__device__ __forceinline__ void expert_item(const float* __restrict__ w_gate, const float* __restrict__ w_up, const float* __restrict__ w_down, bf16* __restrict__ Wt_gu, bf16* __restrict__ Wt_d, int r, LAS float* scr, int lane) {
    if (r < XI_GU) { const int e = r / 512, q = r % 512, kb = q / 32, nb = q % 32, n0 = 32 * nb, pn = n0 >> 8, bj = (n0 >> 7) & 1, j0 = n0 & 127;
        const float* src = (bj ? w_up : w_gate) + (size_t)e * 1024 * 512 + (size_t)(64 * kb) * 512 + 128 * pn + j0;
        tr_item<true>(src, 512, (bf16*)((unsigned char*)Wt_gu + ((size_t)e * 1024 + n0) * 1024 + 64 * kb), 1024, 32.0f, scr, lane); }
    else { r -= XI_GU; const int e = r / 256, q = r % 256, kb = q / 32, nb = q % 32;
        tr_item<true>(w_down + (size_t)e * 512 * 1024 + (size_t)(64 * kb) * 1024 + 32 * nb, 1024, (bf16*)((unsigned char*)Wt_d + ((size_t)e * 1024 + 32 * nb) * 512 + 64 * kb), 512, 32.0f, scr, lane); }
}
struct P0Args { const float *c, *ada_w, *ada_b, *w_in, *w_o, *w_rg, *w_re, *w_gate, *w_up, *w_down; bf16 *Wt_in, *Wt_o, *Wt_gu, *Wt_d; float *Wr, *mod; };
__device__ __forceinline__ void p0_prologue(const P0Args& a, LAS unsigned char* lds, int vcu, int G, int tid, int wave, int lane) {
    LAS float* scr = (LAS float*)(lds + wave * 8448);
    const int gw = vcu * NWAVES + wave, NGW = G * NWAVES;
    constexpr int I_IN = 16 * 96, I_O = 16 * 32, I_GU = 32 * 16 * 32, I_D = 32 * 8 * 32;
    constexpr int NITEMS = I_IN + I_O;
    for (int it = gw; it < NITEMS; it += NGW) {
        int r = it;
        if (r < I_IN) { const int kb = r / 96, nb = r % 96, n0 = 32 * nb, sc = n0 < 1536 ? n0 : n0 + 8;
            const float scale = (n0 < 512 || (n0 >= 1536 && n0 < 2048)) ? C2 : 1.0f;
            tr_item(a.w_in + (size_t)(64 * kb) * IN_COLS + sc, IN_COLS, a.Wt_in + (size_t)n0 * 1024 + 64 * kb, 1024, scale, scr, lane); continue; }
        r -= I_IN;
        { const int kb = r / 32, nb = r % 32;
            tr_item(a.w_o + (size_t)(64 * kb) * 1024 + 32 * nb, 1024, a.Wt_o + (size_t)(32 * nb) * 1024 + 64 * kb, 1024, 1.0f, scr, lane); }
    }
    for (int t = (vcu * NWAVES * 64 + tid); t < 32 * 3 * 2 * 64; t += G * NWAVES * 64) { const int l = t & 63, part = (t >> 6) & 1, ic = t >> 7, c = ic % 3, i = ic / 3, n = 16 * c + (l & 15), k0 = 32 * i + 8 * (l >> 4);
        unsigned short o[8];
#pragma unroll
        for (int j = 0; j < 8; ++j) { const int k = k0 + j; const float w = n < 32 ? a.w_re[k * 32 + n] : (n < 36 ? a.w_rg[k * 4 + (n - 32)] : 0.f);
            const unsigned hi = f2bf(w); const float lo = w - __builtin_bit_cast(float, hi << 16); o[j] = (unsigned short)(part ? f2bf(lo) : hi); }
        v4u pk; pk.x = o[0] | ((unsigned)o[1] << 16); pk.y = o[2] | ((unsigned)o[3] << 16); pk.z = o[4] | ((unsigned)o[5] << 16); pk.w = o[6] | ((unsigned)o[7] << 16);
        *(v4u*)((bf16*)a.Wr + (size_t)t * 8) = pk; }
    for (int t = (vcu * NWAVES * 64 + tid); t < 32 * 2 * 64; t += G * NWAVES * 64) { const int l = t & 63, part = (t >> 6) & 1, i = t >> 7, n = l & 15, k0 = 32 * i + 8 * (l >> 4);
        unsigned short o[8];
#pragma unroll
        for (int j = 0; j < 8; ++j) { const float w = n < 8 ? a.w_in[(size_t)(k0 + j) * IN_COLS + 1536 + n] : 0.f;
            const unsigned hi = f2bf(w); const float lo = w - __builtin_bit_cast(float, hi << 16); o[j] = (unsigned short)(part ? f2bf(lo) : hi); }
        v4u pk; pk.x = o[0] | ((unsigned)o[1] << 16); pk.y = o[2] | ((unsigned)o[3] << 16); pk.z = o[4] | ((unsigned)o[5] << 16); pk.w = o[6] | ((unsigned)o[7] << 16);
        *(v4u*)((bf16*)a.Wr + 131072 + (size_t)t * 8) = pk; }
    __syncthreads();
    LAS float* cs = (LAS float*)(lds + 69632);
    LAS float* red = (LAS float*)(lds + 69632 + 32768);
    for (int i = tid; i < 8192; i += NWAVES * 64) cs[i] = a.c[i];
    __syncthreads();
    for (int ch = vcu; ch < 256; ch += G) {
        const int col = lane % 24, half = lane / 24;
        float acc[8];
#pragma unroll
        for (int b = 0; b < 8; ++b) acc[b] = 0.f;
        if (lane < 48) {
            const int kb = wave * 128 + half * 64;
            const float* wp = a.ada_w + (size_t)kb * 6144 + ch * 24 + col;
#pragma unroll
            for (int k = 0; k < 64; ++k) { const float wv = wp[(size_t)k * 6144];
#pragma unroll
                for (int b = 0; b < 8; ++b) acc[b] = fmaf(cs[b * 1024 + kb + k], wv, acc[b]); }
#pragma unroll
            for (int b = 0; b < 8; ++b) red[((wave * 2 + half) * 8 + b) * 24 + col] = acc[b];
        }
        __syncthreads();
        if (tid < 192) { const int b = tid / 24, cl = tid % 24; float s = a.ada_b[ch * 24 + cl];
#pragma unroll
          for (int w = 0; w < 16; ++w) s += red[(w * 8 + b) * 24 + cl];
          a.mod[b * 6144 + ch * 24 + cl] = s; }
        __syncthreads();
    }
}

typedef short p5_bf16x8 __attribute__((ext_vector_type(8)));
__device__ __forceinline__ void p1_norm(const float* __restrict__ x, const float* __restrict__ g1, const float* __restrict__ mod, const bf16* __restrict__ WfzF, const float* __restrict__ b_f,
                                        bf16* __restrict__ H, float* __restrict__ cumloc, float* __restrict__ blktot, LAS unsigned char* lds, int vcu, int G, int tid, int wave, int lane) {
    LAS float* lf = (LAS float*)(lds + 65536); LAS float* segtot = (LAS float*)(lds + 69632);
    for (int i = tid; i < 4096; i += NWAVES * 64) ((LAS v4u*)lds)[i] = ((const v4u*)WfzF)[i];
    __syncthreads();
    for (int rb = vcu; rb < T / 128; rb += G) {
        const int b = rb >> 5;
        { f32x4 A[4], Bc[4];
#pragma unroll
          for (int j = 0; j < 4; ++j) { const int col = 256 * j + 4 * lane; const f32x4 g = *(const f32x4*)(g1 + col), sc = *(const f32x4*)(mod + b * 6144 + 1024 + col);
            A[j] = g * (1.0f + sc); Bc[j] = *(const f32x4*)(mod + b * 6144 + col); }
          f32x4 XB[3][4];
          const int row0 = rb * 128 + wave * 16;
#define P1_ISS(i) { const f32x4* xr = (const f32x4*)(x + (size_t)(row0 + (i)) * D) + lane; _Pragma("unroll") for (int j = 0; j < 4; ++j) XB[(i) % 3][j] = xr[64 * j]; }
#pragma unroll
          for (int rr = 0; rr < 16; ++rr) {
            if (rr == 0) { P1_ISS(0) P1_ISS(1) P1_ISS(2) __builtin_amdgcn_sched_barrier(0); }
            float s = 0.f;
#pragma unroll
            for (int j = 0; j < 4; ++j) { const f32x4 v = XB[rr % 3][j]; s += (v.x * v.x + v.y * v.y) + (v.z * v.z + v.w * v.w); }
            const float rstd = 1.0f / sqrtf(wave_sum(s) * (1.0f / D) + 1e-6f);
            v2u* o8 = (v2u*)(H + (size_t)(row0 + rr) * D) + lane;
#pragma unroll
            for (int j = 0; j < 4; ++j) { const f32x4 h = XB[rr % 3][j] * rstd * A[j] + Bc[j]; v2u w; w.x = pk2(h.x, h.y); w.y = pk2(h.z, h.w); o8[64 * j] = w; }
            __builtin_amdgcn_sched_barrier(0);
            if (rr + 3 < 16) { P1_ISS(rr + 3) __builtin_amdgcn_sched_barrier(0); }
          } }
#undef P1_ISS
        VM_WAIT();
        f32x4 acc = (f32x4){0.f, 0.f, 0.f, 0.f};
        { const bf16* ap = H + (size_t)(rb * 128 + wave * 16 + (lane & 15)) * D + 8 * (lane >> 4);
          const LAS p5_bf16x8* bp = (const LAS p5_bf16x8*)lds + lane;
#pragma unroll 8
          for (int i = 0; i < 32; ++i) {
            const p5_bf16x8 af = *(const p5_bf16x8*)(ap + 32 * i);
            acc = __builtin_amdgcn_mfma_f32_16x16x32_bf16(af, bp[(i * 2 + 0) * 64], acc, 0, 0, 0);
            acc = __builtin_amdgcn_mfma_f32_16x16x32_bf16(af, bp[(i * 2 + 1) * 64], acc, 0, 0, 0); } }
        if ((lane & 15) < 8) { const float bfv = b_f[lane & 15];
#pragma unroll
            for (int r = 0; r < 4; ++r) { const float z = acc[r] + bfv; lf[(wave * 16 + 4 * (lane >> 4) + r) * 8 + (lane & 15)] = fminf(z, 0.f) - log1pf(expf(-fabsf(z))); } }
        __syncthreads();
        float run[16]; const int hh = tid & 7, seg = (tid >> 3) & 7;
        if (tid < 64) { float s = 0.f;
#pragma unroll
            for (int i = 0; i < 16; ++i) { s += lf[(seg * 16 + i) * 8 + hh]; run[i] = s; }
            segtot[seg * 8 + hh] = s; }
        __syncthreads();
        if (tid < 64) { float off = 0.f;
            for (int s2 = 0; s2 < seg; ++s2) off += segtot[s2 * 8 + hh];
            float* cp = cumloc + (size_t)(b * 8 + hh) * SEQ + (rb & 31) * 128 + seg * 16;
            const float NL2E = -1.4426950408889634f;
#pragma unroll
            for (int i = 0; i < 4; ++i) { f32x4 t; t.x = (run[4 * i] + off) * NL2E; t.y = (run[4 * i + 1] + off) * NL2E; t.z = (run[4 * i + 2] + off) * NL2E; t.w = (run[4 * i + 3] + off) * NL2E; *(f32x4*)(cp + 4 * i) = t; }
            if (seg == 7) blktot[rb * 8 + hh] = (run[15] + off) * NL2E; }
        __syncthreads();
    }
}

__device__ __forceinline__ void p5_route(const bf16* __restrict__ x1, const float* __restrict__ g2, const float* __restrict__ mod, const bf16* __restrict__ WrF, const float* __restrict__ b_rg, const float* __restrict__ b_re,
                                         bf16* __restrict__ H2, unsigned char* __restrict__ H2F8, gu32* cnt, int* __restrict__ stok, int* __restrict__ rt_e, int* __restrict__ rt_pos, float* __restrict__ rt_w,
                                         LAS unsigned char* lds, int vcu, int G, int tid, int wave, int lane) {
    LAS unsigned* CNT = (LAS unsigned*)lds; LAS unsigned* BASE = (LAS unsigned*)(lds + 128); LAS unsigned* REC = (LAS unsigned*)(lds + 256); LAS unsigned char* RB = lds + 4352 + wave * 16640;
    LAS float* LG = (LAS float*)RB;
    if (tid < 32) CNT[tid] = 0u;
    __syncthreads();
    for (int rb = vcu; rb < T / 128; rb += G) {
        const int b = rb >> 5;
        v2u KEEP[16][2];
        { f32x4 A[4], Bc[4];
#pragma unroll
          for (int j = 0; j < 4; ++j) { const int col = 256 * j + 4 * lane; const f32x4 g = *(const f32x4*)(g2 + col), sc = *(const f32x4*)(mod + b * 6144 + 4096 + col);
            A[j] = g * (1.0f + sc); Bc[j] = *(const f32x4*)(mod + b * 6144 + 3072 + col); }
          v2u XB[4][4];
          const int row0 = rb * 128 + wave * 16;
#define P5_ISS(i) { const GAS v2u* xr = (const GAS v2u*)(x1 + (size_t)(row0 + (i)) * D) + lane; _Pragma("unroll") for (int j = 0; j < 4; ++j) XB[(i) % 4][j] = xr[64 * j]; }
#pragma unroll
          for (int rr = 0; rr < 16; ++rr) {
            if (rr == 0) { P5_ISS(0) P5_ISS(1) P5_ISS(2) P5_ISS(3) __builtin_amdgcn_sched_barrier(0); }
            f32x4 v[4]; float s = 0.f;
#pragma unroll
            for (int j = 0; j < 4; ++j) { const v2u xw = XB[rr % 4][j]; v[j].x = bflo(xw.x); v[j].y = bfhi(xw.x); v[j].z = bflo(xw.y); v[j].w = bfhi(xw.y); s += (v[j].x * v[j].x + v[j].y * v[j].y) + (v[j].z * v[j].z + v[j].w * v[j].w); }
            const float rstd = 1.0f / sqrtf(wave_sum(s) * (1.0f / D) + 1e-6f);
            GAS unsigned* o4 = (GAS unsigned*)(H2F8 + (size_t)(row0 + rr) * D) + lane;
#pragma unroll
            for (int j = 0; j < 4; ++j) { const f32x4 h = v[j] * rstd * A[j] + Bc[j]; v2u w; w.x = pk2(h.x, h.y); w.y = pk2(h.z, h.w);
                if (j < 2) *(LAS v2u*)(RB + rr * 1040 + (256 * j + 4 * lane) * 2) = w; else KEEP[rr][j - 2] = w;
                int t = 0; t = __builtin_amdgcn_cvt_pk_fp8_f32(h.x, h.y, t, false); t = __builtin_amdgcn_cvt_pk_fp8_f32(h.z, h.w, t, true); o4[64 * j] = (unsigned)t; }
            __builtin_amdgcn_sched_barrier(0);
            if (rr + 4 < 16) { P5_ISS(rr + 4) __builtin_amdgcn_sched_barrier(0); }
          } }
#undef P5_ISS
        f32x4 acc[3];
#pragma unroll
        for (int c = 0; c < 3; ++c) acc[c] = (f32x4){0.f, 0.f, 0.f, 0.f};
        { const LAS unsigned char* ar = RB + (lane & 15) * 1040 + (lane >> 4) * 16;
          const GAS p5_bf16x8* bp = (const GAS p5_bf16x8*)WrF + lane;
#pragma unroll
          for (int hf = 0; hf < 2; ++hf) {
            if (hf == 1) {
#pragma unroll
                for (int rr = 0; rr < 16; ++rr)
#pragma unroll
                    for (int j = 0; j < 2; ++j) *(LAS v2u*)(RB + rr * 1040 + (256 * j + 4 * lane) * 2) = KEEP[rr][j];
            }
            LDS_WAIT();
#pragma unroll 4
            for (int i = 0; i < 16; ++i) {
                const p5_bf16x8 af = *(const LAS p5_bf16x8*)(ar + i * 64);
#pragma unroll
                for (int c = 0; c < 3; ++c) {
                    const p5_bf16x8 bh = bp[(((hf * 16 + i) * 3 + c) * 2 + 0) * 64], bl = bp[(((hf * 16 + i) * 3 + c) * 2 + 1) * 64];
                    acc[c] = __builtin_amdgcn_mfma_f32_16x16x32_bf16(af, bh, acc[c], 0, 0, 0);
                    acc[c] = __builtin_amdgcn_mfma_f32_16x16x32_bf16(af, bl, acc[c], 0, 0, 0); }
            }
          } }
#pragma unroll
        for (int c = 0; c < 3; ++c)
#pragma unroll
            for (int r = 0; r < 4; ++r) LG[(4 * (lane >> 4) + r) * 48 + 16 * c + (lane & 15)] = acc[c][r];
        LDS_WAIT();
        if (lane < 16) {
            const LAS float* L = LG + lane * 48;
            float gl[4];
#pragma unroll
            for (int i = 0; i < 4; ++i) gl[i] = L[32 + i] + b_rg[i];
            int g = 0; float gm = gl[0];
#pragma unroll
            for (int i = 1; i < 4; ++i) if (gl[i] > gm) { gm = gl[i]; g = i; }
            float gs = 0.f;
#pragma unroll
            for (int i = 0; i < 4; ++i) gs += expf(gl[i] - gm);
            const float pg = 1.0f / gs;
            float el[8];
#pragma unroll
            for (int i = 0; i < 8; ++i) el[i] = L[g * 8 + i] + b_re[g * 8 + i];
            int i1 = 0; float m1 = el[0];
#pragma unroll
            for (int i = 1; i < 8; ++i) if (el[i] > m1) { m1 = el[i]; i1 = i; }
            int i2 = -1; float m2 = -3.0e38f;
#pragma unroll
            for (int i = 0; i < 8; ++i) if (i != i1 && el[i] > m2) { m2 = el[i]; i2 = i; }
            const float ex = expf(m2 - m1); const float w1 = pg / (1.0f + ex), w2 = pg * ex / (1.0f + ex);
            const int e1 = g * 8 + i1, e2 = g * 8 + i2, rl = wave * 16 + lane;
            const unsigned p1 = __hip_atomic_fetch_add(&CNT[e1], 1u, __ATOMIC_RELAXED, __HIP_MEMORY_SCOPE_WORKGROUP), p2 = __hip_atomic_fetch_add(&CNT[e2], 1u, __ATOMIC_RELAXED, __HIP_MEMORY_SCOPE_WORKGROUP);
            REC[(rl * 2 + 0) * 4 + 0] = (unsigned)e1; REC[(rl * 2 + 0) * 4 + 1] = p1; REC[(rl * 2 + 0) * 4 + 2] = __float_as_uint(w1);
            REC[(rl * 2 + 1) * 4 + 0] = (unsigned)e2; REC[(rl * 2 + 1) * 4 + 1] = p2; REC[(rl * 2 + 1) * 4 + 2] = __float_as_uint(w2);
        }
        __syncthreads();
        if (tid < 32) BASE[tid] = __hip_atomic_fetch_add(cnt + 64 * tid, CNT[tid], RLX_AGENT);
        __syncthreads();
        if (tid < 256) { const unsigned e = REC[tid * 4 + 0], pl = REC[tid * 4 + 1], wb = REC[tid * 4 + 2]; const unsigned pos = BASE[e] + pl; const int tok = rb * 128 + (tid >> 1);
            stok[(size_t)e * 65536 + pos] = tok; rt_e[tok * 2 + (tid & 1)] = (int)e; rt_pos[tok * 2 + (tid & 1)] = (int)pos; rt_w[tok * 2 + (tid & 1)] = __uint_as_float(wb); }
        __syncthreads();
        if (tid < 32) CNT[tid] = 0u;
        __syncthreads();
    }
}

__device__ __forceinline__ void moe_tables(gu32* cnt, LAS int* TB, LAS int* CN, int tid) {
    if (tid < 64) {
        const int e = tid & 31; const int c = (int)__hip_atomic_load(cnt + 64 * e, RLX_AGENT); const int nt = (c + 255) >> 8; int v = nt;
#pragma unroll
        for (int off = 1; off < 32; off <<= 1) { const int t = __builtin_amdgcn_ds_bpermute(((tid - off) & 63) << 2, v); v += (e >= off) ? t : 0; }
        if (tid < 32) { CN[e] = c; TB[e] = v - nt; if (e == 31) TB[32] = v; } }
    __syncthreads();
}
struct MoeOrder {
    const LAS int* TB; const LAS int* CN; const int* stok; int G, c; bool gather;
    __device__ __forceinline__ bool next(int i, pg8::Unit& u) const {
        const int L = i * G + c; if (L >= 4 * TB[32]) return false;
        const int gt = L >> 2, ct = L & 3; int e = 0;
        for (int k = 1; k < 32; ++k) e += (gt >= TB[k]) ? 1 : 0;
        u.pm = gt; u.pn = e * 4 + ct; u.e = e; return true;
    }
    __device__ __forceinline__ void a_off(const pg8::Unit& u, const int (&RA)[2], const int (&CA)[2], int KB  , unsigned (&off)[2][2]) const {
        if (gather) {
            const int p0 = (u.pm - TB[u.e]) * 256, n = CN[u.e];
#pragma unroll
            for (int h = 0; h < 2; ++h)
#pragma unroll
                for (int i = 0; i < 2; ++i) { const int pos = p0 + h * 128 + RA[i]; const int tok = pos < n ? stok[(size_t)u.e * 65536 + pos] : 0;
                    off[h][i] = (unsigned)((size_t)tok * KB + CA[i] * 2); }
            __builtin_amdgcn_s_waitcnt(0x0F70);
        } else {
#pragma unroll
            for (int h = 0; h < 2; ++h)
#pragma unroll
                for (int i = 0; i < 2; ++i) off[h][i] = (unsigned)((size_t)(u.pm * 256 + h * 128 + RA[i]) * KB + CA[i] * 2);
        }
    }
};

__device__ __forceinline__ void p8_final(const bf16* __restrict__ x1, float* __restrict__ xo, const bf16* __restrict__ Y, const float* __restrict__ mod, const float* __restrict__ gf,
                                         const int* __restrict__ rt_e, const int* __restrict__ rt_pos, const float* __restrict__ rt_w, const LAS int* TB,
                                         int vcu, int G, int wave, int lane) {
    const int gw = vcu * NWAVES + wave, NGW = G * NWAVES;
    f32x4 gfv[4];
#pragma unroll
    for (int j = 0; j < 4; ++j) gfv[j] = *(const f32x4*)(gf + 256 * j + 4 * lane);
    if (NGW == 2048) {
        int s0v, s1v; float w0v, w1v;
        { const int r = gw + (lane & 15) * 2048; const int e0 = rt_e[r * 2], e1 = rt_e[r * 2 + 1];
          s0v = TB[e0] * 256 + rt_pos[r * 2]; s1v = TB[e1] * 256 + rt_pos[r * 2 + 1]; w0v = 0.125f * rt_w[r * 2]; w1v = 0.125f * rt_w[r * 2 + 1]; }
        v2u XB[3][4]; unsigned YA[3][4], YC[3][4]; f32x4 g2v[4];
#define P8_ISS(i) { const int s0 = __builtin_amdgcn_readlane(s0v, (i)), s1 = __builtin_amdgcn_readlane(s1v, (i)); const v2u* x1r = (const v2u*)(x1 + (size_t)(gw + (i) * 2048) * D) + lane; \
            const unsigned* y0 = (const unsigned*)((const unsigned char*)Y + (size_t)s0 * D) + lane; const unsigned* y1 = (const unsigned*)((const unsigned char*)Y + (size_t)s1 * D) + lane; \
            _Pragma("unroll") for (int j = 0; j < 4; ++j) { XB[(i) % 3][j] = x1r[64 * j]; YA[(i) % 3][j] = y0[64 * j]; YC[(i) % 3][j] = y1[64 * j]; } }
#pragma unroll
        for (int i = 0; i < 16; ++i) {
            if (i == 0) { P8_ISS(0) P8_ISS(1) P8_ISS(2) __builtin_amdgcn_sched_barrier(0); }
            if ((i & 1) == 0) {
#pragma unroll
                for (int j = 0; j < 4; ++j) g2v[j] = *(const f32x4*)(mod + (i >> 1) * 6144 + 5120 + 256 * j + 4 * lane); }
            const float w0 = __uint_as_float((unsigned)__builtin_amdgcn_readlane((int)__float_as_uint(w0v), i)), w1 = __uint_as_float((unsigned)__builtin_amdgcn_readlane((int)__float_as_uint(w1v), i));
            f32x4* xr = (f32x4*)(xo + (size_t)(gw + i * 2048) * D) + lane;
            f32x4 v[4]; float s = 0.f;
#pragma unroll
            for (int j = 0; j < 4; ++j) { const v2u xw = XB[i % 3][j]; f32x4 xv; xv.x = bflo(xw.x); xv.y = bfhi(xw.x); xv.z = bflo(xw.y); xv.w = bfhi(xw.y); const unsigned a = YA[i % 3][j], c = YC[i % 3][j];
                const auto a01 = __builtin_amdgcn_cvt_pk_f32_fp8(a, false), a23 = __builtin_amdgcn_cvt_pk_f32_fp8(a, true), c01 = __builtin_amdgcn_cvt_pk_f32_fp8(c, false), c23 = __builtin_amdgcn_cvt_pk_f32_fp8(c, true);
                f32x4 y; y.x = w0 * a01[0] + w1 * c01[0]; y.y = w0 * a01[1] + w1 * c01[1]; y.z = w0 * a23[0] + w1 * c23[0]; y.w = w0 * a23[1] + w1 * c23[1];
                v[j] = xv + g2v[j] * y; s += (v[j].x * v[j].x + v[j].y * v[j].y) + (v[j].z * v[j].z + v[j].w * v[j].w); }
            const float rstd = 1.0f / sqrtf(wave_sum(s) * (1.0f / D) + 1e-6f);
#pragma unroll
            for (int j = 0; j < 4; ++j) xr[64 * j] = v[j] * rstd * gfv[j];
            __builtin_amdgcn_sched_barrier(0);
            if (i + 3 < 16) { P8_ISS(i + 3) __builtin_amdgcn_sched_barrier(0); }
        }
#undef P8_ISS
        return;
    }
#pragma unroll 2
    for (int row = gw; row < T; row += NGW) {
        const int b = row >> 12;
        const int e0 = rt_e[row * 2], e1 = rt_e[row * 2 + 1]; const int s0 = TB[e0] * 256 + rt_pos[row * 2], s1 = TB[e1] * 256 + rt_pos[row * 2 + 1];
        const float w0 = 0.125f * rt_w[row * 2], w1 = 0.125f * rt_w[row * 2 + 1];
        f32x4* xr = (f32x4*)(xo + (size_t)row * D) + lane; const v2u* x1r = (const v2u*)(x1 + (size_t)row * D) + lane;
        const unsigned* y0 = (const unsigned*)((const unsigned char*)Y + (size_t)s0 * D) + lane; const unsigned* y1 = (const unsigned*)((const unsigned char*)Y + (size_t)s1 * D) + lane;
        f32x4 v[4]; float s = 0.f;
#pragma unroll
        for (int j = 0; j < 4; ++j) { const v2u xw = x1r[64 * j]; f32x4 xv; xv.x = bflo(xw.x); xv.y = bfhi(xw.x); xv.z = bflo(xw.y); xv.w = bfhi(xw.y); const unsigned a = y0[64 * j], c = y1[64 * j]; const f32x4 g2 = *(const f32x4*)(mod + b * 6144 + 5120 + 256 * j + 4 * lane);
            const auto a01 = __builtin_amdgcn_cvt_pk_f32_fp8(a, false), a23 = __builtin_amdgcn_cvt_pk_f32_fp8(a, true), c01 = __builtin_amdgcn_cvt_pk_f32_fp8(c, false), c23 = __builtin_amdgcn_cvt_pk_f32_fp8(c, true);
            f32x4 y; y.x = w0 * a01[0] + w1 * c01[0]; y.y = w0 * a01[1] + w1 * c01[1]; y.z = w0 * a23[0] + w1 * c23[0]; y.w = w0 * a23[1] + w1 * c23[1];
            v[j] = xv + g2 * y; s += (v[j].x * v[j].x + v[j].y * v[j].y) + (v[j].z * v[j].z + v[j].w * v[j].w); }
        const float rstd = 1.0f / sqrtf(wave_sum(s) * (1.0f / D) + 1e-6f);
#pragma unroll
        for (int j = 0; j < 4; ++j) xr[64 * j] = v[j] * rstd * gfv[j];
    }
}

constexpr int ATT_NU = 256;
__device__ const unsigned short ATT_ORDER[256] = {127, 126, 125, 512, 124, 123, 122, 513, 121, 120, 119, 514, 118, 85, 86, 515, 87, 88, 89, 516, 90, 91, 92, 517, 93, 94, 95, 518, 117, 84, 116, 519, 83, 115, 259, 520, 260, 261, 262, 521, 263, 291, 292, 522, 293, 294, 295, 523, 323, 324, 325, 524, 326, 327, 355, 525, 356, 357, 358, 526, 359, 387, 388, 527, 389, 390, 391, 528, 419, 420, 421, 529, 422, 423, 451, 530, 452, 453, 454, 531, 455, 483, 484, 532, 485, 486, 487, 533, 82, 114, 81, 534, 113, 80, 112, 535, 79, 111, 258, 536, 290, 322, 354, 537, 386, 418, 450, 538, 482, 78, 110, 539, 77, 109, 76, 540, 108, 75, 107, 541, 74, 106, 73, 542, 105, 257, 289, 543, 321, 353, 385, 544, 417, 449, 481, 545, 72, 104, 71, 546, 103, 38, 39, 547, 40, 41, 42, 548, 43, 44, 45, 549, 46, 47, 48, 550, 49, 50, 51, 551, 52, 53, 54, 552, 55, 56, 57, 553, 58, 59, 60, 554, 61, 62, 63, 555, 70, 102, 37, 556, 69, 101, 36, 557, 68, 100, 256, 558, 288, 320, 352, 559, 384, 416, 448, 560, 480, 35, 67, 561, 99, 34, 66, 562, 98, 2, 3, 563, 4, 5, 6, 564, 7, 8, 9, 565, 10, 11, 12, 566, 13, 14, 15, 567, 16, 17, 18, 568, 19, 20, 21, 569, 22, 23, 24, 570, 25, 26, 27, 571, 28, 29, 30, 572, 31, 1, 33, 573, 65, 97, 0, 574, 32, 64, 96, 575};
struct Args { const float* in[22]; float* out; unsigned char* ws; int ph_lo, ph_hi; };
typedef __attribute__((address_space(4))) const unsigned long long cu64;
__device__ __forceinline__ cu64* karg() { cu64* p = (cu64*)__builtin_amdgcn_kernarg_segment_ptr(); asm volatile("" : "+s"(p)); return p; }
#define KA_IN(ka, i) ((const float*)(ka)[i])
#define KA_OUT(ka) ((float*)(ka)[22])
#define KA_WS(ka) ((unsigned char*)(ka)[23])
__global__ void __launch_bounds__(NWAVES * 64, 2) fwd_kernel(Args args) {
    extern __shared__ __attribute__((aligned(16))) unsigned char lds_raw[];
    LAS unsigned char* lds = (LAS unsigned char*)lds_raw;
    volatile LAS unsigned* MISC = (volatile LAS unsigned*)(lds + MISC_OFF);
    const int wave = __builtin_amdgcn_readfirstlane((int)threadIdx.x >> 6);
    const int G = gridDim.x; const int bx = blockIdx.x; const int vcu = (G % 8 == 0) ? (bx % 8) * (G / 8) + bx / 8 : bx;
    if (wave == 0) MISC[fresh_lane()] = 0u;
    __syncthreads();
    XcdBarrier bar = xcd_barrier_post((unsigned*)((gu32*)(args.ws + WS_CTL) + CW_BAR), MISC + 8); bar.wave = wave;
    const int lo = args.ph_lo, hi = args.ph_hi;
    unsigned long long prof_acc = 0;
#ifndef PHASE_MASK
#define PHASE_MASK 0x1ff
#endif
#define IN(k) ((((PHASE_MASK) >> (k)) & 1) && lo <= (k) && (k) < hi)
#define SEAM(k) do { if (IN(k) && IN((k) + 1)) { unsigned long long t0_ = 0; if (PROF_ID == 30 + (k)) t0_ = __builtin_amdgcn_s_memrealtime(); xcd_barrier(bar); if (PROF_ID == 30 + (k)) prof_acc += __builtin_amdgcn_s_memrealtime() - t0_; } } while (0)
#define PH_T0(k) unsigned long long pht0_##k = 0; if (PROF_ID == 20 + (k)) pht0_##k = __builtin_amdgcn_s_memrealtime()
#define PH_T1(k) do { if (PROF_ID == 20 + (k)) prof_acc += __builtin_amdgcn_s_memrealtime() - pht0_##k; } while (0)
#ifndef PROBE_PHASE
#define PROBE_PHASE -1
#endif
#define REP(k) _Pragma("unroll 1") for (int rep_ = 0; rep_ < ((PROBE_PHASE) == (k) ? 2 : 1); ++rep_)

    PH_T0(0);
    if (IN(0)) REP(0) {
        cu64* ka = karg(); unsigned char* ws = KA_WS(ka);
        P0Args a{KA_IN(ka, 1), KA_IN(ka, 2), KA_IN(ka, 3), KA_IN(ka, 5), KA_IN(ka, 12), KA_IN(ka, 14), KA_IN(ka, 16), KA_IN(ka, 18), KA_IN(ka, 19), KA_IN(ka, 20),
                 (bf16*)(ws + WS_WIN), (bf16*)(ws + WS_WO), (bf16*)(ws + WS_WGU), (bf16*)(ws + WS_WD), (float*)(ws + WS_WR), (float*)(ws + WS_MOD)};
        const int lane = fresh_lane(), tid = wave * 64 + lane; p0_prologue(a, lds, vcu, G, tid, wave, lane);
    }
    PH_T1(0);
    SEAM(0);
    PH_T0(1);
    if (IN(1)) REP(1) { cu64* ka = karg(); unsigned char* ws = KA_WS(ka); const int lane = fresh_lane(), tid = wave * 64 + lane;
        p1_norm(KA_IN(ka, 0), KA_IN(ka, 4), (const float*)(ws + WS_MOD), (const bf16*)(ws + WS_WR) + 131072, KA_IN(ka, 6), (bf16*)(ws + WS_H), (float*)(ws + WS_CUM), (float*)(ws + WS_BLK), lds, vcu, G, tid, wave, lane); }
    PH_T1(1);
    SEAM(1);
#define P2BODY { cu64* ka = karg(); unsigned char* ws = KA_WS(ka); pg8::Gemm g{(const bf16*)(ws + WS_H), (const bf16*)(ws + WS_WIN), T, NQKV, D}; pg8::StaticOrder S; S.init(T, NQKV, G, bx); \
        pg8::EpiStore E{(bf16*)(ws + WS_QKV), NQKV, 0xffff, (unsigned*)(ws + WS_CTL) + CW_KM}; \
        pg8::gemm_phase<pg8::EpiStore, pg8::StaticOrder, true, true>(lds, g, S, E, wave); }
    PH_T0(2);
    if (IN(2)) { P2BODY if (PROBE_PHASE == 2) P2BODY }
    PH_T1(2);
    SEAM(2);
    PH_T0(3);
    if (IN(3)) REP(3) {
        float lam;
        { cu64* ka = karg(); const float* lq1 = KA_IN(ka, 7); const float* lk1 = KA_IN(ka, 8); const float* lq2 = KA_IN(ka, 9); const float* lk2 = KA_IN(ka, 10);
          const int lane = fresh_lane(); const float a = wave_sum(lq1[lane] * lk1[lane]), b2 = wave_sum(lq2[lane] * lk2[lane]); lam = expf(a) - expf(b2) + LAM_INIT; }
        volatile LAS int* QSLOT = (volatile LAS int*)(lds + MISC_OFF + 64);
        const int xq0 = (G >= 8) ? (vcu * 8) / G : 0;
#pragma unroll 1
        for (int qi = 0; qi < 8; ++qi) {
            const int xq = (xq0 + qi) & 7;
#pragma unroll 1
            for (;;) {
                cu64* ka = karg(); unsigned char* ws = KA_WS(ka);
                if (wave == 0 && fresh_lane() == 0) QSLOT[0] = (int)__hip_atomic_fetch_add((gu32*)(ws + WS_CTL) + CW_QH + 64 * xq, 1u, RLX_AGENT);
                __syncthreads();
                const int idx = __builtin_amdgcn_readfirstlane(QSLOT[0]);
                __syncthreads();
                if (idx >= ATT_NU) break;
                const int u = ATT_ORDER[idx], h = (u >> 5) & 7, qb = u & 31;
                if ((u >> 8) == 2) {
                    LAS float* scr = (LAS float*)(lds + wave * 8448); const int lane_ = fresh_lane(); const int it0 = (xq * 64 + (u & 255)) * XI_PER_UNIT + wave * 6;
#pragma unroll 1
                    for (int k = 0; k < 6; ++k) expert_item(KA_IN(ka, 18), KA_IN(ka, 19), KA_IN(ka, 20), (bf16*)(ws + WS_WGU), (bf16*)(ws + WS_WD), it0 + k, scr, lane_);
                    __syncthreads();
                } else
                if ((u >> 8) == 0) { PROF_BEGIN(1); att::diff_unit(lds, (const bf16*)(ws + WS_QKV), (bf16*)(ws + WS_H), KA_IN(ka, 11), lam, (const unsigned*)(ws + WS_CTL) + CW_KM, xq, h, qb, wave, prof_acc); PROF_END(1, prof_acc); }
                else { PROF_BEGIN(2); att::fox2_unit(lds, (const bf16*)(ws + WS_QKV), (bf16*)(ws + WS_H), (const float*)(ws + WS_CUM), (const float*)(ws + WS_BLK), (const unsigned*)(ws + WS_CTL) + CW_KM, xq, h, qb, wave, prof_acc); PROF_END(2, prof_acc); }
            }
        }
    }
    PH_T1(3);
    SEAM(3);
#define P4BODY { cu64* ka = karg(); unsigned char* ws = KA_WS(ka); pg8::Gemm g{(const bf16*)(ws + WS_H), (const bf16*)(ws + WS_WO), T, D, D}; pg8::StaticOrder S; S.init(T, D, G, bx); \
        pg8::EpiResid E{KA_IN(ka, 0), (bf16*)(ws + WS_X1), (const float*)(ws + WS_MOD) + 2048}; \
        pg8::gemm_phase<pg8::EpiResid, pg8::StaticOrder, true, true>(lds, g, S, E, wave); }
    PH_T0(4);
    if (IN(4)) { P4BODY if (PROBE_PHASE == 4) P4BODY }
    PH_T1(4);
    SEAM(4);
    PH_T0(5);
    if (IN(5)) { cu64* ka = karg(); unsigned char* ws = KA_WS(ka); int* rt_e = (int*)(ws + WS_RT); const int lane = fresh_lane(), tid = wave * 64 + lane;
        p5_route((const bf16*)(ws + WS_X1), KA_IN(ka, 13), (const float*)(ws + WS_MOD), (const bf16*)(ws + WS_WR), KA_IN(ka, 15), KA_IN(ka, 17), (bf16*)(ws + WS_H), ws + WS_H2F8, (gu32*)(ws + WS_CTL) + CW_CNT, (int*)(ws + WS_STOK),
                 rt_e, rt_e + 2 * T, (float*)(rt_e + 4 * T), lds, vcu, G, tid, wave, lane); }
    PH_T1(5);
    SEAM(5);
    LAS int* TB = (LAS int*)(lds + 131072); LAS int* CN = (LAS int*)(lds + 131072 + 256);
#define P6BODY { cu64* ka = karg(); unsigned char* ws = KA_WS(ka); moe_tables((gu32*)(ws + WS_CTL) + CW_CNT, TB, CN, wave * 64 + fresh_lane()); pg8::Gemm g{(const bf16*)(ws + WS_H2F8), (const bf16*)(ws + WS_WGU), T, 1024, D}; \
        MoeOrder S{TB, CN, (const int*)(ws + WS_STOK), G, bx, true}; pg8::EpiSwigluF8 E{ws + WS_HID}; \
        pg8::gemm_phase<pg8::EpiSwigluF8, MoeOrder, true, true, true>(lds, g, S, E, wave); }
    PH_T0(6);
    if (IN(6)) { P6BODY if (PROBE_PHASE == 6) P6BODY }
    PH_T1(6);
    SEAM(6);
#define P7BODY { cu64* ka = karg(); unsigned char* ws = KA_WS(ka); moe_tables((gu32*)(ws + WS_CTL) + CW_CNT, TB, CN, wave * 64 + fresh_lane()); pg8::Gemm g{(const bf16*)(ws + WS_HID), (const bf16*)(ws + WS_WD), NSLOT_MAX, 1024, DEXP}; \
        MoeOrder S{TB, CN, (const int*)(ws + WS_STOK), G, bx, false}; pg8::EpiStoreF8 E{ws + WS_Y}; \
        pg8::gemm_phase<pg8::EpiStoreF8, MoeOrder, true, true, true>(lds, g, S, E, wave); }
    PH_T0(7);
    if (IN(7)) { P7BODY if (PROBE_PHASE == 7) P7BODY }
    PH_T1(7);
    SEAM(7);
    PH_T0(8);
    if (IN(8)) { cu64* ka = karg(); unsigned char* ws = KA_WS(ka); int* rt_e = (int*)(ws + WS_RT);
        moe_tables((gu32*)(ws + WS_CTL) + CW_CNT, TB, CN, wave * 64 + fresh_lane());
        p8_final((const bf16*)(ws + WS_X1), KA_OUT(ka), (const bf16*)(ws + WS_Y), (const float*)(ws + WS_MOD), KA_IN(ka, 21), rt_e, rt_e + 2 * T, (const float*)(rt_e + 4 * T), TB, vcu, G, wave, fresh_lane());
    }
    PH_T1(8);
    if (PROF_ID != 0) { const unsigned long long t0_ = __builtin_amdgcn_s_memrealtime(); while (__builtin_amdgcn_s_memrealtime() - t0_ < prof_acc) __builtin_amdgcn_s_sleep(8); }
#undef IN
#undef SEAM
}

#ifndef MK_N_LAUNCHES
#define MK_N_LAUNCHES 1
#endif
extern "C" void kernel_launch(void* const* d_in, const int* in_sizes, int n_in, void* d_out, int out_size, void* d_ws, size_t ws_size, hipStream_t stream) {
    static int grid = 0;
    if (grid == 0) {
        if (n_in != 22 || in_sizes[0] != T * D || out_size != T * D || ws_size < WS_END) { fprintf(stderr, "kernel_launch: shape/workspace mismatch (n_in %d, in0 %d, out %d, ws %zu, need %zu)\n", n_in, n_in > 0 ? in_sizes[0] : -1, out_size, ws_size, (size_t)WS_END); grid = -1; return; }
        int dev = 0, cus = 0, per_cu = 0;
        if (hipGetDevice(&dev) != hipSuccess || hipDeviceGetAttribute(&cus, hipDeviceAttributeMultiprocessorCount, dev) != hipSuccess) { grid = -1; return; }
        if (hipFuncSetAttribute((const void*)fwd_kernel, hipFuncAttributeMaxDynamicSharedMemorySize, LDS_BYTES) != hipSuccess) { fprintf(stderr, "kernel_launch: hipFuncSetAttribute failed\n"); grid = -1; return; }
        if (hipOccupancyMaxActiveBlocksPerMultiprocessor(&per_cu, (const void*)fwd_kernel, NWAVES * 64, LDS_BYTES) != hipSuccess || per_cu < 1) fprintf(stderr, "kernel_launch: occupancy query reports %d\n", per_cu);
        (void)hipGetLastError();
        grid = cus > 0 ? cus : 256;
    }
    if (grid < 0) return;
    (void)hipMemsetAsync((char*)d_ws + WS_CTL, 0, CTL_ZERO_BYTES, stream);
    Args a{};
    for (int i = 0; i < 22; ++i) a.in[i] = (const float*)d_in[i];
    a.out = (float*)d_out; a.ws = (unsigned char*)d_ws;
    if (MK_N_LAUNCHES == 1) { a.ph_lo = 0; a.ph_hi = NPH; hipLaunchKernelGGL(fwd_kernel, dim3(grid), dim3(NWAVES * 64), LDS_BYTES, stream, a); }
    else for (int p = 0; p < NPH; ++p) { a.ph_lo = p; a.ph_hi = p + 1; hipLaunchKernelGGL(fwd_kernel, dim3(grid), dim3(NWAVES * 64), LDS_BYTES, stream, a); }
    const hipError_t le = hipPeekAtLastError();
    if (le != hipSuccess) fprintf(stderr, "kernel_launch: launch failed: %s\n", hipGetErrorName(le));
}
```
